# Optimizing an MI355X kernel written in HIP

```python
import math
import jax
import jax.numpy as jnp
from jax import lax
import numpy as np

D_MODEL = 1024
BATCH = 16
SEQ = 2048
DEPTH = 2

GRID_W = 64
CTX_LEN = 256
HEAD_DIM = 64
D_MIX = D_MODEL
RWKV_WIDTH = D_MIX // 4
RWKV_HEADS = RWKV_WIDTH // HEAD_DIM
RWKV_LORA_W = 64
RWKV_LORA_A = 64
RWKV_LORA_G = 128
RWKV_IN = 3 * RWKV_WIDTH + RWKV_LORA_W + RWKV_LORA_A + RWKV_LORA_G
RWKV_SPLITS = (RWKV_WIDTH, 2 * RWKV_WIDTH, 3 * RWKV_WIDTH, 3 * RWKV_WIDTH + RWKV_LORA_W, 3 * RWKV_WIDTH + RWKV_LORA_W + RWKV_LORA_A)
CONV_W = 3
GN_EPS = 64e-5
S5_WIDTH = D_MIX // 4
S5_CH = 16
S5_GROUPS = S5_WIDTH // S5_CH
S5_STATE = 64
ATT_WIDTH = D_MIX - RWKV_WIDTH - S5_WIDTH
ATT_HEADS = ATT_WIDTH // HEAD_DIM
ATT_KV_HEADS = 2
ATT_GQ = ATT_HEADS // ATT_KV_HEADS
WINDOW = 128
ATT_BLOCK = 128
ROPE_BASE = 10000.0
IN_SPLITS = (RWKV_IN, RWKV_IN + S5_WIDTH, RWKV_IN + S5_WIDTH + ATT_WIDTH, RWKV_IN + S5_WIDTH + ATT_WIDTH + ATT_KV_HEADS * HEAD_DIM)
D_IN = IN_SPLITS[-1] + ATT_KV_HEADS * HEAD_DIM
N_GROUPS = 4
EXPERTS_PER_GROUP = 8
N_EXPERTS = N_GROUPS * EXPERTS_PER_GROUP
TOP_K_EXPERT = 2
D_EXPERT = 512
MOE_BLOCK = 128
N_MOD = 6
DEEPNORM_ALPHA = (2.0 * DEPTH) ** 0.25
DEEPNORM_BETA = (8.0 * DEPTH) ** -0.25
LN_EPS = 1e-5
F32 = jnp.float32

kernel_name = 'hybrid_rwkv7_s5_swa_hmoe_dit_block'


def layer_norm(x, g, b):
    xf = x.astype(F32)
    mu = jnp.mean(xf, axis=-1, keepdims=True)
    var = jnp.mean(jnp.square(xf - mu), axis=-1, keepdims=True)
    return ((xf - mu) * lax.rsqrt(var + LN_EPS) * g + b).astype(x.dtype)


def centred_conv(u, w):
    half = CONV_W // 2
    L = u.shape[1]
    up = jnp.pad(u, ((0, 0), (half, half), (0, 0)))
    return sum(up[:, j:j + L] * w[j] for j in range(CONV_W))


def rwkv_features(p, conv_w, w0, w2, a0, a2, k_k, k_a):
    p = centred_conv(p, conv_w)
    r, k, v, w_lo, a_lo, g_lo = jnp.split(p, RWKV_SPLITS, axis=-1)
    B, L = r.shape[:2]
    heads = lambda t: t.reshape(B, L, RWKV_HEADS, HEAD_DIM)
    kk = heads(k * k_k).astype(F32)
    kk = kk * lax.rsqrt(jnp.sum(kk * kk, axis=-1, keepdims=True) + 1e-12)
    dirs = []
    for d in range(2):
        w_log = -jax.nn.softplus(-(w0[d] + jnp.tanh(w_lo) @ w2[d])) - 0.5
        decay = jnp.exp(-jnp.exp(w_log))
        a = jax.nn.sigmoid(a0[d] + a_lo @ a2[d])
        k_d = k * (1.0 + (a - 1.0) * k_a)
        dirs.append((heads(decay), heads(k_d), heads(a)))
    return heads(r), heads(v), kk, g_lo, dirs


def rwkv_scan(r, decay, k, v, kk, kk_a, s0, reverse, emit):
    xs = tuple(jnp.moveaxis(t.astype(F32), 1, 0) for t in (r, decay, k, v, kk, kk_a))

    def step(s, inp):
        r_t, w_t, k_t, v_t, kk_t, b_t = inp
        s_kk = jnp.einsum('bhvk,bhk->bhv', s, kk_t)
        s = s * w_t[:, :, None, :] - s_kk[..., None] * b_t[:, :, None, :] + v_t[..., None] * k_t[:, :, None, :]
        return s, (jnp.einsum('bhvk,bhk->bhv', s, r_t) if emit else None)

    s_final, ys = lax.scan(step, s0, xs, reverse=reverse)
    return s_final, (jnp.moveaxis(ys, 0, 1) if emit else None)


def rwkv_output(y, feats, g2, r_k, gn_w, gn_b):
    r, v, kk, g_lo, dirs = feats
    B, L = y.shape[:2]
    mu = jnp.mean(y, axis=-1, keepdims=True)
    var = jnp.mean(jnp.square(y - mu), axis=-1, keepdims=True)
    yn = ((y - mu) * lax.rsqrt(var + GN_EPS)).reshape(B, L, RWKV_WIDTH) * gn_w + gn_b
    k_sum = dirs[0][1] + dirs[1][1]
    bonus = jnp.sum(r * k_sum * r_k, axis=-1, keepdims=True) * v
    gate = jax.nn.sigmoid(g_lo) @ g2
    return (yn.astype(v.dtype) + bonus.reshape(B, L, RWKV_WIDTH)) * gate


def rwkv_mixer(p_ctx, p_lat, emit_ctx, conv_w, w0, w2, a0, a2, g2, k_k, k_a, r_k, gn_w, gn_b):
    fc = rwkv_features(p_ctx, conv_w, w0, w2, a0, a2, k_k, k_a)
    fl = rwkv_features(p_lat, conv_w, w0, w2, a0, a2, k_k, k_a)
    B = p_lat.shape[0]
    s0 = jnp.zeros((B, RWKV_HEADS, HEAD_DIM, HEAD_DIM), F32)
    y_lat, y_ctx = [], []
    for d, rev in enumerate((False, True)):
        rc, vc, kkc, _, dc = fc
        rl, vl, kkl, _, dl = fl
        s_ctx, yc = rwkv_scan(rc, dc[d][0], dc[d][1], vc, kkc, kkc * dc[d][2], s0, rev, emit_ctx)
        _, yl = rwkv_scan(rl, dl[d][0], dl[d][1], vl, kkl, kkl * dl[d][2], s_ctx, rev, True)
        y_lat.append(yl)
        y_ctx.append(yc)
    out_lat = rwkv_output(y_lat[0] + y_lat[1], fl, g2, r_k, gn_w, gn_b)
    out_ctx = rwkv_output(y_ctx[0] + y_ctx[1], fc, g2, r_k, gn_w, gn_b) if emit_ctx else None
    return out_lat, out_ctx


def s5_discretise(lam_re, lam_im, log_dt):
    dt = jnp.exp(log_dt)[:, None]
    mag = jnp.exp(lam_re * dt)
    ab_re = mag * jnp.cos(lam_im * dt)
    ab_im = mag * jnp.sin(lam_im * dt)
    nr, ni = ab_re - 1.0, ab_im
    den = lam_re * lam_re + lam_im * lam_im
    coef_re = (nr * lam_re + ni * lam_im) / den
    coef_im = (ni * lam_re - nr * lam_im) / den
    return ab_re, ab_im, coef_re, coef_im


def s5_scan(u, ab_re, ab_im, coef_re, coef_im, b_re, b_im, h0_re, h0_im):
    b_re, b_im = b_re.astype(F32), b_im.astype(F32)
    bb_re = coef_re[..., None] * b_re - coef_im[..., None] * b_im
    bb_im = coef_re[..., None] * b_im + coef_im[..., None] * b_re
    bu_re = jnp.einsum('gpc,blgc->blgp', bb_re, u)
    bu_im = jnp.einsum('gpc,blgc->blgp', bb_im, u)
    bu_re = bu_re.at[:, 0].add(ab_re * h0_re - ab_im * h0_im)
    bu_im = bu_im.at[:, 0].add(ab_re * h0_im + ab_im * h0_re)
    L = u.shape[1]
    a_re = jnp.broadcast_to(ab_re, (1, L) + ab_re.shape)
    a_im = jnp.broadcast_to(ab_im, (1, L) + ab_im.shape)

    def combine(e1, e2):
        a1r, a1i, b1r, b1i = e1
        a2r, a2i, b2r, b2i = e2
        return (a2r * a1r - a2i * a1i, a2r * a1i + a2i * a1r,
                a2r * b1r - a2i * b1i + b2r, a2r * b1i + a2i * b1r + b2i)

    _, _, h_re, h_im = lax.associative_scan(combine, (a_re, a_im, bu_re, bu_im), axis=1)
    return h_re, h_im


def s5_readout(h_re, h_im, c_re, c_im):
    y = jnp.einsum('gcp,blgp->blgc', c_re.astype(F32), h_re) - jnp.einsum('gcp,blgp->blgc', c_im.astype(F32), h_im)
    return y.reshape(y.shape[0], y.shape[1], S5_WIDTH)


def s5_glu(y, glu_w, glu_b):
    z = jax.nn.gelu(y)
    return z * jax.nn.sigmoid(z @ glu_w + glu_b)


def s5_mixer(u_ctx, u_lat, emit_ctx, lam_re, lam_im, log_dt, b_re, b_im, c_re, c_im, d_skip, glu_w, glu_b):
    B, C = u_ctx.shape[:2]
    L = u_lat.shape[1]
    uc = u_ctx.astype(F32).reshape(B, C, S5_GROUPS, S5_CH)
    ul = u_lat.astype(F32).reshape(B, L, S5_GROUPS, S5_CH)
    h0 = jnp.zeros((B, S5_GROUPS, S5_STATE), F32)
    y_lat = d_skip * u_lat.astype(F32)
    y_ctx = d_skip * u_ctx.astype(F32) if emit_ctx else None
    for d in range(2):
        order = (lambda t: jnp.flip(t, axis=1)) if d == 1 else (lambda t: t)
        disc = s5_discretise(lam_re[d].astype(F32), lam_im[d].astype(F32), log_dt[d].astype(F32))
        hc_re, hc_im = s5_scan(order(uc), *disc, b_re, b_im, h0, h0)
        hl_re, hl_im = s5_scan(order(ul), *disc, b_re, b_im, hc_re[:, -1], hc_im[:, -1])
        y_lat = y_lat + order(s5_readout(hl_re, hl_im, c_re, c_im))
        if emit_ctx:
            y_ctx = y_ctx + order(s5_readout(hc_re, hc_im, c_re, c_im))
    out_lat = s5_glu(y_lat, glu_w, glu_b).astype(u_lat.dtype)
    out_ctx = s5_glu(y_ctx, glu_w, glu_b).astype(u_ctx.dtype) if emit_ctx else None
    return out_lat, out_ctx


def axial_rope_tables(L):
    rows = L // GRID_W
    row_id, col_id = jnp.meshgrid(jnp.arange(rows, dtype=F32), jnp.arange(GRID_W, dtype=F32), indexing='ij')
    n_freq = HEAD_DIM // 4
    inv_freq = ROPE_BASE ** (-jnp.arange(n_freq, dtype=F32) / n_freq)
    ang = jnp.concatenate([row_id.reshape(-1, 1) * inv_freq, col_id.reshape(-1, 1) * inv_freq], axis=-1)
    return jnp.cos(ang), jnp.sin(ang)


def apply_rope(t, cos, sin):
    extra = t.ndim - 3
    cos = cos.reshape(cos.shape[:1] + (1,) * extra + cos.shape[1:])
    sin = sin.reshape(sin.shape[:1] + (1,) * extra + sin.shape[1:])
    t1, t2 = jnp.split(t, 2, axis=-1)
    return jnp.concatenate([t1 * cos - t2 * sin, t2 * cos + t1 * sin], axis=-1).astype(t.dtype)


def softmax_with_sink(scores, sink):
    s_sink = jnp.broadcast_to(sink[None, :, :, None, None], scores.shape[:-1] + (1,))
    p = jax.nn.softmax(jnp.concatenate([scores, s_sink], axis=-1), axis=-1)
    return p[..., :-1]


def attention_mixer(q_ctx, k_ctx, v_ctx, q_lat, k_lat, v_lat, sink, emit_ctx):
    B, L, _ = q_lat.shape
    C = k_ctx.shape[1]
    nb = L // ATT_BLOCK
    scale = HEAD_DIM ** -0.5
    cos, sin = axial_rope_tables(L)
    q = apply_rope(q_lat.reshape(B, L, ATT_KV_HEADS, ATT_GQ, HEAD_DIM), cos, sin)
    k = apply_rope(k_lat.reshape(B, L, ATT_KV_HEADS, HEAD_DIM), cos, sin)
    v = v_lat.reshape(B, L, ATT_KV_HEADS, HEAD_DIM)
    kc = k_ctx.reshape(B, C, ATT_KV_HEADS, HEAD_DIM)
    vc = v_ctx.reshape(B, C, ATT_KV_HEADS, HEAD_DIM)
    sink = sink.reshape(ATT_KV_HEADS, ATT_GQ).astype(F32)

    def neighbours(t):
        tp = jnp.pad(t, ((0, 0), (ATT_BLOCK, ATT_BLOCK), (0, 0), (0, 0)))
        tp = tp.reshape(B, nb + 2, ATT_BLOCK, ATT_KV_HEADS, HEAD_DIM)
        return jnp.moveaxis(jnp.concatenate([tp[:, :-2], tp[:, 1:-1], tp[:, 2:]], axis=2), 1, 0)

    qb = jnp.moveaxis(q.reshape(B, nb, ATT_BLOCK, ATT_KV_HEADS, ATT_GQ, HEAD_DIM), 1, 0)
    kb, vb = neighbours(k), neighbours(v)
    blk = jnp.arange(nb)[:, None, None] * ATT_BLOCK
    q_pos = blk + jnp.arange(ATT_BLOCK)[None, :, None]
    k_pos = blk - ATT_BLOCK + jnp.arange(3 * ATT_BLOCK)[None, None, :]
    band_mask = (jnp.abs(q_pos - k_pos) <= WINDOW) & (k_pos >= 0) & (k_pos < L)
    n_band = 3 * ATT_BLOCK

    def attend_block(inp):
        q_blk, k_blk, v_blk, m = inp
        s_lat = jnp.einsum('bqhgd,bkhd->bhgqk', q_blk, k_blk, preferred_element_type=F32) * scale
        s_lat = jnp.where(m, s_lat, -jnp.inf)
        s_ctx = jnp.einsum('bqhgd,bchd->bhgqc', q_blk, kc, preferred_element_type=F32) * scale
        p = softmax_with_sink(jnp.concatenate([s_lat, s_ctx], axis=-1), sink)
        o = jnp.einsum('bhgqk,bkhd->bqhgd', p[..., :n_band].astype(v_blk.dtype), v_blk)
        return o + jnp.einsum('bhgqc,bchd->bqhgd', p[..., n_band:].astype(vc.dtype), vc)

    ob = lax.map(attend_block, (qb, kb, vb, band_mask))
    out_lat = jnp.moveaxis(ob, 0, 1).reshape(B, L, ATT_WIDTH).astype(q_lat.dtype)
    out_ctx = None
    if emit_ctx:
        qc = q_ctx.reshape(B, C, ATT_KV_HEADS, ATT_GQ, HEAD_DIM)
        s_cc = jnp.einsum('bqhgd,bchd->bhgqc', qc, kc, preferred_element_type=F32) * scale
        p_cc = softmax_with_sink(s_cc, sink)
        out_ctx = jnp.einsum('bhgqc,bchd->bqhgd', p_cc.astype(vc.dtype), vc).reshape(B, C, ATT_WIDTH).astype(q_ctx.dtype)
    return out_lat, out_ctx


def routed_experts(h, experts, weights, w_gate, w_up, w_down):
    T, D = h.shape
    A = T * TOP_K_EXPERT
    P = -(-A // MOE_BLOCK) * MOE_BLOCK + N_EXPERTS * MOE_BLOCK
    n_blk = P // MOE_BLOCK
    flat_e = experts.reshape(-1)
    flat_tok = jnp.repeat(jnp.arange(T, dtype=jnp.int32), TOP_K_EXPERT)
    flat_w = weights.reshape(-1)
    order = jnp.argsort(flat_e)
    se = flat_e[order]
    counts = jnp.zeros((N_EXPERTS,), jnp.int32).at[flat_e].add(1)
    start = jnp.cumsum(counts) - counts
    padded = (counts + MOE_BLOCK - 1) // MOE_BLOCK * MOE_BLOCK
    pend = jnp.cumsum(padded)
    pstart = pend - padded
    dest = pstart[se] + (jnp.arange(A, dtype=jnp.int32) - start[se])
    tok_buf = jnp.zeros((P,), jnp.int32).at[dest].set(flat_tok[order])
    w_buf = jnp.zeros((P,), F32).at[dest].set(flat_w[order])
    blk_exp = jnp.minimum(jnp.searchsorted(pend, jnp.arange(n_blk) * MOE_BLOCK, side='right'), N_EXPERTS - 1)
    xb = h[tok_buf].reshape(n_blk, MOE_BLOCK, D)

    def run_block(inp):
        x_blk, e = inp
        return (jax.nn.silu(x_blk @ w_gate[e]) * (x_blk @ w_up[e])) @ w_down[e]

    yb = lax.map(run_block, (xb, blk_exp)).reshape(P, D)
    return jnp.zeros_like(h).at[tok_buf].add(yb * w_buf[:, None].astype(h.dtype))


def hier_moe(h, rg_w, rg_b, re_w, re_b, w_gate, w_up, w_down):
    T = h.shape[0]
    g_logits = (h @ rg_w + rg_b).astype(F32)
    g_idx = jnp.argmax(g_logits, axis=-1)
    g_prob = jnp.take_along_axis(jax.nn.softmax(g_logits, axis=-1), g_idx[:, None], axis=-1)
    e_logits = (h @ re_w + re_b).astype(F32).reshape(T, N_GROUPS, EXPERTS_PER_GROUP)
    e_logits = jnp.take_along_axis(e_logits, g_idx[:, None, None], axis=1)[:, 0]
    top_logits, top_idx = lax.top_k(e_logits, TOP_K_EXPERT)
    weights = g_prob * jax.nn.softmax(top_logits, axis=-1)
    experts = g_idx[:, None] * EXPERTS_PER_GROUP + top_idx
    return routed_experts(h, experts, weights, w_gate, w_up, w_down)


def trunk_layer(x, xc, c, c_ctx, last, w_mod, b_mod, w_in, rwkv_conv, rwkv_w0, rwkv_w2, rwkv_a0, rwkv_a2, rwkv_g2,
                rwkv_k_k, rwkv_k_a, rwkv_r_k, rwkv_gn_w, rwkv_gn_b, s5_lam_re, s5_lam_im, s5_log_dt, s5_b_re, s5_b_im,
                s5_c_re, s5_c_im, s5_d, s5_glu_w, s5_glu_b, attn_sink, w_out, ln1_g, ln1_b, ln2_g, ln2_b,
                router_group_w, router_group_b, router_expert_w, router_expert_b, expert_w_gate, expert_w_up, expert_w_down):
    emit_ctx = not last
    B, L, D = x.shape
    mod = jax.nn.silu(c) @ w_mod + b_mod
    mod_c = jax.nn.silu(c_ctx) @ w_mod + b_mod
    sh1, sc1, gt1, sh2, sc2, gt2 = jnp.split(mod[:, None, :], N_MOD, axis=-1)
    csh1, csc1, cgt1, csh2, csc2, cgt2 = jnp.split(mod_c, N_MOD, axis=-1)

    proj = (x * (1.0 + sc1) + sh1) @ w_in
    proj_c = (xc * (1.0 + csc1) + csh1) @ w_in
    pr, ps, pq, pk, pv = jnp.split(proj, IN_SPLITS, axis=-1)
    cr, cs, cq, ck, cv = jnp.split(proj_c, IN_SPLITS, axis=-1)
    yr, yr_c = rwkv_mixer(cr, pr, emit_ctx, rwkv_conv, rwkv_w0, rwkv_w2, rwkv_a0, rwkv_a2, rwkv_g2,
                          rwkv_k_k, rwkv_k_a, rwkv_r_k, rwkv_gn_w, rwkv_gn_b)
    ys, ys_c = s5_mixer(cs, ps, emit_ctx, s5_lam_re, s5_lam_im, s5_log_dt, s5_b_re, s5_b_im, s5_c_re, s5_c_im,
                        s5_d, s5_glu_w, s5_glu_b)
    ya, ya_c = attention_mixer(cq, ck, cv, pq, pk, pv, attn_sink, emit_ctx)
    mix = jnp.concatenate([yr, ys, ya], axis=-1) @ w_out
    x = layer_norm(DEEPNORM_ALPHA * x + gt1 * mix, ln1_g, ln1_b)
    if emit_ctx:
        mix_c = jnp.concatenate([yr_c, ys_c, ya_c], axis=-1) @ w_out
        xc = layer_norm(DEEPNORM_ALPHA * xc + cgt1 * mix_c, ln1_g, ln1_b)

    moe_params = (router_group_w, router_group_b, router_expert_w, router_expert_b, expert_w_gate, expert_w_up, expert_w_down)
    h = x * (1.0 + sc2) + sh2
    if emit_ctx:
        hc = xc * (1.0 + csc2) + csh2
        y = hier_moe(jnp.concatenate([h.reshape(-1, D), hc.reshape(-1, D)], axis=0), *moe_params)
        y_lat = y[:B * L].reshape(B, L, D)
        y_ctx = y[B * L:].reshape(xc.shape)
        xc = layer_norm(DEEPNORM_ALPHA * xc + cgt2 * y_ctx, ln2_g, ln2_b)
    else:
        y_lat = hier_moe(h.reshape(-1, D), *moe_params).reshape(B, L, D)
        xc = None
    x = layer_norm(DEEPNORM_ALPHA * x + gt2 * y_lat, ln2_g, ln2_b)
    return x, xc


def setup_inputs(seed: int = 0) -> dict:
    key = jax.random.key(seed)
    ks = iter(jax.random.split(key, 48))
    nrm = lambda shape, s: s * jax.random.normal(next(ks), shape, F32)
    Dp, D = DEPTH, D_MODEL
    ratio = jnp.arange(RWKV_WIDTH, dtype=F32) / (RWKV_WIDTH - 1)
    n_idx = jnp.arange(S5_STATE, dtype=F32)
    side = jnp.array([0.25, 0.5, 0.25], F32)[:, None]
    return {
        'x': nrm((BATCH, SEQ, D), 1.0),
        'c': nrm((BATCH, D), 1.0),
        'ctx': nrm((BATCH, CTX_LEN, D), 1.0),
        'c_ctx': nrm((D,), 1.0),
        'w_mod': nrm((Dp, D, N_MOD * D), 0.5 * D ** -0.5),
        'b_mod': nrm((Dp, N_MOD * D), 0.01),
        'w_in': nrm((Dp, D, D_IN), D ** -0.5),
        'rwkv_conv': side + nrm((Dp, CONV_W, RWKV_IN), 0.05),
        'rwkv_w0': -6.0 + 5.0 * ratio ** 0.85 + nrm((Dp, 2, RWKV_WIDTH), 0.1),
        'rwkv_w2': nrm((Dp, 2, RWKV_LORA_W, RWKV_WIDTH), 0.1),
        'rwkv_a0': nrm((Dp, 2, RWKV_WIDTH), 0.1),
        'rwkv_a2': nrm((Dp, 2, RWKV_LORA_A, RWKV_WIDTH), 0.1),
        'rwkv_g2': nrm((Dp, RWKV_LORA_G, RWKV_WIDTH), RWKV_LORA_G ** -0.5),
        'rwkv_k_k': 0.85 + nrm((Dp, RWKV_WIDTH), 0.02),
        'rwkv_k_a': 1.0 + nrm((Dp, RWKV_WIDTH), 0.02),
        'rwkv_r_k': nrm((Dp, RWKV_HEADS, HEAD_DIM), 0.1),
        'rwkv_gn_w': 1.0 + nrm((Dp, RWKV_WIDTH), 0.02),
        'rwkv_gn_b': nrm((Dp, RWKV_WIDTH), 0.01),
        's5_lam_re': -0.5 + nrm((Dp, 2, S5_GROUPS, S5_STATE), 0.01),
        's5_lam_im': math.pi * n_idx + nrm((Dp, 2, S5_GROUPS, S5_STATE), 0.01),
        's5_log_dt': jax.random.uniform(next(ks), (Dp, 2, S5_GROUPS), F32, math.log(1e-3), math.log(1e-1)),
        's5_b_re': nrm((Dp, S5_GROUPS, S5_STATE, S5_CH), (2 * S5_CH) ** -0.5),
        's5_b_im': nrm((Dp, S5_GROUPS, S5_STATE, S5_CH), (2 * S5_CH) ** -0.5),
        's5_c_re': nrm((Dp, S5_GROUPS, S5_CH, S5_STATE), 0.5),
        's5_c_im': nrm((Dp, S5_GROUPS, S5_CH, S5_STATE), 0.5),
        's5_d': nrm((Dp, S5_WIDTH), 1.0),
        's5_glu_w': nrm((Dp, S5_WIDTH, S5_WIDTH), S5_WIDTH ** -0.5),
        's5_glu_b': nrm((Dp, S5_WIDTH), 0.01),
        'attn_sink': nrm((Dp, ATT_HEADS), 0.5),
        'w_out': nrm((Dp, D_MIX, D), DEEPNORM_BETA * D_MIX ** -0.5),
        'ln1_g': 1.0 + nrm((Dp, D), 0.05),
        'ln1_b': nrm((Dp, D), 0.01),
        'ln2_g': 1.0 + nrm((Dp, D), 0.05),
        'ln2_b': nrm((Dp, D), 0.01),
        'router_group_w': nrm((Dp, D, N_GROUPS), D ** -0.5),
        'router_group_b': nrm((Dp, N_GROUPS), 0.01),
        'router_expert_w': nrm((Dp, D, N_EXPERTS), D ** -0.5),
        'router_expert_b': nrm((Dp, N_EXPERTS), 0.01),
        'expert_w_gate': nrm((Dp, N_EXPERTS, D, D_EXPERT), D ** -0.5),
        'expert_w_up': nrm((Dp, N_EXPERTS, D, D_EXPERT), D ** -0.5),
        'expert_w_down': nrm((Dp, N_EXPERTS, D_EXPERT, D), DEEPNORM_BETA * D_EXPERT ** -0.5),
    }


def reference(x, c, ctx, c_ctx, w_mod, b_mod, w_in, rwkv_conv, rwkv_w0, rwkv_w2, rwkv_a0, rwkv_a2, rwkv_g2,
              rwkv_k_k, rwkv_k_a, rwkv_r_k, rwkv_gn_w, rwkv_gn_b, s5_lam_re, s5_lam_im, s5_log_dt, s5_b_re, s5_b_im,
              s5_c_re, s5_c_im, s5_d, s5_glu_w, s5_glu_b, attn_sink, w_out, ln1_g, ln1_b, ln2_g, ln2_b,
              router_group_w, router_group_b, router_expert_w, router_expert_b, expert_w_gate, expert_w_up, expert_w_down):
    stacked = (w_mod, b_mod, w_in, rwkv_conv, rwkv_w0, rwkv_w2, rwkv_a0, rwkv_a2, rwkv_g2, rwkv_k_k, rwkv_k_a,
               rwkv_r_k, rwkv_gn_w, rwkv_gn_b, s5_lam_re, s5_lam_im, s5_log_dt, s5_b_re, s5_b_im, s5_c_re, s5_c_im,
               s5_d, s5_glu_w, s5_glu_b, attn_sink, w_out, ln1_g, ln1_b, ln2_g, ln2_b, router_group_w,
               router_group_b, router_expert_w, router_expert_b, expert_w_gate, expert_w_up, expert_w_down)
    xc = ctx
    for i in range(DEPTH):
        layer_params = [p[i] for p in stacked]
        x, xc = trunk_layer(x, xc, c, c_ctx, i == DEPTH - 1, *layer_params)
    return x
```

```cpp
#include <hip/hip_runtime.h>
#include <hip/hip_cooperative_groups.h>
#include <cstdio>
#include <cstdint>
namespace cg = cooperative_groups;

#ifndef MK_MULTI
#define MK_MULTI 0
#endif

#define DEVI __device__ __forceinline__
typedef unsigned short bf16_t;
typedef short bf16x8 __attribute__((ext_vector_type(8)));
typedef float f32x4 __attribute__((ext_vector_type(4)));
typedef float f32x16 __attribute__((ext_vector_type(16)));

constexpr int D = 1024, NB = 16, SEQ = 2048, CTXL = 256;
constexpr int NLAT = NB * SEQ;
constexpr int NCTX = NB * CTXL;
constexpr int NT = NLAT + NCTX;
constexpr int DIN = 2048;
constexpr int NTHREADS = 512;
constexpr float ALPHA = 1.41421356237309515f;
constexpr float LN_EPS = 1e-5f, GN_EPS = 64e-5f;
constexpr int NCH = NT / 32;
constexpr int SLOT_CAP = 81920;

enum { I_X = 0, I_C, I_CTX, I_CCTX, I_WMOD, I_BMOD, I_WIN, I_CONV, I_W0, I_W2, I_A0, I_A2, I_G2, I_KK, I_KA, I_RK, I_GNW, I_GNB,
       I_LRE, I_LIM, I_LDT, I_BRE, I_BIM, I_CRE, I_CIM, I_SD, I_GLUW, I_GLUB, I_SINK, I_WOUT, I_LN1G, I_LN1B, I_LN2G, I_LN2B,
       I_RGW, I_RGB, I_REW, I_REB, I_EWG, I_EWU, I_EWD, N_IN };

constexpr size_t MiB = 1048576;
constexpr size_t WS_CTL = 0;
constexpr size_t WS_BAR = 512 * 1024;
constexpr size_t WS_MOD = 1 * MiB;
constexpr size_t WS_ROPE = 2 * MiB;
constexpr size_t WS_WIN_T = 4 * MiB;
constexpr size_t WS_WOUT_T = 12 * MiB;
constexpr size_t WS_FW = 16 * MiB;
constexpr size_t WS_GLU_T = 18 * MiB;
constexpr size_t WS_RW = 19 * MiB;
constexpr size_t WS_KTAB = 20 * MiB;
constexpr size_t WS_TTG = 22 * MiB;
constexpr size_t WS_EM = 46 * MiB;
constexpr size_t WS_HC = 54 * MiB;
constexpr size_t WS_LIST = 63 * MiB;
constexpr size_t WS_ROUTE = 68 * MiB;
constexpr size_t WS_RWT = 69 * MiB;
constexpr size_t WS_APOW = 70 * MiB;
constexpr size_t WS_BBT = 71 * MiB + 512 * 1024;
constexpr size_t WS_X = 72 * MiB;
constexpr size_t WS_R = 216 * MiB;
constexpr size_t WS_PROJ = WS_R;
constexpr size_t WS_FEAT = WS_R + 144 * MiB;
constexpr size_t WS_YMIX = WS_R + 234 * MiB;
constexpr size_t WS_MIX = WS_R + 144 * MiB;
constexpr size_t WS_EW = WS_R;
constexpr size_t WS_H = WS_R + 234 * MiB;
constexpr size_t WS_ACT = WS_R + 96 * MiB;
constexpr size_t WS_YROWS = WS_R + 176 * MiB;
constexpr size_t WS_UDH = WS_R + 336 * MiB;
constexpr size_t WS_END = WS_UDH + 28 * MiB;
constexpr size_t DO_XMOD = 0;
constexpr size_t DO_YF = 0;
constexpr size_t DO_YB = 36 * MiB;
constexpr size_t DO_HE = 72 * MiB;
constexpr size_t DO_ZB = 90 * MiB;

struct Params {
  const float* in[N_IN];
  float* out;
  unsigned char* ws;
  int ph_lo, ph_hi;
};


DEVI unsigned long long rfl64(unsigned long long v) { const unsigned lo = __builtin_amdgcn_readfirstlane((unsigned)v), hi = __builtin_amdgcn_readfirstlane((unsigned)(v >> 32)); return ((unsigned long long)hi << 32) | lo; }
DEVI unsigned char* uws(const Params& p) { return (unsigned char*)rfl64((unsigned long long)p.ws); }
DEVI float* uout(const Params& p) { return (float*)rfl64((unsigned long long)p.out); }
DEVI const float* uin(const Params& p, int i) { return (const float*)rfl64((unsigned long long)p.in[i]); }

DEVI float bf2f(bf16_t v) { return __uint_as_float(((unsigned)v) << 16); }
typedef __bf16 hwbf2 __attribute__((ext_vector_type(2)));
typedef float hwf2 __attribute__((ext_vector_type(2)));
DEVI bf16_t f2bf(float f) { return __builtin_bit_cast(unsigned short, (__bf16)f); }
DEVI unsigned pack2(float a, float b) { const hwf2 v = {a, b}; return __builtin_bit_cast(unsigned, __builtin_convertvector(v, hwbf2)); }
DEVI float lo_bf(unsigned u) { return __uint_as_float(u << 16); }
DEVI float hi_bf(unsigned u) { return __uint_as_float(u & 0xFFFF0000u); }
DEVI unsigned short f2h(float f) { _Float16 h = (_Float16)f; return __builtin_bit_cast(unsigned short, h); }
DEVI float h2f(unsigned short u) { return (float)__builtin_bit_cast(_Float16, u); }
DEVI float sigmoidf(float x) { return __builtin_amdgcn_rcpf(1.f + __expf(-x)); }
DEVI float gelu_tanh(float x) { const float u = 0.7978845608028654f * (x + 0.044715f * x * x * x); return x - x * __builtin_amdgcn_rcpf(1.f + __expf(2.f * u)); }

template <int CTRL> DEVI float dpp_f(float x) { return __int_as_float(__builtin_amdgcn_update_dpp(0, __float_as_int(x), CTRL, 0xF, 0xF, false)); }
DEVI float row_sum16(float x) {
  x += dpp_f<0xB1>(x);
  x += dpp_f<0x4E>(x);
  x += dpp_f<0x141>(x);
  x += dpp_f<0x140>(x);
  return x;
}
DEVI float wave_sum(float x) { x = row_sum16(x); x += __shfl_xor(x, 16); x += __shfl_xor(x, 32); return x; }

DEVI int tid_() { int t = threadIdx.x; asm volatile("" : "+v"(t)); return t; }
DEVI int bid_() { int b = blockIdx.x; asm volatile("" : "+s"(b)); return b; }
DEVI void ld8f(const float* p, float (&o)[8]) { const float4 a = *(const float4*)p, b = *(const float4*)(p + 4); o[0] = a.x; o[1] = a.y; o[2] = a.z; o[3] = a.w; o[4] = b.x; o[5] = b.y; o[6] = b.z; o[7] = b.w; }
DEVI void ld8b(const bf16_t* p, float (&o)[8]) { const uint4 u = *(const uint4*)p; o[0] = lo_bf(u.x); o[1] = hi_bf(u.x); o[2] = lo_bf(u.y); o[3] = hi_bf(u.y); o[4] = lo_bf(u.z); o[5] = hi_bf(u.z); o[6] = lo_bf(u.w); o[7] = hi_bf(u.w); }
DEVI void st8f(float* p, const float (&v)[8]) { *(float4*)p = make_float4(v[0], v[1], v[2], v[3]); *(float4*)(p + 4) = make_float4(v[4], v[5], v[6], v[7]); }
DEVI void st8b(bf16_t* p, const float (&v)[8]) { *(uint4*)p = make_uint4(pack2(v[0], v[1]), pack2(v[2], v[3]), pack2(v[4], v[5]), pack2(v[6], v[7])); }
typedef _Float16 hx8 __attribute__((ext_vector_type(8)));
DEVI void ld8h(const _Float16* p, float (&o)[8]) { const hx8 u = *(const hx8*)p;
#pragma unroll
  for (int e = 0; e < 8; ++e) o[e] = (float)u[e]; }
DEVI void st8h(_Float16* p, const float (&v)[8]) { hx8 u;
#pragma unroll
  for (int e = 0; e < 8; ++e) u[e] = (_Float16)v[e];
  *(hx8*)p = u; }

DEVI int bidx_of(int R) { return R < NLAT ? (R >> 11) : 16; }
DEVI const float* xin_row(const Params& p, int R) { return R < NLAT ? uin(p, I_X) + (size_t)R * D : uin(p, I_CTX) + (size_t)(R - NLAT) * D; }

constexpr int LDT = 40;
constexpr int SMEM_BYTES = 143360;
constexpr int DSM_BYTES = SMEM_BYTES + 1024;
constexpr int MISC_PARAMS = 0, MISC_PRE = 384, MISC_CNT = 528, MISC_BLKE = 656, MISC_XB = 1008;
template <class AL, class BL, class EP>
DEVI void gemm_tile(unsigned char* smem, int kbeg, int kend, AL&& aload, BL&& bload, EP&& epi) {
  const int tid = tid_(), lane = tid & 63, wid = tid >> 6;
  const int wr = wid >> 1, wc = wid & 1, fr = lane & 15, fq = lane >> 4;
  bf16_t* sA = (bf16_t*)smem;
  bf16_t* sB = (bf16_t*)(smem + 2 * 256 * LDT * 2);
  const int lrow = tid >> 2, kq = (tid & 3) * 8;
  f32x4 acc[4][4];
#pragma unroll
  for (int m = 0; m < 4; ++m)
#pragma unroll
    for (int n = 0; n < 4; ++n) acc[m][n] = (f32x4){0.f, 0.f, 0.f, 0.f};
  uint4 ra0 = aload(0, kbeg + kq), ra1 = aload(1, kbeg + kq), rb = bload(kbeg + kq);
  int buf = 0;
#pragma unroll 1
  for (int k = kbeg; k < kend; k += 32) {
    *(uint4*)(sA + (buf * 256 + lrow) * LDT + kq) = ra0;
    *(uint4*)(sA + (buf * 256 + lrow + 128) * LDT + kq) = ra1;
    *(uint4*)(sB + (buf * 128 + lrow) * LDT + kq) = rb;
    __syncthreads();
    if (k + 32 < kend) { ra0 = aload(0, k + 32 + kq); ra1 = aload(1, k + 32 + kq); rb = bload(k + 32 + kq); }
    bf16x8 bfr[4];
#pragma unroll
    for (int n = 0; n < 4; ++n) bfr[n] = *(const bf16x8*)(sB + (buf * 128 + wc * 64 + n * 16 + fr) * LDT + fq * 8);
#pragma unroll
    for (int m = 0; m < 4; ++m) {
      const bf16x8 af = *(const bf16x8*)(sA + (buf * 256 + wr * 64 + m * 16 + fr) * LDT + fq * 8);
#pragma unroll
      for (int n = 0; n < 4; ++n) acc[m][n] = __builtin_amdgcn_mfma_f32_16x16x32_bf16(bfr[n], af, acc[m][n], 0, 0, 0);
    }
    buf ^= 1;
  }
  __syncthreads();
  epi(acc, wr, wc, fr, fq);
}


namespace g8 {
#define G8_LAS __attribute__((address_space(3)))
constexpr int BM = 256, BK = 64, HALF = 128, HTB = HALF * BK * 2;
DEVI int lds_byte(int r, int c) { const int st = (r >> 4) * 2 + (c >> 5), rr = r & 15, cc = c & 31, ob = rr * 64 + cc * 2; return st * 1024 + (ob ^ (((ob >> 9) & 1) << 5)); }
DEVI void stage_rc(int b, int& R, int& C) { const int st = b / 1024, sb = b % 1024, swz = sb ^ (((sb >> 9) & 1) << 5); R = (st >> 1) * 16 + swz / 64; C = (st & 1) * 32 + (swz % 64) / 2; }
DEVI int perm32(int rho) { const int n = rho >> 4, i = rho & 15; return 8 * (i >> 2) + 4 * n + (i & 3); }
struct Unit { int pm, pn, e; };
DEVI int xcd_remap(int L, int n) { const int q = n >> 3, r = n & 7, x = L & 7, off = L >> 3; return (x < r ? x * (q + 1) : r * (q + 1) + (x - r) * q) + off; }

template <class Epi, class Sched>
DEVI void gemm(G8_LAS unsigned char* lds, const int Kin, const Sched& S, const Epi& E) {
  int K = Kin; asm volatile("" : "+s"(K));
  const int tid = tid_(), wid = __builtin_amdgcn_readfirstlane(tid >> 6), lane = tid & 63, wr = wid >> 2, wc = wid & 3, fr = lane & 15, fq = lane >> 4;
  const int nt = K / BK;
  unsigned voffB[2];
#pragma unroll
  for (int i = 0; i < 2; ++i) { int R, C; stage_rc(tid * 16 + i * 8192, R, C); const int Rb = Epi::PERM ? ((R & ~31) + perm32(R & 31)) : R; voffB[i] = (unsigned)(Rb * K + C) * 2u; }
  const size_t kstep = (size_t)(BK * 2);
  const size_t hstepB = (size_t)HALF * K * 2;
  const unsigned ldsw = (unsigned)wid * 1024u;
  const int aoff = lds_byte(wr * 64 + fr, fq * 8), boff = lds_byte(wc * 32 + fr, fq * 8);
#define G8_SA(b, h) (((b) * 2 + (h)) * HTB)
#define G8_SB(b, h) ((4 + (b) * 2 + (h)) * HTB)
#define G8_STAGE_B(bufoff, gbase) do { _Pragma("unroll") for (int _i = 0; _i < 2; ++_i) \
    __builtin_amdgcn_global_load_lds((const unsigned*)((const char*)(gbase) + voffB[_i]), (G8_LAS unsigned*)(lds + (bufoff) + ldsw + _i * 8192), 16, 0, 0); } while (0)
#define G8_STAGE_A(bufoff, ubase, o0, o1) do { \
    __builtin_amdgcn_global_load_lds((const unsigned*)((ubase) + (o0)), (G8_LAS unsigned*)(lds + (bufoff) + ldsw), 16, 0, 0); \
    __builtin_amdgcn_global_load_lds((const unsigned*)((ubase) + (o1)), (G8_LAS unsigned*)(lds + (bufoff) + ldsw + 8192), 16, 0, 0); } while (0)
#define G8_LDA(dst, b, h) do { _Pragma("unroll") for (int m = 0; m < 4; ++m) _Pragma("unroll") for (int k = 0; k < 2; ++k) dst[m][k] = *(const G8_LAS bf16x8*)(lds + G8_SA(b, h) + aoff + m * 2048 + k * 1024); } while (0)
#define G8_LDB(dst, b, h) do { _Pragma("unroll") for (int n = 0; n < 2; ++n) _Pragma("unroll") for (int k = 0; k < 2; ++k) dst[n][k] = *(const G8_LAS bf16x8*)(lds + G8_SB(b, h) + boff + n * 2048 + k * 1024); } while (0)
#define G8_MMA(ai, bj, At, Bt) do { __builtin_amdgcn_s_setprio(1); _Pragma("unroll") for (int m = 0; m < 4; ++m) _Pragma("unroll") for (int n = 0; n < 2; ++n) _Pragma("unroll") for (int k = 0; k < 2; ++k) \
    acc[ai][bj][m][n] = __builtin_amdgcn_mfma_f32_16x16x32_bf16(Bt[n][k], At[m][k], acc[ai][bj][m][n], 0, 0, 0); __builtin_amdgcn_s_setprio(0); } while (0)
#define G8_WAIT_V(n) asm volatile("s_waitcnt vmcnt(" #n ")" ::: "memory")
#define G8_WAIT_L(n) asm volatile("s_waitcnt lgkmcnt(" #n ")" ::: "memory")
#define G8_BAR __builtin_amdgcn_s_barrier()
#define G8_SCHED __builtin_amdgcn_sched_barrier(0)
  Unit cur, nxt; int ui = 0;
  if (!S.next(0, cur)) return;
  f32x4 acc[2][2][4][2];
#pragma unroll
  for (int a = 0; a < 2; ++a)
#pragma unroll
    for (int b = 0; b < 2; ++b)
#pragma unroll
      for (int m = 0; m < 4; ++m)
#pragma unroll
        for (int n = 0; n < 2; ++n) acc[a][b][m][n] = (f32x4){0.f, 0.f, 0.f, 0.f};
  bf16x8 At[4][2], B0[2][2], B1[2][2];
  unsigned cA[2][2], nA[2][2];
  const char* const Ab = S.a_base();
  S.a_offs(cur, tid, cA);
  const char* cB = S.b_ptr(cur);
  G8_STAGE_B(G8_SB(0, 0), cB); G8_STAGE_A(G8_SA(0, 0), Ab, cA[0][0], cA[0][1]); G8_STAGE_B(G8_SB(0, 1), cB + hstepB); G8_STAGE_A(G8_SA(0, 1), Ab, cA[1][0], cA[1][1]);
  if (wr == 1) G8_BAR;
  G8_WAIT_V(4); G8_BAR;
  G8_STAGE_B(G8_SB(1, 0), cB + kstep); G8_STAGE_A(G8_SA(1, 0), Ab + kstep, cA[0][0], cA[0][1]); G8_STAGE_B(G8_SB(1, 1), cB + hstepB + kstep);
  G8_WAIT_V(6); G8_BAR;
  for (;;) {
    const bool has_next = S.next(ui + 1, nxt);
    const char* nB = cB;
    if (has_next) { S.a_offs(nxt, tid_(), nA); nB = S.b_ptr(nxt); }
    else { nA[0][0] = cA[0][0]; nA[0][1] = cA[0][1]; nA[1][0] = cA[1][0]; nA[1][1] = cA[1][1]; }
    for (int t = 0; t < nt; t += 2) {
      const bool last = (t == nt - 2);
      const size_t k1 = (size_t)(t + 1) * kstep, k2 = (size_t)(t + 2) * kstep;
      const char* b2 = last ? nB : cB + k2; const char* b3 = b2 + kstep;
      const char* Ab2 = last ? Ab : Ab + k2;
      unsigned a2[2][2];
#pragma unroll
      for (int h = 0; h < 2; ++h)
#pragma unroll
        for (int i = 0; i < 2; ++i) a2[h][i] = last ? nA[h][i] : cA[h][i];
      G8_LDB(B0, 0, 0); G8_SCHED; G8_LDA(At, 0, 0); G8_STAGE_A(G8_SA(1, 1), Ab + k1, cA[1][0], cA[1][1]);
      G8_WAIT_L(8); G8_BAR; G8_WAIT_L(0); G8_MMA(0, 0, At, B0); G8_BAR; G8_SCHED;
      G8_LDB(B1, 0, 1); G8_STAGE_B(G8_SB(0, 0), b2);
      G8_BAR; G8_WAIT_L(0); G8_MMA(0, 1, At, B1); G8_BAR;
      G8_LDA(At, 0, 1); G8_STAGE_A(G8_SA(0, 0), Ab2, a2[0][0], a2[0][1]);
      G8_BAR; G8_WAIT_L(0); G8_MMA(1, 0, At, B0); G8_BAR; G8_SCHED;
      G8_STAGE_B(G8_SB(0, 1), b2 + hstepB);
      G8_WAIT_V(6); G8_BAR; G8_MMA(1, 1, At, B1); G8_BAR;
      G8_LDB(B0, 1, 0); G8_SCHED; G8_LDA(At, 1, 0); G8_STAGE_A(G8_SA(0, 1), Ab2, a2[1][0], a2[1][1]);
      G8_WAIT_L(8); G8_BAR; G8_WAIT_L(0); G8_MMA(0, 0, At, B0); G8_BAR; G8_SCHED;
      G8_LDB(B1, 1, 1); G8_STAGE_B(G8_SB(1, 0), b3);
      G8_BAR; G8_WAIT_L(0); G8_MMA(0, 1, At, B1); G8_BAR;
      G8_LDA(At, 1, 1); G8_STAGE_A(G8_SA(1, 0), Ab2 + kstep, a2[0][0], a2[0][1]);
      G8_BAR; G8_WAIT_L(0); G8_MMA(1, 0, At, B0); G8_BAR; G8_SCHED;
      G8_STAGE_B(G8_SB(1, 1), b3 + hstepB);
      G8_WAIT_V(6); G8_BAR; G8_MMA(1, 1, At, B1); G8_BAR;
    }
    E(acc, cur);
    if (!has_next) break;
#pragma unroll
    for (int a = 0; a < 2; ++a)
#pragma unroll
      for (int b = 0; b < 2; ++b)
#pragma unroll
        for (int m = 0; m < 4; ++m)
#pragma unroll
          for (int n = 0; n < 2; ++n) acc[a][b][m][n] = (f32x4){0.f, 0.f, 0.f, 0.f};
    cur = nxt; cB = nB; ++ui;
#pragma unroll
    for (int h = 0; h < 2; ++h)
#pragma unroll
      for (int i = 0; i < 2; ++i) cA[h][i] = nA[h][i];
  }
  G8_WAIT_V(0);
  if (wr == 0) G8_BAR;
  G8_BAR;
#undef G8_SA
#undef G8_SB
#undef G8_STAGE_A
#undef G8_STAGE_B
#undef G8_LDA
#undef G8_LDB
#undef G8_MMA
#undef G8_WAIT_V
#undef G8_WAIT_L
#undef G8_BAR
#undef G8_SCHED
}

struct DenseSched {
  const bf16_t* A; const bf16_t* Bt; int K, nM, nN, G, c;
  DEVI bool next(int i, Unit& u) const {
    const int nwg = nM * nN; const long L = (long)i * G + c; if (L >= nwg) return false;
    const int wgid = xcd_remap((int)L, nwg);
    const int nig = 8 * nN, gid = wgid / nig, fm = gid * 8, gsz = (nM - fm) < 8 ? (nM - fm) : 8;
    u.pm = fm + ((wgid % nig) % gsz); u.pn = (wgid % nig) / gsz; u.e = 0; return true;
  }
  DEVI const char* a_base() const { return (const char*)A; }
  DEVI void a_offs(const Unit& u, int tid, unsigned (&ao)[2][2]) const {
#pragma unroll
    for (int i = 0; i < 2; ++i) {
      int R, C; stage_rc(tid * 16 + i * 8192, R, C);
#pragma unroll
      for (int h = 0; h < 2; ++h) ao[h][i] = ((unsigned)(u.pm * 256 + h * 128 + R) * (unsigned)K + (unsigned)C) * 2u;
    }
  }
  DEVI const char* b_ptr(const Unit& u) const { return (const char*)(Bt + (size_t)u.pn * 256 * K); }
};
}

struct TrRegs { float4 v[2][4]; };
DEVI void transpose_load(TrRegs& t, const float* __restrict__ src, int ld_src, int k0, int n0) {
  const int tid = tid_();
  const int kr = tid >> 4, c4 = (tid & 15) * 4;
#pragma unroll
  for (int i = 0; i < 2; ++i)
#pragma unroll
    for (int w = 0; w < 4; ++w) t.v[i][w] = *(const float4*)(src + (size_t)(k0 + kr + 32 * i) * ld_src + n0 + w * 64 + c4);
}
template <class RM>
DEVI void transpose_finish(unsigned char* smem, const TrRegs& t, int k0, int n0, bf16_t* dst, int ld_dst, RM&& rowmap) {
  bf16_t* T = (bf16_t*)smem;
  const int tid = tid_();
  const int kr = tid >> 4, c4 = (tid & 15) * 4;
#pragma unroll
  for (int i = 0; i < 2; ++i)
#pragma unroll
    for (int w = 0; w < 4; ++w) {
      const int kk = kr + 32 * i; bf16_t* tp = T + (w * 64 + c4) * 72 + kk;
      tp[0] = f2bf(t.v[i][w].x); tp[72] = f2bf(t.v[i][w].y); tp[144] = f2bf(t.v[i][w].z); tp[216] = f2bf(t.v[i][w].w);
    }
  __syncthreads();
  const int k8 = (tid & 7) * 8;
#pragma unroll
  for (int j = 0; j < 4; ++j) {
    const int nn = (tid >> 3) + 64 * j;
    const uint4 o = *(const uint4*)(T + nn * 72 + k8);
    *(uint4*)(dst + (size_t)rowmap(n0 + nn) * ld_dst + k0 + k8) = o;
  }
  __syncthreads();
}
template <class RM>
DEVI void transpose_tile(unsigned char* smem, const float* __restrict__ src, int ld_src, int k0, int n0, bf16_t* dst, int ld_dst, RM&& rowmap) {
  TrRegs t; transpose_load(t, src, ld_src, k0, n0);
  transpose_finish(smem, t, k0, n0, dst, ld_dst, rowmap);
}

struct S5Disc { float lm, th, ar, ai, cr, ci; };
DEVI S5Disc s5disc(const Params& p, int l, int d, int g, int pp) {
  const int idx = ((l * 2 + d) * 16 + g) * 64 + pp;
  const float lr = uin(p, I_LRE)[idx], li = uin(p, I_LIM)[idx];
  const float dt = expf(uin(p, I_LDT)[(l * 2 + d) * 16 + g]);
  S5Disc r; r.lm = lr * dt; r.th = li * dt;
  const float mag = expf(r.lm), cs = cosf(r.th), sn = sinf(r.th), sh = sinf(0.5f * r.th);
  r.ar = mag * cs; r.ai = mag * sn;
  const float nr = expm1f(r.lm) * cs - 2.f * sh * sh, ni = r.ai, den = lr * lr + li * li;
  r.cr = (nr * lr + ni * li) / den; r.ci = (ni * lr - nr * li) / den;
  return r;
}

DEVI void phase0a(const Params& p, unsigned char* smem) {
  const int tid = tid_(), bid = bid_(), G = gridDim.x;
  unsigned char* ws = uws(p);
  if (bid == 0 && tid < 128) ((int*)(ws + WS_CTL))[tid] = 0;
  constexpr int N_MOD = 384, N_KT = 256, N_ROPE = 128, N_TRW = 256 + 128, N_EL = 640;
  constexpr int N_AP = 265;
  constexpr int N_BB = 128;
  const int total = N_MOD + N_KT + N_ROPE + N_TRW + N_EL + N_AP + N_BB;
  for (int it0 = bid; it0 < total; it0 += G) {
    int it = it0;
    if (it < N_MOD) {
      const int l = it / 192, col0 = (it % 192) * 32;
      const int c = tid & 31, kg = tid >> 5;
      float* sS = (float*)smem;
      float acc[17];
#pragma unroll
      for (int b = 0; b < 17; ++b) acc[b] = 0.f;
      const float* W = uin(p, I_WMOD) + (size_t)l * D * 6144 + col0 + c;
      for (int kc = 0; kc < 4; ++kc) {
        __syncthreads();
        for (int e = tid; e < 17 * 256; e += NTHREADS) {
          const int b = e >> 8, k = kc * 256 + (e & 255);
          const float cv = (b < 16) ? uin(p, I_C)[b * D + k] : uin(p, I_CCTX)[k];
          sS[e] = cv / (1.f + __expf(-cv));
        }
        __syncthreads();
        float wv[16];
#pragma unroll
        for (int i = 0; i < 16; ++i) wv[i] = W[(size_t)(kc * 256 + kg + 16 * i) * 6144];
#pragma unroll
        for (int i = 0; i < 16; ++i) {
          const int kl = kg + 16 * i;
#pragma unroll
          for (int b = 0; b < 17; ++b) acc[b] = fmaf(sS[b * 256 + kl], wv[i], acc[b]);
        }
      }
      __syncthreads();
      float* sR = (float*)smem;
#pragma unroll
      for (int b = 0; b < 17; ++b) sR[(kg * 17 + b) * 32 + c] = acc[b];
      __syncthreads();
      for (int e = tid; e < 17 * 32; e += NTHREADS) {
        const int b = e >> 5, cc = e & 31;
        float s = 0.f;
#pragma unroll
        for (int q = 0; q < 16; ++q) s += sR[(q * 17 + b) * 32 + cc];
        ((float*)(ws + WS_MOD))[(size_t)(l * 17 + b) * 6144 + col0 + cc] = s + uin(p, I_BMOD)[l * 6144 + col0 + cc];
      }
      __syncthreads();
      continue;
    }
    it -= N_MOD;
    if (it < N_KT) {
      const int gid = it * NTHREADS + tid;
      const int pg = gid & 7, cc = (gid >> 3) & 255, c = cc >> 4, c2 = cc & 15;
      const int lgd = gid >> 11, d = lgd & 1, g = (lgd >> 1) & 15, l = lgd >> 5;
      float K[32];
#pragma unroll
      for (int j = 0; j < 32; ++j) K[j] = 0.f;
      for (int q = 0; q < 8; ++q) {
        const int pp = pg * 8 + q;
        const S5Disc dd = s5disc(p, l, d, g, pp);
        const float ar = dd.ar, ai = dd.ai;
        const float br = uin(p, I_BRE)[((l * 16 + g) * 64 + pp) * 16 + c2], bi = uin(p, I_BIM)[((l * 16 + g) * 64 + pp) * 16 + c2];
        const float bbr = dd.cr * br - dd.ci * bi, bbi = dd.cr * bi + dd.ci * br;
        const float cr = uin(p, I_CRE)[((l * 16 + g) * 16 + c) * 64 + pp], ci = uin(p, I_CIM)[((l * 16 + g) * 16 + c) * 64 + pp];
        const float zr = cr * bbr - ci * bbi, zi = cr * bbi + ci * bbr;
        float pr = 1.f, pi = 0.f;
#pragma unroll
        for (int j = 0; j < 32; ++j) {
          K[j] += zr * pr - zi * pi;
          const float nr = pr * ar - pi * ai, ni = pr * ai + pi * ar;
          pr = nr; pi = ni;
        }
      }
#pragma unroll
      for (int j = 0; j < 32; ++j) { float v = K[j]; v += __shfl_xor(v, 1); v += __shfl_xor(v, 2); v += __shfl_xor(v, 4); K[j] = v; }
      if (pg == 0) {
        float* KT = (float*)(ws + WS_KTAB) + (size_t)(((l * 16 + g) * 2 + d) * 32) * 256 + c * 16 + c2;
#pragma unroll
        for (int j = 0; j < 32; ++j) KT[j * 256] = K[j];
      }
      continue;
    }
    it -= N_KT;
    if (it < N_ROPE) {
      const int e = it * NTHREADS + tid;
      const int pos = e >> 5, i = e & 31;
      const float inv = powf(10000.f, -(float)(i & 15) / 16.f);
      const float ang = (float)((i < 16) ? (pos >> 6) : (pos & 63)) * inv;
      ((float*)(ws + WS_ROPE))[e] = cosf(ang);
      ((float*)(ws + WS_ROPE))[65536 + e] = sinf(ang);
      continue;
    }
    it -= N_ROPE;
    if (it < N_TRW) {
      if (it < 256) {
        const int l = it >> 7, r = it & 127, kt = r >> 3, ntl = r & 7;
        transpose_tile(smem, uin(p, I_WIN) + (size_t)l * D * DIN, DIN, kt * 64, ntl * 256, (bf16_t*)(ws + WS_WIN_T) + (size_t)l * DIN * D, D,
          [](int n) { if (n >= 1280 && n < 1920) { const int d = n & 63; return (n & ~63) + 32 * ((d >> 4) & 1) + 8 * ((d >> 2) & 3) + 4 * (d >> 5) + (d & 3); } return n; });
      } else {
        const int r0 = it - 256, l = r0 >> 6, r = r0 & 63, kt = r >> 2, ntl = r & 3;
        transpose_tile(smem, uin(p, I_WOUT) + (size_t)l * D * D, D, kt * 64, ntl * 256, (bf16_t*)(ws + WS_WOUT_T) + (size_t)l * D * D, D, [](int n) { return n; });
      }
      continue;
    }
    it -= N_TRW;
    if (it < N_EL) {
      for (int q = 0; q < 4; ++q) {
        int e = (it * 4 + q) * NTHREADS + tid;
        if (e < 655360) {
          const int l = e / 327680, r = e % 327680, n = r >> 8, k = r & 255;
          float v = 0.f;
          if (n < 512) { const int d = n >> 8, col = n & 255; if (k < 64) v = uin(p, I_W2)[((l * 2 + d) * 64 + k) * 256 + col]; }
          else if (n < 1024) { const int d = (n - 512) >> 8, col = n & 255; if (k >= 64 && k < 128) v = uin(p, I_A2)[((l * 2 + d) * 64 + (k - 64)) * 256 + col]; }
          else { const int col = n - 1024; if (k >= 128) v = uin(p, I_G2)[(l * 128 + (k - 128)) * 256 + col]; }
          ((bf16_t*)(ws + WS_FW))[e] = f2bf(v);
          continue;
        }
        e -= 655360;
        if (e < 131072) {
          const int l = e >> 16, r = e & 65535, n = r >> 8, k = r & 255;
          ((bf16_t*)(ws + WS_GLU_T))[e] = f2bf(uin(p, I_GLUW)[(l * 256 + k) * 256 + n]);
          continue;
        }
        e -= 131072;
        if (e < 524288) {
          const int l = e >> 18, r = e & 262143, hl = r >> 17, n = (r >> 10) & 127, k = r & 1023;
          float v = 0.f;
          if (n < 4) v = uin(p, I_RGW)[(l * D + k) * 4 + n];
          else if (n < 36) v = uin(p, I_REW)[(l * D + k) * 32 + (n - 4)];
          const bf16_t h = f2bf(v);
          ((bf16_t*)(ws + WS_RW))[e] = hl ? f2bf(v - bf2f(h)) : h;
        }
      }
      continue;
    }
    it -= N_EL;
    if (it < N_AP) {
      const int e = it * NTHREADS + tid;
      if (e < 2 * 2 * 16 * 64 * 33) {
        const int j = e % 33, r = e / 33, pp = r & 63, g = (r >> 6) & 15, d = (r >> 10) & 1, l = r >> 11;
        const S5Disc dd = s5disc(p, l, d, g, pp);
        const float mg = expf(dd.lm * (float)j), an = dd.th * (float)j;
        ((float2*)(ws + WS_APOW))[e] = make_float2(mg * cosf(an), mg * sinf(an));
      }
      continue;
    }
    it -= N_AP;
    {
      const int e = it * NTHREADS + tid;
      const int c2 = e & 15, pp = (e >> 4) & 63, g = (e >> 10) & 15, d = (e >> 14) & 1, l = e >> 15;
      const S5Disc dd = s5disc(p, l, d, g, pp);
      const float br = uin(p, I_BRE)[((l * 16 + g) * 64 + pp) * 16 + c2], bi = uin(p, I_BIM)[((l * 16 + g) * 64 + pp) * 16 + c2];
      ((float2*)(ws + WS_BBT))[e] = make_float2(dd.cr * br - dd.ci * bi, dd.cr * bi + dd.ci * br);
    }
  }
}

DEVI void write_xmod_row(const float4 v[4], const float* modl, bf16_t* dstrow, int lane) {
#pragma unroll
  for (int i = 0; i < 4; ++i) {
    const int col = i * 256 + lane * 4;
    const float4 sh = *(const float4*)(modl + col), sc = *(const float4*)(modl + 1024 + col);
    uint2 o; o.x = pack2(v[i].x * (1.f + sc.x) + sh.x, v[i].y * (1.f + sc.y) + sh.y); o.y = pack2(v[i].z * (1.f + sc.z) + sh.z, v[i].w * (1.f + sc.w) + sh.w);
    *(uint2*)(dstrow + col) = o;
  }
}
DEVI void phase0b(const Params& p, unsigned char* smem) {
  const int tid = tid_(), bid = bid_(), G = gridDim.x, lane = tid & 63, wid = tid >> 6;
  unsigned char* ws = uws(p);
  {
    bf16_t* XM = (bf16_t*)((unsigned char*)uout(p) + DO_XMOD);
    const float* MOD = (const float*)(ws + WS_MOD);
    const int nw = G * 8, gw = bid * 8 + wid, rpw = (NT + nw - 1) / nw;
    const int R0 = gw * rpw, R1 = (R0 + rpw < NT) ? (R0 + rpw) : NT;
    const int c0 = lane * 8, c1 = 512 + lane * 8;
    float sh[2][8], sc[2][8], xv[2][8];
    int curb = -1;
    if (R0 < R1) { ld8f(xin_row(p, R0) + c0, xv[0]); ld8f(xin_row(p, R0) + c1, xv[1]); }
    for (int R = R0; R < R1; ++R) {
      float xn[2][8];
#pragma unroll
      for (int h = 0; h < 2; ++h)
#pragma unroll
        for (int e = 0; e < 8; ++e) xn[h][e] = 0.f;
      if (R + 1 < R1) { ld8f(xin_row(p, R + 1) + c0, xn[0]); ld8f(xin_row(p, R + 1) + c1, xn[1]); }
      const int bi = bidx_of(R);
      if (bi != curb) { curb = bi; const float* modl = MOD + (size_t)bi * 6144; ld8f(modl + c0, sh[0]); ld8f(modl + c1, sh[1]); ld8f(modl + 1024 + c0, sc[0]); ld8f(modl + 1024 + c1, sc[1]); }
#pragma unroll
      for (int h = 0; h < 2; ++h) {
        float xm[8];
#pragma unroll
        for (int e = 0; e < 8; ++e) xm[e] = xv[h][e] * (1.f + sc[h][e]) + sh[h][e];
        st8b(XM + (size_t)R * D + (h ? c1 : c0), xm);
      }
#pragma unroll
      for (int h = 0; h < 2; ++h)
#pragma unroll
        for (int e = 0; e < 8; ++e) xv[h][e] = xn[h][e];
    }
  }
  const float* KT = (const float*)(ws + WS_KTAB);
  const float2* AP = (const float2*)(ws + WS_APOW);
  const float2* BB = (const float2*)(ws + WS_BBT);
  const long nthreads = (long)G * NTHREADS, gt = (long)bid * NTHREADS + tid;
  const long n_ttg = 2L * 16 * 512 * 96;
  for (long e = gt; e < n_ttg; e += nthreads) {
    const int k8 = (int)(e % 96), m = (int)((e / 96) & 511), g = (int)((e / (96 * 512)) & 15), l = (int)(e / (96 * 512 * 16));
    const int tau = m >> 4, c = m & 15, k = k8 * 8;
    float v[8];
    if (k < 512) {
      const int sg = k >> 4, c2 = k & 15;
      const float* K0 = KT + (size_t)(((l * 16 + g) * 2 + 0) * 32) * 256 + c * 16 + c2;
      const float* K1 = KT + (size_t)(((l * 16 + g) * 2 + 1) * 32) * 256 + c * 16 + c2;
      if (sg < tau) { for (int q = 0; q < 8; ++q) v[q] = K0[(tau - sg) * 256 + q]; }
      else if (sg > tau) { for (int q = 0; q < 8; ++q) v[q] = K1[(sg - tau) * 256 + q]; }
      else { for (int q = 0; q < 8; ++q) v[q] = K0[q] + K1[q] + ((c2 + q == c) ? uin(p, I_SD)[l * 256 + g * 16 + c] : 0.f); }
    } else {
      const int q0 = k - 512, d = q0 >> 7, isim = (q0 >> 6) & 1, p0 = q0 & 63;
      const int j = d ? (32 - tau) : (tau + 1);
      for (int q = 0; q < 8; ++q) {
        const int pp = p0 + q;
        const float2 a = AP[((size_t)(((l * 2 + d) * 16 + g) * 64 + pp)) * 33 + j];
        const float cr = uin(p, I_CRE)[((l * 16 + g) * 16 + c) * 64 + pp], ci = uin(p, I_CIM)[((l * 16 + g) * 16 + c) * 64 + pp];
        v[q] = isim ? -(cr * a.y + ci * a.x) : (cr * a.x - ci * a.y);
      }
    }
    uint4 o; o.x = pack2(v[0], v[1]); o.y = pack2(v[2], v[3]); o.z = pack2(v[4], v[5]); o.w = pack2(v[6], v[7]);
    *(uint4*)((bf16_t*)(ws + WS_TTG) + (size_t)e * 8) = o;
  }
  const long n_em = 2L * 16 * 256 * 64;
  for (long e = gt; e < n_em; e += nthreads) {
    const int k8 = (int)(e & 63), r = (int)((e >> 6) & 255), g = (int)((e >> 14) & 15), l = (int)(e >> 18);
    const int d = r >> 7, isim = (r >> 6) & 1, pp = r & 63, k = k8 * 8, sg = k >> 4, c2 = k & 15;
    const int j = d ? sg : (31 - sg);
    const float2 a = AP[((size_t)(((l * 2 + d) * 16 + g) * 64 + pp)) * 33 + j];
    float v[8];
    for (int q = 0; q < 8; ++q) {
      const float2 bb = BB[(size_t)((((l * 2 + d) * 16 + g) * 64 + pp) * 16) + c2 + q];
      v[q] = isim ? (a.x * bb.y + a.y * bb.x) : (a.x * bb.x - a.y * bb.y);
    }
    uint4 o; o.x = pack2(v[0], v[1]); o.y = pack2(v[2], v[3]); o.z = pack2(v[4], v[5]); o.w = pack2(v[6], v[7]);
    *(uint4*)((bf16_t*)(ws + WS_EM) + (size_t)e * 8) = o;
  }
}

struct EpiInproj {
  static constexpr bool PERM = true;
  bf16_t* PROJ; bf16_t* UDH; const float* RC; const float* RS;
  DEVI void operator()(const f32x4 (&acc)[2][2][4][2], const g8::Unit& u) const {
    const int tid = tid_(), wid = __builtin_amdgcn_readfirstlane(tid >> 6), lane = tid & 63, wr = wid >> 2, wc = wid & 3, fr = lane & 15, fq = lane >> 4;
    const bool lat = u.pm < 128;
#pragma unroll
    for (int ai = 0; ai < 2; ++ai)
#pragma unroll
      for (int m = 0; m < 4; ++m) {
        const int row = u.pm * 256 + ai * 128 + wr * 64 + m * 16 + fr, pos = row & 2047;
#pragma unroll
        for (int bj = 0; bj < 2; ++bj) {
          const int cb = u.pn * 256 + bj * 128 + wc * 32 + 8 * fq;
          f32x4 x0 = acc[ai][bj][m][0], x1 = acc[ai][bj][m][1];
          const bool isq = (u.pn == 5 || u.pn == 6), isk = (u.pn == 7 && bj == 0);
          if ((isq || isk) && lat) {
            const int i0 = 16 * (wc & 1) + 4 * fq;
            const float4 cs = *(const float4*)(RC + pos * 32 + i0), sn = *(const float4*)(RS + pos * 32 + i0);
            const f32x4 y0 = (f32x4){x0[0] * cs.x - x1[0] * sn.x, x0[1] * cs.y - x1[1] * sn.y, x0[2] * cs.z - x1[2] * sn.z, x0[3] * cs.w - x1[3] * sn.w};
            const f32x4 y1 = (f32x4){x1[0] * cs.x + x0[0] * sn.x, x1[1] * cs.y + x0[1] * sn.y, x1[2] * cs.z + x0[2] * sn.z, x1[3] * cs.w + x0[3] * sn.w};
            x0 = y0; x1 = y1;
          }
          if (isq) { x0 = x0 * 0.125f; x1 = x1 * 0.125f; }
          const uint4 o = make_uint4(pack2(x0[0], x0[1]), pack2(x0[2], x0[3]), pack2(x1[0], x1[1]), pack2(x1[2], x1[3]));
          if (u.pn == 4) {
            const int g = (cb - 1024) >> 4, c = cb & 15;
            *(uint4*)(UDH + ((size_t)(g * NCH + (row >> 5))) * 768 + (row & 31) * 16 + c) = o;
          } else {
            *(uint4*)(PROJ + (size_t)row * DIN + cb) = o;
          }
        }
        asm volatile("" ::: "memory");
      }
  }
};
DEVI void phase_inproj(const Params& p, int l, unsigned char* smem) {
  unsigned char* ws = uws(p);
  g8::DenseSched S{(const bf16_t*)((unsigned char*)uout(p) + DO_XMOD), (const bf16_t*)(ws + WS_WIN_T) + (size_t)l * DIN * D, D, 144, 8, (int)gridDim.x, bid_()};
  EpiInproj E{(bf16_t*)(ws + WS_PROJ), (bf16_t*)(ws + WS_UDH), (const float*)(ws + WS_ROPE), (const float*)(ws + WS_ROPE) + 65536};
  __syncthreads();
  g8::gemm((G8_LAS unsigned char*)smem, D, S, E);
  __syncthreads();
}

DEVI void phase_feat(const Params& p, int l, unsigned char* smem) {
  unsigned char* ws = uws(p);
  const bf16_t* PROJ = (const bf16_t*)(ws + WS_PROJ);
  unsigned short* FEAT = (unsigned short*)(ws + WS_FEAT);
  const bf16_t* FW = (const bf16_t*)(ws + WS_FW) + (size_t)l * 1280 * 256;
  const bf16_t* EM = (const bf16_t*)(ws + WS_EM) + (size_t)l * 16 * 256 * 512;
  float* HE = (float*)((unsigned char*)uout(p) + DO_HE);
  const float* CW = uin(p, I_CONV) + l * 3 * 1024;
  const int tid = tid_(), lrow = tid >> 2;
  for (int it = bid_(); it < 432 + 160; it += gridDim.x) {
    if (it < 432) {
      const int mt = it / 3, typ = it % 3;
      const int kb = typ == 0 ? 0 : (typ == 1 ? 64 : 128), KK = typ == 2 ? 128 : 64, lda = KK + 8;
      const int nt_lo = typ == 0 ? 0 : (typ == 1 ? 4 : 8), nt_n = typ == 2 ? 2 : 4;
      bf16_t* sA = (bf16_t*)smem;
      bf16_t* sB = sA + 256 * 136;
      {
        const int ppr = KK >> 3;
        const int kfix = kb + (tid % ppr) * 8;
        float wc0[8], wc1[8], wc2[8];
        ld8f(CW + 768 + kfix, wc0); ld8f(CW + 1024 + 768 + kfix, wc1); ld8f(CW + 2048 + 768 + kfix, wc2);
        for (int pc = tid; pc < 256 * ppr; pc += NTHREADS) {
          const int rr = pc / ppr, k = kfix;
          const int R = mt * 256 + rr;
          const int t = R < NLAT ? (R & 2047) : ((R - NLAT) & 255); const int len = R < NLAT ? SEQ : CTXL;
          const bf16_t* pcur = PROJ + (size_t)R * DIN + 768 + k;
          const uint4 vc = *(const uint4*)pcur;
          uint4 vp = make_uint4(0, 0, 0, 0), vn = make_uint4(0, 0, 0, 0);
          if (t > 0) vp = *(const uint4*)(pcur - DIN);
          if (t < len - 1) vn = *(const uint4*)(pcur + DIN);
          float x[8];
          const unsigned up[4] = {vp.x, vp.y, vp.z, vp.w}, uc[4] = {vc.x, vc.y, vc.z, vc.w}, un[4] = {vn.x, vn.y, vn.z, vn.w};
#pragma unroll
          for (int q = 0; q < 4; ++q) {
            x[2 * q] = lo_bf(up[q]) * wc0[2 * q] + lo_bf(uc[q]) * wc1[2 * q] + lo_bf(un[q]) * wc2[2 * q];
            x[2 * q + 1] = hi_bf(up[q]) * wc0[2 * q + 1] + hi_bf(uc[q]) * wc1[2 * q + 1] + hi_bf(un[q]) * wc2[2 * q + 1];
          }
          if (typ == 0) { for (int q = 0; q < 8; ++q) x[q] = 1.f - 2.f * __builtin_amdgcn_rcpf(1.f + __expf(2.f * x[q])); }
          else if (typ == 2) { for (int q = 0; q < 8; ++q) x[q] = sigmoidf(x[q]); }
          *(uint4*)(sA + rr * lda + (k - kb)) = make_uint4(pack2(x[0], x[1]), pack2(x[2], x[3]), pack2(x[4], x[5]), pack2(x[6], x[7]));
        }
      }
      const int lane = tid & 63, wid = tid >> 6, wr = wid >> 1, wc = wid & 1, fr = lane & 15, fq = lane >> 4;
      for (int nq = 0; nq < nt_n; ++nq) {
        const int ntl = nt_lo + nq;
        __syncthreads();
        {
          const int ppr = KK >> 3;
          for (int pc = tid; pc < 128 * ppr; pc += NTHREADS) {
            const int rr = pc / ppr, k = (pc % ppr) * 8;
            *(uint4*)(sB + rr * lda + k) = *(const uint4*)(FW + (size_t)(ntl * 128 + rr) * 256 + kb + k);
          }
        }
        __syncthreads();
        f32x4 acc[4][4];
#pragma unroll
        for (int m = 0; m < 4; ++m)
#pragma unroll
          for (int n = 0; n < 4; ++n) acc[m][n] = (f32x4){0.f, 0.f, 0.f, 0.f};
        for (int k0 = 0; k0 < KK; k0 += 32) {
          bf16x8 bfr[4];
#pragma unroll
          for (int n = 0; n < 4; ++n) bfr[n] = *(const bf16x8*)(sB + (wc * 64 + n * 16 + fr) * lda + k0 + fq * 8);
#pragma unroll
          for (int m = 0; m < 4; ++m) {
            const bf16x8 af = *(const bf16x8*)(sA + (wr * 64 + m * 16 + fr) * lda + k0 + fq * 8);
#pragma unroll
            for (int n = 0; n < 4; ++n) acc[m][n] = __builtin_amdgcn_mfma_f32_16x16x32_bf16(bfr[n], af, acc[m][n], 0, 0, 0);
          }
        }
#pragma unroll
        for (int m = 0; m < 4; ++m) {
          const int row = mt * 256 + wr * 64 + m * 16 + fr;
#pragma unroll
          for (int n = 0; n < 4; ++n) {
            const int ng = ntl * 128 + wc * 64 + n * 16 + fq * 4;
            float o[4];
            if (typ == 0) {
              const float4 w0 = *(const float4*)(uin(p, I_W0) + (l * 2 + (ng >> 8)) * 256 + (ng & 255));
              const float wv[4] = {w0.x, w0.y, w0.z, w0.w};
#pragma unroll
              for (int j = 0; j < 4; ++j) {
                const float e = 0.6065306597126334f * sigmoidf(acc[m][n][j] + wv[j]);
                o[j] = 1.f - __expf(-e);
              }
            } else if (typ == 1) {
              const float4 a0 = *(const float4*)(uin(p, I_A0) + (l * 2 + ((ng - 512) >> 8)) * 256 + (ng & 255));
              const float av[4] = {a0.x, a0.y, a0.z, a0.w};
#pragma unroll
              for (int j = 0; j < 4; ++j) o[j] = sigmoidf(acc[m][n][j] + av[j]);
            } else {
#pragma unroll
              for (int j = 0; j < 4; ++j) o[j] = acc[m][n][j];
            }
            uint2 w; w.x = (unsigned)f2h(o[0]) | ((unsigned)f2h(o[1]) << 16); w.y = (unsigned)f2h(o[2]) | ((unsigned)f2h(o[3]) << 16);
            *(uint2*)(FEAT + (size_t)row * 1280 + ng) = w;
          }
        }
      }
      __syncthreads();
    } else {
      const int j = it - 432, g = j / 10, rest = j % 10, mt5 = rest >> 1, nt2 = rest & 1;
      int n0 = mt5 * 256 + lrow, n1 = n0 + 128; if (n0 > NCH - 1) n0 = NCH - 1; if (n1 > NCH - 1) n1 = NCH - 1;
      const bf16_t* UDH = (const bf16_t*)(ws + WS_UDH);
      const bf16_t* a0 = UDH + (size_t)(g * NCH + n0) * 768; const bf16_t* a1 = UDH + (size_t)(g * NCH + n1) * 768;
      const bf16_t* b0 = EM + (size_t)(g * 256 + nt2 * 128 + lrow) * 512;
      gemm_tile(smem, 0, 512,
        [&](int i, int k) { return *(const uint4*)((i ? a1 : a0) + k); },
        [&](int k) { return *(const uint4*)(b0 + k); },
        [&](f32x4 (&acc)[4][4], int wr, int wc, int fr, int fq) {
#pragma unroll
          for (int m = 0; m < 4; ++m) {
            const int n = mt5 * 256 + wr * 64 + m * 16 + fr;
            if (n < NCH) {
#pragma unroll
              for (int nn = 0; nn < 4; ++nn)
                *(f32x4*)(HE + (size_t)(g * NCH + n) * 256 + nt2 * 128 + wc * 64 + nn * 16 + fq * 4) = acc[m][nn];
            }
          }
        });
    }
  }
}


DEVI float row_reduce_scatter16(const float (&v)[16], int lane16) {
  float a[8], b[4], c[2];
  const bool b3 = (lane16 & 8) != 0, b2 = (lane16 & 4) != 0, b1 = (lane16 & 2) != 0, b0 = (lane16 & 1) != 0;
#pragma unroll
  for (int k = 0; k < 8; ++k) { const float send = b3 ? v[k] : v[k + 8], keep = b3 ? v[k + 8] : v[k]; a[k] = keep + dpp_f<0x128>(send); }
#pragma unroll
  for (int k = 0; k < 4; ++k) { const float send = b2 ? a[k] : a[k + 4], keep = b2 ? a[k + 4] : a[k]; b[k] = keep + dpp_f<0x141>(send); }
#pragma unroll
  for (int k = 0; k < 2; ++k) { const float send = b1 ? b[k] : b[k + 2], keep = b1 ? b[k + 2] : b[k]; c[k] = keep + dpp_f<0x4E>(send); }
  { const float send = b0 ? c[0] : c[1], keep = b0 ? c[1] : c[0]; return keep + dpp_f<0xB1>(send); }
}
DEVI float mul_mix_lo(float a, unsigned hpair) { float r; asm("v_fma_mix_f32 %0, %1, %2, 0 op_sel_hi:[0,1,0]" : "=v"(r) : "v"(a), "v"(hpair)); return r; }
constexpr int RC_SLOT = 17664;
constexpr int RC_KK = 0, RC_RR = 2304, RC_KDB = 4608, RC_TT = 8704, RC_MM = 9728, RC_V = 10752, RC_G = 12800, RC_KD = 13056, RC_BB = 15360;
DEVI bf16x8 rc_pack8(const f32x4& a, const f32x4& b) {
  typedef unsigned u4v __attribute__((ext_vector_type(4)));
  const u4v u = {pack2(a[0], a[1]), pack2(a[2], a[3]), pack2(b[0], b[1]), pack2(b[2], b[3])};
  return __builtin_bit_cast(bf16x8, u);
}
DEVI bf16x8 rc_pack8(const f32x4& a, uint2 b) {
  typedef unsigned u4v __attribute__((ext_vector_type(4)));
  const u4v u = {pack2(a[0], a[1]), pack2(a[2], a[3]), b.x, b.y};
  return __builtin_bit_cast(bf16x8, u);
}
DEVI bf16x8 rc_pack8(uint2 a, const f32x4& b) {
  typedef unsigned u4v __attribute__((ext_vector_type(4)));
  const u4v u = {a.x, a.y, pack2(b[0], b[1]), pack2(b[2], b[3])};
  return __builtin_bit_cast(bf16x8, u);
}
template <int DIR>
DEVI void rwkv_chunked(const Params& p, int l, int it, unsigned char* smem) {
  unsigned char* ws = uws(p);
  const int b = it >> 3, h = (it >> 1) & 3;
  const bf16_t* PROJ = (const bf16_t*)(ws + WS_PROJ);
  const unsigned short* FEAT = (const unsigned short*)(ws + WS_FEAT);
  float* Y = (float*)((unsigned char*)uout(p) + (DIR ? DO_YB : DO_YF));
  const int tid = tid_(), lane = tid & 63, wid = __builtin_amdgcn_readfirstlane(tid >> 6);
  const int cl = lane & 15, cq = lane >> 4;
  const int hc = h * 64 + lane;
  const float* CW = uin(p, I_CONV) + l * 3 * 1024;
  float cwr[3], cwk[3], cwv[3];
#pragma unroll
  for (int dl = 0; dl < 3; ++dl) { cwr[dl] = CW[dl * 1024 + hc]; cwk[dl] = CW[dl * 1024 + 256 + hc]; cwv[dl] = CW[dl * 1024 + 512 + hc]; }
  const float kkw = uin(p, I_KK)[l * 256 + hc], kaw = uin(p, I_KA)[l * 256 + hc];
  const int pj = 32 * (lane >> 5) + 8 * ((lane >> 2) & 3) + 4 * ((lane >> 4) & 1) + (lane & 3);
  unsigned char* slot = smem + wid * RC_SLOT;
  const f32x4 zero4 = {0.f, 0.f, 0.f, 0.f};
  f32x4 acc[4] = {zero4, zero4, zero4, zero4};
  uint4 raw0, raw1, raw2, raw3, raw4, raw5, raw6, raw7, raw8, raw9, raw10;
  auto chunk_geom = [&](int c, bool& isctx, int& seqlen, int& lo, int& rowbase) __attribute__((always_inline)) {
    const int n0 = c * 16; isctx = n0 < 256; seqlen = isctx ? 256 : 2048; const int m0 = isctx ? n0 : n0 - 256;
    lo = DIR ? (seqlen - 16 - m0) : m0;
    rowbase = isctx ? (NLAT + b * CTXL) : (b * SEQ);
  };
#define RC_LDP(ld, dst) do { const int L_ = (ld) * 64 + lane_; const int Lc_ = L_ < 432 ? L_ : 431; const int u_ = Lc_ / 24, sg_ = (Lc_ % 24) >> 3, part_ = Lc_ & 7; \
    int tau_ = lo_ - 1 + u_; tau_ = tau_ < 0 ? 0 : (tau_ >= seqlen_ ? seqlen_ - 1 : tau_); \
    dst = *(const uint4*)(PROJ + (size_t)(rowbase_ + tau_) * DIN + h * 64 + sg_ * 256 + part_ * 8); } while (0)
#define RC_LDF(ld, dst) do { const int L_ = (ld) * 64 + lane_; const int o_ = L_ >> 4, sg_ = (L_ >> 3) & 1, part_ = L_ & 7; \
    dst = *(const uint4*)(FEAT + (size_t)(rowbase_ + lo_ + o_) * 1280 + DIR * 256 + sg_ * 512 + h * 64 + part_ * 8); } while (0)
#define RC_LOAD_RAW(c) do { bool isctx_; int seqlen_, lo_, rowbase_; chunk_geom((c), isctx_, seqlen_, lo_, rowbase_); const int lane_ = tid_() & 63;     \
    RC_LDP(0, raw0); RC_LDP(1, raw1); RC_LDP(2, raw2); RC_LDP(3, raw3); RC_LDP(4, raw4); RC_LDP(5, raw5); RC_LDP(6, raw6); \
    RC_LDF(0, raw7); RC_LDF(1, raw8); RC_LDF(2, raw9); RC_LDF(3, raw10); } while (0)
  RC_LOAD_RAW(wid);
  for (int batch = 0; batch < 18; ++batch) {
    {
      const int c = batch * 8 + wid;
      bool isctx; int seqlen, lo, rowbase; chunk_geom(c, isctx, seqlen, lo, rowbase);
      *(uint4*)(slot + (0 * 64 + lane) * 16) = raw0; *(uint4*)(slot + (1 * 64 + lane) * 16) = raw1; *(uint4*)(slot + (2 * 64 + lane) * 16) = raw2; *(uint4*)(slot + (3 * 64 + lane) * 16) = raw3;
      *(uint4*)(slot + (4 * 64 + lane) * 16) = raw4; *(uint4*)(slot + (5 * 64 + lane) * 16) = raw5; if (6 * 64 + lane < 432) *(uint4*)(slot + (6 * 64 + lane) * 16) = raw6;
      *(uint4*)(slot + 6912 + (0 * 64 + lane) * 16) = raw7; *(uint4*)(slot + 6912 + (1 * 64 + lane) * 16) = raw8; *(uint4*)(slot + 6912 + (2 * 64 + lane) * 16) = raw9; *(uint4*)(slot + 6912 + (3 * 64 + lane) * 16) = raw10;
      const unsigned short* sraw = (const unsigned short*)slot + lane;
      const bool ok_lo = lo - 1 >= 0, ok_hi = lo + 16 < seqlen;
      float kC[16], kkr[16], sq[16];
      {
        float Rk[18];
#pragma unroll
        for (int u = 0; u < 18; ++u) Rk[u] = __uint_as_float((unsigned)sraw[(u * 3 + 1) * 64] << 16);
        if (!ok_lo) Rk[0] = 0.f;
        if (!ok_hi) Rk[17] = 0.f;
#pragma unroll
        for (int o = 0; o < 16; ++o) { kC[o] = cwk[0] * Rk[o] + cwk[1] * Rk[o + 1] + cwk[2] * Rk[o + 2]; kkr[o] = kC[o] * kkw; sq[o] = kkr[o] * kkr[o]; }
      }
      float tot = row_reduce_scatter16(sq, cl);
      tot += __shfl_xor(tot, 16); tot += __shfl_xor(tot, 32);
      const float invv = rsqrtf(tot + 1e-12f);
      float rC[16], vC[16], xwF[16], aF[16];
      {
        float Rr[18], Rv[18];
#pragma unroll
        for (int u = 0; u < 18; ++u) { Rr[u] = __uint_as_float((unsigned)sraw[(u * 3 + 0) * 64] << 16); Rv[u] = __uint_as_float((unsigned)sraw[(u * 3 + 2) * 64] << 16); }
        if (!ok_lo) { Rr[0] = 0.f; Rv[0] = 0.f; }
        if (!ok_hi) { Rr[17] = 0.f; Rv[17] = 0.f; }
#pragma unroll
        for (int o = 0; o < 16; ++o) { rC[o] = cwr[0] * Rr[o] + cwr[1] * Rr[o + 1] + cwr[2] * Rr[o + 2]; vC[o] = cwv[0] * Rv[o] + cwv[1] * Rv[o + 1] + cwv[2] * Rv[o + 2]; }
#pragma unroll
        for (int o = 0; o < 16; ++o) { xwF[o] = h2f(sraw[3456 + (o * 2 + 0) * 64]); aF[o] = h2f(sraw[3456 + (o * 2 + 1) * 64]); }
      }
      float G = 1.f;
      float kdq[4], bbq[4], vq[4];
      bf16_t* sKK = (bf16_t*)(slot + RC_KK); bf16_t* sRR = (bf16_t*)(slot + RC_RR); bf16_t* sKD = (bf16_t*)(slot + RC_KD); bf16_t* sBB = (bf16_t*)(slot + RC_BB);
#pragma unroll
      for (int s = 0; s < 16; ++s) {
        const int o = DIR ? (15 - s) : s;
        const float inv = __int_as_float(__builtin_amdgcn_readlane(__float_as_int(invv), o));
        const float okk = kkr[o] * inv, a = aF[o], ob = okk * a, okd = kC[o] * (1.f + (a - 1.f) * kaw), w = 1.f - xwF[o];
        const float kkt = okk * G;
        G *= w;
        const float ig = __builtin_amdgcn_rcpf(G);
        const float rt = rC[o] * G, kdt = okd * ig, bt = ob * ig;
        sKK[s * 72 + pj] = f2bf(kkt); sRR[s * 72 + pj] = f2bf(rt); sKD[s * 72 + pj] = f2bf(kdt); sBB[s * 72 + pj] = f2bf(bt);
        kdq[s & 3] = kdt; bbq[s & 3] = -bt; vq[s & 3] = vC[o];
        if ((s & 3) == 3) {
          const int fi = ((lane >> 4) * 4 + (s >> 2)) * 16 + (lane & 15);
          *(uint4*)(slot + RC_KDB + fi * 16) = make_uint4(pack2(kdq[0], kdq[1]), pack2(kdq[2], kdq[3]), pack2(bbq[0], bbq[1]), pack2(bbq[2], bbq[3]));
          *(uint2*)(slot + RC_V + fi * 8) = make_uint2(pack2(vq[0], vq[1]), pack2(vq[2], vq[3]));
        }
      }
      ((float*)(slot + RC_G))[lane] = G;
      const bf16x8 aK0 = *(const bf16x8*)(sKK + cl * 72 + 8 * cq), aK1 = *(const bf16x8*)(sKK + cl * 72 + 32 + 8 * cq);
      const bf16x8 aR0 = *(const bf16x8*)(sRR + cl * 72 + 8 * cq), aR1 = *(const bf16x8*)(sRR + cl * 72 + 32 + 8 * cq);
      const bf16x8 bD0 = *(const bf16x8*)(sKD + cl * 72 + 8 * cq), bD1 = *(const bf16x8*)(sKD + cl * 72 + 32 + 8 * cq);
      const bf16x8 bB0 = *(const bf16x8*)(sBB + cl * 72 + 8 * cq), bB1 = *(const bf16x8*)(sBB + cl * 72 + 32 + 8 * cq);
      f32x4 Abk = __builtin_amdgcn_mfma_f32_16x16x32_bf16(aK0, bB0, zero4, 0, 0, 0); Abk = __builtin_amdgcn_mfma_f32_16x16x32_bf16(aK1, bB1, Abk, 0, 0, 0);
      f32x4 Avk = __builtin_amdgcn_mfma_f32_16x16x32_bf16(aK0, bD0, zero4, 0, 0, 0); Avk = __builtin_amdgcn_mfma_f32_16x16x32_bf16(aK1, bD1, Avk, 0, 0, 0);
      f32x4 Mbr = __builtin_amdgcn_mfma_f32_16x16x32_bf16(aR0, bB0, zero4, 0, 0, 0); Mbr = __builtin_amdgcn_mfma_f32_16x16x32_bf16(aR1, bB1, Mbr, 0, 0, 0);
      f32x4 Mvr = __builtin_amdgcn_mfma_f32_16x16x32_bf16(aR0, bD0, zero4, 0, 0, 0); Mvr = __builtin_amdgcn_mfma_f32_16x16x32_bf16(aR1, bD1, Mvr, 0, 0, 0);
      float* tA = (float*)(slot + RC_KD); float* tVT = tA + 256;
      bf16_t* sMM = (bf16_t*)(slot + RC_MM);
#pragma unroll
      for (int r = 0; r < 4; ++r) {
        const int t = 4 * cq + r;
        const float abk = (cl < t) ? Abk[r] : 0.f, avk = (cl < t) ? Avk[r] : 0.f, mbr = (cl <= t) ? Mbr[r] : 0.f, mvr = (cl <= t) ? Mvr[r] : 0.f;
        tA[t * 16 + cl] = abk; Avk[r] = avk;
        sMM[((cl >> 2) * 16 + t) * 8 + (cl & 3)] = f2bf(mvr); sMM[((cl >> 2) * 16 + t) * 8 + 4 + (cl & 3)] = f2bf(-mbr);
      }
      *(float4*)(tVT + cl * 16 + 4 * cq) = make_float4(Avk[0], Avk[1], Avk[2], Avk[3]);
      {
        const bool isTA = ((lane >> 4) & 1) != 0;
        float X[16];
        {
          const float4* pv = (const float4*)(tVT + cl * 16);
          const float4 r0 = pv[0], r1 = pv[1], r2 = pv[2], r3 = pv[3];
          const float rh[16] = {r0.x, r0.y, r0.z, r0.w, r1.x, r1.y, r1.z, r1.w, r2.x, r2.y, r2.z, r2.w, r3.x, r3.y, r3.z, r3.w};
#pragma unroll
          for (int t = 0; t < 16; ++t) X[t] = isTA ? rh[t] : ((t == cl) ? 1.f : 0.f);
        }
#pragma unroll
        for (int t = 1; t < 16; ++t) {
          float a = X[t];
#pragma unroll
          for (int s4 = 0; s4 * 4 < t; ++s4) {
            const float4 ar = *(const float4*)(tA + t * 16 + 4 * s4);
            if (4 * s4 + 0 < t) a = fmaf(-ar.x, X[4 * s4 + 0], a);
            if (4 * s4 + 1 < t) a = fmaf(-ar.y, X[4 * s4 + 1], a);
            if (4 * s4 + 2 < t) a = fmaf(-ar.z, X[4 * s4 + 2], a);
            if (4 * s4 + 3 < t) a = fmaf(-ar.w, X[4 * s4 + 3], a);
          }
          X[t] = a;
        }
        bf16_t* sTT = (bf16_t*)(slot + RC_TT);
        if (lane < 32) {
#pragma unroll
          for (int t = 0; t < 16; ++t) sTT[((cl >> 2) * 16 + t) * 8 + (cl & 3) + (isTA ? 4 : 0)] = f2bf(X[t]);
        }
      }
    }
    __syncthreads();
    if (batch + 1 < 18) RC_LOAD_RAW((batch + 1) * 8 + wid);
    if (wid < 4) {
      const int itile = wid;
#pragma unroll 1
      for (int k = 0; k < 8; ++k) {
        const unsigned char* sl = smem + k * RC_SLOT;
        const bf16x8 aK0 = *(const bf16x8*)(sl + RC_KK + (cl * 72 + 8 * cq) * 2), aK1 = *(const bf16x8*)(sl + RC_KK + (cl * 72 + 32 + 8 * cq) * 2);
        const bf16x8 aR0 = *(const bf16x8*)(sl + RC_RR + (cl * 72 + 8 * cq) * 2), aR1 = *(const bf16x8*)(sl + RC_RR + (cl * 72 + 32 + 8 * cq) * 2);
        const bf16x8 fTT = *(const bf16x8*)(sl + RC_TT + lane * 16), fMM = *(const bf16x8*)(sl + RC_MM + lane * 16);
        const uint2 fV = *(const uint2*)(sl + RC_V + (itile * 64 + lane) * 8);
        const bf16x8 Bs0 = rc_pack8(acc[0], acc[1]), Bs1 = rc_pack8(acc[2], acc[3]);
        f32x4 P = __builtin_amdgcn_mfma_f32_16x16x32_bf16(aK0, Bs0, zero4, 0, 0, 0); P = __builtin_amdgcn_mfma_f32_16x16x32_bf16(aK1, Bs1, P, 0, 0, 0);
        f32x4 Yv = __builtin_amdgcn_mfma_f32_16x16x32_bf16(aR0, Bs0, zero4, 0, 0, 0); Yv = __builtin_amdgcn_mfma_f32_16x16x32_bf16(aR1, Bs1, Yv, 0, 0, 0);
        const f32x4 SA = __builtin_amdgcn_mfma_f32_16x16x32_bf16(fTT, rc_pack8(P, fV), zero4, 0, 0, 0);
        const bf16x8 Bvs = rc_pack8(fV, SA);
        Yv = __builtin_amdgcn_mfma_f32_16x16x32_bf16(fMM, Bvs, Yv, 0, 0, 0);
#pragma unroll
        for (int jt = 0; jt < 4; ++jt) {
          const bf16x8 fKDB = *(const bf16x8*)(sl + RC_KDB + (jt * 64 + lane) * 16);
          const float4 g = *(const float4*)(sl + RC_G + (16 * jt + 4 * cq) * 4);
          acc[jt] = __builtin_amdgcn_mfma_f32_16x16x32_bf16(fKDB, Bvs, acc[jt], 0, 0, 0);
          acc[jt][0] *= g.x; acc[jt][1] *= g.y; acc[jt][2] *= g.z; acc[jt][3] *= g.w;
        }
        bool isctx; int seqlen, lo, rowbase; chunk_geom(batch * 8 + k, isctx, seqlen, lo, rowbase);
        if (!(l == 1 && isctx)) {
#pragma unroll
          for (int r = 0; r < 4; ++r) {
            const int t = 4 * cq + r, o = DIR ? (15 - t) : t;
            Y[(size_t)(rowbase + lo + o) * 256 + h * 64 + itile * 16 + cl] = Yv[r];
          }
        }
      }
    }
    __syncthreads();
  }
#undef RC_LDP
#undef RC_LDF
#undef RC_LOAD_RAW
}

DEVI void s5_carry_item(const Params& p, int l, int g, int b) {
  unsigned char* ws = uws(p);
  const int tid = tid_();
  if (tid >= 128) return;
  const float* HE = (const float*)((unsigned char*)uout(p) + DO_HE) + (size_t)g * NCH * 256;
  bf16_t* UDH = (bf16_t*)(ws + WS_UDH) + (size_t)g * NCH * 768;
  const int dd = tid >> 6, pp = tid & 63;
  const float2 aT = ((const float2*)(ws + WS_APOW))[((size_t)(((l * 2 + dd) * 16 + g) * 64 + pp)) * 33 + 32];
  const int off = dd * 128 + pp;
  float hr = 0.f, hi = 0.f;
  {
    float er[8], ei[8];
#pragma unroll
    for (int c = 0; c < 8; ++c) { const int n = 1024 + b * 8 + (dd ? (7 - c) : c); er[c] = HE[(size_t)n * 256 + off]; ei[c] = HE[(size_t)n * 256 + off + 64]; }
#pragma unroll
    for (int c = 0; c < 8; ++c) {
      const int n = 1024 + b * 8 + (dd ? (7 - c) : c);
      UDH[(size_t)n * 768 + 512 + off] = f2bf(hr); UDH[(size_t)n * 768 + 512 + off + 64] = f2bf(hi);
      const float nr = aT.x * hr - aT.y * hi + er[c], ni = aT.x * hi + aT.y * hr + ei[c];
      hr = nr; hi = ni;
    }
  }
#pragma unroll 1
  for (int c0 = 0; c0 < 64; c0 += 16) {
    float er[16], ei[16];
#pragma unroll
    for (int c = 0; c < 16; ++c) { const int n = b * 64 + (dd ? (63 - c0 - c) : (c0 + c)); er[c] = HE[(size_t)n * 256 + off]; ei[c] = HE[(size_t)n * 256 + off + 64]; }
#pragma unroll
    for (int c = 0; c < 16; ++c) {
      const int n = b * 64 + (dd ? (63 - c0 - c) : (c0 + c));
      UDH[(size_t)n * 768 + 512 + off] = f2bf(hr); UDH[(size_t)n * 768 + 512 + off + 64] = f2bf(hi);
      const float nr = aT.x * hr - aT.y * hi + er[c], ni = aT.x * hi + aT.y * hr + ei[c];
      hr = nr; hi = ni;
    }
  }
}

struct S5Sched {
  const bf16_t* UDH; const bf16_t* TTG; int G, c, ntile;
  DEVI bool next(int i, g8::Unit& u) const {
    const int L = i * G + c; if (L >= 16 * ntile * 2) return false;
    u.e = L / (ntile * 2); const int r = L % (ntile * 2); u.pm = r >> 1; u.pn = r & 1; return true;
  }
  DEVI const char* a_base() const { return (const char*)UDH; }
  DEVI void a_offs(const g8::Unit& u, int tid, unsigned (&ao)[2][2]) const {
#pragma unroll
    for (int i = 0; i < 2; ++i) {
      int R, C; g8::stage_rc(tid * 16 + i * 8192, R, C);
#pragma unroll
      for (int h = 0; h < 2; ++h) ao[h][i] = ((unsigned)(u.e * NCH + u.pm * 256 + h * 128 + R) * 768u + (unsigned)C) * 2u;
    }
  }
  DEVI const char* b_ptr(const g8::Unit& u) const { return (const char*)(TTG + ((size_t)u.e * 512 + (size_t)u.pn * 256) * 768); }
};
struct EpiS5 {
  static constexpr bool PERM = true;
  bf16_t* ZB;
  DEVI void operator()(const f32x4 (&acc)[2][2][4][2], const g8::Unit& u) const {
    const int tid = tid_(), wid = __builtin_amdgcn_readfirstlane(tid >> 6), lane = tid & 63, wr = wid >> 2, wc = wid & 3, fr = lane & 15, fq = lane >> 4;
#pragma unroll
    for (int ai = 0; ai < 2; ++ai)
#pragma unroll
      for (int m = 0; m < 4; ++m) {
        const int n = u.pm * 256 + ai * 128 + wr * 64 + m * 16 + fr;
        if (n < NCH) {
#pragma unroll
          for (int bj = 0; bj < 2; ++bj) {
            const int mc = u.pn * 256 + bj * 128 + wc * 32 + 8 * fq, tau = mc >> 4, c = mc & 15;
            const f32x4 v0 = acc[ai][bj][m][0], v1 = acc[ai][bj][m][1];
            *(uint4*)(ZB + ((size_t)n * 32 + tau) * 256 + u.e * 16 + c) = make_uint4(pack2(gelu_tanh(v0[0]), gelu_tanh(v0[1])), pack2(gelu_tanh(v0[2]), gelu_tanh(v0[3])),
                                                                                   pack2(gelu_tanh(v1[0]), gelu_tanh(v1[1])), pack2(gelu_tanh(v1[2]), gelu_tanh(v1[3])));
          }
        }
        asm volatile("" ::: "memory");
      }
  }
};

DEVI void attn_item(const Params& p, int l, int b, int qb, int hq, unsigned char* smem) {
  unsigned char* ws = uws(p);
  const bf16_t* PROJ = (const bf16_t*)(ws + WS_PROJ);
  bf16_t* YMIX = (bf16_t*)(ws + WS_YMIX);
  bf16_t* sKV = (bf16_t*)smem;
  const int tid = tid_(), lane = tid & 63, wid = tid >> 6, r = lane & 31, hh = lane >> 5;
  const int kvh = hq >> 2;
  const bool ctxq = qb < 0;
  const int qrow0 = ctxq ? (NLAT + b * CTXL + wid * 32) : (b * SEQ + qb * 256 + wid * 32);
  const int q0pos = qb * 256 + wid * 32;
  bf16x8 qf[4];
  {
    const bf16_t* qp = PROJ + (size_t)(qrow0 + r) * DIN + 1280 + hq * 64 + hh * 8;
#pragma unroll
    for (int ks = 0; ks < 4; ++ks) qf[ks] = *(const bf16x8*)(qp + ks * 16);
  }
  f32x16 O0, O1;
#pragma unroll
  for (int i = 0; i < 16; ++i) { O0[i] = 0.f; O1[i] = 0.f; }
  float mrun = uin(p, I_SINK)[l * 8 + hq];
  float lsum = (hh == 0) ? 1.f : 0.f;
  const int jlo = ctxq ? 0 : (qb == 0 ? 2 : 0), jhi = ctxq ? 0 : (qb == 7 ? 6 : 8);
  const int nchunk = 4 + (jhi - jlo);
  const int nstage = (nchunk + 2) / 3;
  const int skey = tid >> 3, spc = (tid & 7) * 8;
  auto chunk_row0 = [&](int c) { return c < 4 ? (NLAT + b * CTXL + c * 64) : (b * SEQ + qb * 256 - 128 + (jlo + c - 4) * 64); };
  uint4 kr0, kr1, kr2, vr0, vr1, vr2;
  kr0 = kr1 = kr2 = vr0 = vr1 = vr2 = make_uint4(0, 0, 0, 0);
#define ATT_LOAD1(j, KR, VR, st_) do { const int c_ = (st_) * 3 + (j); if (c_ < nchunk) { \
    const bf16_t* kp_ = PROJ + (size_t)(chunk_row0(c_) + skey) * DIN + 1792 + kvh * 64 + spc; KR = *(const uint4*)kp_; VR = *(const uint4*)(kp_ + 128); } } while (0)
#define ATT_LOAD_STAGE(st_) do { ATT_LOAD1(0, kr0, vr0, st_); ATT_LOAD1(1, kr1, vr1, st_); ATT_LOAD1(2, kr2, vr2, st_); } while (0)
#define ATT_WRITE1(j, KR, VR) do { if (st * 3 + (j) < nchunk) { bf16_t* sKb_ = sB + (j) * (2 * 64 * 72); bf16_t* sVb_ = sKb_ + 64 * 72; \
    *(uint4*)(sKb_ + skey * 72 + spc) = KR; \
    sVb_[(spc + 0) * 72 + skey] = (bf16_t)(VR.x & 0xFFFF); sVb_[(spc + 1) * 72 + skey] = (bf16_t)(VR.x >> 16); \
    sVb_[(spc + 2) * 72 + skey] = (bf16_t)(VR.y & 0xFFFF); sVb_[(spc + 3) * 72 + skey] = (bf16_t)(VR.y >> 16); \
    sVb_[(spc + 4) * 72 + skey] = (bf16_t)(VR.z & 0xFFFF); sVb_[(spc + 5) * 72 + skey] = (bf16_t)(VR.z >> 16); \
    sVb_[(spc + 6) * 72 + skey] = (bf16_t)(VR.w & 0xFFFF); sVb_[(spc + 7) * 72 + skey] = (bf16_t)(VR.w >> 16); } } while (0)
  ATT_LOAD_STAGE(0);
  int buf = 0;
  for (int st = 0; st < nstage; ++st) {
    bf16_t* sB = sKV + buf * (6 * 64 * 72);
    ATT_WRITE1(0, kr0, vr0); ATT_WRITE1(1, kr1, vr1); ATT_WRITE1(2, kr2, vr2);
    __syncthreads();
    if (st + 1 < nstage) ATT_LOAD_STAGE(st + 1);
#pragma unroll 1
    for (int j = 0; j < 3; ++j) {
      const int c = st * 3 + j;
      if (c >= nchunk) break;
      const bf16_t* sKb = sB + j * (2 * 64 * 72); const bf16_t* sVb = sKb + 64 * 72;
      const bool band = c >= 4;
      const int kstart = band ? (qb * 256 - 128 + (jlo + c - 4) * 64) : 0;
      bool need0 = true, full0 = true, need1 = true, full1 = true;
      if (band) {
        need0 = (kstart + 31 >= q0pos - 128) && (kstart <= q0pos + 31 + 128);
        full0 = (kstart >= q0pos + 31 - 128) && (kstart + 31 <= q0pos + 128);
        need1 = (kstart + 63 >= q0pos - 128) && (kstart + 32 <= q0pos + 31 + 128);
        full1 = (kstart + 32 >= q0pos + 31 - 128) && (kstart + 63 <= q0pos + 128);
      }
      auto qk_tile = [&](int tt, f32x16& S) __attribute__((always_inline)) {
#pragma unroll
        for (int i = 0; i < 16; ++i) S[i] = 0.f;
#pragma unroll
        for (int ks = 0; ks < 4; ++ks) {
          const bf16x8 kf = *(const bf16x8*)(sKb + (tt * 32 + r) * 72 + ks * 16 + hh * 8);
          S = __builtin_amdgcn_mfma_f32_32x32x16_bf16(kf, qf[ks], S, 0, 0, 0);
        }
      };
      auto mask_tile = [&](int tt, f32x16& S) __attribute__((always_inline)) {
        const int ts = kstart + tt * 32;
#pragma unroll
        for (int i = 0; i < 16; ++i) {
          const int kpos = ts + (i & 3) + 8 * (i >> 2) + 4 * hh;
          const int dl = (q0pos + r) - kpos;
          if (dl > 128 || dl < -128) S[i] = -1e30f;
        }
      };
      auto pv_tile = [&](int tt, const f32x16& S) __attribute__((always_inline)) {
        bf16x8 pf[2];
#pragma unroll
        for (int s2 = 0; s2 < 2; ++s2) {
          const uint4 u = make_uint4(pack2(S[8 * s2], S[8 * s2 + 1]), pack2(S[8 * s2 + 2], S[8 * s2 + 3]), pack2(S[8 * s2 + 4], S[8 * s2 + 5]), pack2(S[8 * s2 + 6], S[8 * s2 + 7]));
          pf[s2] = __builtin_bit_cast(bf16x8, u);
        }
#pragma unroll
        for (int s2 = 0; s2 < 2; ++s2) {
          {
            const bf16_t* vp = sVb + (0 * 32 + r) * 72 + tt * 32 + 16 * s2 + 4 * hh;
            const uint2 lo = *(const uint2*)vp, hi = *(const uint2*)(vp + 8);
            const uint4 u = make_uint4(lo.x, lo.y, hi.x, hi.y);
            O0 = __builtin_amdgcn_mfma_f32_32x32x16_bf16(__builtin_bit_cast(bf16x8, u), pf[s2], O0, 0, 0, 0);
          }
          {
            const bf16_t* vp = sVb + (1 * 32 + r) * 72 + tt * 32 + 16 * s2 + 4 * hh;
            const uint2 lo = *(const uint2*)vp, hi = *(const uint2*)(vp + 8);
            const uint4 u = make_uint4(lo.x, lo.y, hi.x, hi.y);
            O1 = __builtin_amdgcn_mfma_f32_32x32x16_bf16(__builtin_bit_cast(bf16x8, u), pf[s2], O1, 0, 0, 0);
          }
        }
      };
      if (need0 && need1) {
        f32x16 S0, S1;
        qk_tile(0, S0); qk_tile(1, S1);
        if (!full0) mask_tile(0, S0);
        if (!full1) mask_tile(1, S1);
        float mx = fmaxf(S0[0], S1[0]);
#pragma unroll
        for (int i = 1; i < 16; ++i) mx = fmaxf(mx, fmaxf(S0[i], S1[i]));
        mx = fmaxf(mx, __shfl_xor(mx, 32));
        const float mnew = fmaxf(mrun, mx);
        const float alpha = __expf(mrun - mnew);
        mrun = mnew;
        float ps = 0.f;
#pragma unroll
        for (int i = 0; i < 16; ++i) { S0[i] = __expf(S0[i] - mnew); S1[i] = __expf(S1[i] - mnew); ps += S0[i] + S1[i]; }
        lsum = lsum * alpha + ps;
#pragma unroll
        for (int i = 0; i < 16; ++i) { O0[i] *= alpha; O1[i] *= alpha; }
        pv_tile(0, S0); pv_tile(1, S1);
      } else if (need0 || need1) {
        const int tt = need0 ? 0 : 1;
        const bool full = need0 ? full0 : full1;
        f32x16 S;
        qk_tile(tt, S);
        if (!full) mask_tile(tt, S);
        float mx = S[0];
#pragma unroll
        for (int i = 1; i < 16; ++i) mx = fmaxf(mx, S[i]);
        mx = fmaxf(mx, __shfl_xor(mx, 32));
        const float mnew = fmaxf(mrun, mx);
        const float alpha = __expf(mrun - mnew);
        mrun = mnew;
        float ps = 0.f;
#pragma unroll
        for (int i = 0; i < 16; ++i) { S[i] = __expf(S[i] - mnew); ps += S[i]; }
        lsum = lsum * alpha + ps;
#pragma unroll
        for (int i = 0; i < 16; ++i) { O0[i] *= alpha; O1[i] *= alpha; }
        pv_tile(tt, S);
      }
    }
    buf ^= 1;
  }
  const float lt = lsum + __shfl_xor(lsum, 32);
  const float inv = 1.f / lt;
  bf16_t* op = YMIX + (size_t)(qrow0 + r) * D + 512 + hq * 64 + 4 * hh;
#pragma unroll
  for (int g4 = 0; g4 < 4; ++g4) {
    uint2 o; o.x = pack2(O0[4 * g4] * inv, O0[4 * g4 + 1] * inv); o.y = pack2(O0[4 * g4 + 2] * inv, O0[4 * g4 + 3] * inv);
    *(uint2*)(op + 8 * g4) = o;
    uint2 o1; o1.x = pack2(O1[4 * g4] * inv, O1[4 * g4 + 1] * inv); o1.y = pack2(O1[4 * g4 + 2] * inv, O1[4 * g4 + 3] * inv);
    *(uint2*)(op + 32 + 8 * g4) = o1;
  }
  __syncthreads();
}

DEVI void phase_mixers(const Params& p, int l, unsigned char* smem) {
  const int bid = bid_(), G = gridDim.x;
  const int nsb = (G >> 4) * 8 + ((G & 15) < 8 ? (G & 15) : 8);
  if (((bid >> 3) & 1) == 0) {
    for (int it = (bid >> 4) * 8 + (bid & 7); it < 128; it += nsb) { if (it & 1) rwkv_chunked<1>(p, l, it, smem); else rwkv_chunked<0>(p, l, it, smem); }
  }
  const int n_attn = (l == 0) ? 1152 : 1024, nq = 256 + n_attn;
  int* ctr = (int*)(uws(p) + WS_CTL) + 64 + l;
  volatile int* sTick = (volatile int*)(smem + SMEM_BYTES - 16);
  const int tid = tid_();
  __syncthreads();
  if (tid == 0) sTick[0] = atomicAdd(ctr, 1);
  __syncthreads();
  int cur = sTick[0];
  while (cur < nq) {
    int nxt = 0;
    if (tid == 0) nxt = atomicAdd(ctr, 1);
    if (cur < 256) s5_carry_item(p, l, cur >> 4, cur & 15);
    else {
      const int a = cur - 256;
      if (a < 1024) attn_item(p, l, a >> 6, (a >> 3) & 7, a & 7, smem);
      else attn_item(p, l, (a - 1024) >> 3, -1, (a - 1024) & 7, smem);
    }
    __syncthreads();
    if (tid == 0) sTick[0] = nxt;
    __syncthreads();
    cur = sTick[0];
  }
}

DEVI void phase_mixfin(const Params& p, int l, unsigned char* smem) {
  unsigned char* ws = uws(p);
  const int tid = tid_(), bid = bid_(), G = gridDim.x;
  bf16_t* YMIX = (bf16_t*)(ws + WS_YMIX);
  {
    S5Sched S{(const bf16_t*)(ws + WS_UDH), (const bf16_t*)(ws + WS_TTG) + (size_t)l * 16 * 512 * 768, G, bid, (l == 1) ? 4 : 5};
    EpiS5 E{(bf16_t*)((unsigned char*)uout(p) + DO_ZB)};
    __syncthreads();
    g8::gemm((G8_LAS unsigned char*)smem, 768, S, E);
    __syncthreads();
  }
  {
    const bf16_t* PROJ = (const bf16_t*)(ws + WS_PROJ);
    const unsigned short* FEAT = (const unsigned short*)(ws + WS_FEAT);
    const float* YF = (const float*)((unsigned char*)uout(p) + DO_YF); const float* YB = (const float*)((unsigned char*)uout(p) + DO_YB);
    const float* CW = uin(p, I_CONV) + l * 3 * 1024;
    const int c4 = (tid & 15) * 4;
    const int nbusy = (16 * ((l == 1) ? 4 : 5) * 2 < G) ? 16 * ((l == 1) ? 4 : 5) * 2 : G;
    const int nvirt = nbusy + 2 * (G - nbusy);
    const int ustride = (nvirt * NTHREADS) >> 4;
    const int nun = ((l == 1) ? NLAT : NT) * 4;
    const int vb0 = (bid < nbusy) ? bid : nbusy + 2 * (bid - nbusy);
    const int u0 = (vb0 * NTHREADS + tid) >> 4;
    const int h = u0 & 3, hc = h * 64 + c4;
    float cwr[3][4], cwk[3][4], cwv[3][4], kaw[4], rkw[4], gnw[4], gnb[4];
#pragma unroll
    for (int dl = 0; dl < 3; ++dl)
#pragma unroll
      for (int e = 0; e < 4; ++e) { cwr[dl][e] = CW[dl * 1024 + hc + e]; cwk[dl][e] = CW[dl * 1024 + 256 + hc + e]; cwv[dl][e] = CW[dl * 1024 + 512 + hc + e]; }
#pragma unroll
    for (int e = 0; e < 4; ++e) { kaw[e] = uin(p, I_KA)[l * 256 + hc + e]; rkw[e] = uin(p, I_RK)[l * 256 + hc + e]; gnw[e] = uin(p, I_GNW)[l * 256 + hc + e]; gnb[e] = uin(p, I_GNB)[l * 256 + hc + e]; }
    for (int pass = 0; pass < ((bid < nbusy) ? 1 : 2); ++pass)
    for (int u = u0 + pass * 32; u < nun; u += ustride) {
      const int R = u >> 2;
      const int t = R < NLAT ? (R & 2047) : ((R - NLAT) & 255); const int len = R < NLAT ? SEQ : CTXL;
      const float4 yf = *(const float4*)(YF + (size_t)R * 256 + hc), yb = *(const float4*)(YB + (size_t)R * 256 + hc);
      float y[4] = {yf.x + yb.x, yf.y + yb.y, yf.z + yb.z, yf.w + yb.w};
      const float mu = row_sum16(y[0] + y[1] + y[2] + y[3]) * (1.f / 64.f);
      float q = 0.f;
#pragma unroll
      for (int e = 0; e < 4; ++e) { y[e] -= mu; q += y[e] * y[e]; }
      const float rstd = rsqrtf(row_sum16(q) * (1.f / 64.f) + GN_EPS);
      const bf16_t* pr = PROJ + (size_t)R * DIN + hc;
      const uint2 zc = make_uint2(0, 0);
      const uint2 rc = *(const uint2*)pr, kc = *(const uint2*)(pr + 256), vc = *(const uint2*)(pr + 512);
      uint2 rp = zc, kp = zc, vp = zc, rn = zc, kn = zc, vn = zc;
      if (t > 0) { rp = *(const uint2*)(pr - DIN); kp = *(const uint2*)(pr - DIN + 256); vp = *(const uint2*)(pr - DIN + 512); }
      if (t < len - 1) { rn = *(const uint2*)(pr + DIN); kn = *(const uint2*)(pr + DIN + 256); vn = *(const uint2*)(pr + DIN + 512); }
      const float rpf[4] = {lo_bf(rp.x), hi_bf(rp.x), lo_bf(rp.y), hi_bf(rp.y)}, rcf[4] = {lo_bf(rc.x), hi_bf(rc.x), lo_bf(rc.y), hi_bf(rc.y)}, rnf[4] = {lo_bf(rn.x), hi_bf(rn.x), lo_bf(rn.y), hi_bf(rn.y)};
      const float kpf[4] = {lo_bf(kp.x), hi_bf(kp.x), lo_bf(kp.y), hi_bf(kp.y)}, kcf[4] = {lo_bf(kc.x), hi_bf(kc.x), lo_bf(kc.y), hi_bf(kc.y)}, knf[4] = {lo_bf(kn.x), hi_bf(kn.x), lo_bf(kn.y), hi_bf(kn.y)};
      const float vpf[4] = {lo_bf(vp.x), hi_bf(vp.x), lo_bf(vp.y), hi_bf(vp.y)}, vcf[4] = {lo_bf(vc.x), hi_bf(vc.x), lo_bf(vc.y), hi_bf(vc.y)}, vnf[4] = {lo_bf(vn.x), hi_bf(vn.x), lo_bf(vn.y), hi_bf(vn.y)};
      const unsigned short* fr_ = FEAT + (size_t)R * 1280 + hc;
      const uint2 a0u = *(const uint2*)(fr_ + 512), a1u = *(const uint2*)(fr_ + 768), gtu = *(const uint2*)(fr_ + 1024);
      const float a0[4] = {h2f(a0u.x & 0xFFFF), h2f(a0u.x >> 16), h2f(a0u.y & 0xFFFF), h2f(a0u.y >> 16)};
      const float a1[4] = {h2f(a1u.x & 0xFFFF), h2f(a1u.x >> 16), h2f(a1u.y & 0xFFFF), h2f(a1u.y >> 16)};
      const float gt[4] = {h2f(gtu.x & 0xFFFF), h2f(gtu.x >> 16), h2f(gtu.y & 0xFFFF), h2f(gtu.y >> 16)};
      float bs = 0.f, vv[4];
#pragma unroll
      for (int e = 0; e < 4; ++e) {
        const float r = cwr[0][e] * rpf[e] + cwr[1][e] * rcf[e] + cwr[2][e] * rnf[e];
        const float k = cwk[0][e] * kpf[e] + cwk[1][e] * kcf[e] + cwk[2][e] * knf[e];
        vv[e] = cwv[0][e] * vpf[e] + cwv[1][e] * vcf[e] + cwv[2][e] * vnf[e];
        const float ksum = k * (2.f + (a0[e] + a1[e] - 2.f) * kaw[e]);
        bs += r * ksum * rkw[e];
      }
      bs = row_sum16(bs);
      float o[4];
#pragma unroll
      for (int e = 0; e < 4; ++e) {
        const float yn = y[e] * rstd * gnw[e] + gnb[e];
        o[e] = (yn + bs * vv[e]) * gt[e];
      }
      uint2 w; w.x = pack2(o[0], o[1]); w.y = pack2(o[2], o[3]);
      *(uint2*)(YMIX + (size_t)R * D + hc) = w;
    }
  }
}

struct EpiGlu {
  static constexpr bool PERM = true;
  const bf16_t* ZB; bf16_t* YMIX; const float* gb;
  DEVI void operator()(const f32x4 (&acc)[2][2][4][2], const g8::Unit& u) const {
    const int tid = tid_(), wid = __builtin_amdgcn_readfirstlane(tid >> 6), lane = tid & 63, wr = wid >> 2, wc = wid & 3, fr = lane & 15, fq = lane >> 4;
#pragma unroll
    for (int ai = 0; ai < 2; ++ai)
#pragma unroll
      for (int m = 0; m < 4; ++m) {
        const int row = u.pm * 256 + ai * 128 + wr * 64 + m * 16 + fr;
#pragma unroll
        for (int bj = 0; bj < 2; ++bj) {
          const int col = bj * 128 + wc * 32 + 8 * fq;
          const uint4 zz = *(const uint4*)(ZB + (size_t)row * 256 + col);
          const float4 b0 = *(const float4*)(gb + col), b1 = *(const float4*)(gb + col + 4);
          const f32x4 v0 = acc[ai][bj][m][0], v1 = acc[ai][bj][m][1];
          *(uint4*)(YMIX + (size_t)row * D + 256 + col) = make_uint4(
            pack2(lo_bf(zz.x) * sigmoidf(v0[0] + b0.x), hi_bf(zz.x) * sigmoidf(v0[1] + b0.y)), pack2(lo_bf(zz.y) * sigmoidf(v0[2] + b0.z), hi_bf(zz.y) * sigmoidf(v0[3] + b0.w)),
            pack2(lo_bf(zz.z) * sigmoidf(v1[0] + b1.x), hi_bf(zz.z) * sigmoidf(v1[1] + b1.y)), pack2(lo_bf(zz.w) * sigmoidf(v1[2] + b1.z), hi_bf(zz.w) * sigmoidf(v1[3] + b1.w)));
        }
        asm volatile("" ::: "memory");
      }
  }
};
DEVI void phase_glu(const Params& p, int l, unsigned char* smem) {
  unsigned char* ws = uws(p);
  g8::DenseSched S{(const bf16_t*)((unsigned char*)uout(p) + DO_ZB), (const bf16_t*)(ws + WS_GLU_T) + (size_t)l * 65536, 256, (l == 1) ? 128 : 144, 1, (int)gridDim.x, bid_()};
  EpiGlu E{(const bf16_t*)((unsigned char*)uout(p) + DO_ZB), (bf16_t*)(ws + WS_YMIX), uin(p, I_GLUB) + l * 256};
  __syncthreads();
  g8::gemm((G8_LAS unsigned char*)smem, 256, S, E);
  __syncthreads();
}

struct EpiBf16 {
  static constexpr bool PERM = true;
  bf16_t* O; int ldc;
  DEVI void operator()(const f32x4 (&acc)[2][2][4][2], const g8::Unit& u) const {
    const int tid = tid_(), wid = __builtin_amdgcn_readfirstlane(tid >> 6), lane = tid & 63, wr = wid >> 2, wc = wid & 3, fr = lane & 15, fq = lane >> 4;
#pragma unroll
    for (int ai = 0; ai < 2; ++ai)
#pragma unroll
      for (int m = 0; m < 4; ++m) {
        bf16_t* rowp = O + (size_t)(u.pm * 256 + ai * 128 + wr * 64 + m * 16 + fr) * ldc + u.pn * 256 + wc * 32 + 8 * fq;
#pragma unroll
        for (int bj = 0; bj < 2; ++bj) {
          const f32x4 v0 = acc[ai][bj][m][0], v1 = acc[ai][bj][m][1];
          *(uint4*)(rowp + bj * 128) = make_uint4(pack2(v0[0], v0[1]), pack2(v0[2], v0[3]), pack2(v1[0], v1[1]), pack2(v1[2], v1[3]));
        }
      }
  }
};
DEVI void phase_outproj(const Params& p, int l, unsigned char* smem) {
  unsigned char* ws = uws(p);
  g8::DenseSched S{(const bf16_t*)(ws + WS_YMIX), (const bf16_t*)(ws + WS_WOUT_T) + (size_t)l * D * D, D, (l == 1) ? 128 : 144, 4, (int)gridDim.x, bid_()};
  EpiBf16 E{(bf16_t*)(ws + WS_MIX), D};
  __syncthreads();
  g8::gemm((G8_LAS unsigned char*)smem, D, S, E);
  __syncthreads();
}

DEVI void phase_ln1(const Params& p, int l, unsigned char* smem) {
  unsigned char* ws = uws(p);
  const int tid = tid_(), lane = tid & 63, wid = tid >> 6;
  const bf16_t* MIX = (const bf16_t*)(ws + WS_MIX);
  _Float16* X = (_Float16*)(ws + WS_X);
  bf16_t* H = (bf16_t*)(ws + WS_H);
  const float* MOD = (const float*)(ws + WS_MOD);
  const int nrows1 = (l == 1) ? NLAT : NT;
  const int nw = gridDim.x * 8, gw = bid_() * 8 + wid;
  const int rpw = (nrows1 + nw - 1) / nw;
  const int R0 = gw * rpw, R1 = (R0 + rpw < nrows1) ? (R0 + rpw) : nrows1;
  const int c0 = lane * 8, c1 = 512 + lane * 8;
  float g[2][8], bb[2][8], gt[2][8], sh[2][8], sc[2][8];
  ld8f(uin(p, I_LN1G) + l * D + c0, g[0]); ld8f(uin(p, I_LN1G) + l * D + c1, g[1]);
  ld8f(uin(p, I_LN1B) + l * D + c0, bb[0]); ld8f(uin(p, I_LN1B) + l * D + c1, bb[1]);
  int curb = -1;
  float xv[2][8], mx[2][8];
  auto load_row = [&](int Rr, float (&xo)[2][8], float (&mo)[2][8]) {
    if (l == 0) { const float* xr = xin_row(p, Rr); ld8f(xr + c0, xo[0]); ld8f(xr + c1, xo[1]); }
    else { const _Float16* xr = X + (size_t)Rr * D; ld8h(xr + c0, xo[0]); ld8h(xr + c1, xo[1]); }
    ld8b(MIX + (size_t)Rr * D + c0, mo[0]); ld8b(MIX + (size_t)Rr * D + c1, mo[1]);
  };
  if (R0 < R1) load_row(R0, xv, mx);
  for (int R = R0; R < R1; ++R) {
    float xn[2][8], mn[2][8];
#pragma unroll
    for (int h = 0; h < 2; ++h)
#pragma unroll
      for (int e = 0; e < 8; ++e) { xn[h][e] = 0.f; mn[h][e] = 0.f; }
    if (R + 1 < R1) load_row(R + 1, xn, mn);
    const int bi = bidx_of(R);
    if (bi != curb) {
      curb = bi;
      const float* modl = MOD + (size_t)(l * 17 + bi) * 6144;
      ld8f(modl + 2048 + c0, gt[0]); ld8f(modl + 2048 + c1, gt[1]);
      ld8f(modl + 3072 + c0, sh[0]); ld8f(modl + 3072 + c1, sh[1]);
      ld8f(modl + 4096 + c0, sc[0]); ld8f(modl + 4096 + c1, sc[1]);
    }
    float v[2][8]; float s = 0.f;
#pragma unroll
    for (int h = 0; h < 2; ++h)
#pragma unroll
      for (int e = 0; e < 8; ++e) { v[h][e] = ALPHA * xv[h][e] + gt[h][e] * mx[h][e]; s += v[h][e]; }
    const float mu = wave_sum(s) * (1.f / 1024.f);
    float q = 0.f;
#pragma unroll
    for (int h = 0; h < 2; ++h)
#pragma unroll
      for (int e = 0; e < 8; ++e) { v[h][e] -= mu; q += v[h][e] * v[h][e]; }
    const float rstd = rsqrtf(wave_sum(q) * (1.f / 1024.f) + LN_EPS);
#pragma unroll
    for (int h = 0; h < 2; ++h) {
      float x1[8], hm[8];
#pragma unroll
      for (int e = 0; e < 8; ++e) { x1[e] = v[h][e] * rstd * g[h][e] + bb[h][e]; hm[e] = x1[e] * (1.f + sc[h][e]) + sh[h][e]; }
      st8h(X + (size_t)R * D + (h ? c1 : c0), x1);
      st8b(H + (size_t)R * D + (h ? c1 : c0), hm);
    }
#pragma unroll
    for (int h = 0; h < 2; ++h)
#pragma unroll
      for (int e = 0; e < 8; ++e) { xv[h][e] = xn[h][e]; mx[h][e] = mn[h][e]; }
  }
}

DEVI void phase_router(const Params& p, int l, unsigned char* smem) {
  unsigned char* ws = uws(p);
  const int tid = tid_(), lrow = tid >> 2;
  const bf16_t* H = (const bf16_t*)(ws + WS_H);
  const bf16_t* RWH = (const bf16_t*)(ws + WS_RW) + (size_t)l * 2 * 128 * 1024;
  int* CNT = (int*)(ws + WS_CTL) + l * 32;
  int* LIST = (int*)(ws + WS_LIST);
  int4* ROUTE = (int4*)(ws + WS_ROUTE);
  float2* RWT = (float2*)(ws + WS_RWT);
  bf16_t* EW1 = (bf16_t*)(ws + WS_EW); bf16_t* EW2 = EW1 + (size_t)32 * 1024 * 1024;
  constexpr int N_CONV = 32 * 96;
  const int nmt = (l == 1) ? 128 : 144;
  for (int it0 = bid_(); it0 < nmt; it0 += gridDim.x) {
    {
      const int mt = it0;
      const bf16_t* a0 = H + (size_t)(mt * 256 + lrow) * D; const bf16_t* a1 = a0 + (size_t)128 * D;
      const bf16_t* b0 = RWH + (size_t)lrow * 1024;
      gemm_tile(smem, 0, D,
        [&](int i, int k) { return *(const uint4*)((i ? a1 : a0) + k); },
        [&](int k) { return *(const uint4*)(b0 + k); },
        [&](f32x4 (&acc)[4][4], int wr, int wc, int fr, int fq) {
          float* sLog = (float*)smem;
          if (wc == 0) {
#pragma unroll
            for (int m = 0; m < 4; ++m)
#pragma unroll
              for (int n = 0; n < 3; ++n)
#pragma unroll
                for (int j = 0; j < 4; ++j) { const int col = n * 16 + fq * 4 + j; if (col < 36) sLog[(wr * 64 + m * 16 + fr) * 37 + col] = acc[m][n][j]; }
          }
        });
      int* sHist = (int*)(smem + 40960); int* sBase = sHist + 32;
      if (tid < 32) sHist[tid] = 0;
      __syncthreads();
      int e1 = 0, e2 = 0, lp1 = 0, lp2 = 0; float w1 = 0.f, w2 = 0.f;
      if (tid < 256) {
        const float* lg = (const float*)smem + tid * 37;
        float gl[4]; int gi = 0; float gmax;
#pragma unroll
        for (int i = 0; i < 4; ++i) gl[i] = lg[i] + uin(p, I_RGB)[l * 4 + i];
        gmax = gl[0];
#pragma unroll
        for (int i = 1; i < 4; ++i) if (gl[i] > gmax) { gmax = gl[i]; gi = i; }
        float gs = 0.f;
#pragma unroll
        for (int i = 0; i < 4; ++i) gs += expf(gl[i] - gmax);
        const float gprob = 1.f / gs;
        float el[8];
#pragma unroll
        for (int j = 0; j < 8; ++j) el[j] = lg[4 + gi * 8 + j] + uin(p, I_REB)[l * 32 + gi * 8 + j];
        int i1 = 0; float l1 = el[0];
#pragma unroll
        for (int j = 1; j < 8; ++j) if (el[j] > l1) { l1 = el[j]; i1 = j; }
        int i2 = (i1 == 0) ? 1 : 0; float l2 = -3.0e38f;
#pragma unroll
        for (int j = 0; j < 8; ++j) if (j != i1 && el[j] > l2) { l2 = el[j]; i2 = j; }
        const float ex = expf(l2 - l1);
        w1 = gprob / (1.f + ex); w2 = gprob * ex / (1.f + ex);
        e1 = gi * 8 + i1; e2 = gi * 8 + i2;
        lp1 = atomicAdd(&sHist[e1], 1); lp2 = atomicAdd(&sHist[e2], 1);
      }
      __syncthreads();
      if (tid < 32) sBase[tid] = atomicAdd(&CNT[tid], sHist[tid]);
      __syncthreads();
      if (tid < 256) {
        const int R = mt * 256 + tid;
        const int p1 = sBase[e1] + lp1, p2 = sBase[e2] + lp2;
        LIST[(size_t)e1 * NT + p1] = R; LIST[(size_t)e2 * NT + p2] = R;
        ROUTE[R] = make_int4(e1, p1, e2, p2);
        RWT[R] = make_float2(w1, w2);
      }
      __syncthreads();
    }
  }
  {
    auto conv_src = [&](int j, const float*& src, int& ld, int& k0, int& n0) {
      const int e = j / 96, r = j % 96;
      if (r < 64) { const int kt = r >> 2, ct = r & 3, up = ct >> 1; src = (up ? uin(p, I_EWU) : uin(p, I_EWG)) + (size_t)(l * 32 + e) * 1024 * 512; ld = 512; k0 = kt * 64; n0 = (ct & 1) * 256; }
      else { const int r2 = r - 64, kt = r2 >> 2, ntl = r2 & 3; src = uin(p, I_EWD) + (size_t)(l * 32 + e) * 512 * 1024; ld = 1024; k0 = kt * 64; n0 = ntl * 256; }
    };
    const int G = gridDim.x;
    int j = bid_();
    TrRegs cur, nxt;
    const float* src; int ld, k0, n0;
    if (j < N_CONV) { conv_src(j, src, ld, k0, n0); transpose_load(cur, src, ld, k0, n0); }
    while (j < N_CONV) {
      int jn;
      if (j < 8 * G) { jn = j + G; if (jn >= 8 * G) jn = (bid_() >= nmt) ? (8 * G + bid_() - nmt) : N_CONV; }
      else jn = j + (G - nmt);
      if (jn < N_CONV) { const float* s2; int ld2, k2, n2; conv_src(jn, s2, ld2, k2, n2); transpose_load(nxt, s2, ld2, k2, n2); }
      const int e = j / 96, r = j % 96;
      if (r < 64) {
        const int kt = r >> 2, ct = r & 3, up = ct >> 1;
        transpose_finish(smem, cur, kt * 64, (ct & 1) * 256, EW1 + (size_t)e * 1024 * 1024, 1024,
          [&](int c) { return 256 * (c >> 7) + 128 * ((c >> 6) & 1) + 32 * ((c >> 4) & 3) + 16 * up + (c & 15); });
      } else {
        const int r2 = r - 64, kt = r2 >> 2, ntl = r2 & 3;
        transpose_finish(smem, cur, kt * 64, ntl * 256, EW2 + (size_t)e * 1024 * 512, 512, [](int n) { return n; });
      }
      cur = nxt; j = jn;
    }
  }
}

DEVI void moe_prefix(const Params& p, int l, int* sPre, int* sCnt) {
  const int* CNT = (const int*)(uws(p) + WS_CTL) + l * 32;
  if (tid_() == 0) {
    int s = 0;
    for (int e = 0; e < 32; ++e) { const int c = CNT[e]; sCnt[e] = c; sPre[e] = s; s += (c + 255) >> 8; }
    sPre[32] = s;
  }
  __syncthreads();
  {
    unsigned char* sBlkE = (unsigned char*)sPre + (MISC_BLKE - MISC_PRE);
    const int nb = sPre[32];
    for (int rb = tid_(); rb < nb; rb += NTHREADS) { int e = 0; for (int q = 1; q < 32; ++q) if (sPre[q] <= rb) e = q; sBlkE[rb] = (unsigned char)e; }
  }
  __syncthreads();
}

struct MoeSched {
  const int* sPre; const int* sCnt; const unsigned char* sBlkE; const bf16_t* Abase; const int* LIST; const bf16_t* Wbase; int K; size_t wstride; int nN, G, c, gather;
  DEVI bool next(int i, g8::Unit& u) const {
    const int nwg = sPre[32] * nN; const long L = (long)i * G + c; if (L >= nwg) return false;
    const int w = g8::xcd_remap((int)L, nwg);
    u.pm = w / nN; u.pn = w % nN;
    u.e = sBlkE[u.pm]; return true;
  }
  DEVI const char* a_base() const { return (const char*)Abase; }
  DEVI void a_offs(const g8::Unit& u, int tid, unsigned (&ao)[2][2]) const {
#pragma unroll
    for (int i = 0; i < 2; ++i) {
      int R, C; g8::stage_rc(tid * 16 + i * 8192, R, C);
#pragma unroll
      for (int h = 0; h < 2; ++h) {
        int row = u.pm * 256 + h * 128 + R;
        if (gather) {
          const int sl = (u.pm - sPre[u.e]) * 256 + h * 128 + R;
          row = LIST[(size_t)u.e * NT + (sl < sCnt[u.e] ? sl : 0)];
        }
        ao[h][i] = ((unsigned)row * (unsigned)K + (unsigned)C) * 2u;
      }
    }
  }
  DEVI const char* b_ptr(const g8::Unit& u) const { return (const char*)(Wbase + (size_t)u.e * wstride + (size_t)u.pn * 256 * K); }
};
struct EpiMoe1 {
  static constexpr bool PERM = false;
  bf16_t* ACT;
  DEVI void operator()(const f32x4 (&acc)[2][2][4][2], const g8::Unit& u) const {
    const int tid = tid_(), wid = __builtin_amdgcn_readfirstlane(tid >> 6), lane = tid & 63, wr = wid >> 2, wc = wid & 3, fr = lane & 15, fq = lane >> 4;
#pragma unroll
    for (int ai = 0; ai < 2; ++ai)
#pragma unroll
      for (int m = 0; m < 4; ++m) {
        const size_t slot = (size_t)u.pm * 256 + ai * 128 + wr * 64 + m * 16 + fr;
#pragma unroll
        for (int bj = 0; bj < 2; ++bj) {
          const f32x4 g = acc[ai][bj][m][0], up = acc[ai][bj][m][1];
          float o[4];
#pragma unroll
          for (int j = 0; j < 4; ++j) o[j] = g[j] * __builtin_amdgcn_rcpf(1.f + __expf(-g[j])) * up[j];
          uint2 w; w.x = pack2(o[0], o[1]); w.y = pack2(o[2], o[3]);
          *(uint2*)(ACT + slot * 512 + u.pn * 128 + bj * 64 + wc * 16 + 4 * fq) = w;
        }
      }
  }
};
DEVI void phase_moe1(const Params& p, int l, unsigned char* smem) {
  unsigned char* ws = uws(p);
  int* sPre = (int*)(smem + SMEM_BYTES + MISC_PRE); int* sCnt = (int*)(smem + SMEM_BYTES + MISC_CNT);
  moe_prefix(p, l, sPre, sCnt);
  MoeSched S{sPre, sCnt, (const unsigned char*)(smem + SMEM_BYTES + MISC_BLKE), (const bf16_t*)(ws + WS_H), (const int*)(ws + WS_LIST), (const bf16_t*)(ws + WS_EW), D, (size_t)1024 * 1024, 4, (int)gridDim.x, bid_(), 1};
  EpiMoe1 E{(bf16_t*)(ws + WS_ACT)};
  g8::gemm((G8_LAS unsigned char*)smem, D, S, E);
  __syncthreads();
}
DEVI void phase_moe2(const Params& p, int l, unsigned char* smem) {
  unsigned char* ws = uws(p);
  int* sPre = (int*)(smem + SMEM_BYTES + MISC_PRE); int* sCnt = (int*)(smem + SMEM_BYTES + MISC_CNT);
  moe_prefix(p, l, sPre, sCnt);
  MoeSched S{sPre, sCnt, (const unsigned char*)(smem + SMEM_BYTES + MISC_BLKE), (const bf16_t*)(ws + WS_ACT), (const int*)(ws + WS_LIST), (const bf16_t*)(ws + WS_EW) + (size_t)32 * 1024 * 1024, 512, (size_t)1024 * 512, 4, (int)gridDim.x, bid_(), 0};
  EpiBf16 E{(bf16_t*)(ws + WS_YROWS), D};
  g8::gemm((G8_LAS unsigned char*)smem, 512, S, E);
  __syncthreads();
}

DEVI void phase_ln2(const Params& p, int l, unsigned char* smem) {
  unsigned char* ws = uws(p);
  int* sPre = (int*)(smem + SMEM_BYTES + MISC_PRE); int* sCnt = (int*)(smem + SMEM_BYTES + MISC_CNT);
  moe_prefix(p, l, sPre, sCnt);
  const int tid = tid_(), lane = tid & 63, wid = tid >> 6;
  _Float16* X = (_Float16*)(ws + WS_X);
  const bf16_t* YR = (const bf16_t*)(ws + WS_YROWS);
  const int4* ROUTE = (const int4*)(ws + WS_ROUTE);
  const float2* RWT = (const float2*)(ws + WS_RWT);
  const float* MOD = (const float*)(ws + WS_MOD);
  const float* g2 = uin(p, I_LN2G) + l * D; const float* b2 = uin(p, I_LN2B) + l * D;
  bf16_t* XM = (bf16_t*)((unsigned char*)uout(p) + DO_XMOD);
  const int nrows = (l == 0) ? NT : NLAT;
  const int nw = gridDim.x * 8, gw = bid_() * 8 + wid;
  const int rpw = (nrows + nw - 1) / nw;
  const int R0 = gw * rpw, R1 = (R0 + rpw < nrows) ? (R0 + rpw) : nrows;
  const int c0 = lane * 8, c1 = 512 + lane * 8;
  float g[2][8], bb[2][8], gt[2][8], sh1n[2][8], sc1n[2][8];
  ld8f(g2 + c0, g[0]); ld8f(g2 + c1, g[1]); ld8f(b2 + c0, bb[0]); ld8f(b2 + c1, bb[1]);
  int curb = -1;
  float xv[2][8], ua[2][8], ub[2][8]; float2 rw = make_float2(0.f, 0.f);
  int4 rt_n = make_int4(0, 0, 0, 0); float2 rw_n = make_float2(0.f, 0.f);
  auto load_data = [&](int Rr, const int4& rt, float (&xo)[2][8], float (&ao)[2][8], float (&bo)[2][8]) {
    const bf16_t* ya = YR + ((size_t)sPre[rt.x] * 256 + rt.y) * 1024; const bf16_t* yb = YR + ((size_t)sPre[rt.z] * 256 + rt.w) * 1024;
    const _Float16* xr = X + (size_t)Rr * D;
    ld8h(xr + c0, xo[0]); ld8h(xr + c1, xo[1]); ld8b(ya + c0, ao[0]); ld8b(ya + c1, ao[1]); ld8b(yb + c0, bo[0]); ld8b(yb + c1, bo[1]);
  };
  if (R0 < R1) { const int4 rt0 = ROUTE[R0]; rw = RWT[R0]; load_data(R0, rt0, xv, ua, ub); }
  if (R0 + 1 < R1) { rt_n = ROUTE[R0 + 1]; rw_n = RWT[R0 + 1]; }
  for (int R = R0; R < R1; ++R) {
    float xn[2][8], an[2][8], bn[2][8];
#pragma unroll
    for (int h = 0; h < 2; ++h)
#pragma unroll
      for (int e = 0; e < 8; ++e) { xn[h][e] = 0.f; an[h][e] = 0.f; bn[h][e] = 0.f; }
    if (R + 1 < R1) load_data(R + 1, rt_n, xn, an, bn);
    const float2 rw_next = rw_n;
    if (R + 2 < R1) { rt_n = ROUTE[R + 2]; rw_n = RWT[R + 2]; }
    const int bi = bidx_of(R);
    if (bi != curb) {
      curb = bi;
      const float* modl = MOD + (size_t)(l * 17 + bi) * 6144;
      ld8f(modl + 5120 + c0, gt[0]); ld8f(modl + 5120 + c1, gt[1]);
      if (l == 0) {
        const float* modn = MOD + (size_t)(1 * 17 + bi) * 6144;
        ld8f(modn + c0, sh1n[0]); ld8f(modn + c1, sh1n[1]); ld8f(modn + 1024 + c0, sc1n[0]); ld8f(modn + 1024 + c1, sc1n[1]);
      }
    }
    float v[2][8]; float s = 0.f;
#pragma unroll
    for (int h = 0; h < 2; ++h)
#pragma unroll
      for (int e = 0; e < 8; ++e) { v[h][e] = ALPHA * xv[h][e] + gt[h][e] * (rw.x * ua[h][e] + rw.y * ub[h][e]); s += v[h][e]; }
    const float mu = wave_sum(s) * (1.f / 1024.f);
    float q = 0.f;
#pragma unroll
    for (int h = 0; h < 2; ++h)
#pragma unroll
      for (int e = 0; e < 8; ++e) { v[h][e] -= mu; q += v[h][e] * v[h][e]; }
    const float rstd = rsqrtf(wave_sum(q) * (1.f / 1024.f) + LN_EPS);
#pragma unroll
    for (int h = 0; h < 2; ++h) {
      float x2[8];
#pragma unroll
      for (int e = 0; e < 8; ++e) x2[e] = v[h][e] * rstd * g[h][e] + bb[h][e];
      const int cc = h ? c1 : c0;
      if (l == 0) {
        st8h(X + (size_t)R * D + cc, x2);
        float xm[8];
#pragma unroll
        for (int e = 0; e < 8; ++e) xm[e] = x2[e] * (1.f + sc1n[h][e]) + sh1n[h][e];
        st8b(XM + (size_t)R * D + cc, xm);
      } else {
        st8f(uout(p) + (size_t)R * D + cc, x2);
      }
    }
#pragma unroll
    for (int h = 0; h < 2; ++h)
#pragma unroll
      for (int e = 0; e < 8; ++e) { xv[h][e] = xn[h][e]; ua[h][e] = an[h][e]; ub[h][e] = bn[h][e]; }
    rw = rw_next;
  }
}

#define XB_TMO      128
#define XB_XCNT(j)  (256  + 64 * (j))
#define XB_XSUB(j)  (1280 + 64 * (j))
#define XB_XGEN(j)  (2304 + 64 * (j))
#define XB_TOP      3328
#define XB_TOPGEN   3392
#define XCD_BAR_WORDS 3456
#define XB_SPIN_CAP (1u << 20)
DEVI unsigned xb_ld(unsigned* p) { return __hip_atomic_load(p, __ATOMIC_RELAXED, __HIP_MEMORY_SCOPE_AGENT); }
DEVI unsigned xb_add(unsigned* p, unsigned v) { return __hip_atomic_fetch_add(p, v, __ATOMIC_RELAXED, __HIP_MEMORY_SCOPE_AGENT); }
DEVI unsigned xb_xcc_id() { return (unsigned)__builtin_amdgcn_s_getreg((3 << 11) | 20) & 0xFu; }
#define XB_SPIN(cond, bar) do { unsigned _sp = 0; while (cond) { __builtin_amdgcn_s_sleep(1); \
    if ((++_sp & 255u) == 0u) { if (xb_ld(&(bar)[XB_TMO])) break; if (_sp > XB_SPIN_CAP) { atomicAdd(&(bar)[XB_TMO], 1u); break; } } } } while (0)
DEVI void xcd_barrier_complete(unsigned* bar, unsigned x, unsigned& nloc, unsigned& nx) {
  const unsigned G = gridDim.x;
  unsigned sum, cnt, mine, sp = 0u;
  for (;;) {
    sum = 0u; cnt = 0u; mine = 0u;
#pragma unroll
    for (unsigned j = 0; j < 16; ++j) { const unsigned c = xb_ld(&bar[XB_XCNT(j)]); sum += c; cnt += (c > 0u) ? 1u : 0u; mine = (j == x) ? c : mine; }
    if (sum == G) break;
    __builtin_amdgcn_s_sleep(1);
    if ((++sp & 255u) == 0u) { if (xb_ld(&bar[XB_TMO])) break; if (sp > XB_SPIN_CAP) { atomicAdd(&bar[XB_TMO], 1u); break; } }
  }
  nloc = mine > 0u ? mine : 1u; nx = cnt > 0u ? cnt : 1u;
}
DEVI void xcd_barrier(unsigned* bar, volatile unsigned* st) {
  asm volatile("s_waitcnt vmcnt(0)" ::: "memory");
  __syncthreads();
  if (threadIdx.x == 0) {
    __builtin_amdgcn_s_waitcnt(0);
    const unsigned x = xb_xcc_id();
    unsigned nloc = st[0], nx = st[1];
    if (nloc == 0u) { xcd_barrier_complete(bar, x, nloc, nx); st[0] = nloc; st[1] = nx; }
    const unsigned old = xb_add(&bar[XB_XSUB(x)], 1u);
    const unsigned gen = old / nloc;
    if (old + 1u == (gen + 1u) * nloc) {
      __builtin_amdgcn_fence(__ATOMIC_RELEASE, "agent");
      asm volatile("s_waitcnt vmcnt(0)" ::: "memory");
      const unsigned og = xb_add(&bar[XB_TOP], 1u);
      const unsigned tg = og / nx;
      if (og + 1u == (tg + 1u) * nx) xb_add(&bar[XB_TOPGEN], 1u);
      else XB_SPIN(xb_ld(&bar[XB_TOPGEN]) == tg, bar);
      __builtin_amdgcn_fence(__ATOMIC_ACQUIRE, "agent");
      xb_add(&bar[XB_XGEN(x)], 1u);
      asm volatile("s_waitcnt vmcnt(0)" ::: "memory");
    } else {
      XB_SPIN(xb_ld(&bar[XB_XGEN(x)]) == gen, bar);
      __builtin_amdgcn_fence(__ATOMIC_ACQUIRE, "agent");
      asm volatile("s_waitcnt vmcnt(0)" ::: "memory");
    }
  }
  __syncthreads();
}

constexpr int N_PHASES = 24;
DEVI void run_phase(const Params& p, int ph, unsigned char* smem) {
  if (ph == 0) { phase0a(p, smem); return; }
  if (ph == 1) { phase0b(p, smem); return; }
  const int l = (ph - 2) / 11, s = (ph - 2) % 11;
  switch (s) {
    case 0: phase_inproj(p, l, smem); break;
    case 1: phase_feat(p, l, smem); break;
    case 2: phase_mixers(p, l, smem); break;
    case 3: phase_mixfin(p, l, smem); break;
    case 4: phase_glu(p, l, smem); break;
    case 5: phase_outproj(p, l, smem); break;
    case 6: phase_ln1(p, l, smem); break;
    case 7: phase_router(p, l, smem); break;
    case 8: phase_moe1(p, l, smem); break;
    case 9: phase_moe2(p, l, smem); break;
    default: phase_ln2(p, l, smem); break;
  }
}

__global__ void __launch_bounds__(NTHREADS, 2) fwd_megakernel(Params pk) {
  extern __shared__ __attribute__((aligned(16))) unsigned char smem[];
  Params* spp = (Params*)(smem + SMEM_BYTES + MISC_PARAMS);
  if (threadIdx.x == 0) { *spp = pk; ((volatile unsigned*)(smem + SMEM_BYTES + MISC_XB))[0] = 0u; ((volatile unsigned*)(smem + SMEM_BYTES + MISC_XB))[1] = 0u; }
  __syncthreads();
  const Params& p = *spp;
  const int ph_lo = __builtin_amdgcn_readfirstlane(p.ph_lo), ph_hi = __builtin_amdgcn_readfirstlane(p.ph_hi);
#if MK_MULTI
  for (int ph = ph_lo; ph < ph_hi; ++ph) run_phase(p, ph, smem);
#else
  cg::grid_group grid = cg::this_grid();
  if (threadIdx.x == 0) (void)xb_add(&((unsigned*)(uws(p) + WS_BAR))[XB_XCNT(xb_xcc_id())], 1u);
  for (int ph = ph_lo; ph < ph_hi; ++ph) {
    run_phase(p, ph, smem);
#ifdef DUP_MASK
    if ((DUP_MASK >> ph) & 1) { __syncthreads(); run_phase(p, ph, smem); }
#endif
    if (ph + 1 < ph_hi) {
      if (ph == ph_lo) grid.sync();
      else xcd_barrier((unsigned*)(uws(p) + WS_BAR), (volatile unsigned*)(smem + SMEM_BYTES + MISC_XB));
    }
  }
#endif
}

extern "C" void kernel_launch(void* const* d_in, const int* in_sizes, int n_in, void* d_out, int out_size,
                              void* d_ws, size_t ws_size, hipStream_t stream) {
  static int grid_blocks = 0;
  if (!grid_blocks) {
    int dev = 0, cus = 0, per_cu = 0;
    (void)hipGetDevice(&dev);
    (void)hipDeviceGetAttribute(&cus, hipDeviceAttributeMultiprocessorCount, dev);
    (void)hipFuncSetAttribute((const void*)fwd_megakernel, hipFuncAttributeMaxDynamicSharedMemorySize, DSM_BYTES);
    (void)hipOccupancyMaxActiveBlocksPerMultiprocessor(&per_cu, fwd_megakernel, NTHREADS, DSM_BYTES);
    if (per_cu > 1) per_cu = 1;
    grid_blocks = cus * per_cu;
    if (n_in != N_IN || out_size != NLAT * D || ws_size < WS_END) {
      fprintf(stderr, "kernel_launch: unexpected sizes n_in=%d out=%d ws=%zu (need %zu)\n", n_in, out_size, ws_size, (size_t)WS_END);
      grid_blocks = -1;
    }
    fprintf(stderr, "kernel_launch: grid=%d (cus=%d per_cu=%d) ws=%zu\n", grid_blocks, cus, per_cu, ws_size);
  }
  if (grid_blocks <= 0) return;
  Params p{};
  for (int i = 0; i < N_IN; ++i) p.in[i] = (const float*)d_in[i];
  p.out = (float*)d_out; p.ws = (unsigned char*)d_ws;
#if MK_MULTI
  for (int ph = 0; ph < N_PHASES; ++ph) {
    p.ph_lo = ph; p.ph_hi = ph + 1;
    hipLaunchKernelGGL(fwd_megakernel, dim3(grid_blocks), dim3(NTHREADS), DSM_BYTES, stream, p);
  }
#else
  p.ph_lo = 0; p.ph_hi = N_PHASES;
  (void)hipMemsetAsync((unsigned char*)d_ws + WS_BAR, 0, XCD_BAR_WORDS * 4, stream);
  void* args[] = {&p};
  hipError_t e = hipLaunchCooperativeKernel((void*)fwd_megakernel, dim3(grid_blocks), dim3(NTHREADS), args, DSM_BYTES, stream);
  if (e != hipSuccess) fprintf(stderr, "cooperative launch failed: %s (grid %d)\n", hipGetErrorString(e), grid_blocks);
#endif
}
```

```cpp
#include <hip/hip_runtime.h>
#include <hip/hip_cooperative_groups.h>
#include <cstdio>
#include <cstdint>
namespace cg = cooperative_groups;

#ifndef MK_MULTI
#define MK_MULTI 0
#endif

#define DEVI __device__ __forceinline__
typedef unsigned short bf16_t;
typedef short bf16x8 __attribute__((ext_vector_type(8)));
typedef float f32x4 __attribute__((ext_vector_type(4)));
typedef float f32x16 __attribute__((ext_vector_type(16)));

constexpr int D = 1024, NB = 16, SEQ = 2048, CTXL = 256;
constexpr int NLAT = NB * SEQ;
constexpr int NCTX = NB * CTXL;
constexpr int NT = NLAT + NCTX;
constexpr int DIN = 2048;
constexpr int NTHREADS = 512;
constexpr float ALPHA = 1.41421356237309515f;
constexpr float LN_EPS = 1e-5f, GN_EPS = 64e-5f;
constexpr int NCH = NT / 32;
constexpr int SLOT_CAP = 81920;

enum { I_X = 0, I_C, I_CTX, I_CCTX, I_WMOD, I_BMOD, I_WIN, I_CONV, I_W0, I_W2, I_A0, I_A2, I_G2, I_KK, I_KA, I_RK, I_GNW, I_GNB,
       I_LRE, I_LIM, I_LDT, I_BRE, I_BIM, I_CRE, I_CIM, I_SD, I_GLUW, I_GLUB, I_SINK, I_WOUT, I_LN1G, I_LN1B, I_LN2G, I_LN2B,
       I_RGW, I_RGB, I_REW, I_REB, I_EWG, I_EWU, I_EWD, N_IN };

constexpr size_t MiB = 1048576;
constexpr size_t WS_CTL = 0;
constexpr size_t WS_BAR = 512 * 1024;
constexpr size_t WS_MOD = 1 * MiB;
constexpr size_t WS_ROPE = 2 * MiB;
constexpr size_t WS_WIN_T = 4 * MiB;
constexpr size_t WS_WOUT_T = 12 * MiB;
constexpr size_t WS_FW = 16 * MiB;
constexpr size_t WS_GLU_T = 18 * MiB;
constexpr size_t WS_RW = 19 * MiB;
constexpr size_t WS_KTAB = 20 * MiB;
constexpr size_t WS_TTG = 22 * MiB;
constexpr size_t WS_EM = 46 * MiB;
constexpr size_t WS_HC = 54 * MiB;
constexpr size_t WS_LIST = 63 * MiB;
constexpr size_t WS_ROUTE = 68 * MiB;
constexpr size_t WS_RWT = 69 * MiB;
constexpr size_t WS_APOW = 70 * MiB;
constexpr size_t WS_BBT = 71 * MiB + 512 * 1024;
constexpr size_t WS_X = 72 * MiB;
constexpr size_t WS_R = 216 * MiB;
constexpr size_t WS_PROJ = WS_R;
constexpr size_t WS_FEAT = WS_R + 144 * MiB;
constexpr size_t WS_YMIX = WS_R + 234 * MiB;
constexpr size_t WS_MIX = WS_R + 144 * MiB;
constexpr size_t WS_EW = WS_R;
constexpr size_t WS_H = WS_R + 234 * MiB;
constexpr size_t WS_ACT = WS_R + 96 * MiB;
constexpr size_t WS_YROWS = WS_R + 176 * MiB;
constexpr size_t WS_UDH = WS_R + 336 * MiB;
constexpr size_t WS_END = WS_UDH + 28 * MiB;
constexpr size_t DO_XMOD = 0;
constexpr size_t DO_YF = 0;
constexpr size_t DO_YB = 36 * MiB;
constexpr size_t DO_HE = 72 * MiB;
constexpr size_t DO_ZB = 90 * MiB;

struct Params {
  const float* in[N_IN];
  float* out;
  unsigned char* ws;
  int ph_lo, ph_hi;
};


DEVI unsigned long long rfl64(unsigned long long v) { const unsigned lo = __builtin_amdgcn_readfirstlane((unsigned)v), hi = __builtin_amdgcn_readfirstlane((unsigned)(v >> 32)); return ((unsigned long long)hi << 32) | lo; }
DEVI unsigned char* uws(const Params& p) { return (unsigned char*)rfl64((unsigned long long)p.ws); }
DEVI float* uout(const Params& p) { return (float*)rfl64((unsigned long long)p.out); }
DEVI const float* uin(const Params& p, int i) { return (const float*)rfl64((unsigned long long)p.in[i]); }

DEVI float bf2f(bf16_t v) { return __uint_as_float(((unsigned)v) << 16); }
typedef __bf16 hwbf2 __attribute__((ext_vector_type(2)));
typedef float hwf2 __attribute__((ext_vector_type(2)));
DEVI bf16_t f2bf(float f) { return __builtin_bit_cast(unsigned short, (__bf16)f); }
DEVI unsigned pack2(float a, float b) { const hwf2 v = {a, b}; return __builtin_bit_cast(unsigned, __builtin_convertvector(v, hwbf2)); }
DEVI float lo_bf(unsigned u) { return __uint_as_float(u << 16); }
DEVI float hi_bf(unsigned u) { return __uint_as_float(u & 0xFFFF0000u); }
DEVI unsigned short f2h(float f) { _Float16 h = (_Float16)f; return __builtin_bit_cast(unsigned short, h); }
DEVI float h2f(unsigned short u) { return (float)__builtin_bit_cast(_Float16, u); }
DEVI float sigmoidf(float x) { return __builtin_amdgcn_rcpf(1.f + __expf(-x)); }
DEVI float gelu_tanh(float x) { const float u = 0.7978845608028654f * (x + 0.044715f * x * x * x); return x - x * __builtin_amdgcn_rcpf(1.f + __expf(2.f * u)); }

template <int CTRL> DEVI float dpp_f(float x) { return __int_as_float(__builtin_amdgcn_update_dpp(0, __float_as_int(x), CTRL, 0xF, 0xF, false)); }
DEVI float row_sum16(float x) {
  x += dpp_f<0xB1>(x);
  x += dpp_f<0x4E>(x);
  x += dpp_f<0x141>(x);
  x += dpp_f<0x140>(x);
  return x;
}
DEVI float shfl_xor_l(float x, int m) {
  int lane = (int)__builtin_amdgcn_mbcnt_hi(~0u, __builtin_amdgcn_mbcnt_lo(~0u, 0u));
  asm volatile("" : "+v"(lane));
  return __int_as_float(__builtin_amdgcn_ds_bpermute((lane ^ m) << 2, __float_as_int(x)));
}
DEVI float wave_sum(float x) { x = row_sum16(x); x += shfl_xor_l(x, 16); x += shfl_xor_l(x, 32); return x; }

DEVI int tid_() { int t = threadIdx.x; asm volatile("" : "+v"(t)); return t; }
DEVI int bid_() { int b = blockIdx.x; asm volatile("" : "+s"(b)); return b; }
DEVI void ld8f(const float* p, float (&o)[8]) { const float4 a = *(const float4*)p, b = *(const float4*)(p + 4); o[0] = a.x; o[1] = a.y; o[2] = a.z; o[3] = a.w; o[4] = b.x; o[5] = b.y; o[6] = b.z; o[7] = b.w; }
DEVI void ld8b(const bf16_t* p, float (&o)[8]) { const uint4 u = *(const uint4*)p; o[0] = lo_bf(u.x); o[1] = hi_bf(u.x); o[2] = lo_bf(u.y); o[3] = hi_bf(u.y); o[4] = lo_bf(u.z); o[5] = hi_bf(u.z); o[6] = lo_bf(u.w); o[7] = hi_bf(u.w); }
DEVI void st8f(float* p, const float (&v)[8]) { *(float4*)p = make_float4(v[0], v[1], v[2], v[3]); *(float4*)(p + 4) = make_float4(v[4], v[5], v[6], v[7]); }
DEVI void st8b(bf16_t* p, const float (&v)[8]) { *(uint4*)p = make_uint4(pack2(v[0], v[1]), pack2(v[2], v[3]), pack2(v[4], v[5]), pack2(v[6], v[7])); }
typedef _Float16 hx8 __attribute__((ext_vector_type(8)));
DEVI void ld8h(const _Float16* p, float (&o)[8]) { const hx8 u = *(const hx8*)p;
#pragma unroll
  for (int e = 0; e < 8; ++e) o[e] = (float)u[e]; }
DEVI void st8h(_Float16* p, const float (&v)[8]) { hx8 u;
#pragma unroll
  for (int e = 0; e < 8; ++e) u[e] = (_Float16)v[e];
  *(hx8*)p = u; }

DEVI int bidx_of(int R) { return R < NLAT ? (R >> 11) : 16; }
DEVI const float* xin_row(const Params& p, int R) { return R < NLAT ? uin(p, I_X) + (size_t)R * D : uin(p, I_CTX) + (size_t)(R - NLAT) * D; }

constexpr int LDT = 40;
constexpr int SMEM_BYTES = 143360;
constexpr int DSM_BYTES = SMEM_BYTES + 1024;
constexpr int MISC_PARAMS = 0, MISC_PRE = 384, MISC_CNT = 528, MISC_BLKE = 656, MISC_XB = 1008;
template <class AL, class BL, class EP>
DEVI void gemm_tile(unsigned char* smem, int kbeg, int kend, AL&& aload, BL&& bload, EP&& epi) {
  const int tid = tid_(), lane = tid & 63, wid = tid >> 6;
  const int wr = wid >> 1, wc = wid & 1, fr = lane & 15, fq = lane >> 4;
  bf16_t* sA = (bf16_t*)smem;
  bf16_t* sB = (bf16_t*)(smem + 2 * 256 * LDT * 2);
  const int lrow = tid >> 2, kq = (tid & 3) * 8;
  f32x4 acc[4][4];
#pragma unroll
  for (int m = 0; m < 4; ++m)
#pragma unroll
    for (int n = 0; n < 4; ++n) acc[m][n] = (f32x4){0.f, 0.f, 0.f, 0.f};
  uint4 ra0 = aload(0, kbeg + kq), ra1 = aload(1, kbeg + kq), rb = bload(kbeg + kq);
  int buf = 0;
#pragma unroll 1
  for (int k = kbeg; k < kend; k += 32) {
    *(uint4*)(sA + (buf * 256 + lrow) * LDT + kq) = ra0;
    *(uint4*)(sA + (buf * 256 + lrow + 128) * LDT + kq) = ra1;
    *(uint4*)(sB + (buf * 128 + lrow) * LDT + kq) = rb;
    __syncthreads();
    if (k + 32 < kend) { ra0 = aload(0, k + 32 + kq); ra1 = aload(1, k + 32 + kq); rb = bload(k + 32 + kq); }
    bf16x8 bfr[4];
#pragma unroll
    for (int n = 0; n < 4; ++n) bfr[n] = *(const bf16x8*)(sB + (buf * 128 + wc * 64 + n * 16 + fr) * LDT + fq * 8);
#pragma unroll
    for (int m = 0; m < 4; ++m) {
      const bf16x8 af = *(const bf16x8*)(sA + (buf * 256 + wr * 64 + m * 16 + fr) * LDT + fq * 8);
#pragma unroll
      for (int n = 0; n < 4; ++n) acc[m][n] = __builtin_amdgcn_mfma_f32_16x16x32_bf16(bfr[n], af, acc[m][n], 0, 0, 0);
    }
    buf ^= 1;
  }
  __syncthreads();
  epi(acc, wr, wc, fr, fq);
}


namespace g8 {
#define G8_LAS __attribute__((address_space(3)))
constexpr int BM = 256, BK = 64, HALF = 128, HTB = HALF * BK * 2;
DEVI int lds_byte(int r, int c) { const int st = (r >> 4) * 2 + (c >> 5), rr = r & 15, cc = c & 31, ob = rr * 64 + cc * 2; return st * 1024 + (ob ^ (((ob >> 9) & 1) << 5)); }
DEVI void stage_rc(int b, int& R, int& C) { const int st = b / 1024, sb = b % 1024, swz = sb ^ (((sb >> 9) & 1) << 5); R = (st >> 1) * 16 + swz / 64; C = (st & 1) * 32 + (swz % 64) / 2; }
DEVI int perm32(int rho) { const int n = rho >> 4, i = rho & 15; return 8 * (i >> 2) + 4 * n + (i & 3); }
struct Unit { int pm, pn, e; };
DEVI int xcd_remap(int L, int n) { const int q = n >> 3, r = n & 7, x = L & 7, off = L >> 3; return (x < r ? x * (q + 1) : r * (q + 1) + (x - r) * q) + off; }

template <class Epi, class Sched>
DEVI void gemm(G8_LAS unsigned char* lds, const int Kin, const Sched& S, const Epi& E) {
  int K = Kin; asm volatile("" : "+s"(K));
  const int tid = tid_(), wid = __builtin_amdgcn_readfirstlane(tid >> 6), lane = tid & 63, wr = wid >> 2, wc = wid & 3, fr = lane & 15, fq = lane >> 4;
  const int nt = K / BK;
  unsigned voffB[2];
#pragma unroll
  for (int i = 0; i < 2; ++i) { int R, C; stage_rc(tid * 16 + i * 8192, R, C); const int Rb = Epi::PERM ? ((R & ~31) + perm32(R & 31)) : R; voffB[i] = (unsigned)(Rb * K + C) * 2u; }
  const size_t kstep = (size_t)(BK * 2);
  const size_t hstepB = (size_t)HALF * K * 2;
  const unsigned ldsw = (unsigned)wid * 1024u;
  const int aoff = lds_byte(wr * 64 + fr, fq * 8), boff = lds_byte(wc * 32 + fr, fq * 8);
#define G8_SA(b, h) (((b) * 2 + (h)) * HTB)
#define G8_SB(b, h) ((4 + (b) * 2 + (h)) * HTB)
#define G8_STAGE_B(bufoff, gbase) do { _Pragma("unroll") for (int _i = 0; _i < 2; ++_i) \
    __builtin_amdgcn_global_load_lds((const unsigned*)((const char*)(gbase) + voffB[_i]), (G8_LAS unsigned*)(lds + (bufoff) + ldsw + _i * 8192), 16, 0, 0); } while (0)
#define G8_STAGE_A(bufoff, ubase, o0, o1) do { \
    __builtin_amdgcn_global_load_lds((const unsigned*)((ubase) + (o0)), (G8_LAS unsigned*)(lds + (bufoff) + ldsw), 16, 0, 0); \
    __builtin_amdgcn_global_load_lds((const unsigned*)((ubase) + (o1)), (G8_LAS unsigned*)(lds + (bufoff) + ldsw + 8192), 16, 0, 0); } while (0)
#define G8_LDA(dst, b, h) do { _Pragma("unroll") for (int m = 0; m < 4; ++m) _Pragma("unroll") for (int k = 0; k < 2; ++k) dst[m][k] = *(const G8_LAS bf16x8*)(lds + G8_SA(b, h) + aoff + m * 2048 + k * 1024); } while (0)
#define G8_LDB(dst, b, h) do { _Pragma("unroll") for (int n = 0; n < 2; ++n) _Pragma("unroll") for (int k = 0; k < 2; ++k) dst[n][k] = *(const G8_LAS bf16x8*)(lds + G8_SB(b, h) + boff + n * 2048 + k * 1024); } while (0)
#define G8_MMA(ai, bj, At, Bt) do { __builtin_amdgcn_s_setprio(1); _Pragma("unroll") for (int m = 0; m < 4; ++m) _Pragma("unroll") for (int n = 0; n < 2; ++n) _Pragma("unroll") for (int k = 0; k < 2; ++k) \
    acc[ai][bj][m][n] = __builtin_amdgcn_mfma_f32_16x16x32_bf16(Bt[n][k], At[m][k], acc[ai][bj][m][n], 0, 0, 0); __builtin_amdgcn_s_setprio(0); } while (0)
#define G8_WAIT_V(n) asm volatile("s_waitcnt vmcnt(" #n ")" ::: "memory")
#define G8_WAIT_L(n) asm volatile("s_waitcnt lgkmcnt(" #n ")" ::: "memory")
#define G8_BAR __builtin_amdgcn_s_barrier()
#define G8_SCHED __builtin_amdgcn_sched_barrier(0)
  Unit cur, nxt; int ui = 0;
  if (!S.next(0, cur)) return;
  f32x4 acc[2][2][4][2];
#pragma unroll
  for (int a = 0; a < 2; ++a)
#pragma unroll
    for (int b = 0; b < 2; ++b)
#pragma unroll
      for (int m = 0; m < 4; ++m)
#pragma unroll
        for (int n = 0; n < 2; ++n) acc[a][b][m][n] = (f32x4){0.f, 0.f, 0.f, 0.f};
  bf16x8 At[4][2], B0[2][2], B1[2][2];
  unsigned cA[2][2], nA[2][2];
  const char* const Ab = S.a_base();
  S.a_offs(cur, tid, cA);
  const char* cB = S.b_ptr(cur);
  G8_STAGE_B(G8_SB(0, 0), cB); G8_STAGE_A(G8_SA(0, 0), Ab, cA[0][0], cA[0][1]); G8_STAGE_B(G8_SB(0, 1), cB + hstepB); G8_STAGE_A(G8_SA(0, 1), Ab, cA[1][0], cA[1][1]);
  if (wr == 1) G8_BAR;
  G8_WAIT_V(4); G8_BAR;
  G8_STAGE_B(G8_SB(1, 0), cB + kstep); G8_STAGE_A(G8_SA(1, 0), Ab + kstep, cA[0][0], cA[0][1]); G8_STAGE_B(G8_SB(1, 1), cB + hstepB + kstep);
  G8_WAIT_V(6); G8_BAR;
  for (;;) {
    const bool has_next = S.next(ui + 1, nxt);
    const char* nB = cB;
    if (has_next) { S.a_offs(nxt, tid_(), nA); nB = S.b_ptr(nxt); }
    else { nA[0][0] = cA[0][0]; nA[0][1] = cA[0][1]; nA[1][0] = cA[1][0]; nA[1][1] = cA[1][1]; }
    for (int t = 0; t < nt; t += 2) {
      const bool last = (t == nt - 2);
      const size_t k1 = (size_t)(t + 1) * kstep, k2 = (size_t)(t + 2) * kstep;
      const char* b2 = last ? nB : cB + k2; const char* b3 = b2 + kstep;
      const char* Ab2 = last ? Ab : Ab + k2;
      unsigned a2[2][2];
#pragma unroll
      for (int h = 0; h < 2; ++h)
#pragma unroll
        for (int i = 0; i < 2; ++i) a2[h][i] = last ? nA[h][i] : cA[h][i];
      G8_LDB(B0, 0, 0); G8_SCHED; G8_LDA(At, 0, 0); G8_STAGE_A(G8_SA(1, 1), Ab + k1, cA[1][0], cA[1][1]);
      G8_WAIT_L(8); G8_BAR; G8_WAIT_L(0); G8_MMA(0, 0, At, B0); G8_BAR; G8_SCHED;
      G8_LDB(B1, 0, 1); G8_STAGE_B(G8_SB(0, 0), b2);
      G8_BAR; G8_WAIT_L(0); G8_MMA(0, 1, At, B1); G8_BAR;
      G8_LDA(At, 0, 1); G8_STAGE_A(G8_SA(0, 0), Ab2, a2[0][0], a2[0][1]);
      G8_BAR; G8_WAIT_L(0); G8_MMA(1, 0, At, B0); G8_BAR; G8_SCHED;
      G8_STAGE_B(G8_SB(0, 1), b2 + hstepB);
      G8_WAIT_V(6); G8_BAR; G8_MMA(1, 1, At, B1); G8_BAR;
      G8_LDB(B0, 1, 0); G8_SCHED; G8_LDA(At, 1, 0); G8_STAGE_A(G8_SA(0, 1), Ab2, a2[1][0], a2[1][1]);
      G8_WAIT_L(8); G8_BAR; G8_WAIT_L(0); G8_MMA(0, 0, At, B0); G8_BAR; G8_SCHED;
      G8_LDB(B1, 1, 1); G8_STAGE_B(G8_SB(1, 0), b3);
      G8_BAR; G8_WAIT_L(0); G8_MMA(0, 1, At, B1); G8_BAR;
      G8_LDA(At, 1, 1); G8_STAGE_A(G8_SA(1, 0), Ab2 + kstep, a2[0][0], a2[0][1]);
      G8_BAR; G8_WAIT_L(0); G8_MMA(1, 0, At, B0); G8_BAR; G8_SCHED;
      G8_STAGE_B(G8_SB(1, 1), b3 + hstepB);
      G8_WAIT_V(6); G8_BAR; G8_MMA(1, 1, At, B1); G8_BAR;
    }
    E(acc, cur);
    if (!has_next) break;
#pragma unroll
    for (int a = 0; a < 2; ++a)
#pragma unroll
      for (int b = 0; b < 2; ++b)
#pragma unroll
        for (int m = 0; m < 4; ++m)
#pragma unroll
          for (int n = 0; n < 2; ++n) acc[a][b][m][n] = (f32x4){0.f, 0.f, 0.f, 0.f};
    cur = nxt; cB = nB; ++ui;
#pragma unroll
    for (int h = 0; h < 2; ++h)
#pragma unroll
      for (int i = 0; i < 2; ++i) cA[h][i] = nA[h][i];
  }
  G8_WAIT_V(0);
  if (wr == 0) G8_BAR;
  G8_BAR;
#undef G8_SA
#undef G8_SB
#undef G8_STAGE_A
#undef G8_STAGE_B
#undef G8_LDA
#undef G8_LDB
#undef G8_MMA
#undef G8_WAIT_V
#undef G8_WAIT_L
#undef G8_BAR
#undef G8_SCHED
}

struct DenseSched {
  const bf16_t* A; const bf16_t* Bt; int K, nM, nN, G, c;
  DEVI bool next(int i, Unit& u) const {
    const int nwg = nM * nN; const long L = (long)i * G + c; if (L >= nwg) return false;
    const int wgid = xcd_remap((int)L, nwg);
    const int nig = 8 * nN, gid = wgid / nig, fm = gid * 8, gsz = (nM - fm) < 8 ? (nM - fm) : 8;
    u.pm = fm + ((wgid % nig) % gsz); u.pn = (wgid % nig) / gsz; u.e = 0; return true;
  }
  DEVI const char* a_base() const { return (const char*)A; }
  DEVI void a_offs(const Unit& u, int tid, unsigned (&ao)[2][2]) const {
#pragma unroll
    for (int i = 0; i < 2; ++i) {
      int R, C; stage_rc(tid * 16 + i * 8192, R, C);
#pragma unroll
      for (int h = 0; h < 2; ++h) ao[h][i] = ((unsigned)(u.pm * 256 + h * 128 + R) * (unsigned)K + (unsigned)C) * 2u;
    }
  }
  DEVI const char* b_ptr(const Unit& u) const { return (const char*)(Bt + (size_t)u.pn * 256 * K); }
};
}

struct TrRegs { float4 v[2][4]; };
DEVI void transpose_load(TrRegs& t, const float* __restrict__ src, int ld_src, int k0, int n0) {
  const int tid = tid_();
  const int kr = tid >> 4, c4 = (tid & 15) * 4;
#pragma unroll
  for (int i = 0; i < 2; ++i)
#pragma unroll
    for (int w = 0; w < 4; ++w) t.v[i][w] = *(const float4*)(src + (size_t)(k0 + kr + 32 * i) * ld_src + n0 + w * 64 + c4);
}
template <class RM>
DEVI void transpose_finish(unsigned char* smem, const TrRegs& t, int k0, int n0, bf16_t* dst, int ld_dst, RM&& rowmap) {
  bf16_t* T = (bf16_t*)smem;
  const int tid = tid_();
  const int kr = tid >> 4, c4 = (tid & 15) * 4;
#pragma unroll
  for (int i = 0; i < 2; ++i)
#pragma unroll
    for (int w = 0; w < 4; ++w) {
      const int kk = kr + 32 * i; bf16_t* tp = T + (w * 64 + c4) * 72 + kk;
      tp[0] = f2bf(t.v[i][w].x); tp[72] = f2bf(t.v[i][w].y); tp[144] = f2bf(t.v[i][w].z); tp[216] = f2bf(t.v[i][w].w);
    }
  __syncthreads();
  const int k8 = (tid & 7) * 8;
#pragma unroll
  for (int j = 0; j < 4; ++j) {
    const int nn = (tid >> 3) + 64 * j;
    const uint4 o = *(const uint4*)(T + nn * 72 + k8);
    *(uint4*)(dst + (size_t)rowmap(n0 + nn) * ld_dst + k0 + k8) = o;
  }
  __syncthreads();
}
template <class RM>
DEVI void transpose_tile(unsigned char* smem, const float* __restrict__ src, int ld_src, int k0, int n0, bf16_t* dst, int ld_dst, RM&& rowmap) {
  TrRegs t; transpose_load(t, src, ld_src, k0, n0);
  transpose_finish(smem, t, k0, n0, dst, ld_dst, rowmap);
}

struct S5Disc { float lm, th, ar, ai, cr, ci; };
DEVI S5Disc s5disc(const Params& p, int l, int d, int g, int pp) {
  const int idx = ((l * 2 + d) * 16 + g) * 64 + pp;
  const float lr = uin(p, I_LRE)[idx], li = uin(p, I_LIM)[idx];
  const float dt = expf(uin(p, I_LDT)[(l * 2 + d) * 16 + g]);
  S5Disc r; r.lm = lr * dt; r.th = li * dt;
  const float mag = expf(r.lm), cs = cosf(r.th), sn = sinf(r.th), sh = sinf(0.5f * r.th);
  r.ar = mag * cs; r.ai = mag * sn;
  const float nr = expm1f(r.lm) * cs - 2.f * sh * sh, ni = r.ai, den = lr * lr + li * li;
  r.cr = (nr * lr + ni * li) / den; r.ci = (ni * lr - nr * li) / den;
  return r;
}

DEVI void phase0a(const Params& p, unsigned char* smem) {
  const int tid = tid_(), bid = bid_(), G = gridDim.x;
  unsigned char* ws = uws(p);
  if (bid == 0 && tid < 128) ((int*)(ws + WS_CTL))[tid] = 0;
  constexpr int N_MOD = 384, N_KT = 256, N_ROPE = 128, N_TRW = 256 + 128, N_EL = 640;
  constexpr int N_AP = 265;
  constexpr int N_BB = 128;
  const int total = N_MOD + N_KT + N_ROPE + N_TRW + N_EL + N_AP + N_BB;
  for (int it0 = bid; it0 < total; it0 += G) {
    int it = it0;
    if (it < N_MOD) {
      const int l = it / 192, col0 = (it % 192) * 32;
      const int c = tid & 31, kg = tid >> 5;
      float* sS = (float*)smem;
      float acc[17];
#pragma unroll
      for (int b = 0; b < 17; ++b) acc[b] = 0.f;
      const float* W = uin(p, I_WMOD) + (size_t)l * D * 6144 + col0 + c;
      for (int kc = 0; kc < 4; ++kc) {
        __syncthreads();
        for (int e = tid; e < 17 * 256; e += NTHREADS) {
          const int b = e >> 8, k = kc * 256 + (e & 255);
          const float cv = (b < 16) ? uin(p, I_C)[b * D + k] : uin(p, I_CCTX)[k];
          sS[e] = cv / (1.f + __expf(-cv));
        }
        __syncthreads();
        float wv[16];
#pragma unroll
        for (int i = 0; i < 16; ++i) wv[i] = W[(size_t)(kc * 256 + kg + 16 * i) * 6144];
#pragma unroll
        for (int i = 0; i < 16; ++i) {
          const int kl = kg + 16 * i;
#pragma unroll
          for (int b = 0; b < 17; ++b) acc[b] = fmaf(sS[b * 256 + kl], wv[i], acc[b]);
        }
      }
      __syncthreads();
      float* sR = (float*)smem;
#pragma unroll
      for (int b = 0; b < 17; ++b) sR[(kg * 17 + b) * 32 + c] = acc[b];
      __syncthreads();
      for (int e = tid; e < 17 * 32; e += NTHREADS) {
        const int b = e >> 5, cc = e & 31;
        float s = 0.f;
#pragma unroll
        for (int q = 0; q < 16; ++q) s += sR[(q * 17 + b) * 32 + cc];
        ((float*)(ws + WS_MOD))[(size_t)(l * 17 + b) * 6144 + col0 + cc] = s + uin(p, I_BMOD)[l * 6144 + col0 + cc];
      }
      __syncthreads();
      continue;
    }
    it -= N_MOD;
    if (it < N_KT) {
      const int gid = it * NTHREADS + tid;
      const int pg = gid & 7, cc = (gid >> 3) & 255, c = cc >> 4, c2 = cc & 15;
      const int lgd = gid >> 11, d = lgd & 1, g = (lgd >> 1) & 15, l = lgd >> 5;
      float K[32];
#pragma unroll
      for (int j = 0; j < 32; ++j) K[j] = 0.f;
      for (int q = 0; q < 8; ++q) {
        const int pp = pg * 8 + q;
        const S5Disc dd = s5disc(p, l, d, g, pp);
        const float ar = dd.ar, ai = dd.ai;
        const float br = uin(p, I_BRE)[((l * 16 + g) * 64 + pp) * 16 + c2], bi = uin(p, I_BIM)[((l * 16 + g) * 64 + pp) * 16 + c2];
        const float bbr = dd.cr * br - dd.ci * bi, bbi = dd.cr * bi + dd.ci * br;
        const float cr = uin(p, I_CRE)[((l * 16 + g) * 16 + c) * 64 + pp], ci = uin(p, I_CIM)[((l * 16 + g) * 16 + c) * 64 + pp];
        const float zr = cr * bbr - ci * bbi, zi = cr * bbi + ci * bbr;
        float pr = 1.f, pi = 0.f;
#pragma unroll
        for (int j = 0; j < 32; ++j) {
          K[j] += zr * pr - zi * pi;
          const float nr = pr * ar - pi * ai, ni = pr * ai + pi * ar;
          pr = nr; pi = ni;
        }
      }
#pragma unroll
      for (int j = 0; j < 32; ++j) { float v = K[j]; v += dpp_f<0xB1>(v); v += dpp_f<0x4E>(v); v += dpp_f<0x141>(v); K[j] = v; }
      if (pg == 0) {
        float* KT = (float*)(ws + WS_KTAB) + (size_t)(((l * 16 + g) * 2 + d) * 32) * 256 + c * 16 + c2;
#pragma unroll
        for (int j = 0; j < 32; ++j) KT[j * 256] = K[j];
      }
      continue;
    }
    it -= N_KT;
    if (it < N_ROPE) {
      const int e = it * NTHREADS + tid;
      const int pos = e >> 5, i = e & 31;
      const float inv = powf(10000.f, -(float)(i & 15) / 16.f);
      const float ang = (float)((i < 16) ? (pos >> 6) : (pos & 63)) * inv;
      ((float*)(ws + WS_ROPE))[e] = cosf(ang);
      ((float*)(ws + WS_ROPE))[65536 + e] = sinf(ang);
      continue;
    }
    it -= N_ROPE;
    if (it < N_TRW) {
      if (it < 256) {
        const int l = it >> 7, r = it & 127, kt = r >> 3, ntl = r & 7;
        transpose_tile(smem, uin(p, I_WIN) + (size_t)l * D * DIN, DIN, kt * 64, ntl * 256, (bf16_t*)(ws + WS_WIN_T) + (size_t)l * DIN * D, D,
          [](int n) { if (n >= 1280 && n < 1920) { const int d = n & 63; return (n & ~63) + 32 * ((d >> 4) & 1) + 8 * ((d >> 2) & 3) + 4 * (d >> 5) + (d & 3); } return n; });
      } else {
        const int r0 = it - 256, l = r0 >> 6, r = r0 & 63, kt = r >> 2, ntl = r & 3;
        transpose_tile(smem, uin(p, I_WOUT) + (size_t)l * D * D, D, kt * 64, ntl * 256, (bf16_t*)(ws + WS_WOUT_T) + (size_t)l * D * D, D, [](int n) { return n; });
      }
      continue;
    }
    it -= N_TRW;
    if (it < N_EL) {
      for (int q = 0; q < 4; ++q) {
        int e = (it * 4 + q) * NTHREADS + tid;
        if (e < 655360) {
          const int l = e / 327680, r = e % 327680, n = r >> 8, k = r & 255;
          float v = 0.f;
          if (n < 512) { const int d = n >> 8, col = n & 255; if (k < 64) v = uin(p, I_W2)[((l * 2 + d) * 64 + k) * 256 + col]; }
          else if (n < 1024) { const int d = (n - 512) >> 8, col = n & 255; if (k >= 64 && k < 128) v = uin(p, I_A2)[((l * 2 + d) * 64 + (k - 64)) * 256 + col]; }
          else { const int col = n - 1024; if (k >= 128) v = uin(p, I_G2)[(l * 128 + (k - 128)) * 256 + col]; }
          ((bf16_t*)(ws + WS_FW))[e] = f2bf(v);
          continue;
        }
        e -= 655360;
        if (e < 131072) {
          const int l = e >> 16, r = e & 65535, n = r >> 8, k = r & 255;
          ((bf16_t*)(ws + WS_GLU_T))[e] = f2bf(uin(p, I_GLUW)[(l * 256 + k) * 256 + n]);
          continue;
        }
        e -= 131072;
        if (e < 524288) {
          const int l = e >> 18, r = e & 262143, hl = r >> 17, n = (r >> 10) & 127, k = r & 1023;
          float v = 0.f;
          if (n < 4) v = uin(p, I_RGW)[(l * D + k) * 4 + n];
          else if (n < 36) v = uin(p, I_REW)[(l * D + k) * 32 + (n - 4)];
          const bf16_t h = f2bf(v);
          ((bf16_t*)(ws + WS_RW))[e] = hl ? f2bf(v - bf2f(h)) : h;
        }
      }
      continue;
    }
    it -= N_EL;
    if (it < N_AP) {
      const int e = it * NTHREADS + tid;
      if (e < 2 * 2 * 16 * 64 * 33) {
        const int j = e % 33, r = e / 33, pp = r & 63, g = (r >> 6) & 15, d = (r >> 10) & 1, l = r >> 11;
        const S5Disc dd = s5disc(p, l, d, g, pp);
        const float mg = expf(dd.lm * (float)j), an = dd.th * (float)j;
        ((float2*)(ws + WS_APOW))[e] = make_float2(mg * cosf(an), mg * sinf(an));
      }
      continue;
    }
    it -= N_AP;
    {
      const int e = it * NTHREADS + tid;
      const int c2 = e & 15, pp = (e >> 4) & 63, g = (e >> 10) & 15, d = (e >> 14) & 1, l = e >> 15;
      const S5Disc dd = s5disc(p, l, d, g, pp);
      const float br = uin(p, I_BRE)[((l * 16 + g) * 64 + pp) * 16 + c2], bi = uin(p, I_BIM)[((l * 16 + g) * 64 + pp) * 16 + c2];
      ((float2*)(ws + WS_BBT))[e] = make_float2(dd.cr * br - dd.ci * bi, dd.cr * bi + dd.ci * br);
    }
  }
}

DEVI void write_xmod_row(const float4 v[4], const float* modl, bf16_t* dstrow, int lane) {
#pragma unroll
  for (int i = 0; i < 4; ++i) {
    const int col = i * 256 + lane * 4;
    const float4 sh = *(const float4*)(modl + col), sc = *(const float4*)(modl + 1024 + col);
    uint2 o; o.x = pack2(v[i].x * (1.f + sc.x) + sh.x, v[i].y * (1.f + sc.y) + sh.y); o.y = pack2(v[i].z * (1.f + sc.z) + sh.z, v[i].w * (1.f + sc.w) + sh.w);
    *(uint2*)(dstrow + col) = o;
  }
}
DEVI void phase0b(const Params& p, unsigned char* smem) {
  const int tid = tid_(), bid = bid_(), G = gridDim.x, lane = tid & 63, wid = tid >> 6;
  unsigned char* ws = uws(p);
  {
    bf16_t* XM = (bf16_t*)((unsigned char*)uout(p) + DO_XMOD);
    const float* MOD = (const float*)(ws + WS_MOD);
    const int nw = G * 8, gw = bid * 8 + wid, rpw = (NT + nw - 1) / nw;
    const int R0 = gw * rpw, R1 = (R0 + rpw < NT) ? (R0 + rpw) : NT;
    const int c0 = lane * 8, c1 = 512 + lane * 8;
    float sh[2][8], sc[2][8], xv[2][8];
    int curb = -1;
    if (R0 < R1) { ld8f(xin_row(p, R0) + c0, xv[0]); ld8f(xin_row(p, R0) + c1, xv[1]); }
    for (int R = R0; R < R1; ++R) {
      float xn[2][8];
#pragma unroll
      for (int h = 0; h < 2; ++h)
#pragma unroll
        for (int e = 0; e < 8; ++e) xn[h][e] = 0.f;
      if (R + 1 < R1) { ld8f(xin_row(p, R + 1) + c0, xn[0]); ld8f(xin_row(p, R + 1) + c1, xn[1]); }
      const int bi = bidx_of(R);
      if (bi != curb) { curb = bi; const float* modl = MOD + (size_t)bi * 6144; ld8f(modl + c0, sh[0]); ld8f(modl + c1, sh[1]); ld8f(modl + 1024 + c0, sc[0]); ld8f(modl + 1024 + c1, sc[1]); }
#pragma unroll
      for (int h = 0; h < 2; ++h) {
        float xm[8];
#pragma unroll
        for (int e = 0; e < 8; ++e) xm[e] = xv[h][e] * (1.f + sc[h][e]) + sh[h][e];
        st8b(XM + (size_t)R * D + (h ? c1 : c0), xm);
      }
#pragma unroll
      for (int h = 0; h < 2; ++h)
#pragma unroll
        for (int e = 0; e < 8; ++e) xv[h][e] = xn[h][e];
    }
  }
  const float* KT = (const float*)(ws + WS_KTAB);
  const float2* AP = (const float2*)(ws + WS_APOW);
  const float2* BB = (const float2*)(ws + WS_BBT);
  const long nthreads = (long)G * NTHREADS, gt = (long)bid * NTHREADS + tid;
  const long n_ttg = 2L * 16 * 512 * 96;
  for (long e = gt; e < n_ttg; e += nthreads) {
    const int k8 = (int)(e % 96), m = (int)((e / 96) & 511), g = (int)((e / (96 * 512)) & 15), l = (int)(e / (96 * 512 * 16));
    const int tau = m >> 4, c = m & 15, k = k8 * 8;
    float v[8];
    if (k < 512) {
      const int sg = k >> 4, c2 = k & 15;
      const float* K0 = KT + (size_t)(((l * 16 + g) * 2 + 0) * 32) * 256 + c * 16 + c2;
      const float* K1 = KT + (size_t)(((l * 16 + g) * 2 + 1) * 32) * 256 + c * 16 + c2;
      if (sg < tau) { for (int q = 0; q < 8; ++q) v[q] = K0[(tau - sg) * 256 + q]; }
      else if (sg > tau) { for (int q = 0; q < 8; ++q) v[q] = K1[(sg - tau) * 256 + q]; }
      else { for (int q = 0; q < 8; ++q) v[q] = K0[q] + K1[q] + ((c2 + q == c) ? uin(p, I_SD)[l * 256 + g * 16 + c] : 0.f); }
    } else {
      const int q0 = k - 512, d = q0 >> 7, isim = (q0 >> 6) & 1, p0 = q0 & 63;
      const int j = d ? (32 - tau) : (tau + 1);
      for (int q = 0; q < 8; ++q) {
        const int pp = p0 + q;
        const float2 a = AP[((size_t)(((l * 2 + d) * 16 + g) * 64 + pp)) * 33 + j];
        const float cr = uin(p, I_CRE)[((l * 16 + g) * 16 + c) * 64 + pp], ci = uin(p, I_CIM)[((l * 16 + g) * 16 + c) * 64 + pp];
        v[q] = isim ? -(cr * a.y + ci * a.x) : (cr * a.x - ci * a.y);
      }
    }
    uint4 o; o.x = pack2(v[0], v[1]); o.y = pack2(v[2], v[3]); o.z = pack2(v[4], v[5]); o.w = pack2(v[6], v[7]);
    *(uint4*)((bf16_t*)(ws + WS_TTG) + (size_t)e * 8) = o;
  }
  const long n_em = 2L * 16 * 256 * 64;
  for (long e = gt; e < n_em; e += nthreads) {
    const int k8 = (int)(e & 63), r = (int)((e >> 6) & 255), g = (int)((e >> 14) & 15), l = (int)(e >> 18);
    const int d = r >> 7, isim = (r >> 6) & 1, pp = r & 63, k = k8 * 8, sg = k >> 4, c2 = k & 15;
    const int j = d ? sg : (31 - sg);
    const float2 a = AP[((size_t)(((l * 2 + d) * 16 + g) * 64 + pp)) * 33 + j];
    float v[8];
    for (int q = 0; q < 8; ++q) {
      const float2 bb = BB[(size_t)((((l * 2 + d) * 16 + g) * 64 + pp) * 16) + c2 + q];
      v[q] = isim ? (a.x * bb.y + a.y * bb.x) : (a.x * bb.x - a.y * bb.y);
    }
    uint4 o; o.x = pack2(v[0], v[1]); o.y = pack2(v[2], v[3]); o.z = pack2(v[4], v[5]); o.w = pack2(v[6], v[7]);
    *(uint4*)((bf16_t*)(ws + WS_EM) + (size_t)e * 8) = o;
  }
}

struct EpiInproj {
  static constexpr bool PERM = true;
  bf16_t* PROJ; bf16_t* UDH; const float* RC; const float* RS;
  DEVI void operator()(const f32x4 (&acc)[2][2][4][2], const g8::Unit& u) const {
    const int tid = tid_(), wid = __builtin_amdgcn_readfirstlane(tid >> 6), lane = tid & 63, wr = wid >> 2, wc = wid & 3, fr = lane & 15, fq = lane >> 4;
    const bool lat = u.pm < 128;
#pragma unroll
    for (int ai = 0; ai < 2; ++ai)
#pragma unroll
      for (int m = 0; m < 4; ++m) {
        const int row = u.pm * 256 + ai * 128 + wr * 64 + m * 16 + fr, pos = row & 2047;
#pragma unroll
        for (int bj = 0; bj < 2; ++bj) {
          const int cb = u.pn * 256 + bj * 128 + wc * 32 + 8 * fq;
          f32x4 x0 = acc[ai][bj][m][0], x1 = acc[ai][bj][m][1];
          const bool isq = (u.pn == 5 || u.pn == 6), isk = (u.pn == 7 && bj == 0);
          if ((isq || isk) && lat) {
            const int i0 = 16 * (wc & 1) + 4 * fq;
            const float4 cs = *(const float4*)(RC + pos * 32 + i0), sn = *(const float4*)(RS + pos * 32 + i0);
            const f32x4 y0 = (f32x4){x0[0] * cs.x - x1[0] * sn.x, x0[1] * cs.y - x1[1] * sn.y, x0[2] * cs.z - x1[2] * sn.z, x0[3] * cs.w - x1[3] * sn.w};
            const f32x4 y1 = (f32x4){x1[0] * cs.x + x0[0] * sn.x, x1[1] * cs.y + x0[1] * sn.y, x1[2] * cs.z + x0[2] * sn.z, x1[3] * cs.w + x0[3] * sn.w};
            x0 = y0; x1 = y1;
          }
          if (isq) { x0 = x0 * 0.125f; x1 = x1 * 0.125f; }
          const uint4 o = make_uint4(pack2(x0[0], x0[1]), pack2(x0[2], x0[3]), pack2(x1[0], x1[1]), pack2(x1[2], x1[3]));
          if (u.pn == 4) {
            const int g = (cb - 1024) >> 4, c = cb & 15;
            *(uint4*)(UDH + ((size_t)(g * NCH + (row >> 5))) * 768 + (row & 31) * 16 + c) = o;
          } else {
            *(uint4*)(PROJ + (size_t)row * DIN + cb) = o;
          }
        }
        asm volatile("" ::: "memory");
      }
  }
};
DEVI void phase_inproj(const Params& p, int l, unsigned char* smem) {
  unsigned char* ws = uws(p);
  g8::DenseSched S{(const bf16_t*)((unsigned char*)uout(p) + DO_XMOD), (const bf16_t*)(ws + WS_WIN_T) + (size_t)l * DIN * D, D, 144, 8, (int)gridDim.x, bid_()};
  EpiInproj E{(bf16_t*)(ws + WS_PROJ), (bf16_t*)(ws + WS_UDH), (const float*)(ws + WS_ROPE), (const float*)(ws + WS_ROPE) + 65536};
  __syncthreads();
  g8::gemm((G8_LAS unsigned char*)smem, D, S, E);
  __syncthreads();
}

DEVI void phase_feat(const Params& p, int l, unsigned char* smem) {
  unsigned char* ws = uws(p);
  const bf16_t* PROJ = (const bf16_t*)(ws + WS_PROJ);
  unsigned short* FEAT = (unsigned short*)(ws + WS_FEAT);
  const bf16_t* FW = (const bf16_t*)(ws + WS_FW) + (size_t)l * 1280 * 256;
  const bf16_t* EM = (const bf16_t*)(ws + WS_EM) + (size_t)l * 16 * 256 * 512;
  float* HE = (float*)((unsigned char*)uout(p) + DO_HE);
  const float* CW = uin(p, I_CONV) + l * 3 * 1024;
  const int tid = tid_(), lrow = tid >> 2;
  for (int it = bid_(); it < 432 + 160; it += gridDim.x) {
    if (it < 432) {
      const int mt = it / 3, typ = it % 3;
      const int kb = typ == 0 ? 0 : (typ == 1 ? 64 : 128), KK = typ == 2 ? 128 : 64, lda = KK + 8;
      const int nt_lo = typ == 0 ? 0 : (typ == 1 ? 4 : 8), nt_n = typ == 2 ? 2 : 4;
      bf16_t* sA = (bf16_t*)smem;
      bf16_t* sB = sA + 256 * 136;
      {
        const int ppr = KK >> 3;
        const int kfix = kb + (tid % ppr) * 8;
        float wc0[8], wc1[8], wc2[8];
        ld8f(CW + 768 + kfix, wc0); ld8f(CW + 1024 + 768 + kfix, wc1); ld8f(CW + 2048 + 768 + kfix, wc2);
        for (int pc = tid; pc < 256 * ppr; pc += NTHREADS) {
          const int rr = pc / ppr, k = kfix;
          const int R = mt * 256 + rr;
          const int t = R < NLAT ? (R & 2047) : ((R - NLAT) & 255); const int len = R < NLAT ? SEQ : CTXL;
          const bf16_t* pcur = PROJ + (size_t)R * DIN + 768 + k;
          const uint4 vc = *(const uint4*)pcur;
          uint4 vp = make_uint4(0, 0, 0, 0), vn = make_uint4(0, 0, 0, 0);
          if (t > 0) vp = *(const uint4*)(pcur - DIN);
          if (t < len - 1) vn = *(const uint4*)(pcur + DIN);
          float x[8];
          const unsigned up[4] = {vp.x, vp.y, vp.z, vp.w}, uc[4] = {vc.x, vc.y, vc.z, vc.w}, un[4] = {vn.x, vn.y, vn.z, vn.w};
#pragma unroll
          for (int q = 0; q < 4; ++q) {
            x[2 * q] = lo_bf(up[q]) * wc0[2 * q] + lo_bf(uc[q]) * wc1[2 * q] + lo_bf(un[q]) * wc2[2 * q];
            x[2 * q + 1] = hi_bf(up[q]) * wc0[2 * q + 1] + hi_bf(uc[q]) * wc1[2 * q + 1] + hi_bf(un[q]) * wc2[2 * q + 1];
          }
          if (typ == 0) { for (int q = 0; q < 8; ++q) x[q] = 1.f - 2.f * __builtin_amdgcn_rcpf(1.f + __expf(2.f * x[q])); }
          else if (typ == 2) { for (int q = 0; q < 8; ++q) x[q] = sigmoidf(x[q]); }
          *(uint4*)(sA + rr * lda + (k - kb)) = make_uint4(pack2(x[0], x[1]), pack2(x[2], x[3]), pack2(x[4], x[5]), pack2(x[6], x[7]));
        }
      }
      const int lane = tid & 63, wid = tid >> 6, wr = wid >> 1, wc = wid & 1, fr = lane & 15, fq = lane >> 4;
      for (int nq = 0; nq < nt_n; ++nq) {
        const int ntl = nt_lo + nq;
        __syncthreads();
        {
          const int ppr = KK >> 3;
          for (int pc = tid; pc < 128 * ppr; pc += NTHREADS) {
            const int rr = pc / ppr, k = (pc % ppr) * 8;
            *(uint4*)(sB + rr * lda + k) = *(const uint4*)(FW + (size_t)(ntl * 128 + rr) * 256 + kb + k);
          }
        }
        __syncthreads();
        f32x4 acc[4][4];
#pragma unroll
        for (int m = 0; m < 4; ++m)
#pragma unroll
          for (int n = 0; n < 4; ++n) acc[m][n] = (f32x4){0.f, 0.f, 0.f, 0.f};
        for (int k0 = 0; k0 < KK; k0 += 32) {
          bf16x8 bfr[4];
#pragma unroll
          for (int n = 0; n < 4; ++n) bfr[n] = *(const bf16x8*)(sB + (wc * 64 + n * 16 + fr) * lda + k0 + fq * 8);
#pragma unroll
          for (int m = 0; m < 4; ++m) {
            const bf16x8 af = *(const bf16x8*)(sA + (wr * 64 + m * 16 + fr) * lda + k0 + fq * 8);
#pragma unroll
            for (int n = 0; n < 4; ++n) acc[m][n] = __builtin_amdgcn_mfma_f32_16x16x32_bf16(bfr[n], af, acc[m][n], 0, 0, 0);
          }
        }
#pragma unroll
        for (int m = 0; m < 4; ++m) {
          const int row = mt * 256 + wr * 64 + m * 16 + fr;
#pragma unroll
          for (int n = 0; n < 4; ++n) {
            const int ng = ntl * 128 + wc * 64 + n * 16 + fq * 4;
            float o[4];
            if (typ == 0) {
              const float4 w0 = *(const float4*)(uin(p, I_W0) + (l * 2 + (ng >> 8)) * 256 + (ng & 255));
              const float wv[4] = {w0.x, w0.y, w0.z, w0.w};
#pragma unroll
              for (int j = 0; j < 4; ++j) {
                const float e = 0.6065306597126334f * sigmoidf(acc[m][n][j] + wv[j]);
                o[j] = 1.f - __expf(-e);
              }
            } else if (typ == 1) {
              const float4 a0 = *(const float4*)(uin(p, I_A0) + (l * 2 + ((ng - 512) >> 8)) * 256 + (ng & 255));
              const float av[4] = {a0.x, a0.y, a0.z, a0.w};
#pragma unroll
              for (int j = 0; j < 4; ++j) o[j] = sigmoidf(acc[m][n][j] + av[j]);
            } else {
#pragma unroll
              for (int j = 0; j < 4; ++j) o[j] = acc[m][n][j];
            }
            uint2 w; w.x = (unsigned)f2h(o[0]) | ((unsigned)f2h(o[1]) << 16); w.y = (unsigned)f2h(o[2]) | ((unsigned)f2h(o[3]) << 16);
            *(uint2*)(FEAT + (size_t)row * 1280 + ng) = w;
          }
        }
      }
      __syncthreads();
    } else {
      const int j = it - 432, g = j / 10, rest = j % 10, mt5 = rest >> 1, nt2 = rest & 1;
      int n0 = mt5 * 256 + lrow, n1 = n0 + 128; if (n0 > NCH - 1) n0 = NCH - 1; if (n1 > NCH - 1) n1 = NCH - 1;
      const bf16_t* UDH = (const bf16_t*)(ws + WS_UDH);
      const bf16_t* a0 = UDH + (size_t)(g * NCH + n0) * 768; const bf16_t* a1 = UDH + (size_t)(g * NCH + n1) * 768;
      const bf16_t* b0 = EM + (size_t)(g * 256 + nt2 * 128 + lrow) * 512;
      gemm_tile(smem, 0, 512,
        [&](int i, int k) { return *(const uint4*)((i ? a1 : a0) + k); },
        [&](int k) { return *(const uint4*)(b0 + k); },
        [&](f32x4 (&acc)[4][4], int wr, int wc, int fr, int fq) {
#pragma unroll
          for (int m = 0; m < 4; ++m) {
            const int n = mt5 * 256 + wr * 64 + m * 16 + fr;
            if (n < NCH) {
#pragma unroll
              for (int nn = 0; nn < 4; ++nn)
                *(f32x4*)(HE + (size_t)(g * NCH + n) * 256 + nt2 * 128 + wc * 64 + nn * 16 + fq * 4) = acc[m][nn];
            }
          }
        });
    }
  }
}


DEVI float row_reduce_scatter16(const float (&v)[16], int lane16) {
  float a[8], b[4], c[2];
  const bool b3 = (lane16 & 8) != 0, b2 = (lane16 & 4) != 0, b1 = (lane16 & 2) != 0, b0 = (lane16 & 1) != 0;
#pragma unroll
  for (int k = 0; k < 8; ++k) { const float send = b3 ? v[k] : v[k + 8], keep = b3 ? v[k + 8] : v[k]; a[k] = keep + dpp_f<0x128>(send); }
#pragma unroll
  for (int k = 0; k < 4; ++k) { const float send = b2 ? a[k] : a[k + 4], keep = b2 ? a[k + 4] : a[k]; b[k] = keep + dpp_f<0x141>(send); }
#pragma unroll
  for (int k = 0; k < 2; ++k) { const float send = b1 ? b[k] : b[k + 2], keep = b1 ? b[k + 2] : b[k]; c[k] = keep + dpp_f<0x4E>(send); }
  { const float send = b0 ? c[0] : c[1], keep = b0 ? c[1] : c[0]; return keep + dpp_f<0xB1>(send); }
}
DEVI float mul_mix_lo(float a, unsigned hpair) { float r; asm("v_fma_mix_f32 %0, %1, %2, 0 op_sel_hi:[0,1,0]" : "=v"(r) : "v"(a), "v"(hpair)); return r; }
constexpr int RC_SLOT = 17664;
constexpr int RC_KK = 0, RC_RR = 2304, RC_KDB = 4608, RC_TT = 8704, RC_MM = 9728, RC_V = 10752, RC_G = 12800, RC_KD = 13056, RC_BB = 15360;
DEVI bf16x8 rc_pack8(const f32x4& a, const f32x4& b) {
  typedef unsigned u4v __attribute__((ext_vector_type(4)));
  const u4v u = {pack2(a[0], a[1]), pack2(a[2], a[3]), pack2(b[0], b[1]), pack2(b[2], b[3])};
  return __builtin_bit_cast(bf16x8, u);
}
DEVI bf16x8 rc_pack8(const f32x4& a, uint2 b) {
  typedef unsigned u4v __attribute__((ext_vector_type(4)));
  const u4v u = {pack2(a[0], a[1]), pack2(a[2], a[3]), b.x, b.y};
  return __builtin_bit_cast(bf16x8, u);
}
DEVI bf16x8 rc_pack8(uint2 a, const f32x4& b) {
  typedef unsigned u4v __attribute__((ext_vector_type(4)));
  const u4v u = {a.x, a.y, pack2(b[0], b[1]), pack2(b[2], b[3])};
  return __builtin_bit_cast(bf16x8, u);
}
template <int DIR>
DEVI void rwkv_chunked(const Params& p, int l, int it, unsigned char* smem) {
  unsigned char* ws = uws(p);
  const int b = it >> 3, h = (it >> 1) & 3;
  const bf16_t* PROJ = (const bf16_t*)(ws + WS_PROJ);
  const unsigned short* FEAT = (const unsigned short*)(ws + WS_FEAT);
  float* Y = (float*)((unsigned char*)uout(p) + (DIR ? DO_YB : DO_YF));
  const int tid = tid_(), lane = tid & 63, wid = __builtin_amdgcn_readfirstlane(tid >> 6);
  const int cl = lane & 15, cq = lane >> 4;
  const int hc = h * 64 + lane;
  const float* CW = uin(p, I_CONV) + l * 3 * 1024;
  float cwr[3], cwk[3], cwv[3];
#pragma unroll
  for (int dl = 0; dl < 3; ++dl) { cwr[dl] = CW[dl * 1024 + hc]; cwk[dl] = CW[dl * 1024 + 256 + hc]; cwv[dl] = CW[dl * 1024 + 512 + hc]; }
  const float kkw = uin(p, I_KK)[l * 256 + hc], kaw = uin(p, I_KA)[l * 256 + hc];
  const int pj = 32 * (lane >> 5) + 8 * ((lane >> 2) & 3) + 4 * ((lane >> 4) & 1) + (lane & 3);
  unsigned char* slot = smem + wid * RC_SLOT;
  const f32x4 zero4 = {0.f, 0.f, 0.f, 0.f};
  f32x4 acc[4] = {zero4, zero4, zero4, zero4};
  uint4 raw0, raw1, raw2, raw3, raw4, raw5, raw6, raw7, raw8, raw9, raw10;
  auto chunk_geom = [&](int c, bool& isctx, int& seqlen, int& lo, int& rowbase) __attribute__((always_inline)) {
    const int n0 = c * 16; isctx = n0 < 256; seqlen = isctx ? 256 : 2048; const int m0 = isctx ? n0 : n0 - 256;
    lo = DIR ? (seqlen - 16 - m0) : m0;
    rowbase = isctx ? (NLAT + b * CTXL) : (b * SEQ);
  };
#define RC_LDP(ld, dst) do { const int L_ = (ld) * 64 + lane_; const int Lc_ = L_ < 432 ? L_ : 431; const int u_ = Lc_ / 24, sg_ = (Lc_ % 24) >> 3, part_ = Lc_ & 7; \
    int tau_ = lo_ - 1 + u_; tau_ = tau_ < 0 ? 0 : (tau_ >= seqlen_ ? seqlen_ - 1 : tau_); \
    dst = *(const uint4*)(PROJ + (size_t)(rowbase_ + tau_) * DIN + h * 64 + sg_ * 256 + part_ * 8); } while (0)
#define RC_LDF(ld, dst) do { const int L_ = (ld) * 64 + lane_; const int o_ = L_ >> 4, sg_ = (L_ >> 3) & 1, part_ = L_ & 7; \
    dst = *(const uint4*)(FEAT + (size_t)(rowbase_ + lo_ + o_) * 1280 + DIR * 256 + sg_ * 512 + h * 64 + part_ * 8); } while (0)
#define RC_LOAD_RAW(c) do { bool isctx_; int seqlen_, lo_, rowbase_; chunk_geom((c), isctx_, seqlen_, lo_, rowbase_); const int lane_ = tid_() & 63;     \
    RC_LDP(0, raw0); RC_LDP(1, raw1); RC_LDP(2, raw2); RC_LDP(3, raw3); RC_LDP(4, raw4); RC_LDP(5, raw5); RC_LDP(6, raw6); \
    RC_LDF(0, raw7); RC_LDF(1, raw8); RC_LDF(2, raw9); RC_LDF(3, raw10); } while (0)
  RC_LOAD_RAW(wid);
  for (int batch = 0; batch < 18; ++batch) {
    {
      const int c = batch * 8 + wid;
      bool isctx; int seqlen, lo, rowbase; chunk_geom(c, isctx, seqlen, lo, rowbase);
      *(uint4*)(slot + (0 * 64 + lane) * 16) = raw0; *(uint4*)(slot + (1 * 64 + lane) * 16) = raw1; *(uint4*)(slot + (2 * 64 + lane) * 16) = raw2; *(uint4*)(slot + (3 * 64 + lane) * 16) = raw3;
      *(uint4*)(slot + (4 * 64 + lane) * 16) = raw4; *(uint4*)(slot + (5 * 64 + lane) * 16) = raw5; if (6 * 64 + lane < 432) *(uint4*)(slot + (6 * 64 + lane) * 16) = raw6;
      *(uint4*)(slot + 6912 + (0 * 64 + lane) * 16) = raw7; *(uint4*)(slot + 6912 + (1 * 64 + lane) * 16) = raw8; *(uint4*)(slot + 6912 + (2 * 64 + lane) * 16) = raw9; *(uint4*)(slot + 6912 + (3 * 64 + lane) * 16) = raw10;
      const unsigned short* sraw = (const unsigned short*)slot + lane;
      const bool ok_lo = lo - 1 >= 0, ok_hi = lo + 16 < seqlen;
      float kC[16], kkr[16], sq[16];
      {
        float Rk[18];
#pragma unroll
        for (int u = 0; u < 18; ++u) Rk[u] = __uint_as_float((unsigned)sraw[(u * 3 + 1) * 64] << 16);
        if (!ok_lo) Rk[0] = 0.f;
        if (!ok_hi) Rk[17] = 0.f;
#pragma unroll
        for (int o = 0; o < 16; ++o) { kC[o] = cwk[0] * Rk[o] + cwk[1] * Rk[o + 1] + cwk[2] * Rk[o + 2]; kkr[o] = kC[o] * kkw; sq[o] = kkr[o] * kkr[o]; }
      }
      float tot = row_reduce_scatter16(sq, cl);
      tot += shfl_xor_l(tot, 16); tot += shfl_xor_l(tot, 32);
      const float invv = rsqrtf(tot + 1e-12f);
      float rC[16], vC[16], xwF[16], aF[16];
      {
        float Rr[18], Rv[18];
#pragma unroll
        for (int u = 0; u < 18; ++u) { Rr[u] = __uint_as_float((unsigned)sraw[(u * 3 + 0) * 64] << 16); Rv[u] = __uint_as_float((unsigned)sraw[(u * 3 + 2) * 64] << 16); }
        if (!ok_lo) { Rr[0] = 0.f; Rv[0] = 0.f; }
        if (!ok_hi) { Rr[17] = 0.f; Rv[17] = 0.f; }
#pragma unroll
        for (int o = 0; o < 16; ++o) { rC[o] = cwr[0] * Rr[o] + cwr[1] * Rr[o + 1] + cwr[2] * Rr[o + 2]; vC[o] = cwv[0] * Rv[o] + cwv[1] * Rv[o + 1] + cwv[2] * Rv[o + 2]; }
#pragma unroll
        for (int o = 0; o < 16; ++o) { xwF[o] = h2f(sraw[3456 + (o * 2 + 0) * 64]); aF[o] = h2f(sraw[3456 + (o * 2 + 1) * 64]); }
      }
      float G = 1.f;
      float kdq[4], bbq[4], vq[4];
      bf16_t* sKK = (bf16_t*)(slot + RC_KK); bf16_t* sRR = (bf16_t*)(slot + RC_RR); bf16_t* sKD = (bf16_t*)(slot + RC_KD); bf16_t* sBB = (bf16_t*)(slot + RC_BB);
#pragma unroll
      for (int s = 0; s < 16; ++s) {
        const int o = DIR ? (15 - s) : s;
        const float inv = __int_as_float(__builtin_amdgcn_readlane(__float_as_int(invv), o));
        const float okk = kkr[o] * inv, a = aF[o], ob = okk * a, okd = kC[o] * (1.f + (a - 1.f) * kaw), w = 1.f - xwF[o];
        const float kkt = okk * G;
        G *= w;
        const float ig = __builtin_amdgcn_rcpf(G);
        const float rt = rC[o] * G, kdt = okd * ig, bt = ob * ig;
        sKK[s * 72 + pj] = f2bf(kkt); sRR[s * 72 + pj] = f2bf(rt); sKD[s * 72 + pj] = f2bf(kdt); sBB[s * 72 + pj] = f2bf(bt);
        kdq[s & 3] = kdt; bbq[s & 3] = -bt; vq[s & 3] = vC[o];
        if ((s & 3) == 3) {
          const int fi = ((lane >> 4) * 4 + (s >> 2)) * 16 + (lane & 15);
          *(uint4*)(slot + RC_KDB + fi * 16) = make_uint4(pack2(kdq[0], kdq[1]), pack2(kdq[2], kdq[3]), pack2(bbq[0], bbq[1]), pack2(bbq[2], bbq[3]));
          *(uint2*)(slot + RC_V + fi * 8) = make_uint2(pack2(vq[0], vq[1]), pack2(vq[2], vq[3]));
        }
      }
      ((float*)(slot + RC_G))[lane] = G;
      const bf16x8 aK0 = *(const bf16x8*)(sKK + cl * 72 + 8 * cq), aK1 = *(const bf16x8*)(sKK + cl * 72 + 32 + 8 * cq);
      const bf16x8 aR0 = *(const bf16x8*)(sRR + cl * 72 + 8 * cq), aR1 = *(const bf16x8*)(sRR + cl * 72 + 32 + 8 * cq);
      const bf16x8 bD0 = *(const bf16x8*)(sKD + cl * 72 + 8 * cq), bD1 = *(const bf16x8*)(sKD + cl * 72 + 32 + 8 * cq);
      const bf16x8 bB0 = *(const bf16x8*)(sBB + cl * 72 + 8 * cq), bB1 = *(const bf16x8*)(sBB + cl * 72 + 32 + 8 * cq);
      f32x4 Abk = __builtin_amdgcn_mfma_f32_16x16x32_bf16(aK0, bB0, zero4, 0, 0, 0); Abk = __builtin_amdgcn_mfma_f32_16x16x32_bf16(aK1, bB1, Abk, 0, 0, 0);
      f32x4 Avk = __builtin_amdgcn_mfma_f32_16x16x32_bf16(aK0, bD0, zero4, 0, 0, 0); Avk = __builtin_amdgcn_mfma_f32_16x16x32_bf16(aK1, bD1, Avk, 0, 0, 0);
      f32x4 Mbr = __builtin_amdgcn_mfma_f32_16x16x32_bf16(aR0, bB0, zero4, 0, 0, 0); Mbr = __builtin_amdgcn_mfma_f32_16x16x32_bf16(aR1, bB1, Mbr, 0, 0, 0);
      f32x4 Mvr = __builtin_amdgcn_mfma_f32_16x16x32_bf16(aR0, bD0, zero4, 0, 0, 0); Mvr = __builtin_amdgcn_mfma_f32_16x16x32_bf16(aR1, bD1, Mvr, 0, 0, 0);
      float* tA = (float*)(slot + RC_KD); float* tVT = tA + 256;
      bf16_t* sMM = (bf16_t*)(slot + RC_MM);
#pragma unroll
      for (int r = 0; r < 4; ++r) {
        const int t = 4 * cq + r;
        const float abk = (cl < t) ? Abk[r] : 0.f, avk = (cl < t) ? Avk[r] : 0.f, mbr = (cl <= t) ? Mbr[r] : 0.f, mvr = (cl <= t) ? Mvr[r] : 0.f;
        tA[t * 16 + cl] = abk; Avk[r] = avk;
        sMM[((cl >> 2) * 16 + t) * 8 + (cl & 3)] = f2bf(mvr); sMM[((cl >> 2) * 16 + t) * 8 + 4 + (cl & 3)] = f2bf(-mbr);
      }
      *(float4*)(tVT + cl * 16 + 4 * cq) = make_float4(Avk[0], Avk[1], Avk[2], Avk[3]);
      {
        const bool isTA = ((lane >> 4) & 1) != 0;
        float X[16];
        {
          const float4* pv = (const float4*)(tVT + cl * 16);
          const float4 r0 = pv[0], r1 = pv[1], r2 = pv[2], r3 = pv[3];
          const float rh[16] = {r0.x, r0.y, r0.z, r0.w, r1.x, r1.y, r1.z, r1.w, r2.x, r2.y, r2.z, r2.w, r3.x, r3.y, r3.z, r3.w};
#pragma unroll
          for (int t = 0; t < 16; ++t) X[t] = isTA ? rh[t] : ((t == cl) ? 1.f : 0.f);
        }
#pragma unroll
        for (int t = 1; t < 16; ++t) {
          float a = X[t];
#pragma unroll
          for (int s4 = 0; s4 * 4 < t; ++s4) {
            const float4 ar = *(const float4*)(tA + t * 16 + 4 * s4);
            if (4 * s4 + 0 < t) a = fmaf(-ar.x, X[4 * s4 + 0], a);
            if (4 * s4 + 1 < t) a = fmaf(-ar.y, X[4 * s4 + 1], a);
            if (4 * s4 + 2 < t) a = fmaf(-ar.z, X[4 * s4 + 2], a);
            if (4 * s4 + 3 < t) a = fmaf(-ar.w, X[4 * s4 + 3], a);
          }
          X[t] = a;
        }
        bf16_t* sTT = (bf16_t*)(slot + RC_TT);
        if (lane < 32) {
#pragma unroll
          for (int t = 0; t < 16; ++t) sTT[((cl >> 2) * 16 + t) * 8 + (cl & 3) + (isTA ? 4 : 0)] = f2bf(X[t]);
        }
      }
    }
    __syncthreads();
    if (batch + 1 < 18) RC_LOAD_RAW((batch + 1) * 8 + wid);
    if (wid < 4) {
      const int itile = wid;
      bf16x8 nK0, nK1, nR0, nR1, nTT; uint2 nV;
#define RC_CONS_LOAD(sl_) do { nK0 = *(const bf16x8*)((sl_) + RC_KK + (cl * 72 + 8 * cq) * 2); nK1 = *(const bf16x8*)((sl_) + RC_KK + (cl * 72 + 32 + 8 * cq) * 2); \
        nR0 = *(const bf16x8*)((sl_) + RC_RR + (cl * 72 + 8 * cq) * 2); nR1 = *(const bf16x8*)((sl_) + RC_RR + (cl * 72 + 32 + 8 * cq) * 2); \
        nTT = *(const bf16x8*)((sl_) + RC_TT + lane * 16); nV = *(const uint2*)((sl_) + RC_V + (itile * 64 + lane) * 8); } while (0)
      RC_CONS_LOAD(smem);
#pragma unroll 1
      for (int k = 0; k < 8; ++k) {
        const unsigned char* sl = smem + k * RC_SLOT;
        const bf16x8 aK0 = nK0, aK1 = nK1, aR0 = nR0, aR1 = nR1, fTT = nTT; const uint2 fV = nV;
        const bf16x8 fMM = *(const bf16x8*)(sl + RC_MM + lane * 16);
        const bf16x8 Bs0 = rc_pack8(acc[0], acc[1]), Bs1 = rc_pack8(acc[2], acc[3]);
        f32x4 P = __builtin_amdgcn_mfma_f32_16x16x32_bf16(aK0, Bs0, zero4, 0, 0, 0); P = __builtin_amdgcn_mfma_f32_16x16x32_bf16(aK1, Bs1, P, 0, 0, 0);
        f32x4 Yv = __builtin_amdgcn_mfma_f32_16x16x32_bf16(aR0, Bs0, zero4, 0, 0, 0); Yv = __builtin_amdgcn_mfma_f32_16x16x32_bf16(aR1, Bs1, Yv, 0, 0, 0);
        if (k + 1 < 8) RC_CONS_LOAD(sl + RC_SLOT);
        const f32x4 SA = __builtin_amdgcn_mfma_f32_16x16x32_bf16(fTT, rc_pack8(P, fV), zero4, 0, 0, 0);
        const bf16x8 Bvs = rc_pack8(fV, SA);
        Yv = __builtin_amdgcn_mfma_f32_16x16x32_bf16(fMM, Bvs, Yv, 0, 0, 0);
#pragma unroll
        for (int jt = 0; jt < 4; ++jt) {
          const bf16x8 fKDB = *(const bf16x8*)(sl + RC_KDB + (jt * 64 + lane) * 16);
          const float4 g = *(const float4*)(sl + RC_G + (16 * jt + 4 * cq) * 4);
          acc[jt] = __builtin_amdgcn_mfma_f32_16x16x32_bf16(fKDB, Bvs, acc[jt], 0, 0, 0);
          acc[jt][0] *= g.x; acc[jt][1] *= g.y; acc[jt][2] *= g.z; acc[jt][3] *= g.w;
        }
        bool isctx; int seqlen, lo, rowbase; chunk_geom(batch * 8 + k, isctx, seqlen, lo, rowbase);
        if (!(l == 1 && isctx)) {
#pragma unroll
          for (int r = 0; r < 4; ++r) {
            const int t = 4 * cq + r, o = DIR ? (15 - t) : t;
            Y[(size_t)(rowbase + lo + o) * 256 + h * 64 + itile * 16 + cl] = Yv[r];
          }
        }
      }
    }
    __syncthreads();
  }
#undef RC_LDP
#undef RC_LDF
#undef RC_LOAD_RAW
#undef RC_CONS_LOAD
}

DEVI void s5_carry_item(const Params& p, int l, int g, int b) {
  unsigned char* ws = uws(p);
  const int tid = tid_();
  if (tid >= 128) return;
  const float* HE = (const float*)((unsigned char*)uout(p) + DO_HE) + (size_t)g * NCH * 256;
  bf16_t* UDH = (bf16_t*)(ws + WS_UDH) + (size_t)g * NCH * 768;
  const int dd = tid >> 6, pp = tid & 63;
  const float2 aT = ((const float2*)(ws + WS_APOW))[((size_t)(((l * 2 + dd) * 16 + g) * 64 + pp)) * 33 + 32];
  const int off = dd * 128 + pp;
  float hr = 0.f, hi = 0.f;
  {
    float er[8], ei[8];
#pragma unroll
    for (int c = 0; c < 8; ++c) { const int n = 1024 + b * 8 + (dd ? (7 - c) : c); er[c] = HE[(size_t)n * 256 + off]; ei[c] = HE[(size_t)n * 256 + off + 64]; }
#pragma unroll
    for (int c = 0; c < 8; ++c) {
      const int n = 1024 + b * 8 + (dd ? (7 - c) : c);
      UDH[(size_t)n * 768 + 512 + off] = f2bf(hr); UDH[(size_t)n * 768 + 512 + off + 64] = f2bf(hi);
      const float nr = aT.x * hr - aT.y * hi + er[c], ni = aT.x * hi + aT.y * hr + ei[c];
      hr = nr; hi = ni;
    }
  }
#pragma unroll 1
  for (int c0 = 0; c0 < 64; c0 += 16) {
    float er[16], ei[16];
#pragma unroll
    for (int c = 0; c < 16; ++c) { const int n = b * 64 + (dd ? (63 - c0 - c) : (c0 + c)); er[c] = HE[(size_t)n * 256 + off]; ei[c] = HE[(size_t)n * 256 + off + 64]; }
#pragma unroll
    for (int c = 0; c < 16; ++c) {
      const int n = b * 64 + (dd ? (63 - c0 - c) : (c0 + c));
      UDH[(size_t)n * 768 + 512 + off] = f2bf(hr); UDH[(size_t)n * 768 + 512 + off + 64] = f2bf(hi);
      const float nr = aT.x * hr - aT.y * hi + er[c], ni = aT.x * hi + aT.y * hr + ei[c];
      hr = nr; hi = ni;
    }
  }
}

struct S5Sched {
  const bf16_t* UDH; const bf16_t* TTG; int G, c, ntile;
  DEVI bool next(int i, g8::Unit& u) const {
    const int L = i * G + c; if (L >= 16 * ntile * 2) return false;
    u.e = L / (ntile * 2); const int r = L % (ntile * 2); u.pm = r >> 1; u.pn = r & 1; return true;
  }
  DEVI const char* a_base() const { return (const char*)UDH; }
  DEVI void a_offs(const g8::Unit& u, int tid, unsigned (&ao)[2][2]) const {
#pragma unroll
    for (int i = 0; i < 2; ++i) {
      int R, C; g8::stage_rc(tid * 16 + i * 8192, R, C);
#pragma unroll
      for (int h = 0; h < 2; ++h) ao[h][i] = ((unsigned)(u.e * NCH + u.pm * 256 + h * 128 + R) * 768u + (unsigned)C) * 2u;
    }
  }
  DEVI const char* b_ptr(const g8::Unit& u) const { return (const char*)(TTG + ((size_t)u.e * 512 + (size_t)u.pn * 256) * 768); }
};
struct EpiS5 {
  static constexpr bool PERM = true;
  bf16_t* ZB;
  DEVI void operator()(const f32x4 (&acc)[2][2][4][2], const g8::Unit& u) const {
    const int tid = tid_(), wid = __builtin_amdgcn_readfirstlane(tid >> 6), lane = tid & 63, wr = wid >> 2, wc = wid & 3, fr = lane & 15, fq = lane >> 4;
#pragma unroll
    for (int ai = 0; ai < 2; ++ai)
#pragma unroll
      for (int m = 0; m < 4; ++m) {
        const int n = u.pm * 256 + ai * 128 + wr * 64 + m * 16 + fr;
        if (n < NCH) {
#pragma unroll
          for (int bj = 0; bj < 2; ++bj) {
            const int mc = u.pn * 256 + bj * 128 + wc * 32 + 8 * fq, tau = mc >> 4, c = mc & 15;
            const f32x4 v0 = acc[ai][bj][m][0], v1 = acc[ai][bj][m][1];
            *(uint4*)(ZB + ((size_t)n * 32 + tau) * 256 + u.e * 16 + c) = make_uint4(pack2(gelu_tanh(v0[0]), gelu_tanh(v0[1])), pack2(gelu_tanh(v0[2]), gelu_tanh(v0[3])),
                                                                                   pack2(gelu_tanh(v1[0]), gelu_tanh(v1[1])), pack2(gelu_tanh(v1[2]), gelu_tanh(v1[3])));
          }
        }
        asm volatile("" ::: "memory");
      }
  }
};

DEVI void attn_item(const Params& p, int l, int b, int qb, int hq, unsigned char* smem) {
  unsigned char* ws = uws(p);
  const bf16_t* PROJ = (const bf16_t*)(ws + WS_PROJ);
  bf16_t* YMIX = (bf16_t*)(ws + WS_YMIX);
  bf16_t* sKV = (bf16_t*)smem;
  const int tid = tid_(), lane = tid & 63, wid = tid >> 6, r = lane & 31, hh = lane >> 5;
  const int kvh = hq >> 2;
  const bool ctxq = qb < 0;
  const int qrow0 = ctxq ? (NLAT + b * CTXL + wid * 32) : (b * SEQ + qb * 256 + wid * 32);
  const int q0pos = qb * 256 + wid * 32;
  bf16x8 qf[4];
  {
    const bf16_t* qp = PROJ + (size_t)(qrow0 + r) * DIN + 1280 + hq * 64 + hh * 8;
#pragma unroll
    for (int ks = 0; ks < 4; ++ks) qf[ks] = *(const bf16x8*)(qp + ks * 16);
  }
  f32x16 O0, O1;
#pragma unroll
  for (int i = 0; i < 16; ++i) { O0[i] = 0.f; O1[i] = 0.f; }
  float mrun = uin(p, I_SINK)[l * 8 + hq];
  float lsum = (hh == 0) ? 1.f : 0.f;
  const int jlo = ctxq ? 0 : (qb == 0 ? 2 : 0), jhi = ctxq ? 0 : (qb == 7 ? 6 : 8);
  const int nchunk = 4 + (jhi - jlo);
  const int nstage = (nchunk + 2) / 3;
  const int skey = tid >> 3, spc = (tid & 7) * 8;
  auto chunk_row0 = [&](int c) { return c < 4 ? (NLAT + b * CTXL + c * 64) : (b * SEQ + qb * 256 - 128 + (jlo + c - 4) * 64); };
  uint4 kr0, kr1, kr2, vr0, vr1, vr2;
  kr0 = kr1 = kr2 = vr0 = vr1 = vr2 = make_uint4(0, 0, 0, 0);
#define ATT_LOAD1(j, KR, VR, st_) do { const int c_ = (st_) * 3 + (j); if (c_ < nchunk) { \
    const bf16_t* kp_ = PROJ + (size_t)(chunk_row0(c_) + skey) * DIN + 1792 + kvh * 64 + spc; KR = *(const uint4*)kp_; VR = *(const uint4*)(kp_ + 128); } } while (0)
#define ATT_LOAD_STAGE(st_) do { ATT_LOAD1(0, kr0, vr0, st_); ATT_LOAD1(1, kr1, vr1, st_); ATT_LOAD1(2, kr2, vr2, st_); } while (0)
#define ATT_WRITE1(j, KR, VR) do { if (st * 3 + (j) < nchunk) { bf16_t* sKb_ = sB + (j) * (2 * 64 * 72); bf16_t* sVb_ = sKb_ + 64 * 72; \
    *(uint4*)(sKb_ + skey * 72 + spc) = KR; \
    sVb_[(spc + 0) * 72 + skey] = (bf16_t)(VR.x & 0xFFFF); sVb_[(spc + 1) * 72 + skey] = (bf16_t)(VR.x >> 16); \
    sVb_[(spc + 2) * 72 + skey] = (bf16_t)(VR.y & 0xFFFF); sVb_[(spc + 3) * 72 + skey] = (bf16_t)(VR.y >> 16); \
    sVb_[(spc + 4) * 72 + skey] = (bf16_t)(VR.z & 0xFFFF); sVb_[(spc + 5) * 72 + skey] = (bf16_t)(VR.z >> 16); \
    sVb_[(spc + 6) * 72 + skey] = (bf16_t)(VR.w & 0xFFFF); sVb_[(spc + 7) * 72 + skey] = (bf16_t)(VR.w >> 16); } } while (0)
  ATT_LOAD_STAGE(0);
  int buf = 0;
  for (int st = 0; st < nstage; ++st) {
    bf16_t* sB = sKV + buf * (6 * 64 * 72);
    ATT_WRITE1(0, kr0, vr0); ATT_WRITE1(1, kr1, vr1); ATT_WRITE1(2, kr2, vr2);
    __syncthreads();
    if (st + 1 < nstage) ATT_LOAD_STAGE(st + 1);
#pragma unroll 1
    for (int j = 0; j < 3; ++j) {
      const int c = st * 3 + j;
      if (c >= nchunk) break;
      const bf16_t* sKb = sB + j * (2 * 64 * 72); const bf16_t* sVb = sKb + 64 * 72;
      const bool band = c >= 4;
      const int kstart = band ? (qb * 256 - 128 + (jlo + c - 4) * 64) : 0;
#pragma unroll
      for (int tt = 0; tt < 2; ++tt) {
        const int ts = kstart + tt * 32;
        bool need = true, full = true;
        if (band) {
          need = (ts + 31 >= q0pos - 128) && (ts <= q0pos + 31 + 128);
          full = (ts >= q0pos + 31 - 128) && (ts + 31 <= q0pos + 128);
        }
        if (!need) continue;
        f32x16 S;
#pragma unroll
        for (int i = 0; i < 16; ++i) S[i] = 0.f;
#pragma unroll
        for (int ks = 0; ks < 4; ++ks) {
          const bf16x8 kf = *(const bf16x8*)(sKb + (tt * 32 + r) * 72 + ks * 16 + hh * 8);
          S = __builtin_amdgcn_mfma_f32_32x32x16_bf16(kf, qf[ks], S, 0, 0, 0);
        }
        if (!full) {
#pragma unroll
          for (int i = 0; i < 16; ++i) {
            const int kpos = ts + (i & 3) + 8 * (i >> 2) + 4 * hh;
            const int dl = (q0pos + r) - kpos;
            if (dl > 128 || dl < -128) S[i] = -1e30f;
          }
        }
        float mx = S[0];
#pragma unroll
        for (int i = 1; i < 16; ++i) mx = fmaxf(mx, S[i]);
        mx = fmaxf(mx, shfl_xor_l(mx, 32));
        const float mnew = fmaxf(mrun, mx);
        const float alpha = __expf(mrun - mnew);
        mrun = mnew;
        float ps = 0.f;
#pragma unroll
        for (int i = 0; i < 16; ++i) { S[i] = __expf(S[i] - mnew); ps += S[i]; }
        lsum = lsum * alpha + ps;
#pragma unroll
        for (int i = 0; i < 16; ++i) { O0[i] *= alpha; O1[i] *= alpha; }
        bf16x8 pf[2];
#pragma unroll
        for (int s2 = 0; s2 < 2; ++s2) {
          const uint4 u = make_uint4(pack2(S[8 * s2], S[8 * s2 + 1]), pack2(S[8 * s2 + 2], S[8 * s2 + 3]), pack2(S[8 * s2 + 4], S[8 * s2 + 5]), pack2(S[8 * s2 + 6], S[8 * s2 + 7]));
          pf[s2] = __builtin_bit_cast(bf16x8, u);
        }
#pragma unroll
        for (int s2 = 0; s2 < 2; ++s2) {
          {
            const bf16_t* vp = sVb + (0 * 32 + r) * 72 + tt * 32 + 16 * s2 + 4 * hh;
            const uint2 lo = *(const uint2*)vp, hi = *(const uint2*)(vp + 8);
            const uint4 u = make_uint4(lo.x, lo.y, hi.x, hi.y);
            O0 = __builtin_amdgcn_mfma_f32_32x32x16_bf16(__builtin_bit_cast(bf16x8, u), pf[s2], O0, 0, 0, 0);
          }
          {
            const bf16_t* vp = sVb + (1 * 32 + r) * 72 + tt * 32 + 16 * s2 + 4 * hh;
            const uint2 lo = *(const uint2*)vp, hi = *(const uint2*)(vp + 8);
            const uint4 u = make_uint4(lo.x, lo.y, hi.x, hi.y);
            O1 = __builtin_amdgcn_mfma_f32_32x32x16_bf16(__builtin_bit_cast(bf16x8, u), pf[s2], O1, 0, 0, 0);
          }
        }
      }
    }
    buf ^= 1;
  }
  const float lt = lsum + shfl_xor_l(lsum, 32);
  const float inv = 1.f / lt;
  bf16_t* op = YMIX + (size_t)(qrow0 + r) * D + 512 + hq * 64 + 4 * hh;
#pragma unroll
  for (int g4 = 0; g4 < 4; ++g4) {
    uint2 o; o.x = pack2(O0[4 * g4] * inv, O0[4 * g4 + 1] * inv); o.y = pack2(O0[4 * g4 + 2] * inv, O0[4 * g4 + 3] * inv);
    *(uint2*)(op + 8 * g4) = o;
    uint2 o1; o1.x = pack2(O1[4 * g4] * inv, O1[4 * g4 + 1] * inv); o1.y = pack2(O1[4 * g4 + 2] * inv, O1[4 * g4 + 3] * inv);
    *(uint2*)(op + 32 + 8 * g4) = o1;
  }
  __syncthreads();
}

DEVI void phase_mixers(const Params& p, int l, unsigned char* smem) {
  const int bid = bid_(), G = gridDim.x;
  const int nsb = (G >> 4) * 8 + ((G & 15) < 8 ? (G & 15) : 8);
  if (((bid >> 3) & 1) == 0) {
    for (int it = (bid >> 4) * 8 + (bid & 7); it < 128; it += nsb) { if (it & 1) rwkv_chunked<1>(p, l, it, smem); else rwkv_chunked<0>(p, l, it, smem); }
  }
  const int n_attn = (l == 0) ? 1152 : 1024, nq = 256 + n_attn;
  int* ctr = (int*)(uws(p) + WS_CTL) + 64 + l;
  volatile int* sTick = (volatile int*)(smem + SMEM_BYTES - 16);
  const int tid = tid_();
  __syncthreads();
  if (tid == 0) sTick[0] = atomicAdd(ctr, 1);
  __syncthreads();
  int cur = sTick[0];
  while (cur < nq) {
    int nxt = 0;
    if (tid == 0) nxt = atomicAdd(ctr, 1);
    if (cur < 256) s5_carry_item(p, l, cur >> 4, cur & 15);
    else {
      const int a = cur - 256;
      if (a < 1024) attn_item(p, l, a >> 6, (a >> 3) & 7, a & 7, smem);
      else attn_item(p, l, (a - 1024) >> 3, -1, (a - 1024) & 7, smem);
    }
    __syncthreads();
    if (tid == 0) sTick[0] = nxt;
    __syncthreads();
    cur = sTick[0];
  }
}

DEVI void phase_mixfin(const Params& p, int l, unsigned char* smem) {
  unsigned char* ws = uws(p);
  const int tid = tid_(), bid = bid_(), G = gridDim.x;
  bf16_t* YMIX = (bf16_t*)(ws + WS_YMIX);
  {
    S5Sched S{(const bf16_t*)(ws + WS_UDH), (const bf16_t*)(ws + WS_TTG) + (size_t)l * 16 * 512 * 768, G, bid, (l == 1) ? 4 : 5};
    EpiS5 E{(bf16_t*)((unsigned char*)uout(p) + DO_ZB)};
    __syncthreads();
    g8::gemm((G8_LAS unsigned char*)smem, 768, S, E);
    __syncthreads();
  }
  {
    const bf16_t* PROJ = (const bf16_t*)(ws + WS_PROJ);
    const unsigned short* FEAT = (const unsigned short*)(ws + WS_FEAT);
    const float* YF = (const float*)((unsigned char*)uout(p) + DO_YF); const float* YB = (const float*)((unsigned char*)uout(p) + DO_YB);
    const float* CW = uin(p, I_CONV) + l * 3 * 1024;
    const int c4 = (tid & 15) * 4;
    const int nbusy = (16 * ((l == 1) ? 4 : 5) * 2 < G) ? 16 * ((l == 1) ? 4 : 5) * 2 : G;
    const int nvirt = nbusy + 2 * (G - nbusy);
    const int ustride = (nvirt * NTHREADS) >> 4;
    const int nun = ((l == 1) ? NLAT : NT) * 4;
    const int vb0 = (bid < nbusy) ? bid : nbusy + 2 * (bid - nbusy);
    const int u0 = (vb0 * NTHREADS + tid) >> 4;
    const int h = u0 & 3, hc = h * 64 + c4;
    float cwr[3][4], cwk[3][4], cwv[3][4], kaw[4], rkw[4], gnw[4], gnb[4];
#pragma unroll
    for (int dl = 0; dl < 3; ++dl)
#pragma unroll
      for (int e = 0; e < 4; ++e) { cwr[dl][e] = CW[dl * 1024 + hc + e]; cwk[dl][e] = CW[dl * 1024 + 256 + hc + e]; cwv[dl][e] = CW[dl * 1024 + 512 + hc + e]; }
#pragma unroll
    for (int e = 0; e < 4; ++e) { kaw[e] = uin(p, I_KA)[l * 256 + hc + e]; rkw[e] = uin(p, I_RK)[l * 256 + hc + e]; gnw[e] = uin(p, I_GNW)[l * 256 + hc + e]; gnb[e] = uin(p, I_GNB)[l * 256 + hc + e]; }
    for (int pass = 0; pass < ((bid < nbusy) ? 1 : 2); ++pass)
    for (int u = u0 + pass * 32; u < nun; u += ustride) {
      const int R = u >> 2;
      const int t = R < NLAT ? (R & 2047) : ((R - NLAT) & 255); const int len = R < NLAT ? SEQ : CTXL;
      const float4 yf = *(const float4*)(YF + (size_t)R * 256 + hc), yb = *(const float4*)(YB + (size_t)R * 256 + hc);
      float y[4] = {yf.x + yb.x, yf.y + yb.y, yf.z + yb.z, yf.w + yb.w};
      const float mu = row_sum16(y[0] + y[1] + y[2] + y[3]) * (1.f / 64.f);
      float q = 0.f;
#pragma unroll
      for (int e = 0; e < 4; ++e) { y[e] -= mu; q += y[e] * y[e]; }
      const float rstd = rsqrtf(row_sum16(q) * (1.f / 64.f) + GN_EPS);
      const bf16_t* pr = PROJ + (size_t)R * DIN + hc;
      const uint2 zc = make_uint2(0, 0);
      const uint2 rc = *(const uint2*)pr, kc = *(const uint2*)(pr + 256), vc = *(const uint2*)(pr + 512);
      uint2 rp = zc, kp = zc, vp = zc, rn = zc, kn = zc, vn = zc;
      if (t > 0) { rp = *(const uint2*)(pr - DIN); kp = *(const uint2*)(pr - DIN + 256); vp = *(const uint2*)(pr - DIN + 512); }
      if (t < len - 1) { rn = *(const uint2*)(pr + DIN); kn = *(const uint2*)(pr + DIN + 256); vn = *(const uint2*)(pr + DIN + 512); }
      const float rpf[4] = {lo_bf(rp.x), hi_bf(rp.x), lo_bf(rp.y), hi_bf(rp.y)}, rcf[4] = {lo_bf(rc.x), hi_bf(rc.x), lo_bf(rc.y), hi_bf(rc.y)}, rnf[4] = {lo_bf(rn.x), hi_bf(rn.x), lo_bf(rn.y), hi_bf(rn.y)};
      const float kpf[4] = {lo_bf(kp.x), hi_bf(kp.x), lo_bf(kp.y), hi_bf(kp.y)}, kcf[4] = {lo_bf(kc.x), hi_bf(kc.x), lo_bf(kc.y), hi_bf(kc.y)}, knf[4] = {lo_bf(kn.x), hi_bf(kn.x), lo_bf(kn.y), hi_bf(kn.y)};
      const float vpf[4] = {lo_bf(vp.x), hi_bf(vp.x), lo_bf(vp.y), hi_bf(vp.y)}, vcf[4] = {lo_bf(vc.x), hi_bf(vc.x), lo_bf(vc.y), hi_bf(vc.y)}, vnf[4] = {lo_bf(vn.x), hi_bf(vn.x), lo_bf(vn.y), hi_bf(vn.y)};
      const unsigned short* fr_ = FEAT + (size_t)R * 1280 + hc;
      const uint2 a0u = *(const uint2*)(fr_ + 512), a1u = *(const uint2*)(fr_ + 768), gtu = *(const uint2*)(fr_ + 1024);
      const float a0[4] = {h2f(a0u.x & 0xFFFF), h2f(a0u.x >> 16), h2f(a0u.y & 0xFFFF), h2f(a0u.y >> 16)};
      const float a1[4] = {h2f(a1u.x & 0xFFFF), h2f(a1u.x >> 16), h2f(a1u.y & 0xFFFF), h2f(a1u.y >> 16)};
      const float gt[4] = {h2f(gtu.x & 0xFFFF), h2f(gtu.x >> 16), h2f(gtu.y & 0xFFFF), h2f(gtu.y >> 16)};
      float bs = 0.f, vv[4];
#pragma unroll
      for (int e = 0; e < 4; ++e) {
        const float r = cwr[0][e] * rpf[e] + cwr[1][e] * rcf[e] + cwr[2][e] * rnf[e];
        const float k = cwk[0][e] * kpf[e] + cwk[1][e] * kcf[e] + cwk[2][e] * knf[e];
        vv[e] = cwv[0][e] * vpf[e] + cwv[1][e] * vcf[e] + cwv[2][e] * vnf[e];
        const float ksum = k * (2.f + (a0[e] + a1[e] - 2.f) * kaw[e]);
        bs += r * ksum * rkw[e];
      }
      bs = row_sum16(bs);
      float o[4];
#pragma unroll
      for (int e = 0; e < 4; ++e) {
        const float yn = y[e] * rstd * gnw[e] + gnb[e];
        o[e] = (yn + bs * vv[e]) * gt[e];
      }
      uint2 w; w.x = pack2(o[0], o[1]); w.y = pack2(o[2], o[3]);
      *(uint2*)(YMIX + (size_t)R * D + hc) = w;
    }
  }
}

struct EpiGlu {
  static constexpr bool PERM = true;
  const bf16_t* ZB; bf16_t* YMIX; const float* gb;
  DEVI void operator()(const f32x4 (&acc)[2][2][4][2], const g8::Unit& u) const {
    const int tid = tid_(), wid = __builtin_amdgcn_readfirstlane(tid >> 6), lane = tid & 63, wr = wid >> 2, wc = wid & 3, fr = lane & 15, fq = lane >> 4;
#pragma unroll
    for (int ai = 0; ai < 2; ++ai)
#pragma unroll
      for (int m = 0; m < 4; ++m) {
        const int row = u.pm * 256 + ai * 128 + wr * 64 + m * 16 + fr;
#pragma unroll
        for (int bj = 0; bj < 2; ++bj) {
          const int col = bj * 128 + wc * 32 + 8 * fq;
          const uint4 zz = *(const uint4*)(ZB + (size_t)row * 256 + col);
          const float4 b0 = *(const float4*)(gb + col), b1 = *(const float4*)(gb + col + 4);
          const f32x4 v0 = acc[ai][bj][m][0], v1 = acc[ai][bj][m][1];
          *(uint4*)(YMIX + (size_t)row * D + 256 + col) = make_uint4(
            pack2(lo_bf(zz.x) * sigmoidf(v0[0] + b0.x), hi_bf(zz.x) * sigmoidf(v0[1] + b0.y)), pack2(lo_bf(zz.y) * sigmoidf(v0[2] + b0.z), hi_bf(zz.y) * sigmoidf(v0[3] + b0.w)),
            pack2(lo_bf(zz.z) * sigmoidf(v1[0] + b1.x), hi_bf(zz.z) * sigmoidf(v1[1] + b1.y)), pack2(lo_bf(zz.w) * sigmoidf(v1[2] + b1.z), hi_bf(zz.w) * sigmoidf(v1[3] + b1.w)));
        }
        asm volatile("" ::: "memory");
      }
  }
};
DEVI void phase_glu(const Params& p, int l, unsigned char* smem) {
  unsigned char* ws = uws(p);
  g8::DenseSched S{(const bf16_t*)((unsigned char*)uout(p) + DO_ZB), (const bf16_t*)(ws + WS_GLU_T) + (size_t)l * 65536, 256, (l == 1) ? 128 : 144, 1, (int)gridDim.x, bid_()};
  EpiGlu E{(const bf16_t*)((unsigned char*)uout(p) + DO_ZB), (bf16_t*)(ws + WS_YMIX), uin(p, I_GLUB) + l * 256};
  __syncthreads();
  g8::gemm((G8_LAS unsigned char*)smem, 256, S, E);
  __syncthreads();
}

struct EpiBf16 {
  static constexpr bool PERM = true;
  bf16_t* O; int ldc;
  DEVI void operator()(const f32x4 (&acc)[2][2][4][2], const g8::Unit& u) const {
    const int tid = tid_(), wid = __builtin_amdgcn_readfirstlane(tid >> 6), lane = tid & 63, wr = wid >> 2, wc = wid & 3, fr = lane & 15, fq = lane >> 4;
#pragma unroll
    for (int ai = 0; ai < 2; ++ai)
#pragma unroll
      for (int m = 0; m < 4; ++m) {
        bf16_t* rowp = O + (size_t)(u.pm * 256 + ai * 128 + wr * 64 + m * 16 + fr) * ldc + u.pn * 256 + wc * 32 + 8 * fq;
#pragma unroll
        for (int bj = 0; bj < 2; ++bj) {
          const f32x4 v0 = acc[ai][bj][m][0], v1 = acc[ai][bj][m][1];
          *(uint4*)(rowp + bj * 128) = make_uint4(pack2(v0[0], v0[1]), pack2(v0[2], v0[3]), pack2(v1[0], v1[1]), pack2(v1[2], v1[3]));
        }
      }
  }
};
DEVI void phase_outproj(const Params& p, int l, unsigned char* smem) {
  unsigned char* ws = uws(p);
  g8::DenseSched S{(const bf16_t*)(ws + WS_YMIX), (const bf16_t*)(ws + WS_WOUT_T) + (size_t)l * D * D, D, (l == 1) ? 128 : 144, 4, (int)gridDim.x, bid_()};
  EpiBf16 E{(bf16_t*)(ws + WS_MIX), D};
  __syncthreads();
  g8::gemm((G8_LAS unsigned char*)smem, D, S, E);
  __syncthreads();
}

DEVI void phase_ln1(const Params& p, int l, unsigned char* smem) {
  unsigned char* ws = uws(p);
  const int tid = tid_(), lane = tid & 63, wid = tid >> 6;
  const bf16_t* MIX = (const bf16_t*)(ws + WS_MIX);
  _Float16* X = (_Float16*)(ws + WS_X);
  bf16_t* H = (bf16_t*)(ws + WS_H);
  const float* MOD = (const float*)(ws + WS_MOD);
  const int nrows1 = (l == 1) ? NLAT : NT;
  const int nw = gridDim.x * 8, gw = bid_() * 8 + wid;
  const int rpw = (nrows1 + nw - 1) / nw;
  const int R0 = gw * rpw, R1 = (R0 + rpw < nrows1) ? (R0 + rpw) : nrows1;
  const int c0 = lane * 8, c1 = 512 + lane * 8;
  float g[2][8], bb[2][8], gt[2][8], sh[2][8], sc[2][8];
  ld8f(uin(p, I_LN1G) + l * D + c0, g[0]); ld8f(uin(p, I_LN1G) + l * D + c1, g[1]);
  ld8f(uin(p, I_LN1B) + l * D + c0, bb[0]); ld8f(uin(p, I_LN1B) + l * D + c1, bb[1]);
  int curb = -1;
  float xv[2][8], mx[2][8];
  auto load_row = [&](int Rr, float (&xo)[2][8], float (&mo)[2][8]) {
    if (l == 0) { const float* xr = xin_row(p, Rr); ld8f(xr + c0, xo[0]); ld8f(xr + c1, xo[1]); }
    else { const _Float16* xr = X + (size_t)Rr * D; ld8h(xr + c0, xo[0]); ld8h(xr + c1, xo[1]); }
    ld8b(MIX + (size_t)Rr * D + c0, mo[0]); ld8b(MIX + (size_t)Rr * D + c1, mo[1]);
  };
  if (R0 < R1) load_row(R0, xv, mx);
  for (int R = R0; R < R1; ++R) {
    float xn[2][8], mn[2][8];
#pragma unroll
    for (int h = 0; h < 2; ++h)
#pragma unroll
      for (int e = 0; e < 8; ++e) { xn[h][e] = 0.f; mn[h][e] = 0.f; }
    if (R + 1 < R1) load_row(R + 1, xn, mn);
    const int bi = bidx_of(R);
    if (bi != curb) {
      curb = bi;
      const float* modl = MOD + (size_t)(l * 17 + bi) * 6144;
      ld8f(modl + 2048 + c0, gt[0]); ld8f(modl + 2048 + c1, gt[1]);
      ld8f(modl + 3072 + c0, sh[0]); ld8f(modl + 3072 + c1, sh[1]);
      ld8f(modl + 4096 + c0, sc[0]); ld8f(modl + 4096 + c1, sc[1]);
    }
    float v[2][8]; float s = 0.f;
#pragma unroll
    for (int h = 0; h < 2; ++h)
#pragma unroll
      for (int e = 0; e < 8; ++e) { v[h][e] = ALPHA * xv[h][e] + gt[h][e] * mx[h][e]; s += v[h][e]; }
    const float mu = wave_sum(s) * (1.f / 1024.f);
    float q = 0.f;
#pragma unroll
    for (int h = 0; h < 2; ++h)
#pragma unroll
      for (int e = 0; e < 8; ++e) { v[h][e] -= mu; q += v[h][e] * v[h][e]; }
    const float rstd = rsqrtf(wave_sum(q) * (1.f / 1024.f) + LN_EPS);
#pragma unroll
    for (int h = 0; h < 2; ++h) {
      float x1[8], hm[8];
#pragma unroll
      for (int e = 0; e < 8; ++e) { x1[e] = v[h][e] * rstd * g[h][e] + bb[h][e]; hm[e] = x1[e] * (1.f + sc[h][e]) + sh[h][e]; }
      st8h(X + (size_t)R * D + (h ? c1 : c0), x1);
      st8b(H + (size_t)R * D + (h ? c1 : c0), hm);
    }
#pragma unroll
    for (int h = 0; h < 2; ++h)
#pragma unroll
      for (int e = 0; e < 8; ++e) { xv[h][e] = xn[h][e]; mx[h][e] = mn[h][e]; }
  }
}

DEVI void phase_router(const Params& p, int l, unsigned char* smem) {
  unsigned char* ws = uws(p);
  const int tid = tid_(), lrow = tid >> 2;
  const bf16_t* H = (const bf16_t*)(ws + WS_H);
  const bf16_t* RWH = (const bf16_t*)(ws + WS_RW) + (size_t)l * 2 * 128 * 1024;
  int* CNT = (int*)(ws + WS_CTL) + l * 32;
  int* LIST = (int*)(ws + WS_LIST);
  int4* ROUTE = (int4*)(ws + WS_ROUTE);
  float2* RWT = (float2*)(ws + WS_RWT);
  bf16_t* EW1 = (bf16_t*)(ws + WS_EW); bf16_t* EW2 = EW1 + (size_t)32 * 1024 * 1024;
  constexpr int N_CONV = 32 * 96;
  const int nmt = (l == 1) ? 128 : 144;
  for (int it0 = bid_(); it0 < nmt; it0 += gridDim.x) {
    {
      const int mt = it0;
      const bf16_t* a0 = H + (size_t)(mt * 256 + lrow) * D; const bf16_t* a1 = a0 + (size_t)128 * D;
      const bf16_t* b0 = RWH + (size_t)lrow * 1024;
      gemm_tile(smem, 0, D,
        [&](int i, int k) { return *(const uint4*)((i ? a1 : a0) + k); },
        [&](int k) { return *(const uint4*)(b0 + k); },
        [&](f32x4 (&acc)[4][4], int wr, int wc, int fr, int fq) {
          float* sLog = (float*)smem;
          if (wc == 0) {
#pragma unroll
            for (int m = 0; m < 4; ++m)
#pragma unroll
              for (int n = 0; n < 3; ++n)
#pragma unroll
                for (int j = 0; j < 4; ++j) { const int col = n * 16 + fq * 4 + j; if (col < 36) sLog[(wr * 64 + m * 16 + fr) * 37 + col] = acc[m][n][j]; }
          }
        });
      int* sHist = (int*)(smem + 40960); int* sBase = sHist + 32;
      if (tid < 32) sHist[tid] = 0;
      __syncthreads();
      int e1 = 0, e2 = 0, lp1 = 0, lp2 = 0; float w1 = 0.f, w2 = 0.f;
      if (tid < 256) {
        const float* lg = (const float*)smem + tid * 37;
        float gl[4]; int gi = 0; float gmax;
#pragma unroll
        for (int i = 0; i < 4; ++i) gl[i] = lg[i] + uin(p, I_RGB)[l * 4 + i];
        gmax = gl[0];
#pragma unroll
        for (int i = 1; i < 4; ++i) if (gl[i] > gmax) { gmax = gl[i]; gi = i; }
        float gs = 0.f;
#pragma unroll
        for (int i = 0; i < 4; ++i) gs += expf(gl[i] - gmax);
        const float gprob = 1.f / gs;
        float el[8];
#pragma unroll
        for (int j = 0; j < 8; ++j) el[j] = lg[4 + gi * 8 + j] + uin(p, I_REB)[l * 32 + gi * 8 + j];
        int i1 = 0; float l1 = el[0];
#pragma unroll
        for (int j = 1; j < 8; ++j) if (el[j] > l1) { l1 = el[j]; i1 = j; }
        int i2 = (i1 == 0) ? 1 : 0; float l2 = -3.0e38f;
#pragma unroll
        for (int j = 0; j < 8; ++j) if (j != i1 && el[j] > l2) { l2 = el[j]; i2 = j; }
        const float ex = expf(l2 - l1);
        w1 = gprob / (1.f + ex); w2 = gprob * ex / (1.f + ex);
        e1 = gi * 8 + i1; e2 = gi * 8 + i2;
        lp1 = atomicAdd(&sHist[e1], 1); lp2 = atomicAdd(&sHist[e2], 1);
      }
      __syncthreads();
      if (tid < 32) sBase[tid] = atomicAdd(&CNT[tid], sHist[tid]);
      __syncthreads();
      if (tid < 256) {
        const int R = mt * 256 + tid;
        const int p1 = sBase[e1] + lp1, p2 = sBase[e2] + lp2;
        LIST[(size_t)e1 * NT + p1] = R; LIST[(size_t)e2 * NT + p2] = R;
        ROUTE[R] = make_int4(e1, p1, e2, p2);
        RWT[R] = make_float2(w1, w2);
      }
      __syncthreads();
    }
  }
  {
    auto conv_src = [&](int j, const float*& src, int& ld, int& k0, int& n0) {
      const int e = j / 96, r = j % 96;
      if (r < 64) { const int kt = r >> 2, ct = r & 3, up = ct >> 1; src = (up ? uin(p, I_EWU) : uin(p, I_EWG)) + (size_t)(l * 32 + e) * 1024 * 512; ld = 512; k0 = kt * 64; n0 = (ct & 1) * 256; }
      else { const int r2 = r - 64, kt = r2 >> 2, ntl = r2 & 3; src = uin(p, I_EWD) + (size_t)(l * 32 + e) * 512 * 1024; ld = 1024; k0 = kt * 64; n0 = ntl * 256; }
    };
    const int G = gridDim.x;
    int j = bid_();
    TrRegs cur, nxt;
    const float* src; int ld, k0, n0;
    if (j < N_CONV) { conv_src(j, src, ld, k0, n0); transpose_load(cur, src, ld, k0, n0); }
    while (j < N_CONV) {
      int jn;
      if (j < 8 * G) { jn = j + G; if (jn >= 8 * G) jn = (bid_() >= nmt) ? (8 * G + bid_() - nmt) : N_CONV; }
      else jn = j + (G - nmt);
      if (jn < N_CONV) { const float* s2; int ld2, k2, n2; conv_src(jn, s2, ld2, k2, n2); transpose_load(nxt, s2, ld2, k2, n2); }
      const int e = j / 96, r = j % 96;
      if (r < 64) {
        const int kt = r >> 2, ct = r & 3, up = ct >> 1;
        transpose_finish(smem, cur, kt * 64, (ct & 1) * 256, EW1 + (size_t)e * 1024 * 1024, 1024,
          [&](int c) { return 256 * (c >> 7) + 128 * ((c >> 6) & 1) + 32 * ((c >> 4) & 3) + 16 * up + (c & 15); });
      } else {
        const int r2 = r - 64, kt = r2 >> 2, ntl = r2 & 3;
        transpose_finish(smem, cur, kt * 64, ntl * 256, EW2 + (size_t)e * 1024 * 512, 512, [](int n) { return n; });
      }
      cur = nxt; j = jn;
    }
  }
}

DEVI void moe_prefix(const Params& p, int l, int* sPre, int* sCnt) {
  const int* CNT = (const int*)(uws(p) + WS_CTL) + l * 32;
  if (tid_() == 0) {
    int s = 0;
    for (int e = 0; e < 32; ++e) { const int c = CNT[e]; sCnt[e] = c; sPre[e] = s; s += (c + 255) >> 8; }
    sPre[32] = s;
  }
  __syncthreads();
  {
    unsigned char* sBlkE = (unsigned char*)sPre + (MISC_BLKE - MISC_PRE);
    const int nb = sPre[32];
    for (int rb = tid_(); rb < nb; rb += NTHREADS) { int e = 0; for (int q = 1; q < 32; ++q) if (sPre[q] <= rb) e = q; sBlkE[rb] = (unsigned char)e; }
  }
  __syncthreads();
}

struct MoeSched {
  const int* sPre; const int* sCnt; const unsigned char* sBlkE; const bf16_t* Abase; const int* LIST; const bf16_t* Wbase; int K; size_t wstride; int nN, G, c, gather;
  DEVI bool next(int i, g8::Unit& u) const {
    const int nwg = sPre[32] * nN; const long L = (long)i * G + c; if (L >= nwg) return false;
    const int w = g8::xcd_remap((int)L, nwg);
    u.pm = w / nN; u.pn = w % nN;
    u.e = sBlkE[u.pm]; return true;
  }
  DEVI const char* a_base() const { return (const char*)Abase; }
  DEVI void a_offs(const g8::Unit& u, int tid, unsigned (&ao)[2][2]) const {
#pragma unroll
    for (int i = 0; i < 2; ++i) {
      int R, C; g8::stage_rc(tid * 16 + i * 8192, R, C);
#pragma unroll
      for (int h = 0; h < 2; ++h) {
        int row = u.pm * 256 + h * 128 + R;
        if (gather) {
          const int sl = (u.pm - sPre[u.e]) * 256 + h * 128 + R;
          row = LIST[(size_t)u.e * NT + (sl < sCnt[u.e] ? sl : 0)];
        }
        ao[h][i] = ((unsigned)row * (unsigned)K + (unsigned)C) * 2u;
      }
    }
  }
  DEVI const char* b_ptr(const g8::Unit& u) const { return (const char*)(Wbase + (size_t)u.e * wstride + (size_t)u.pn * 256 * K); }
};
struct EpiMoe1 {
  static constexpr bool PERM = false;
  bf16_t* ACT;
  DEVI void operator()(const f32x4 (&acc)[2][2][4][2], const g8::Unit& u) const {
    const int tid = tid_(), wid = __builtin_amdgcn_readfirstlane(tid >> 6), lane = tid & 63, wr = wid >> 2, wc = wid & 3, fr = lane & 15, fq = lane >> 4;
#pragma unroll
    for (int ai = 0; ai < 2; ++ai)
#pragma unroll
      for (int m = 0; m < 4; ++m) {
        const size_t slot = (size_t)u.pm * 256 + ai * 128 + wr * 64 + m * 16 + fr;
#pragma unroll
        for (int bj = 0; bj < 2; ++bj) {
          const f32x4 g = acc[ai][bj][m][0], up = acc[ai][bj][m][1];
          float o[4];
#pragma unroll
          for (int j = 0; j < 4; ++j) o[j] = g[j] * __builtin_amdgcn_rcpf(1.f + __expf(-g[j])) * up[j];
          uint2 w; w.x = pack2(o[0], o[1]); w.y = pack2(o[2], o[3]);
          *(uint2*)(ACT + slot * 512 + u.pn * 128 + bj * 64 + wc * 16 + 4 * fq) = w;
        }
      }
  }
};
DEVI void phase_moe1(const Params& p, int l, unsigned char* smem) {
  unsigned char* ws = uws(p);
  int* sPre = (int*)(smem + SMEM_BYTES + MISC_PRE); int* sCnt = (int*)(smem + SMEM_BYTES + MISC_CNT);
  moe_prefix(p, l, sPre, sCnt);
  MoeSched S{sPre, sCnt, (const unsigned char*)(smem + SMEM_BYTES + MISC_BLKE), (const bf16_t*)(ws + WS_H), (const int*)(ws + WS_LIST), (const bf16_t*)(ws + WS_EW), D, (size_t)1024 * 1024, 4, (int)gridDim.x, bid_(), 1};
  EpiMoe1 E{(bf16_t*)(ws + WS_ACT)};
  g8::gemm((G8_LAS unsigned char*)smem, D, S, E);
  __syncthreads();
}
DEVI void phase_moe2(const Params& p, int l, unsigned char* smem) {
  unsigned char* ws = uws(p);
  int* sPre = (int*)(smem + SMEM_BYTES + MISC_PRE); int* sCnt = (int*)(smem + SMEM_BYTES + MISC_CNT);
  moe_prefix(p, l, sPre, sCnt);
  MoeSched S{sPre, sCnt, (const unsigned char*)(smem + SMEM_BYTES + MISC_BLKE), (const bf16_t*)(ws + WS_ACT), (const int*)(ws + WS_LIST), (const bf16_t*)(ws + WS_EW) + (size_t)32 * 1024 * 1024, 512, (size_t)1024 * 512, 4, (int)gridDim.x, bid_(), 0};
  EpiBf16 E{(bf16_t*)(ws + WS_YROWS), D};
  g8::gemm((G8_LAS unsigned char*)smem, 512, S, E);
  __syncthreads();
}

DEVI void phase_ln2(const Params& p, int l, unsigned char* smem) {
  unsigned char* ws = uws(p);
  int* sPre = (int*)(smem + SMEM_BYTES + MISC_PRE); int* sCnt = (int*)(smem + SMEM_BYTES + MISC_CNT);
  moe_prefix(p, l, sPre, sCnt);
  const int tid = tid_(), lane = tid & 63, wid = tid >> 6;
  _Float16* X = (_Float16*)(ws + WS_X);
  const bf16_t* YR = (const bf16_t*)(ws + WS_YROWS);
  const int4* ROUTE = (const int4*)(ws + WS_ROUTE);
  const float2* RWT = (const float2*)(ws + WS_RWT);
  const float* MOD = (const float*)(ws + WS_MOD);
  const float* g2 = uin(p, I_LN2G) + l * D; const float* b2 = uin(p, I_LN2B) + l * D;
  bf16_t* XM = (bf16_t*)((unsigned char*)uout(p) + DO_XMOD);
  const int nrows = (l == 0) ? NT : NLAT;
  const int nw = gridDim.x * 8, gw = bid_() * 8 + wid;
  const int rpw = (nrows + nw - 1) / nw;
  const int R0 = gw * rpw, R1 = (R0 + rpw < nrows) ? (R0 + rpw) : nrows;
  const int c0 = lane * 8, c1 = 512 + lane * 8;
  float g[2][8], bb[2][8], gt[2][8], sh1n[2][8], sc1n[2][8];
  ld8f(g2 + c0, g[0]); ld8f(g2 + c1, g[1]); ld8f(b2 + c0, bb[0]); ld8f(b2 + c1, bb[1]);
  int curb = -1;
  float xv[2][8], ua[2][8], ub[2][8]; float2 rw = make_float2(0.f, 0.f);
  int4 rt_n = make_int4(0, 0, 0, 0); float2 rw_n = make_float2(0.f, 0.f);
  auto load_data = [&](int Rr, const int4& rt, float (&xo)[2][8], float (&ao)[2][8], float (&bo)[2][8]) {
    const bf16_t* ya = YR + ((size_t)sPre[rt.x] * 256 + rt.y) * 1024; const bf16_t* yb = YR + ((size_t)sPre[rt.z] * 256 + rt.w) * 1024;
    const _Float16* xr = X + (size_t)Rr * D;
    ld8h(xr + c0, xo[0]); ld8h(xr + c1, xo[1]); ld8b(ya + c0, ao[0]); ld8b(ya + c1, ao[1]); ld8b(yb + c0, bo[0]); ld8b(yb + c1, bo[1]);
  };
  if (R0 < R1) { const int4 rt0 = ROUTE[R0]; rw = RWT[R0]; load_data(R0, rt0, xv, ua, ub); }
  if (R0 + 1 < R1) { rt_n = ROUTE[R0 + 1]; rw_n = RWT[R0 + 1]; }
  for (int R = R0; R < R1; ++R) {
    float xn[2][8], an[2][8], bn[2][8];
#pragma unroll
    for (int h = 0; h < 2; ++h)
#pragma unroll
      for (int e = 0; e < 8; ++e) { xn[h][e] = 0.f; an[h][e] = 0.f; bn[h][e] = 0.f; }
    if (R + 1 < R1) load_data(R + 1, rt_n, xn, an, bn);
    const float2 rw_next = rw_n;
    if (R + 2 < R1) { rt_n = ROUTE[R + 2]; rw_n = RWT[R + 2]; }
    const int bi = bidx_of(R);
    if (bi != curb) {
      curb = bi;
      const float* modl = MOD + (size_t)(l * 17 + bi) * 6144;
      ld8f(modl + 5120 + c0, gt[0]); ld8f(modl + 5120 + c1, gt[1]);
      if (l == 0) {
        const float* modn = MOD + (size_t)(1 * 17 + bi) * 6144;
        ld8f(modn + c0, sh1n[0]); ld8f(modn + c1, sh1n[1]); ld8f(modn + 1024 + c0, sc1n[0]); ld8f(modn + 1024 + c1, sc1n[1]);
      }
    }
    float v[2][8]; float s = 0.f;
#pragma unroll
    for (int h = 0; h < 2; ++h)
#pragma unroll
      for (int e = 0; e < 8; ++e) { v[h][e] = ALPHA * xv[h][e] + gt[h][e] * (rw.x * ua[h][e] + rw.y * ub[h][e]); s += v[h][e]; }
    const float mu = wave_sum(s) * (1.f / 1024.f);
    float q = 0.f;
#pragma unroll
    for (int h = 0; h < 2; ++h)
#pragma unroll
      for (int e = 0; e < 8; ++e) { v[h][e] -= mu; q += v[h][e] * v[h][e]; }
    const float rstd = rsqrtf(wave_sum(q) * (1.f / 1024.f) + LN_EPS);
#pragma unroll
    for (int h = 0; h < 2; ++h) {
      float x2[8];
#pragma unroll
      for (int e = 0; e < 8; ++e) x2[e] = v[h][e] * rstd * g[h][e] + bb[h][e];
      const int cc = h ? c1 : c0;
      if (l == 0) {
        st8h(X + (size_t)R * D + cc, x2);
        float xm[8];
#pragma unroll
        for (int e = 0; e < 8; ++e) xm[e] = x2[e] * (1.f + sc1n[h][e]) + sh1n[h][e];
        st8b(XM + (size_t)R * D + cc, xm);
      } else {
        st8f(uout(p) + (size_t)R * D + cc, x2);
      }
    }
#pragma unroll
    for (int h = 0; h < 2; ++h)
#pragma unroll
      for (int e = 0; e < 8; ++e) { xv[h][e] = xn[h][e]; ua[h][e] = an[h][e]; ub[h][e] = bn[h][e]; }
    rw = rw_next;
  }
}

#define XB_TMO      128
#define XB_XCNT(j)  (256  + 64 * (j))
#define XB_XSUB(j)  (1280 + 64 * (j))
#define XB_XGEN(j)  (2304 + 64 * (j))
#define XB_TOP      3328
#define XB_TOPGEN   3392
#define XCD_BAR_WORDS 3456
#define XB_SPIN_CAP (1u << 20)
DEVI unsigned xb_ld(unsigned* p) { return __hip_atomic_load(p, __ATOMIC_RELAXED, __HIP_MEMORY_SCOPE_AGENT); }
DEVI unsigned xb_add(unsigned* p, unsigned v) { return __hip_atomic_fetch_add(p, v, __ATOMIC_RELAXED, __HIP_MEMORY_SCOPE_AGENT); }
DEVI unsigned xb_xcc_id() { return (unsigned)__builtin_amdgcn_s_getreg((3 << 11) | 20) & 0xFu; }
#define XB_SPIN(cond, bar) do { unsigned _sp = 0; while (cond) { __builtin_amdgcn_s_sleep(1); \
    if ((++_sp & 255u) == 0u) { if (xb_ld(&(bar)[XB_TMO])) break; if (_sp > XB_SPIN_CAP) { atomicAdd(&(bar)[XB_TMO], 1u); break; } } } } while (0)
DEVI void xcd_barrier_complete(unsigned* bar, unsigned x, unsigned& nloc, unsigned& nx) {
  const unsigned G = gridDim.x;
  unsigned sum, cnt, mine, sp = 0u;
  for (;;) {
    sum = 0u; cnt = 0u; mine = 0u;
#pragma unroll
    for (unsigned j = 0; j < 16; ++j) { const unsigned c = xb_ld(&bar[XB_XCNT(j)]); sum += c; cnt += (c > 0u) ? 1u : 0u; mine = (j == x) ? c : mine; }
    if (sum == G) break;
    __builtin_amdgcn_s_sleep(1);
    if ((++sp & 255u) == 0u) { if (xb_ld(&bar[XB_TMO])) break; if (sp > XB_SPIN_CAP) { atomicAdd(&bar[XB_TMO], 1u); break; } }
  }
  nloc = mine > 0u ? mine : 1u; nx = cnt > 0u ? cnt : 1u;
}
DEVI void xcd_barrier(unsigned* bar, volatile unsigned* st) {
  asm volatile("s_waitcnt vmcnt(0)" ::: "memory");
  __syncthreads();
  if (threadIdx.x == 0) {
    __builtin_amdgcn_s_waitcnt(0);
    const unsigned x = xb_xcc_id();
    unsigned nloc = st[0], nx = st[1];
    if (nloc == 0u) { xcd_barrier_complete(bar, x, nloc, nx); st[0] = nloc; st[1] = nx; }
    const unsigned old = xb_add(&bar[XB_XSUB(x)], 1u);
    const unsigned gen = old / nloc;
    if (old + 1u == (gen + 1u) * nloc) {
      __builtin_amdgcn_fence(__ATOMIC_RELEASE, "agent");
      asm volatile("s_waitcnt vmcnt(0)" ::: "memory");
      const unsigned og = xb_add(&bar[XB_TOP], 1u);
      const unsigned tg = og / nx;
      if (og + 1u == (tg + 1u) * nx) xb_add(&bar[XB_TOPGEN], 1u);
      else XB_SPIN(xb_ld(&bar[XB_TOPGEN]) == tg, bar);
      __builtin_amdgcn_fence(__ATOMIC_ACQUIRE, "agent");
      xb_add(&bar[XB_XGEN(x)], 1u);
      asm volatile("s_waitcnt vmcnt(0)" ::: "memory");
    } else {
      XB_SPIN(xb_ld(&bar[XB_XGEN(x)]) == gen, bar);
      __builtin_amdgcn_fence(__ATOMIC_ACQUIRE, "agent");
      asm volatile("s_waitcnt vmcnt(0)" ::: "memory");
    }
  }
  __syncthreads();
}

constexpr int N_PHASES = 24;
DEVI void run_phase(const Params& p, int ph, unsigned char* smem) {
  if (ph == 0) { phase0a(p, smem); return; }
  if (ph == 1) { phase0b(p, smem); return; }
  const int l = (ph - 2) / 11, s = (ph - 2) % 11;
  switch (s) {
    case 0: phase_inproj(p, l, smem); break;
    case 1: phase_feat(p, l, smem); break;
    case 2: phase_mixers(p, l, smem); break;
    case 3: phase_mixfin(p, l, smem); break;
    case 4: phase_glu(p, l, smem); break;
    case 5: phase_outproj(p, l, smem); break;
    case 6: phase_ln1(p, l, smem); break;
    case 7: phase_router(p, l, smem); break;
    case 8: phase_moe1(p, l, smem); break;
    case 9: phase_moe2(p, l, smem); break;
    default: phase_ln2(p, l, smem); break;
  }
}

__global__ void __launch_bounds__(NTHREADS, 2) fwd_megakernel(Params pk) {
  extern __shared__ __attribute__((aligned(16))) unsigned char smem[];
  Params* spp = (Params*)(smem + SMEM_BYTES + MISC_PARAMS);
  if (threadIdx.x == 0) { *spp = pk; ((volatile unsigned*)(smem + SMEM_BYTES + MISC_XB))[0] = 0u; ((volatile unsigned*)(smem + SMEM_BYTES + MISC_XB))[1] = 0u; }
  __syncthreads();
  const Params& p = *spp;
  const int ph_lo = __builtin_amdgcn_readfirstlane(p.ph_lo), ph_hi = __builtin_amdgcn_readfirstlane(p.ph_hi);
#if MK_MULTI
  for (int ph = ph_lo; ph < ph_hi; ++ph) run_phase(p, ph, smem);
#else
  cg::grid_group grid = cg::this_grid();
  if (threadIdx.x == 0) (void)xb_add(&((unsigned*)(uws(p) + WS_BAR))[XB_XCNT(xb_xcc_id())], 1u);
  for (int ph = ph_lo; ph < ph_hi; ++ph) {
    run_phase(p, ph, smem);
#ifdef DUP_MASK
    if ((DUP_MASK >> ph) & 1) { __syncthreads(); run_phase(p, ph, smem); }
#endif
    if (ph + 1 < ph_hi) {
      if (ph == ph_lo) grid.sync();
      else xcd_barrier((unsigned*)(uws(p) + WS_BAR), (volatile unsigned*)(smem + SMEM_BYTES + MISC_XB));
    }
  }
#endif
}

extern "C" void kernel_launch(void* const* d_in, const int* in_sizes, int n_in, void* d_out, int out_size,
                              void* d_ws, size_t ws_size, hipStream_t stream) {
  static int grid_blocks = 0;
  if (!grid_blocks) {
    int dev = 0, cus = 0, per_cu = 0;
    (void)hipGetDevice(&dev);
    (void)hipDeviceGetAttribute(&cus, hipDeviceAttributeMultiprocessorCount, dev);
    (void)hipFuncSetAttribute((const void*)fwd_megakernel, hipFuncAttributeMaxDynamicSharedMemorySize, DSM_BYTES);
    (void)hipOccupancyMaxActiveBlocksPerMultiprocessor(&per_cu, fwd_megakernel, NTHREADS, DSM_BYTES);
    if (per_cu > 1) per_cu = 1;
    grid_blocks = cus * per_cu;
    if (n_in != N_IN || out_size != NLAT * D || ws_size < WS_END) {
      fprintf(stderr, "kernel_launch: unexpected sizes n_in=%d out=%d ws=%zu (need %zu)\n", n_in, out_size, ws_size, (size_t)WS_END);
      grid_blocks = -1;
    }
    fprintf(stderr, "kernel_launch: grid=%d (cus=%d per_cu=%d) ws=%zu\n", grid_blocks, cus, per_cu, ws_size);
  }
  if (grid_blocks <= 0) return;
  Params p{};
  for (int i = 0; i < N_IN; ++i) p.in[i] = (const float*)d_in[i];
  p.out = (float*)d_out; p.ws = (unsigned char*)d_ws;
#if MK_MULTI
  for (int ph = 0; ph < N_PHASES; ++ph) {
    p.ph_lo = ph; p.ph_hi = ph + 1;
    hipLaunchKernelGGL(fwd_megakernel, dim3(grid_blocks), dim3(NTHREADS), DSM_BYTES, stream, p);
  }
#else
  p.ph_lo = 0; p.ph_hi = N_PHASES;
  (void)hipMemsetAsync((unsigned char*)d_ws + WS_BAR, 0, XCD_BAR_WORDS * 4, stream);
  void* args[] = {&p};
  hipError_t e = hipLaunchCooperativeKernel((void*)fwd_megakernel, dim3(grid_blocks), dim3(NTHREADS), args, DSM_BYTES, stream);
  if (e != hipSuccess) fprintf(stderr, "cooperative launch failed: %s (grid %d)\n", hipGetErrorString(e), grid_blocks);
#endif
}
```

```cpp
#include <hip/hip_runtime.h>
#include <hip/hip_cooperative_groups.h>
#include <cstdio>
#include <cstdint>
namespace cg = cooperative_groups;

#ifndef MK_MULTI
#define MK_MULTI 0
#endif

#define DEVI __device__ __forceinline__
typedef unsigned short bf16_t;
typedef short bf16x8 __attribute__((ext_vector_type(8)));
typedef float f32x4 __attribute__((ext_vector_type(4)));
typedef float f32x16 __attribute__((ext_vector_type(16)));

constexpr int D = 1024, NB = 16, SEQ = 2048, CTXL = 256;
constexpr int NLAT = NB * SEQ;
constexpr int NCTX = NB * CTXL;
constexpr int NT = NLAT + NCTX;
constexpr int DIN = 2048;
constexpr int NTHREADS = 512;
constexpr float ALPHA = 1.41421356237309515f;
constexpr float LN_EPS = 1e-5f, GN_EPS = 64e-5f;
constexpr int NCH = NT / 32;
constexpr int SLOT_CAP = 81920;

enum { I_X = 0, I_C, I_CTX, I_CCTX, I_WMOD, I_BMOD, I_WIN, I_CONV, I_W0, I_W2, I_A0, I_A2, I_G2, I_KK, I_KA, I_RK, I_GNW, I_GNB,
       I_LRE, I_LIM, I_LDT, I_BRE, I_BIM, I_CRE, I_CIM, I_SD, I_GLUW, I_GLUB, I_SINK, I_WOUT, I_LN1G, I_LN1B, I_LN2G, I_LN2B,
       I_RGW, I_RGB, I_REW, I_REB, I_EWG, I_EWU, I_EWD, N_IN };

constexpr size_t MiB = 1048576;
constexpr size_t WS_CTL = 0;
constexpr size_t WS_BAR = 512 * 1024;
constexpr size_t WS_MOD = 1 * MiB;
constexpr size_t WS_ROPE = 2 * MiB;
constexpr size_t WS_WIN_T = 4 * MiB;
constexpr size_t WS_WOUT_T = 12 * MiB;
constexpr size_t WS_FW = 16 * MiB;
constexpr size_t WS_GLU_T = 18 * MiB;
constexpr size_t WS_RW = 19 * MiB;
constexpr size_t WS_KTAB = 20 * MiB;
constexpr size_t WS_TTG = 22 * MiB;
constexpr size_t WS_EM = 46 * MiB;
constexpr size_t WS_HC = 54 * MiB;
constexpr size_t WS_LIST = 63 * MiB;
constexpr size_t WS_ROUTE = 68 * MiB;
constexpr size_t WS_RWT = 69 * MiB;
constexpr size_t WS_APOW = 70 * MiB;
constexpr size_t WS_BBT = 71 * MiB + 512 * 1024;
constexpr size_t WS_X = 72 * MiB;
constexpr size_t WS_R = 216 * MiB;
constexpr size_t WS_PROJ = WS_R;
constexpr size_t WS_FEAT = WS_R + 144 * MiB;
constexpr size_t WS_YMIX = WS_R + 234 * MiB;
constexpr size_t WS_MIX = WS_R + 144 * MiB;
constexpr size_t WS_EW = WS_R;
constexpr size_t WS_H = WS_R + 234 * MiB;
constexpr size_t WS_ACT = WS_R + 96 * MiB;
constexpr size_t WS_YROWS = WS_R + 176 * MiB;
constexpr size_t WS_UDH = WS_R + 336 * MiB;
constexpr size_t WS_END = WS_UDH + 28 * MiB;
constexpr size_t DO_XMOD = 0;
constexpr size_t DO_YF = 0;
constexpr size_t DO_YB = 36 * MiB;
constexpr size_t DO_HE = 72 * MiB;
constexpr size_t DO_ZB = 90 * MiB;

struct Params {
  const float* in[N_IN];
  float* out;
  unsigned char* ws;
  int ph_lo, ph_hi;
};


DEVI unsigned long long rfl64(unsigned long long v) { const unsigned lo = __builtin_amdgcn_readfirstlane((unsigned)v), hi = __builtin_amdgcn_readfirstlane((unsigned)(v >> 32)); return ((unsigned long long)hi << 32) | lo; }
DEVI unsigned char* uws(const Params& p) { return (unsigned char*)rfl64((unsigned long long)p.ws); }
DEVI float* uout(const Params& p) { return (float*)rfl64((unsigned long long)p.out); }
DEVI const float* uin(const Params& p, int i) { return (const float*)rfl64((unsigned long long)p.in[i]); }

DEVI float bf2f(bf16_t v) { return __uint_as_float(((unsigned)v) << 16); }
typedef __bf16 hwbf2 __attribute__((ext_vector_type(2)));
typedef float hwf2 __attribute__((ext_vector_type(2)));
DEVI bf16_t f2bf(float f) { return __builtin_bit_cast(unsigned short, (__bf16)f); }
DEVI unsigned pack2(float a, float b) { const hwf2 v = {a, b}; return __builtin_bit_cast(unsigned, __builtin_convertvector(v, hwbf2)); }
DEVI float lo_bf(unsigned u) { return __uint_as_float(u << 16); }
DEVI float hi_bf(unsigned u) { return __uint_as_float(u & 0xFFFF0000u); }
DEVI unsigned short f2h(float f) { _Float16 h = (_Float16)f; return __builtin_bit_cast(unsigned short, h); }
DEVI float h2f(unsigned short u) { return (float)__builtin_bit_cast(_Float16, u); }
DEVI float sigmoidf(float x) { return __builtin_amdgcn_rcpf(1.f + __expf(-x)); }
DEVI float gelu_tanh(float x) { const float u = 0.7978845608028654f * (x + 0.044715f * x * x * x); return x - x * __builtin_amdgcn_rcpf(1.f + __expf(2.f * u)); }

template <int CTRL> DEVI float dpp_f(float x) { return __int_as_float(__builtin_amdgcn_update_dpp(0, __float_as_int(x), CTRL, 0xF, 0xF, false)); }
DEVI float row_sum16(float x) {
  x += dpp_f<0xB1>(x);
  x += dpp_f<0x4E>(x);
  x += dpp_f<0x141>(x);
  x += dpp_f<0x140>(x);
  return x;
}
DEVI float shfl_xor_l(float x, int m) {
  int lane = (int)__builtin_amdgcn_mbcnt_hi(~0u, __builtin_amdgcn_mbcnt_lo(~0u, 0u));
  asm volatile("" : "+v"(lane));
  return __int_as_float(__builtin_amdgcn_ds_bpermute((lane ^ m) << 2, __float_as_int(x)));
}
DEVI float wave_sum(float x) { x = row_sum16(x); x += shfl_xor_l(x, 16); x += shfl_xor_l(x, 32); return x; }

DEVI int tid_() { int t = threadIdx.x; asm volatile("" : "+v"(t)); return t; }
DEVI int bid_() { int b = blockIdx.x; asm volatile("" : "+s"(b)); return b; }
DEVI void ld8f(const float* p, float (&o)[8]) { const float4 a = *(const float4*)p, b = *(const float4*)(p + 4); o[0] = a.x; o[1] = a.y; o[2] = a.z; o[3] = a.w; o[4] = b.x; o[5] = b.y; o[6] = b.z; o[7] = b.w; }
DEVI void ld8b(const bf16_t* p, float (&o)[8]) { const uint4 u = *(const uint4*)p; o[0] = lo_bf(u.x); o[1] = hi_bf(u.x); o[2] = lo_bf(u.y); o[3] = hi_bf(u.y); o[4] = lo_bf(u.z); o[5] = hi_bf(u.z); o[6] = lo_bf(u.w); o[7] = hi_bf(u.w); }
DEVI void st8f(float* p, const float (&v)[8]) { *(float4*)p = make_float4(v[0], v[1], v[2], v[3]); *(float4*)(p + 4) = make_float4(v[4], v[5], v[6], v[7]); }
DEVI void st8b(bf16_t* p, const float (&v)[8]) { *(uint4*)p = make_uint4(pack2(v[0], v[1]), pack2(v[2], v[3]), pack2(v[4], v[5]), pack2(v[6], v[7])); }
typedef _Float16 hx8 __attribute__((ext_vector_type(8)));
DEVI void ld8h(const _Float16* p, float (&o)[8]) { const hx8 u = *(const hx8*)p;
#pragma unroll
  for (int e = 0; e < 8; ++e) o[e] = (float)u[e]; }
DEVI void st8h(_Float16* p, const float (&v)[8]) { hx8 u;
#pragma unroll
  for (int e = 0; e < 8; ++e) u[e] = (_Float16)v[e];
  *(hx8*)p = u; }

DEVI int bidx_of(int R) { return R < NLAT ? (R >> 11) : 16; }
DEVI const float* xin_row(const Params& p, int R) { return R < NLAT ? uin(p, I_X) + (size_t)R * D : uin(p, I_CTX) + (size_t)(R - NLAT) * D; }

constexpr int LDT = 40;
constexpr int SMEM_BYTES = 143360;
constexpr int DSM_BYTES = SMEM_BYTES + 1024;
constexpr int MISC_PARAMS = 0, MISC_PRE = 384, MISC_CNT = 528, MISC_BLKE = 656, MISC_XB = 1008;
template <class AL, class BL, class EP>
DEVI void gemm_tile(unsigned char* smem, int kbeg, int kend, AL&& aload, BL&& bload, EP&& epi) {
  const int tid = tid_(), lane = tid & 63, wid = tid >> 6;
  const int wr = wid >> 1, wc = wid & 1, fr = lane & 15, fq = lane >> 4;
  bf16_t* sA = (bf16_t*)smem;
  bf16_t* sB = (bf16_t*)(smem + 2 * 256 * LDT * 2);
  const int lrow = tid >> 2, kq = (tid & 3) * 8;
  f32x4 acc[4][4];
#pragma unroll
  for (int m = 0; m < 4; ++m)
#pragma unroll
    for (int n = 0; n < 4; ++n) acc[m][n] = (f32x4){0.f, 0.f, 0.f, 0.f};
  uint4 ra0 = aload(0, kbeg + kq), ra1 = aload(1, kbeg + kq), rb = bload(kbeg + kq);
  int buf = 0;
#pragma unroll 1
  for (int k = kbeg; k < kend; k += 32) {
    *(uint4*)(sA + (buf * 256 + lrow) * LDT + kq) = ra0;
    *(uint4*)(sA + (buf * 256 + lrow + 128) * LDT + kq) = ra1;
    *(uint4*)(sB + (buf * 128 + lrow) * LDT + kq) = rb;
    __syncthreads();
    if (k + 32 < kend) { ra0 = aload(0, k + 32 + kq); ra1 = aload(1, k + 32 + kq); rb = bload(k + 32 + kq); }
    bf16x8 bfr[4];
#pragma unroll
    for (int n = 0; n < 4; ++n) bfr[n] = *(const bf16x8*)(sB + (buf * 128 + wc * 64 + n * 16 + fr) * LDT + fq * 8);
#pragma unroll
    for (int m = 0; m < 4; ++m) {
      const bf16x8 af = *(const bf16x8*)(sA + (buf * 256 + wr * 64 + m * 16 + fr) * LDT + fq * 8);
#pragma unroll
      for (int n = 0; n < 4; ++n) acc[m][n] = __builtin_amdgcn_mfma_f32_16x16x32_bf16(bfr[n], af, acc[m][n], 0, 0, 0);
    }
    buf ^= 1;
  }
  __syncthreads();
  epi(acc, wr, wc, fr, fq);
}


namespace g8 {
#define G8_LAS __attribute__((address_space(3)))
constexpr int BM = 256, BK = 64, HALF = 128, HTB = HALF * BK * 2;
DEVI int lds_byte(int r, int c) { const int st = (r >> 4) * 2 + (c >> 5), rr = r & 15, cc = c & 31, ob = rr * 64 + cc * 2; return st * 1024 + (ob ^ (((ob >> 9) & 1) << 5)); }
DEVI void stage_rc(int b, int& R, int& C) { const int st = b / 1024, sb = b % 1024, swz = sb ^ (((sb >> 9) & 1) << 5); R = (st >> 1) * 16 + swz / 64; C = (st & 1) * 32 + (swz % 64) / 2; }
DEVI int perm32(int rho) { const int n = rho >> 4, i = rho & 15; return 8 * (i >> 2) + 4 * n + (i & 3); }
struct Unit { int pm, pn, e; };
DEVI int xcd_remap(int L, int n) { const int q = n >> 3, r = n & 7, x = L & 7, off = L >> 3; return (x < r ? x * (q + 1) : r * (q + 1) + (x - r) * q) + off; }

template <class Epi, class Sched>
DEVI void gemm(G8_LAS unsigned char* lds, const int Kin, const Sched& S, const Epi& E) {
  int K = Kin; asm volatile("" : "+s"(K));
  const int tid = tid_(), wid = __builtin_amdgcn_readfirstlane(tid >> 6), lane = tid & 63, wr = wid >> 2, wc = wid & 3, fr = lane & 15, fq = lane >> 4;
  const int nt = K / BK;
  unsigned voffB[2];
#pragma unroll
  for (int i = 0; i < 2; ++i) { int R, C; stage_rc(tid * 16 + i * 8192, R, C); const int Rb = Epi::PERM ? ((R & ~31) + perm32(R & 31)) : R; voffB[i] = (unsigned)(Rb * K + C) * 2u; }
  const size_t kstep = (size_t)(BK * 2);
  const size_t hstepB = (size_t)HALF * K * 2;
  const unsigned ldsw = (unsigned)wid * 1024u;
  const int aoff = lds_byte(wr * 64 + fr, fq * 8), boff = lds_byte(wc * 32 + fr, fq * 8);
#define G8_SA(b, h) (((b) * 2 + (h)) * HTB)
#define G8_SB(b, h) ((4 + (b) * 2 + (h)) * HTB)
#define G8_STAGE_B(bufoff, gbase) do { _Pragma("unroll") for (int _i = 0; _i < 2; ++_i) \
    __builtin_amdgcn_global_load_lds((const unsigned*)((const char*)(gbase) + voffB[_i]), (G8_LAS unsigned*)(lds + (bufoff) + ldsw + _i * 8192), 16, 0, 0); } while (0)
#define G8_STAGE_A(bufoff, ubase, o0, o1) do { \
    __builtin_amdgcn_global_load_lds((const unsigned*)((ubase) + (o0)), (G8_LAS unsigned*)(lds + (bufoff) + ldsw), 16, 0, 0); \
    __builtin_amdgcn_global_load_lds((const unsigned*)((ubase) + (o1)), (G8_LAS unsigned*)(lds + (bufoff) + ldsw + 8192), 16, 0, 0); } while (0)
#define G8_LDA(dst, b, h) do { _Pragma("unroll") for (int m = 0; m < 4; ++m) _Pragma("unroll") for (int k = 0; k < 2; ++k) dst[m][k] = *(const G8_LAS bf16x8*)(lds + G8_SA(b, h) + aoff + m * 2048 + k * 1024); } while (0)
#define G8_LDB(dst, b, h) do { _Pragma("unroll") for (int n = 0; n < 2; ++n) _Pragma("unroll") for (int k = 0; k < 2; ++k) dst[n][k] = *(const G8_LAS bf16x8*)(lds + G8_SB(b, h) + boff + n * 2048 + k * 1024); } while (0)
#define G8_MMA(ai, bj, At, Bt) do { __builtin_amdgcn_s_setprio(1); _Pragma("unroll") for (int m = 0; m < 4; ++m) _Pragma("unroll") for (int n = 0; n < 2; ++n) _Pragma("unroll") for (int k = 0; k < 2; ++k) \
    acc[ai][bj][m][n] = __builtin_amdgcn_mfma_f32_16x16x32_bf16(Bt[n][k], At[m][k], acc[ai][bj][m][n], 0, 0, 0); __builtin_amdgcn_s_setprio(0); } while (0)
#define G8_WAIT_V(n) asm volatile("s_waitcnt vmcnt(" #n ")" ::: "memory")
#define G8_WAIT_L(n) asm volatile("s_waitcnt lgkmcnt(" #n ")" ::: "memory")
#define G8_BAR __builtin_amdgcn_s_barrier()
#define G8_SCHED __builtin_amdgcn_sched_barrier(0)
  Unit cur, nxt; int ui = 0;
  if (!S.next(0, cur)) return;
  f32x4 acc[2][2][4][2];
#pragma unroll
  for (int a = 0; a < 2; ++a)
#pragma unroll
    for (int b = 0; b < 2; ++b)
#pragma unroll
      for (int m = 0; m < 4; ++m)
#pragma unroll
        for (int n = 0; n < 2; ++n) acc[a][b][m][n] = (f32x4){0.f, 0.f, 0.f, 0.f};
  bf16x8 At[4][2], B0[2][2], B1[2][2];
  unsigned cA[2][2], nA[2][2];
  const char* const Ab = S.a_base();
  S.a_offs(cur, tid, cA);
  const char* cB = S.b_ptr(cur);
  G8_STAGE_B(G8_SB(0, 0), cB); G8_STAGE_A(G8_SA(0, 0), Ab, cA[0][0], cA[0][1]); G8_STAGE_B(G8_SB(0, 1), cB + hstepB); G8_STAGE_A(G8_SA(0, 1), Ab, cA[1][0], cA[1][1]);
  if (wr == 1) G8_BAR;
  G8_WAIT_V(4); G8_BAR;
  G8_STAGE_B(G8_SB(1, 0), cB + kstep); G8_STAGE_A(G8_SA(1, 0), Ab + kstep, cA[0][0], cA[0][1]); G8_STAGE_B(G8_SB(1, 1), cB + hstepB + kstep);
  G8_WAIT_V(6); G8_BAR;
  for (;;) {
    const bool has_next = S.next(ui + 1, nxt);
    const char* nB = cB;
    if (has_next) { S.a_offs(nxt, tid_(), nA); nB = S.b_ptr(nxt); }
    else { nA[0][0] = cA[0][0]; nA[0][1] = cA[0][1]; nA[1][0] = cA[1][0]; nA[1][1] = cA[1][1]; }
    for (int t = 0; t < nt; t += 2) {
      const bool last = (t == nt - 2);
      const size_t k1 = (size_t)(t + 1) * kstep, k2 = (size_t)(t + 2) * kstep;
      const char* b2 = last ? nB : cB + k2; const char* b3 = b2 + kstep;
      const char* Ab2 = last ? Ab : Ab + k2;
      unsigned a2[2][2];
#pragma unroll
      for (int h = 0; h < 2; ++h)
#pragma unroll
        for (int i = 0; i < 2; ++i) a2[h][i] = last ? nA[h][i] : cA[h][i];
      G8_LDB(B0, 0, 0); G8_SCHED; G8_LDA(At, 0, 0); G8_STAGE_A(G8_SA(1, 1), Ab + k1, cA[1][0], cA[1][1]);
      G8_WAIT_L(8); G8_BAR; G8_WAIT_L(0); G8_MMA(0, 0, At, B0); G8_BAR; G8_SCHED;
      G8_LDB(B1, 0, 1); G8_STAGE_B(G8_SB(0, 0), b2);
      G8_BAR; G8_WAIT_L(0); G8_MMA(0, 1, At, B1); G8_BAR;
      G8_LDA(At, 0, 1); G8_STAGE_A(G8_SA(0, 0), Ab2, a2[0][0], a2[0][1]);
      G8_BAR; G8_WAIT_L(0); G8_MMA(1, 0, At, B0); G8_BAR; G8_SCHED;
      G8_STAGE_B(G8_SB(0, 1), b2 + hstepB);
      G8_WAIT_V(6); G8_BAR; G8_MMA(1, 1, At, B1); G8_BAR;
      G8_LDB(B0, 1, 0); G8_SCHED; G8_LDA(At, 1, 0); G8_STAGE_A(G8_SA(0, 1), Ab2, a2[1][0], a2[1][1]);
      G8_WAIT_L(8); G8_BAR; G8_WAIT_L(0); G8_MMA(0, 0, At, B0); G8_BAR; G8_SCHED;
      G8_LDB(B1, 1, 1); G8_STAGE_B(G8_SB(1, 0), b3);
      G8_BAR; G8_WAIT_L(0); G8_MMA(0, 1, At, B1); G8_BAR;
      G8_LDA(At, 1, 1); G8_STAGE_A(G8_SA(1, 0), Ab2 + kstep, a2[0][0], a2[0][1]);
      G8_BAR; G8_WAIT_L(0); G8_MMA(1, 0, At, B0); G8_BAR; G8_SCHED;
      G8_STAGE_B(G8_SB(1, 1), b3 + hstepB);
      G8_WAIT_V(6); G8_BAR; G8_MMA(1, 1, At, B1); G8_BAR;
    }
    E(acc, cur);
    if (!has_next) break;
#pragma unroll
    for (int a = 0; a < 2; ++a)
#pragma unroll
      for (int b = 0; b < 2; ++b)
#pragma unroll
        for (int m = 0; m < 4; ++m)
#pragma unroll
          for (int n = 0; n < 2; ++n) acc[a][b][m][n] = (f32x4){0.f, 0.f, 0.f, 0.f};
    cur = nxt; cB = nB; ++ui;
#pragma unroll
    for (int h = 0; h < 2; ++h)
#pragma unroll
      for (int i = 0; i < 2; ++i) cA[h][i] = nA[h][i];
  }
  G8_WAIT_V(0);
  if (wr == 0) G8_BAR;
  G8_BAR;
#undef G8_SA
#undef G8_SB
#undef G8_STAGE_A
#undef G8_STAGE_B
#undef G8_LDA
#undef G8_LDB
#undef G8_MMA
#undef G8_WAIT_V
#undef G8_WAIT_L
#undef G8_BAR
#undef G8_SCHED
}

struct DenseSched {
  const bf16_t* A; const bf16_t* Bt; int K, nM, nN, G, c;
  DEVI bool next(int i, Unit& u) const {
    const int nwg = nM * nN; const long L = (long)i * G + c; if (L >= nwg) return false;
    const int wgid = xcd_remap((int)L, nwg);
    const int nig = 8 * nN, gid = wgid / nig, fm = gid * 8, gsz = (nM - fm) < 8 ? (nM - fm) : 8;
    u.pm = fm + ((wgid % nig) % gsz); u.pn = (wgid % nig) / gsz; u.e = 0; return true;
  }
  DEVI const char* a_base() const { return (const char*)A; }
  DEVI void a_offs(const Unit& u, int tid, unsigned (&ao)[2][2]) const {
#pragma unroll
    for (int i = 0; i < 2; ++i) {
      int R, C; stage_rc(tid * 16 + i * 8192, R, C);
#pragma unroll
      for (int h = 0; h < 2; ++h) ao[h][i] = ((unsigned)(u.pm * 256 + h * 128 + R) * (unsigned)K + (unsigned)C) * 2u;
    }
  }
  DEVI const char* b_ptr(const Unit& u) const { return (const char*)(Bt + (size_t)u.pn * 256 * K); }
};
}

struct TrRegs { float4 v[2][4]; };
DEVI void transpose_load(TrRegs& t, const float* __restrict__ src, int ld_src, int k0, int n0) {
  const int tid = tid_();
  const int kr = tid >> 4, c4 = (tid & 15) * 4;
#pragma unroll
  for (int i = 0; i < 2; ++i)
#pragma unroll
    for (int w = 0; w < 4; ++w) t.v[i][w] = *(const float4*)(src + (size_t)(k0 + kr + 32 * i) * ld_src + n0 + w * 64 + c4);
}
template <class RM>
DEVI void transpose_finish(unsigned char* smem, const TrRegs& t, int k0, int n0, bf16_t* dst, int ld_dst, RM&& rowmap) {
  bf16_t* T = (bf16_t*)smem;
  const int tid = tid_();
  const int kr = tid >> 4, c4 = (tid & 15) * 4;
#pragma unroll
  for (int i = 0; i < 2; ++i)
#pragma unroll
    for (int w = 0; w < 4; ++w) {
      const int kk = kr + 32 * i; bf16_t* tp = T + (w * 64 + c4) * 72 + kk;
      tp[0] = f2bf(t.v[i][w].x); tp[72] = f2bf(t.v[i][w].y); tp[144] = f2bf(t.v[i][w].z); tp[216] = f2bf(t.v[i][w].w);
    }
  __syncthreads();
  const int k8 = (tid & 7) * 8;
#pragma unroll
  for (int j = 0; j < 4; ++j) {
    const int nn = (tid >> 3) + 64 * j;
    const uint4 o = *(const uint4*)(T + nn * 72 + k8);
    *(uint4*)(dst + (size_t)rowmap(n0 + nn) * ld_dst + k0 + k8) = o;
  }
  __syncthreads();
}
template <class RM>
DEVI void transpose_tile(unsigned char* smem, const float* __restrict__ src, int ld_src, int k0, int n0, bf16_t* dst, int ld_dst, RM&& rowmap) {
  TrRegs t; transpose_load(t, src, ld_src, k0, n0);
  transpose_finish(smem, t, k0, n0, dst, ld_dst, rowmap);
}

struct S5Disc { float lm, th, ar, ai, cr, ci; };
DEVI S5Disc s5disc(const Params& p, int l, int d, int g, int pp) {
  const int idx = ((l * 2 + d) * 16 + g) * 64 + pp;
  const float lr = uin(p, I_LRE)[idx], li = uin(p, I_LIM)[idx];
  const float dt = expf(uin(p, I_LDT)[(l * 2 + d) * 16 + g]);
  S5Disc r; r.lm = lr * dt; r.th = li * dt;
  const float mag = expf(r.lm), cs = cosf(r.th), sn = sinf(r.th), sh = sinf(0.5f * r.th);
  r.ar = mag * cs; r.ai = mag * sn;
  const float nr = expm1f(r.lm) * cs - 2.f * sh * sh, ni = r.ai, den = lr * lr + li * li;
  r.cr = (nr * lr + ni * li) / den; r.ci = (ni * lr - nr * li) / den;
  return r;
}

DEVI void phase0a(const Params& p, unsigned char* smem) {
  const int tid = tid_(), bid = bid_(), G = gridDim.x;
  unsigned char* ws = uws(p);
  if (bid == 0 && tid < 128) ((int*)(ws + WS_CTL))[tid] = 0;
  constexpr int N_MOD = 384, N_KT = 256, N_ROPE = 128, N_TRW = 256 + 128, N_EL = 640;
  constexpr int N_AP = 265;
  constexpr int N_BB = 128;
  const int total = N_MOD + N_KT + N_ROPE + N_TRW + N_EL + N_AP + N_BB;
  for (int it0 = bid; it0 < total; it0 += G) {
    int it = it0;
    if (it < N_MOD) {
      const int l = it / 192, col0 = (it % 192) * 32;
      const int c = tid & 31, kg = tid >> 5;
      float* sS = (float*)smem;
      float acc[17];
#pragma unroll
      for (int b = 0; b < 17; ++b) acc[b] = 0.f;
      const float* W = uin(p, I_WMOD) + (size_t)l * D * 6144 + col0 + c;
      for (int kc = 0; kc < 4; ++kc) {
        __syncthreads();
        for (int e = tid; e < 17 * 256; e += NTHREADS) {
          const int b = e >> 8, k = kc * 256 + (e & 255);
          const float cv = (b < 16) ? uin(p, I_C)[b * D + k] : uin(p, I_CCTX)[k];
          sS[e] = cv / (1.f + __expf(-cv));
        }
        __syncthreads();
        float wv[16];
#pragma unroll
        for (int i = 0; i < 16; ++i) wv[i] = W[(size_t)(kc * 256 + kg + 16 * i) * 6144];
#pragma unroll
        for (int i = 0; i < 16; ++i) {
          const int kl = kg + 16 * i;
#pragma unroll
          for (int b = 0; b < 17; ++b) acc[b] = fmaf(sS[b * 256 + kl], wv[i], acc[b]);
        }
      }
      __syncthreads();
      float* sR = (float*)smem;
#pragma unroll
      for (int b = 0; b < 17; ++b) sR[(kg * 17 + b) * 32 + c] = acc[b];
      __syncthreads();
      for (int e = tid; e < 17 * 32; e += NTHREADS) {
        const int b = e >> 5, cc = e & 31;
        float s = 0.f;
#pragma unroll
        for (int q = 0; q < 16; ++q) s += sR[(q * 17 + b) * 32 + cc];
        ((float*)(ws + WS_MOD))[(size_t)(l * 17 + b) * 6144 + col0 + cc] = s + uin(p, I_BMOD)[l * 6144 + col0 + cc];
      }
      __syncthreads();
      continue;
    }
    it -= N_MOD;
    if (it < N_KT) {
      const int gid = it * NTHREADS + tid;
      const int pg = gid & 7, cc = (gid >> 3) & 255, c = cc >> 4, c2 = cc & 15;
      const int lgd = gid >> 11, d = lgd & 1, g = (lgd >> 1) & 15, l = lgd >> 5;
      float K[32];
#pragma unroll
      for (int j = 0; j < 32; ++j) K[j] = 0.f;
      for (int q = 0; q < 8; ++q) {
        const int pp = pg * 8 + q;
        const S5Disc dd = s5disc(p, l, d, g, pp);
        const float ar = dd.ar, ai = dd.ai;
        const float br = uin(p, I_BRE)[((l * 16 + g) * 64 + pp) * 16 + c2], bi = uin(p, I_BIM)[((l * 16 + g) * 64 + pp) * 16 + c2];
        const float bbr = dd.cr * br - dd.ci * bi, bbi = dd.cr * bi + dd.ci * br;
        const float cr = uin(p, I_CRE)[((l * 16 + g) * 16 + c) * 64 + pp], ci = uin(p, I_CIM)[((l * 16 + g) * 16 + c) * 64 + pp];
        const float zr = cr * bbr - ci * bbi, zi = cr * bbi + ci * bbr;
        float pr = 1.f, pi = 0.f;
#pragma unroll
        for (int j = 0; j < 32; ++j) {
          K[j] += zr * pr - zi * pi;
          const float nr = pr * ar - pi * ai, ni = pr * ai + pi * ar;
          pr = nr; pi = ni;
        }
      }
#pragma unroll
      for (int j = 0; j < 32; ++j) { float v = K[j]; v += dpp_f<0xB1>(v); v += dpp_f<0x4E>(v); v += dpp_f<0x141>(v); K[j] = v; }
      if (pg == 0) {
        float* KT = (float*)(ws + WS_KTAB) + (size_t)(((l * 16 + g) * 2 + d) * 32) * 256 + c * 16 + c2;
#pragma unroll
        for (int j = 0; j < 32; ++j) KT[j * 256] = K[j];
      }
      continue;
    }
    it -= N_KT;
    if (it < N_ROPE) {
      const int e = it * NTHREADS + tid;
      const int pos = e >> 5, i = e & 31;
      const float inv = powf(10000.f, -(float)(i & 15) / 16.f);
      const float ang = (float)((i < 16) ? (pos >> 6) : (pos & 63)) * inv;
      ((float*)(ws + WS_ROPE))[e] = cosf(ang);
      ((float*)(ws + WS_ROPE))[65536 + e] = sinf(ang);
      continue;
    }
    it -= N_ROPE;
    if (it < N_TRW) {
      if (it < 256) {
        const int l = it >> 7, r = it & 127, kt = r >> 3, ntl = r & 7;
        transpose_tile(smem, uin(p, I_WIN) + (size_t)l * D * DIN, DIN, kt * 64, ntl * 256, (bf16_t*)(ws + WS_WIN_T) + (size_t)l * DIN * D, D,
          [](int n) { if (n >= 1280 && n < 1920) { const int d = n & 63; return (n & ~63) + 32 * ((d >> 4) & 1) + 8 * ((d >> 2) & 3) + 4 * (d >> 5) + (d & 3); } return n; });
      } else {
        const int r0 = it - 256, l = r0 >> 6, r = r0 & 63, kt = r >> 2, ntl = r & 3;
        transpose_tile(smem, uin(p, I_WOUT) + (size_t)l * D * D, D, kt * 64, ntl * 256, (bf16_t*)(ws + WS_WOUT_T) + (size_t)l * D * D, D, [](int n) { return n; });
      }
      continue;
    }
    it -= N_TRW;
    if (it < N_EL) {
      for (int q = 0; q < 4; ++q) {
        int e = (it * 4 + q) * NTHREADS + tid;
        if (e < 655360) {
          const int l = e / 327680, r = e % 327680, n = r >> 8, k = r & 255;
          float v = 0.f;
          if (n < 512) { const int d = n >> 8, col = n & 255; if (k < 64) v = uin(p, I_W2)[((l * 2 + d) * 64 + k) * 256 + col]; }
          else if (n < 1024) { const int d = (n - 512) >> 8, col = n & 255; if (k >= 64 && k < 128) v = uin(p, I_A2)[((l * 2 + d) * 64 + (k - 64)) * 256 + col]; }
          else { const int col = n - 1024; if (k >= 128) v = uin(p, I_G2)[(l * 128 + (k - 128)) * 256 + col]; }
          ((bf16_t*)(ws + WS_FW))[e] = f2bf(v);
          continue;
        }
        e -= 655360;
        if (e < 131072) {
          const int l = e >> 16, r = e & 65535, n = r >> 8, k = r & 255;
          ((bf16_t*)(ws + WS_GLU_T))[e] = f2bf(uin(p, I_GLUW)[(l * 256 + k) * 256 + n]);
          continue;
        }
        e -= 131072;
        if (e < 524288) {
          const int l = e >> 18, r = e & 262143, hl = r >> 17, n = (r >> 10) & 127, k = r & 1023;
          float v = 0.f;
          if (n < 4) v = uin(p, I_RGW)[(l * D + k) * 4 + n];
          else if (n < 36) v = uin(p, I_REW)[(l * D + k) * 32 + (n - 4)];
          const bf16_t h = f2bf(v);
          ((bf16_t*)(ws + WS_RW))[e] = hl ? f2bf(v - bf2f(h)) : h;
        }
      }
      continue;
    }
    it -= N_EL;
    if (it < N_AP) {
      const int e = it * NTHREADS + tid;
      if (e < 2 * 2 * 16 * 64 * 33) {
        const int j = e % 33, r = e / 33, pp = r & 63, g = (r >> 6) & 15, d = (r >> 10) & 1, l = r >> 11;
        const S5Disc dd = s5disc(p, l, d, g, pp);
        const float mg = expf(dd.lm * (float)j), an = dd.th * (float)j;
        ((float2*)(ws + WS_APOW))[e] = make_float2(mg * cosf(an), mg * sinf(an));
      }
      continue;
    }
    it -= N_AP;
    {
      const int e = it * NTHREADS + tid;
      const int c2 = e & 15, pp = (e >> 4) & 63, g = (e >> 10) & 15, d = (e >> 14) & 1, l = e >> 15;
      const S5Disc dd = s5disc(p, l, d, g, pp);
      const float br = uin(p, I_BRE)[((l * 16 + g) * 64 + pp) * 16 + c2], bi = uin(p, I_BIM)[((l * 16 + g) * 64 + pp) * 16 + c2];
      ((float2*)(ws + WS_BBT))[e] = make_float2(dd.cr * br - dd.ci * bi, dd.cr * bi + dd.ci * br);
    }
  }
}

DEVI void write_xmod_row(const float4 v[4], const float* modl, bf16_t* dstrow, int lane) {
#pragma unroll
  for (int i = 0; i < 4; ++i) {
    const int col = i * 256 + lane * 4;
    const float4 sh = *(const float4*)(modl + col), sc = *(const float4*)(modl + 1024 + col);
    uint2 o; o.x = pack2(v[i].x * (1.f + sc.x) + sh.x, v[i].y * (1.f + sc.y) + sh.y); o.y = pack2(v[i].z * (1.f + sc.z) + sh.z, v[i].w * (1.f + sc.w) + sh.w);
    *(uint2*)(dstrow + col) = o;
  }
}
DEVI void phase0b(const Params& p, unsigned char* smem) {
  const int tid = tid_(), bid = bid_(), G = gridDim.x, lane = tid & 63, wid = tid >> 6;
  unsigned char* ws = uws(p);
  {
    bf16_t* XM = (bf16_t*)((unsigned char*)uout(p) + DO_XMOD);
    const float* MOD = (const float*)(ws + WS_MOD);
    const int nw = G * 8, gw = bid * 8 + wid, rpw = (NT + nw - 1) / nw;
    const int R0 = gw * rpw, R1 = (R0 + rpw < NT) ? (R0 + rpw) : NT;
    const int c0 = lane * 8, c1 = 512 + lane * 8;
    float sh[2][8], sc[2][8], xv[2][8];
    int curb = -1;
    if (R0 < R1) { ld8f(xin_row(p, R0) + c0, xv[0]); ld8f(xin_row(p, R0) + c1, xv[1]); }
    for (int R = R0; R < R1; ++R) {
      float xn[2][8];
#pragma unroll
      for (int h = 0; h < 2; ++h)
#pragma unroll
        for (int e = 0; e < 8; ++e) xn[h][e] = 0.f;
      if (R + 1 < R1) { ld8f(xin_row(p, R + 1) + c0, xn[0]); ld8f(xin_row(p, R + 1) + c1, xn[1]); }
      const int bi = bidx_of(R);
      if (bi != curb) { curb = bi; const float* modl = MOD + (size_t)bi * 6144; ld8f(modl + c0, sh[0]); ld8f(modl + c1, sh[1]); ld8f(modl + 1024 + c0, sc[0]); ld8f(modl + 1024 + c1, sc[1]); }
#pragma unroll
      for (int h = 0; h < 2; ++h) {
        float xm[8];
#pragma unroll
        for (int e = 0; e < 8; ++e) xm[e] = xv[h][e] * (1.f + sc[h][e]) + sh[h][e];
        st8b(XM + (size_t)R * D + (h ? c1 : c0), xm);
      }
#pragma unroll
      for (int h = 0; h < 2; ++h)
#pragma unroll
        for (int e = 0; e < 8; ++e) xv[h][e] = xn[h][e];
    }
  }
  const float* KT = (const float*)(ws + WS_KTAB);
  const float2* AP = (const float2*)(ws + WS_APOW);
  const float2* BB = (const float2*)(ws + WS_BBT);
  const long nthreads = (long)G * NTHREADS, gt = (long)bid * NTHREADS + tid;
  const long n_ttg = 2L * 16 * 512 * 96;
  for (long e = gt; e < n_ttg; e += nthreads) {
    const int k8 = (int)(e % 96), m = (int)((e / 96) & 511), g = (int)((e / (96 * 512)) & 15), l = (int)(e / (96 * 512 * 16));
    const int tau = m >> 4, c = m & 15, k = k8 * 8;
    float v[8];
    if (k < 512) {
      const int sg = k >> 4, c2 = k & 15;
      const float* K0 = KT + (size_t)(((l * 16 + g) * 2 + 0) * 32) * 256 + c * 16 + c2;
      const float* K1 = KT + (size_t)(((l * 16 + g) * 2 + 1) * 32) * 256 + c * 16 + c2;
      if (sg < tau) { for (int q = 0; q < 8; ++q) v[q] = K0[(tau - sg) * 256 + q]; }
      else if (sg > tau) { for (int q = 0; q < 8; ++q) v[q] = K1[(sg - tau) * 256 + q]; }
      else { for (int q = 0; q < 8; ++q) v[q] = K0[q] + K1[q] + ((c2 + q == c) ? uin(p, I_SD)[l * 256 + g * 16 + c] : 0.f); }
    } else {
      const int q0 = k - 512, d = q0 >> 7, isim = (q0 >> 6) & 1, p0 = q0 & 63;
      const int j = d ? (32 - tau) : (tau + 1);
      for (int q = 0; q < 8; ++q) {
        const int pp = p0 + q;
        const float2 a = AP[((size_t)(((l * 2 + d) * 16 + g) * 64 + pp)) * 33 + j];
        const float cr = uin(p, I_CRE)[((l * 16 + g) * 16 + c) * 64 + pp], ci = uin(p, I_CIM)[((l * 16 + g) * 16 + c) * 64 + pp];
        v[q] = isim ? -(cr * a.y + ci * a.x) : (cr * a.x - ci * a.y);
      }
    }
    uint4 o; o.x = pack2(v[0], v[1]); o.y = pack2(v[2], v[3]); o.z = pack2(v[4], v[5]); o.w = pack2(v[6], v[7]);
    *(uint4*)((bf16_t*)(ws + WS_TTG) + (size_t)e * 8) = o;
  }
  const long n_em = 2L * 16 * 256 * 64;
  for (long e = gt; e < n_em; e += nthreads) {
    const int k8 = (int)(e & 63), r = (int)((e >> 6) & 255), g = (int)((e >> 14) & 15), l = (int)(e >> 18);
    const int d = r >> 7, isim = (r >> 6) & 1, pp = r & 63, k = k8 * 8, sg = k >> 4, c2 = k & 15;
    const int j = d ? sg : (31 - sg);
    const float2 a = AP[((size_t)(((l * 2 + d) * 16 + g) * 64 + pp)) * 33 + j];
    float v[8];
    for (int q = 0; q < 8; ++q) {
      const float2 bb = BB[(size_t)((((l * 2 + d) * 16 + g) * 64 + pp) * 16) + c2 + q];
      v[q] = isim ? (a.x * bb.y + a.y * bb.x) : (a.x * bb.x - a.y * bb.y);
    }
    uint4 o; o.x = pack2(v[0], v[1]); o.y = pack2(v[2], v[3]); o.z = pack2(v[4], v[5]); o.w = pack2(v[6], v[7]);
    *(uint4*)((bf16_t*)(ws + WS_EM) + (size_t)e * 8) = o;
  }
}

struct EpiInproj {
  static constexpr bool PERM = true;
  bf16_t* PROJ; bf16_t* UDH; const float* RC; const float* RS;
  DEVI void operator()(const f32x4 (&acc)[2][2][4][2], const g8::Unit& u) const {
    const int tid = tid_(), wid = __builtin_amdgcn_readfirstlane(tid >> 6), lane = tid & 63, wr = wid >> 2, wc = wid & 3, fr = lane & 15, fq = lane >> 4;
    const bool lat = u.pm < 128;
#pragma unroll
    for (int ai = 0; ai < 2; ++ai)
#pragma unroll
      for (int m = 0; m < 4; ++m) {
        const int row = u.pm * 256 + ai * 128 + wr * 64 + m * 16 + fr, pos = row & 2047;
#pragma unroll
        for (int bj = 0; bj < 2; ++bj) {
          const int cb = u.pn * 256 + bj * 128 + wc * 32 + 8 * fq;
          f32x4 x0 = acc[ai][bj][m][0], x1 = acc[ai][bj][m][1];
          const bool isq = (u.pn == 5 || u.pn == 6), isk = (u.pn == 7 && bj == 0);
          if ((isq || isk) && lat) {
            const int i0 = 16 * (wc & 1) + 4 * fq;
            const float4 cs = *(const float4*)(RC + pos * 32 + i0), sn = *(const float4*)(RS + pos * 32 + i0);
            const f32x4 y0 = (f32x4){x0[0] * cs.x - x1[0] * sn.x, x0[1] * cs.y - x1[1] * sn.y, x0[2] * cs.z - x1[2] * sn.z, x0[3] * cs.w - x1[3] * sn.w};
            const f32x4 y1 = (f32x4){x1[0] * cs.x + x0[0] * sn.x, x1[1] * cs.y + x0[1] * sn.y, x1[2] * cs.z + x0[2] * sn.z, x1[3] * cs.w + x0[3] * sn.w};
            x0 = y0; x1 = y1;
          }
          if (isq) { x0 = x0 * 0.125f; x1 = x1 * 0.125f; }
          const uint4 o = make_uint4(pack2(x0[0], x0[1]), pack2(x0[2], x0[3]), pack2(x1[0], x1[1]), pack2(x1[2], x1[3]));
          if (u.pn == 4) {
            const int g = (cb - 1024) >> 4, c = cb & 15;
            *(uint4*)(UDH + ((size_t)(g * NCH + (row >> 5))) * 768 + (row & 31) * 16 + c) = o;
          } else {
            *(uint4*)(PROJ + (size_t)row * DIN + cb) = o;
          }
        }
        asm volatile("" ::: "memory");
      }
  }
};
DEVI void phase_inproj(const Params& p, int l, unsigned char* smem) {
  unsigned char* ws = uws(p);
  g8::DenseSched S{(const bf16_t*)((unsigned char*)uout(p) + DO_XMOD), (const bf16_t*)(ws + WS_WIN_T) + (size_t)l * DIN * D, D, 144, 8, (int)gridDim.x, bid_()};
  EpiInproj E{(bf16_t*)(ws + WS_PROJ), (bf16_t*)(ws + WS_UDH), (const float*)(ws + WS_ROPE), (const float*)(ws + WS_ROPE) + 65536};
  __syncthreads();
  g8::gemm((G8_LAS unsigned char*)smem, D, S, E);
  __syncthreads();
}

DEVI void phase_feat(const Params& p, int l, unsigned char* smem) {
  unsigned char* ws = uws(p);
  const bf16_t* PROJ = (const bf16_t*)(ws + WS_PROJ);
  unsigned short* FEAT = (unsigned short*)(ws + WS_FEAT);
  const bf16_t* FW = (const bf16_t*)(ws + WS_FW) + (size_t)l * 1280 * 256;
  const bf16_t* EM = (const bf16_t*)(ws + WS_EM) + (size_t)l * 16 * 256 * 512;
  float* HE = (float*)((unsigned char*)uout(p) + DO_HE);
  const float* CW = uin(p, I_CONV) + l * 3 * 1024;
  const int tid = tid_(), lrow = tid >> 2;
  for (int it = bid_(); it < 432 + 160; it += gridDim.x) {
    if (it < 432) {
      const int mt = it / 3, typ = it % 3;
      const int kb = typ == 0 ? 0 : (typ == 1 ? 64 : 128), KK = typ == 2 ? 128 : 64, lda = KK + 8;
      const int nt_lo = typ == 0 ? 0 : (typ == 1 ? 4 : 8), nt_n = typ == 2 ? 2 : 4;
      bf16_t* sA = (bf16_t*)smem;
      bf16_t* sB = sA + 256 * 136;
      {
        const int ppr = KK >> 3;
        const int kfix = kb + (tid % ppr) * 8;
        float wc0[8], wc1[8], wc2[8];
        ld8f(CW + 768 + kfix, wc0); ld8f(CW + 1024 + 768 + kfix, wc1); ld8f(CW + 2048 + 768 + kfix, wc2);
        for (int pc = tid; pc < 256 * ppr; pc += NTHREADS) {
          const int rr = pc / ppr, k = kfix;
          const int R = mt * 256 + rr;
          const int t = R < NLAT ? (R & 2047) : ((R - NLAT) & 255); const int len = R < NLAT ? SEQ : CTXL;
          const bf16_t* pcur = PROJ + (size_t)R * DIN + 768 + k;
          const uint4 vc = *(const uint4*)pcur;
          uint4 vp = make_uint4(0, 0, 0, 0), vn = make_uint4(0, 0, 0, 0);
          if (t > 0) vp = *(const uint4*)(pcur - DIN);
          if (t < len - 1) vn = *(const uint4*)(pcur + DIN);
          float x[8];
          const unsigned up[4] = {vp.x, vp.y, vp.z, vp.w}, uc[4] = {vc.x, vc.y, vc.z, vc.w}, un[4] = {vn.x, vn.y, vn.z, vn.w};
#pragma unroll
          for (int q = 0; q < 4; ++q) {
            x[2 * q] = lo_bf(up[q]) * wc0[2 * q] + lo_bf(uc[q]) * wc1[2 * q] + lo_bf(un[q]) * wc2[2 * q];
            x[2 * q + 1] = hi_bf(up[q]) * wc0[2 * q + 1] + hi_bf(uc[q]) * wc1[2 * q + 1] + hi_bf(un[q]) * wc2[2 * q + 1];
          }
          if (typ == 0) { for (int q = 0; q < 8; ++q) x[q] = 1.f - 2.f * __builtin_amdgcn_rcpf(1.f + __expf(2.f * x[q])); }
          else if (typ == 2) { for (int q = 0; q < 8; ++q) x[q] = sigmoidf(x[q]); }
          *(uint4*)(sA + rr * lda + (k - kb)) = make_uint4(pack2(x[0], x[1]), pack2(x[2], x[3]), pack2(x[4], x[5]), pack2(x[6], x[7]));
        }
      }
      const int lane = tid & 63, wid = tid >> 6, wr = wid >> 1, wc = wid & 1, fr = lane & 15, fq = lane >> 4;
      for (int nq = 0; nq < nt_n; ++nq) {
        const int ntl = nt_lo + nq;
        __syncthreads();
        {
          const int ppr = KK >> 3;
          for (int pc = tid; pc < 128 * ppr; pc += NTHREADS) {
            const int rr = pc / ppr, k = (pc % ppr) * 8;
            *(uint4*)(sB + rr * lda + k) = *(const uint4*)(FW + (size_t)(ntl * 128 + rr) * 256 + kb + k);
          }
        }
        __syncthreads();
        f32x4 acc[4][4];
#pragma unroll
        for (int m = 0; m < 4; ++m)
#pragma unroll
          for (int n = 0; n < 4; ++n) acc[m][n] = (f32x4){0.f, 0.f, 0.f, 0.f};
        for (int k0 = 0; k0 < KK; k0 += 32) {
          bf16x8 bfr[4];
#pragma unroll
          for (int n = 0; n < 4; ++n) bfr[n] = *(const bf16x8*)(sB + (wc * 64 + n * 16 + fr) * lda + k0 + fq * 8);
#pragma unroll
          for (int m = 0; m < 4; ++m) {
            const bf16x8 af = *(const bf16x8*)(sA + (wr * 64 + m * 16 + fr) * lda + k0 + fq * 8);
#pragma unroll
            for (int n = 0; n < 4; ++n) acc[m][n] = __builtin_amdgcn_mfma_f32_16x16x32_bf16(bfr[n], af, acc[m][n], 0, 0, 0);
          }
        }
#pragma unroll
        for (int m = 0; m < 4; ++m) {
          const int row = mt * 256 + wr * 64 + m * 16 + fr;
#pragma unroll
          for (int n = 0; n < 4; ++n) {
            const int ng = ntl * 128 + wc * 64 + n * 16 + fq * 4;
            float o[4];
            if (typ == 0) {
              const float4 w0 = *(const float4*)(uin(p, I_W0) + (l * 2 + (ng >> 8)) * 256 + (ng & 255));
              const float wv[4] = {w0.x, w0.y, w0.z, w0.w};
#pragma unroll
              for (int j = 0; j < 4; ++j) {
                const float e = 0.6065306597126334f * sigmoidf(acc[m][n][j] + wv[j]);
                o[j] = 1.f - __expf(-e);
              }
            } else if (typ == 1) {
              const float4 a0 = *(const float4*)(uin(p, I_A0) + (l * 2 + ((ng - 512) >> 8)) * 256 + (ng & 255));
              const float av[4] = {a0.x, a0.y, a0.z, a0.w};
#pragma unroll
              for (int j = 0; j < 4; ++j) o[j] = sigmoidf(acc[m][n][j] + av[j]);
            } else {
#pragma unroll
              for (int j = 0; j < 4; ++j) o[j] = acc[m][n][j];
            }
            uint2 w; w.x = (unsigned)f2h(o[0]) | ((unsigned)f2h(o[1]) << 16); w.y = (unsigned)f2h(o[2]) | ((unsigned)f2h(o[3]) << 16);
            *(uint2*)(FEAT + (size_t)row * 1280 + ng) = w;
          }
        }
      }
      __syncthreads();
    } else {
      const int j = it - 432, g = j / 10, rest = j % 10, mt5 = rest >> 1, nt2 = rest & 1;
      int n0 = mt5 * 256 + lrow, n1 = n0 + 128; if (n0 > NCH - 1) n0 = NCH - 1; if (n1 > NCH - 1) n1 = NCH - 1;
      const bf16_t* UDH = (const bf16_t*)(ws + WS_UDH);
      const bf16_t* a0 = UDH + (size_t)(g * NCH + n0) * 768; const bf16_t* a1 = UDH + (size_t)(g * NCH + n1) * 768;
      const bf16_t* b0 = EM + (size_t)(g * 256 + nt2 * 128 + lrow) * 512;
      gemm_tile(smem, 0, 512,
        [&](int i, int k) { return *(const uint4*)((i ? a1 : a0) + k); },
        [&](int k) { return *(const uint4*)(b0 + k); },
        [&](f32x4 (&acc)[4][4], int wr, int wc, int fr, int fq) {
#pragma unroll
          for (int m = 0; m < 4; ++m) {
            const int n = mt5 * 256 + wr * 64 + m * 16 + fr;
            if (n < NCH) {
#pragma unroll
              for (int nn = 0; nn < 4; ++nn)
                *(f32x4*)(HE + (size_t)(g * NCH + n) * 256 + nt2 * 128 + wc * 64 + nn * 16 + fq * 4) = acc[m][nn];
            }
          }
        });
    }
  }
}


DEVI float row_reduce_scatter16(const float (&v)[16], int lane16) {
  float a[8], b[4], c[2];
  const bool b3 = (lane16 & 8) != 0, b2 = (lane16 & 4) != 0, b1 = (lane16 & 2) != 0, b0 = (lane16 & 1) != 0;
#pragma unroll
  for (int k = 0; k < 8; ++k) { const float send = b3 ? v[k] : v[k + 8], keep = b3 ? v[k + 8] : v[k]; a[k] = keep + dpp_f<0x128>(send); }
#pragma unroll
  for (int k = 0; k < 4; ++k) { const float send = b2 ? a[k] : a[k + 4], keep = b2 ? a[k + 4] : a[k]; b[k] = keep + dpp_f<0x141>(send); }
#pragma unroll
  for (int k = 0; k < 2; ++k) { const float send = b1 ? b[k] : b[k + 2], keep = b1 ? b[k + 2] : b[k]; c[k] = keep + dpp_f<0x4E>(send); }
  { const float send = b0 ? c[0] : c[1], keep = b0 ? c[1] : c[0]; return keep + dpp_f<0xB1>(send); }
}
DEVI float mul_mix_lo(float a, unsigned hpair) { float r; asm("v_fma_mix_f32 %0, %1, %2, 0 op_sel_hi:[0,1,0]" : "=v"(r) : "v"(a), "v"(hpair)); return r; }
constexpr int RC_SLOT = 17664;
constexpr int RC_KK = 0, RC_RR = 2304, RC_KDB = 4608, RC_TT = 8704, RC_MM = 9728, RC_V = 10752, RC_G = 12800, RC_KD = 13056, RC_BB = 15360;
DEVI bf16x8 rc_pack8(const f32x4& a, const f32x4& b) {
  typedef unsigned u4v __attribute__((ext_vector_type(4)));
  const u4v u = {pack2(a[0], a[1]), pack2(a[2], a[3]), pack2(b[0], b[1]), pack2(b[2], b[3])};
  return __builtin_bit_cast(bf16x8, u);
}
DEVI bf16x8 rc_pack8(const f32x4& a, uint2 b) {
  typedef unsigned u4v __attribute__((ext_vector_type(4)));
  const u4v u = {pack2(a[0], a[1]), pack2(a[2], a[3]), b.x, b.y};
  return __builtin_bit_cast(bf16x8, u);
}
DEVI bf16x8 rc_pack8(uint2 a, const f32x4& b) {
  typedef unsigned u4v __attribute__((ext_vector_type(4)));
  const u4v u = {a.x, a.y, pack2(b[0], b[1]), pack2(b[2], b[3])};
  return __builtin_bit_cast(bf16x8, u);
}
template <int DIR>
DEVI void rwkv_chunked(const Params& p, int l, int it, unsigned char* smem) {
  unsigned char* ws = uws(p);
  const int b = it >> 3, h = (it >> 1) & 3;
  const bf16_t* PROJ = (const bf16_t*)(ws + WS_PROJ);
  const unsigned short* FEAT = (const unsigned short*)(ws + WS_FEAT);
  float* Y = (float*)((unsigned char*)uout(p) + (DIR ? DO_YB : DO_YF));
  const int tid = tid_(), lane = tid & 63, wid = __builtin_amdgcn_readfirstlane(tid >> 6);
  const int cl = lane & 15, cq = lane >> 4;
  const int hc = h * 64 + lane;
  const float* CW = uin(p, I_CONV) + l * 3 * 1024;
  float cwr[3], cwk[3], cwv[3];
#pragma unroll
  for (int dl = 0; dl < 3; ++dl) { cwr[dl] = CW[dl * 1024 + hc]; cwk[dl] = CW[dl * 1024 + 256 + hc]; cwv[dl] = CW[dl * 1024 + 512 + hc]; }
  const float kkw = uin(p, I_KK)[l * 256 + hc], kaw = uin(p, I_KA)[l * 256 + hc];
  const int pj = 32 * (lane >> 5) + 8 * ((lane >> 2) & 3) + 4 * ((lane >> 4) & 1) + (lane & 3);
  unsigned char* slot = smem + wid * RC_SLOT;
  const f32x4 zero4 = {0.f, 0.f, 0.f, 0.f};
  f32x4 acc[4] = {zero4, zero4, zero4, zero4};
  uint4 raw0, raw1, raw2, raw3, raw4, raw5, raw6, raw7, raw8, raw9, raw10;
  auto chunk_geom = [&](int c, bool& isctx, int& seqlen, int& lo, int& rowbase) __attribute__((always_inline)) {
    const int n0 = c * 16; isctx = n0 < 256; seqlen = isctx ? 256 : 2048; const int m0 = isctx ? n0 : n0 - 256;
    lo = DIR ? (seqlen - 16 - m0) : m0;
    rowbase = isctx ? (NLAT + b * CTXL) : (b * SEQ);
  };
#define RC_LDP(ld, dst) do { const int L_ = (ld) * 64 + lane_; const int Lc_ = L_ < 432 ? L_ : 431; const int u_ = Lc_ / 24, sg_ = (Lc_ % 24) >> 3, part_ = Lc_ & 7; \
    int tau_ = lo_ - 1 + u_; tau_ = tau_ < 0 ? 0 : (tau_ >= seqlen_ ? seqlen_ - 1 : tau_); \
    dst = *(const uint4*)(PROJ + (size_t)(rowbase_ + tau_) * DIN + h * 64 + sg_ * 256 + part_ * 8); } while (0)
#define RC_LDF(ld, dst) do { const int L_ = (ld) * 64 + lane_; const int o_ = L_ >> 4, sg_ = (L_ >> 3) & 1, part_ = L_ & 7; \
    dst = *(const uint4*)(FEAT + (size_t)(rowbase_ + lo_ + o_) * 1280 + DIR * 256 + sg_ * 512 + h * 64 + part_ * 8); } while (0)
#define RC_LOAD_RAW(c) do { bool isctx_; int seqlen_, lo_, rowbase_; chunk_geom((c), isctx_, seqlen_, lo_, rowbase_); const int lane_ = tid_() & 63;     \
    RC_LDP(0, raw0); RC_LDP(1, raw1); RC_LDP(2, raw2); RC_LDP(3, raw3); RC_LDP(4, raw4); RC_LDP(5, raw5); RC_LDP(6, raw6); \
    RC_LDF(0, raw7); RC_LDF(1, raw8); RC_LDF(2, raw9); RC_LDF(3, raw10); } while (0)
  RC_LOAD_RAW(wid);
  for (int batch = 0; batch < 18; ++batch) {
    {
      const int c = batch * 8 + wid;
      bool isctx; int seqlen, lo, rowbase; chunk_geom(c, isctx, seqlen, lo, rowbase);
      *(uint4*)(slot + (0 * 64 + lane) * 16) = raw0; *(uint4*)(slot + (1 * 64 + lane) * 16) = raw1; *(uint4*)(slot + (2 * 64 + lane) * 16) = raw2; *(uint4*)(slot + (3 * 64 + lane) * 16) = raw3;
      *(uint4*)(slot + (4 * 64 + lane) * 16) = raw4; *(uint4*)(slot + (5 * 64 + lane) * 16) = raw5; if (6 * 64 + lane < 432) *(uint4*)(slot + (6 * 64 + lane) * 16) = raw6;
      *(uint4*)(slot + 6912 + (0 * 64 + lane) * 16) = raw7; *(uint4*)(slot + 6912 + (1 * 64 + lane) * 16) = raw8; *(uint4*)(slot + 6912 + (2 * 64 + lane) * 16) = raw9; *(uint4*)(slot + 6912 + (3 * 64 + lane) * 16) = raw10;
      const unsigned short* sraw = (const unsigned short*)slot + lane;
      const bool ok_lo = lo - 1 >= 0, ok_hi = lo + 16 < seqlen;
      float kC[16], kkr[16], sq[16];
      {
        float Rk[18];
#pragma unroll
        for (int u = 0; u < 18; ++u) Rk[u] = __uint_as_float((unsigned)sraw[(u * 3 + 1) * 64] << 16);
        if (!ok_lo) Rk[0] = 0.f;
        if (!ok_hi) Rk[17] = 0.f;
#pragma unroll
        for (int o = 0; o < 16; ++o) { kC[o] = cwk[0] * Rk[o] + cwk[1] * Rk[o + 1] + cwk[2] * Rk[o + 2]; kkr[o] = kC[o] * kkw; sq[o] = kkr[o] * kkr[o]; }
      }
      float tot = row_reduce_scatter16(sq, cl);
      tot += shfl_xor_l(tot, 16); tot += shfl_xor_l(tot, 32);
      const float invv = rsqrtf(tot + 1e-12f);
      float rC[16], vC[16], xwF[16], aF[16];
      {
        float Rr[18], Rv[18];
#pragma unroll
        for (int u = 0; u < 18; ++u) { Rr[u] = __uint_as_float((unsigned)sraw[(u * 3 + 0) * 64] << 16); Rv[u] = __uint_as_float((unsigned)sraw[(u * 3 + 2) * 64] << 16); }
        if (!ok_lo) { Rr[0] = 0.f; Rv[0] = 0.f; }
        if (!ok_hi) { Rr[17] = 0.f; Rv[17] = 0.f; }
#pragma unroll
        for (int o = 0; o < 16; ++o) { rC[o] = cwr[0] * Rr[o] + cwr[1] * Rr[o + 1] + cwr[2] * Rr[o + 2]; vC[o] = cwv[0] * Rv[o] + cwv[1] * Rv[o + 1] + cwv[2] * Rv[o + 2]; }
#pragma unroll
        for (int o = 0; o < 16; ++o) { xwF[o] = h2f(sraw[3456 + (o * 2 + 0) * 64]); aF[o] = h2f(sraw[3456 + (o * 2 + 1) * 64]); }
      }
      float G = 1.f;
      float kdq[4], bbq[4], vq[4];
      bf16_t* sKK = (bf16_t*)(slot + RC_KK); bf16_t* sRR = (bf16_t*)(slot + RC_RR); bf16_t* sKD = (bf16_t*)(slot + RC_KD); bf16_t* sBB = (bf16_t*)(slot + RC_BB);
#pragma unroll
      for (int s = 0; s < 16; ++s) {
        const int o = DIR ? (15 - s) : s;
        const float inv = __int_as_float(__builtin_amdgcn_readlane(__float_as_int(invv), o));
        const float okk = kkr[o] * inv, a = aF[o], ob = okk * a, okd = kC[o] * (1.f + (a - 1.f) * kaw), w = 1.f - xwF[o];
        const float kkt = okk * G;
        G *= w;
        const float ig = __builtin_amdgcn_rcpf(G);
        const float rt = rC[o] * G, kdt = okd * ig, bt = ob * ig;
        sKK[s * 72 + pj] = f2bf(kkt); sRR[s * 72 + pj] = f2bf(rt); sKD[s * 72 + pj] = f2bf(kdt); sBB[s * 72 + pj] = f2bf(bt);
        kdq[s & 3] = kdt; bbq[s & 3] = -bt; vq[s & 3] = vC[o];
        if ((s & 3) == 3) {
          const int fi = ((lane >> 4) * 4 + (s >> 2)) * 16 + (lane & 15);
          *(uint4*)(slot + RC_KDB + fi * 16) = make_uint4(pack2(kdq[0], kdq[1]), pack2(kdq[2], kdq[3]), pack2(bbq[0], bbq[1]), pack2(bbq[2], bbq[3]));
          *(uint2*)(slot + RC_V + fi * 8) = make_uint2(pack2(vq[0], vq[1]), pack2(vq[2], vq[3]));
        }
      }
      ((float*)(slot + RC_G))[lane] = G;
      const bf16x8 aK0 = *(const bf16x8*)(sKK + cl * 72 + 8 * cq), aK1 = *(const bf16x8*)(sKK + cl * 72 + 32 + 8 * cq);
      const bf16x8 aR0 = *(const bf16x8*)(sRR + cl * 72 + 8 * cq), aR1 = *(const bf16x8*)(sRR + cl * 72 + 32 + 8 * cq);
      const bf16x8 bD0 = *(const bf16x8*)(sKD + cl * 72 + 8 * cq), bD1 = *(const bf16x8*)(sKD + cl * 72 + 32 + 8 * cq);
      const bf16x8 bB0 = *(const bf16x8*)(sBB + cl * 72 + 8 * cq), bB1 = *(const bf16x8*)(sBB + cl * 72 + 32 + 8 * cq);
      f32x4 Abk = __builtin_amdgcn_mfma_f32_16x16x32_bf16(aK0, bB0, zero4, 0, 0, 0); Abk = __builtin_amdgcn_mfma_f32_16x16x32_bf16(aK1, bB1, Abk, 0, 0, 0);
      f32x4 Avk = __builtin_amdgcn_mfma_f32_16x16x32_bf16(aK0, bD0, zero4, 0, 0, 0); Avk = __builtin_amdgcn_mfma_f32_16x16x32_bf16(aK1, bD1, Avk, 0, 0, 0);
      f32x4 Mbr = __builtin_amdgcn_mfma_f32_16x16x32_bf16(aR0, bB0, zero4, 0, 0, 0); Mbr = __builtin_amdgcn_mfma_f32_16x16x32_bf16(aR1, bB1, Mbr, 0, 0, 0);
      f32x4 Mvr = __builtin_amdgcn_mfma_f32_16x16x32_bf16(aR0, bD0, zero4, 0, 0, 0); Mvr = __builtin_amdgcn_mfma_f32_16x16x32_bf16(aR1, bD1, Mvr, 0, 0, 0);
      float* tA = (float*)(slot + RC_KD); float* tVT = tA + 256;
      bf16_t* sMM = (bf16_t*)(slot + RC_MM);
#pragma unroll
      for (int r = 0; r < 4; ++r) {
        const int t = 4 * cq + r;
        const float abk = (cl < t) ? Abk[r] : 0.f, avk = (cl < t) ? Avk[r] : 0.f, mbr = (cl <= t) ? Mbr[r] : 0.f, mvr = (cl <= t) ? Mvr[r] : 0.f;
        tA[t * 16 + cl] = abk; Avk[r] = avk;
        sMM[((cl >> 2) * 16 + t) * 8 + (cl & 3)] = f2bf(mvr); sMM[((cl >> 2) * 16 + t) * 8 + 4 + (cl & 3)] = f2bf(-mbr);
      }
      *(float4*)(tVT + cl * 16 + 4 * cq) = make_float4(Avk[0], Avk[1], Avk[2], Avk[3]);
      {
        const bool isTA = ((lane >> 4) & 1) != 0;
        float X[16];
        {
          const float4* pv = (const float4*)(tVT + cl * 16);
          const float4 r0 = pv[0], r1 = pv[1], r2 = pv[2], r3 = pv[3];
          const float rh[16] = {r0.x, r0.y, r0.z, r0.w, r1.x, r1.y, r1.z, r1.w, r2.x, r2.y, r2.z, r2.w, r3.x, r3.y, r3.z, r3.w};
#pragma unroll
          for (int t = 0; t < 16; ++t) X[t] = isTA ? rh[t] : ((t == cl) ? 1.f : 0.f);
        }
#pragma unroll
        for (int t = 1; t < 16; ++t) {
          float a = X[t];
#pragma unroll
          for (int s4 = 0; s4 * 4 < t; ++s4) {
            const float4 ar = *(const float4*)(tA + t * 16 + 4 * s4);
            if (4 * s4 + 0 < t) a = fmaf(-ar.x, X[4 * s4 + 0], a);
            if (4 * s4 + 1 < t) a = fmaf(-ar.y, X[4 * s4 + 1], a);
            if (4 * s4 + 2 < t) a = fmaf(-ar.z, X[4 * s4 + 2], a);
            if (4 * s4 + 3 < t) a = fmaf(-ar.w, X[4 * s4 + 3], a);
          }
          X[t] = a;
        }
        bf16_t* sTT = (bf16_t*)(slot + RC_TT);
        if (lane < 32) {
#pragma unroll
          for (int t = 0; t < 16; ++t) sTT[((cl >> 2) * 16 + t) * 8 + (cl & 3) + (isTA ? 4 : 0)] = f2bf(X[t]);
        }
      }
    }
    __syncthreads();
    if (batch + 1 < 18) RC_LOAD_RAW((batch + 1) * 8 + wid);
    if (wid < 4) {
      const int itile = wid;
      bf16x8 nK0, nK1, nR0, nR1, nTT; uint2 nV;
#define RC_CONS_LOAD(sl_) do { nK0 = *(const bf16x8*)((sl_) + RC_KK + (cl * 72 + 8 * cq) * 2); nK1 = *(const bf16x8*)((sl_) + RC_KK + (cl * 72 + 32 + 8 * cq) * 2); \
        nR0 = *(const bf16x8*)((sl_) + RC_RR + (cl * 72 + 8 * cq) * 2); nR1 = *(const bf16x8*)((sl_) + RC_RR + (cl * 72 + 32 + 8 * cq) * 2); \
        nTT = *(const bf16x8*)((sl_) + RC_TT + lane * 16); nV = *(const uint2*)((sl_) + RC_V + (itile * 64 + lane) * 8); } while (0)
      RC_CONS_LOAD(smem);
#pragma unroll 1
      for (int k = 0; k < 8; ++k) {
        const unsigned char* sl = smem + k * RC_SLOT;
        const bf16x8 aK0 = nK0, aK1 = nK1, aR0 = nR0, aR1 = nR1, fTT = nTT; const uint2 fV = nV;
        const bf16x8 fMM = *(const bf16x8*)(sl + RC_MM + lane * 16);
        const bf16x8 Bs0 = rc_pack8(acc[0], acc[1]), Bs1 = rc_pack8(acc[2], acc[3]);
        f32x4 P = __builtin_amdgcn_mfma_f32_16x16x32_bf16(aK0, Bs0, zero4, 0, 0, 0); P = __builtin_amdgcn_mfma_f32_16x16x32_bf16(aK1, Bs1, P, 0, 0, 0);
        f32x4 Yv = __builtin_amdgcn_mfma_f32_16x16x32_bf16(aR0, Bs0, zero4, 0, 0, 0); Yv = __builtin_amdgcn_mfma_f32_16x16x32_bf16(aR1, Bs1, Yv, 0, 0, 0);
        if (k + 1 < 8) RC_CONS_LOAD(sl + RC_SLOT);
        const f32x4 SA = __builtin_amdgcn_mfma_f32_16x16x32_bf16(fTT, rc_pack8(P, fV), zero4, 0, 0, 0);
        const bf16x8 Bvs = rc_pack8(fV, SA);
        Yv = __builtin_amdgcn_mfma_f32_16x16x32_bf16(fMM, Bvs, Yv, 0, 0, 0);
#pragma unroll
        for (int jt = 0; jt < 4; ++jt) {
          const bf16x8 fKDB = *(const bf16x8*)(sl + RC_KDB + (jt * 64 + lane) * 16);
          const float4 g = *(const float4*)(sl + RC_G + (16 * jt + 4 * cq) * 4);
          acc[jt] = __builtin_amdgcn_mfma_f32_16x16x32_bf16(fKDB, Bvs, acc[jt], 0, 0, 0);
          acc[jt][0] *= g.x; acc[jt][1] *= g.y; acc[jt][2] *= g.z; acc[jt][3] *= g.w;
        }
        bool isctx; int seqlen, lo, rowbase; chunk_geom(batch * 8 + k, isctx, seqlen, lo, rowbase);
        if (!(l == 1 && isctx)) {
#pragma unroll
          for (int r = 0; r < 4; ++r) {
            const int t = 4 * cq + r, o = DIR ? (15 - t) : t;
            Y[(size_t)(rowbase + lo + o) * 256 + h * 64 + itile * 16 + cl] = Yv[r];
          }
        }
      }
    }
    __syncthreads();
  }
#undef RC_LDP
#undef RC_LDF
#undef RC_LOAD_RAW
#undef RC_CONS_LOAD
}

DEVI void s5_carry_item(const Params& p, int l, int g, int b) {
  unsigned char* ws = uws(p);
  const int tid = tid_();
  if (tid >= 128) return;
  const float* HE = (const float*)((unsigned char*)uout(p) + DO_HE) + (size_t)g * NCH * 256;
  bf16_t* UDH = (bf16_t*)(ws + WS_UDH) + (size_t)g * NCH * 768;
  const int dd = tid >> 6, pp = tid & 63;
  const float2 aT = ((const float2*)(ws + WS_APOW))[((size_t)(((l * 2 + dd) * 16 + g) * 64 + pp)) * 33 + 32];
  const int off = dd * 128 + pp;
  float hr = 0.f, hi = 0.f;
  {
    float er[8], ei[8];
#pragma unroll
    for (int c = 0; c < 8; ++c) { const int n = 1024 + b * 8 + (dd ? (7 - c) : c); er[c] = HE[(size_t)n * 256 + off]; ei[c] = HE[(size_t)n * 256 + off + 64]; }
#pragma unroll
    for (int c = 0; c < 8; ++c) {
      const int n = 1024 + b * 8 + (dd ? (7 - c) : c);
      UDH[(size_t)n * 768 + 512 + off] = f2bf(hr); UDH[(size_t)n * 768 + 512 + off + 64] = f2bf(hi);
      const float nr = aT.x * hr - aT.y * hi + er[c], ni = aT.x * hi + aT.y * hr + ei[c];
      hr = nr; hi = ni;
    }
  }
#pragma unroll 1
  for (int c0 = 0; c0 < 64; c0 += 16) {
    float er[16], ei[16];
#pragma unroll
    for (int c = 0; c < 16; ++c) { const int n = b * 64 + (dd ? (63 - c0 - c) : (c0 + c)); er[c] = HE[(size_t)n * 256 + off]; ei[c] = HE[(size_t)n * 256 + off + 64]; }
#pragma unroll
    for (int c = 0; c < 16; ++c) {
      const int n = b * 64 + (dd ? (63 - c0 - c) : (c0 + c));
      UDH[(size_t)n * 768 + 512 + off] = f2bf(hr); UDH[(size_t)n * 768 + 512 + off + 64] = f2bf(hi);
      const float nr = aT.x * hr - aT.y * hi + er[c], ni = aT.x * hi + aT.y * hr + ei[c];
      hr = nr; hi = ni;
    }
  }
}

struct S5Sched {
  const bf16_t* UDH; const bf16_t* TTG; int G, c, ntile;
  DEVI bool next(int i, g8::Unit& u) const {
    const int L = i * G + c; if (L >= 16 * ntile * 2) return false;
    u.e = L / (ntile * 2); const int r = L % (ntile * 2); u.pm = r >> 1; u.pn = r & 1; return true;
  }
  DEVI const char* a_base() const { return (const char*)UDH; }
  DEVI void a_offs(const g8::Unit& u, int tid, unsigned (&ao)[2][2]) const {
#pragma unroll
    for (int i = 0; i < 2; ++i) {
      int R, C; g8::stage_rc(tid * 16 + i * 8192, R, C);
#pragma unroll
      for (int h = 0; h < 2; ++h) ao[h][i] = ((unsigned)(u.e * NCH + u.pm * 256 + h * 128 + R) * 768u + (unsigned)C) * 2u;
    }
  }
  DEVI const char* b_ptr(const g8::Unit& u) const { return (const char*)(TTG + ((size_t)u.e * 512 + (size_t)u.pn * 256) * 768); }
};
struct EpiS5 {
  static constexpr bool PERM = true;
  bf16_t* ZB;
  DEVI void operator()(const f32x4 (&acc)[2][2][4][2], const g8::Unit& u) const {
    const int tid = tid_(), wid = __builtin_amdgcn_readfirstlane(tid >> 6), lane = tid & 63, wr = wid >> 2, wc = wid & 3, fr = lane & 15, fq = lane >> 4;
#pragma unroll
    for (int ai = 0; ai < 2; ++ai)
#pragma unroll
      for (int m = 0; m < 4; ++m) {
        const int n = u.pm * 256 + ai * 128 + wr * 64 + m * 16 + fr;
        if (n < NCH) {
#pragma unroll
          for (int bj = 0; bj < 2; ++bj) {
            const int mc = u.pn * 256 + bj * 128 + wc * 32 + 8 * fq, tau = mc >> 4, c = mc & 15;
            const f32x4 v0 = acc[ai][bj][m][0], v1 = acc[ai][bj][m][1];
            *(uint4*)(ZB + ((size_t)n * 32 + tau) * 256 + u.e * 16 + c) = make_uint4(pack2(gelu_tanh(v0[0]), gelu_tanh(v0[1])), pack2(gelu_tanh(v0[2]), gelu_tanh(v0[3])),
                                                                                   pack2(gelu_tanh(v1[0]), gelu_tanh(v1[1])), pack2(gelu_tanh(v1[2]), gelu_tanh(v1[3])));
          }
        }
        asm volatile("" ::: "memory");
      }
  }
};

DEVI void attn_item(const Params& p, int l, int b, int qb, int hq, unsigned char* smem) {
  unsigned char* ws = uws(p);
  const bf16_t* PROJ = (const bf16_t*)(ws + WS_PROJ);
  bf16_t* YMIX = (bf16_t*)(ws + WS_YMIX);
  bf16_t* sKV = (bf16_t*)smem;
  const int tid = tid_(), lane = tid & 63, wid = tid >> 6, r = lane & 31, hh = lane >> 5;
  const int kvh = hq >> 2;
  const bool ctxq = qb < 0;
  const int qrow0 = ctxq ? (NLAT + b * CTXL + wid * 32) : (b * SEQ + qb * 256 + wid * 32);
  const int q0pos = qb * 256 + wid * 32;
  bf16x8 qf[4];
  {
    const bf16_t* qp = PROJ + (size_t)(qrow0 + r) * DIN + 1280 + hq * 64 + hh * 8;
#pragma unroll
    for (int ks = 0; ks < 4; ++ks) qf[ks] = *(const bf16x8*)(qp + ks * 16);
  }
  f32x16 O0, O1;
#pragma unroll
  for (int i = 0; i < 16; ++i) { O0[i] = 0.f; O1[i] = 0.f; }
  float mrun = uin(p, I_SINK)[l * 8 + hq];
  float lsum = (hh == 0) ? 1.f : 0.f;
  const int jlo = ctxq ? 0 : (qb == 0 ? 2 : 0), jhi = ctxq ? 0 : (qb == 7 ? 6 : 8);
  const int nchunk = 4 + (jhi - jlo);
  const int nstage = (nchunk + 2) / 3;
  const int skey = tid >> 3, spc = (tid & 7) * 8;
  auto chunk_row0 = [&](int c) { return c < 4 ? (NLAT + b * CTXL + c * 64) : (b * SEQ + qb * 256 - 128 + (jlo + c - 4) * 64); };
  uint4 kr0, kr1, kr2, vr0, vr1, vr2;
  kr0 = kr1 = kr2 = vr0 = vr1 = vr2 = make_uint4(0, 0, 0, 0);
#define ATT_LOAD1(j, KR, VR, st_) do { const int c_ = (st_) * 3 + (j); if (c_ < nchunk) { \
    const bf16_t* kp_ = PROJ + (size_t)(chunk_row0(c_) + skey) * DIN + 1792 + kvh * 64 + spc; KR = *(const uint4*)kp_; VR = *(const uint4*)(kp_ + 128); } } while (0)
#define ATT_LOAD_STAGE(st_) do { ATT_LOAD1(0, kr0, vr0, st_); ATT_LOAD1(1, kr1, vr1, st_); ATT_LOAD1(2, kr2, vr2, st_); } while (0)
#define ATT_WRITE1(j, KR, VR) do { if (st * 3 + (j) < nchunk) { bf16_t* sKb_ = sB + (j) * (2 * 64 * 72); bf16_t* sVb_ = sKb_ + 64 * 72; \
    *(uint4*)(sKb_ + skey * 72 + spc) = KR; \
    sVb_[(spc + 0) * 72 + skey] = (bf16_t)(VR.x & 0xFFFF); sVb_[(spc + 1) * 72 + skey] = (bf16_t)(VR.x >> 16); \
    sVb_[(spc + 2) * 72 + skey] = (bf16_t)(VR.y & 0xFFFF); sVb_[(spc + 3) * 72 + skey] = (bf16_t)(VR.y >> 16); \
    sVb_[(spc + 4) * 72 + skey] = (bf16_t)(VR.z & 0xFFFF); sVb_[(spc + 5) * 72 + skey] = (bf16_t)(VR.z >> 16); \
    sVb_[(spc + 6) * 72 + skey] = (bf16_t)(VR.w & 0xFFFF); sVb_[(spc + 7) * 72 + skey] = (bf16_t)(VR.w >> 16); } } while (0)
  ATT_LOAD_STAGE(0);
  int buf = 0;
  for (int st = 0; st < nstage; ++st) {
    bf16_t* sB = sKV + buf * (6 * 64 * 72);
    ATT_WRITE1(0, kr0, vr0); ATT_WRITE1(1, kr1, vr1); ATT_WRITE1(2, kr2, vr2);
    __syncthreads();
    if (st + 1 < nstage) ATT_LOAD_STAGE(st + 1);
#pragma unroll 1
    for (int j = 0; j < 3; ++j) {
      const int c = st * 3 + j;
      if (c >= nchunk) break;
      const bf16_t* sKb = sB + j * (2 * 64 * 72); const bf16_t* sVb = sKb + 64 * 72;
      const bool band = c >= 4;
      const int kstart = band ? (qb * 256 - 128 + (jlo + c - 4) * 64) : 0;
#pragma unroll
      for (int tt = 0; tt < 2; ++tt) {
        const int ts = kstart + tt * 32;
        bool need = true, full = true;
        if (band) {
          need = (ts + 31 >= q0pos - 128) && (ts <= q0pos + 31 + 128);
          full = (ts >= q0pos + 31 - 128) && (ts + 31 <= q0pos + 128);
        }
        if (!need) continue;
        f32x16 S;
#pragma unroll
        for (int i = 0; i < 16; ++i) S[i] = 0.f;
#pragma unroll
        for (int ks = 0; ks < 4; ++ks) {
          const bf16x8 kf = *(const bf16x8*)(sKb + (tt * 32 + r) * 72 + ks * 16 + hh * 8);
          S = __builtin_amdgcn_mfma_f32_32x32x16_bf16(kf, qf[ks], S, 0, 0, 0);
        }
        if (!full) {
#pragma unroll
          for (int i = 0; i < 16; ++i) {
            const int kpos = ts + (i & 3) + 8 * (i >> 2) + 4 * hh;
            const int dl = (q0pos + r) - kpos;
            if (dl > 128 || dl < -128) S[i] = -1e30f;
          }
        }
        float mx = S[0];
#pragma unroll
        for (int i = 1; i < 16; ++i) mx = fmaxf(mx, S[i]);
        mx = fmaxf(mx, shfl_xor_l(mx, 32));
        const float mnew = fmaxf(mrun, mx);
        const float alpha = __expf(mrun - mnew);
        mrun = mnew;
        float ps = 0.f;
#pragma unroll
        for (int i = 0; i < 16; ++i) { S[i] = __expf(S[i] - mnew); ps += S[i]; }
        lsum = lsum * alpha + ps;
#pragma unroll
        for (int i = 0; i < 16; ++i) { O0[i] *= alpha; O1[i] *= alpha; }
        bf16x8 pf[2];
#pragma unroll
        for (int s2 = 0; s2 < 2; ++s2) {
          const uint4 u = make_uint4(pack2(S[8 * s2], S[8 * s2 + 1]), pack2(S[8 * s2 + 2], S[8 * s2 + 3]), pack2(S[8 * s2 + 4], S[8 * s2 + 5]), pack2(S[8 * s2 + 6], S[8 * s2 + 7]));
          pf[s2] = __builtin_bit_cast(bf16x8, u);
        }
#pragma unroll
        for (int s2 = 0; s2 < 2; ++s2) {
          {
            const bf16_t* vp = sVb + (0 * 32 + r) * 72 + tt * 32 + 16 * s2 + 4 * hh;
            const uint2 lo = *(const uint2*)vp, hi = *(const uint2*)(vp + 8);
            const uint4 u = make_uint4(lo.x, lo.y, hi.x, hi.y);
            O0 = __builtin_amdgcn_mfma_f32_32x32x16_bf16(__builtin_bit_cast(bf16x8, u), pf[s2], O0, 0, 0, 0);
          }
          {
            const bf16_t* vp = sVb + (1 * 32 + r) * 72 + tt * 32 + 16 * s2 + 4 * hh;
            const uint2 lo = *(const uint2*)vp, hi = *(const uint2*)(vp + 8);
            const uint4 u = make_uint4(lo.x, lo.y, hi.x, hi.y);
            O1 = __builtin_amdgcn_mfma_f32_32x32x16_bf16(__builtin_bit_cast(bf16x8, u), pf[s2], O1, 0, 0, 0);
          }
        }
      }
    }
    buf ^= 1;
  }
  const float lt = lsum + shfl_xor_l(lsum, 32);
  const float inv = 1.f / lt;
  bf16_t* op = YMIX + (size_t)(qrow0 + r) * D + 512 + hq * 64 + 4 * hh;
#pragma unroll
  for (int g4 = 0; g4 < 4; ++g4) {
    uint2 o; o.x = pack2(O0[4 * g4] * inv, O0[4 * g4 + 1] * inv); o.y = pack2(O0[4 * g4 + 2] * inv, O0[4 * g4 + 3] * inv);
    *(uint2*)(op + 8 * g4) = o;
    uint2 o1; o1.x = pack2(O1[4 * g4] * inv, O1[4 * g4 + 1] * inv); o1.y = pack2(O1[4 * g4 + 2] * inv, O1[4 * g4 + 3] * inv);
    *(uint2*)(op + 32 + 8 * g4) = o1;
  }
  __syncthreads();
}

DEVI void phase_mixers(const Params& p, int l, unsigned char* smem) {
  const int bid = bid_(), G = gridDim.x;
  const int nsb = (G >> 4) * 8 + ((G & 15) < 8 ? (G & 15) : 8);
  if (((bid >> 3) & 1) == 0) {
    for (int it = (bid >> 4) * 8 + (bid & 7); it < 128; it += nsb) { if (it & 1) rwkv_chunked<1>(p, l, it, smem); else rwkv_chunked<0>(p, l, it, smem); }
  }
  const int n_attn = (l == 0) ? 1152 : 1024, nq = 256 + n_attn;
  int* ctr = (int*)(uws(p) + WS_CTL) + 64 + l;
  volatile int* sTick = (volatile int*)(smem + SMEM_BYTES - 16);
  const int tid = tid_();
  __syncthreads();
  if (tid == 0) sTick[0] = atomicAdd(ctr, 1);
  __syncthreads();
  int cur = sTick[0];
  while (cur < nq) {
    int nxt = 0;
    if (tid == 0) nxt = atomicAdd(ctr, 1);
    if (cur >= n_attn) { const int c = cur - n_attn; s5_carry_item(p, l, c >> 4, c & 15); }
    else if (cur < 768) { const int bb = cur / 48, r = cur % 48; attn_item(p, l, bb, 1 + (r >> 3), r & 7, smem); }
    else if (cur < 1024) { const int a = cur - 768, bb = a >> 4, r = a & 15; attn_item(p, l, bb, (r >> 3) ? 7 : 0, r & 7, smem); }
    else attn_item(p, l, (cur - 1024) >> 3, -1, (cur - 1024) & 7, smem);
    __syncthreads();
    if (tid == 0) sTick[0] = nxt;
    __syncthreads();
    cur = sTick[0];
  }
}

DEVI void phase_mixfin(const Params& p, int l, unsigned char* smem) {
  unsigned char* ws = uws(p);
  const int tid = tid_(), bid = bid_(), G = gridDim.x;
  bf16_t* YMIX = (bf16_t*)(ws + WS_YMIX);
  {
    S5Sched S{(const bf16_t*)(ws + WS_UDH), (const bf16_t*)(ws + WS_TTG) + (size_t)l * 16 * 512 * 768, G, bid, (l == 1) ? 4 : 5};
    EpiS5 E{(bf16_t*)((unsigned char*)uout(p) + DO_ZB)};
    __syncthreads();
    g8::gemm((G8_LAS unsigned char*)smem, 768, S, E);
    __syncthreads();
  }
  {
    const bf16_t* PROJ = (const bf16_t*)(ws + WS_PROJ);
    const unsigned short* FEAT = (const unsigned short*)(ws + WS_FEAT);
    const float* YF = (const float*)((unsigned char*)uout(p) + DO_YF); const float* YB = (const float*)((unsigned char*)uout(p) + DO_YB);
    const float* CW = uin(p, I_CONV) + l * 3 * 1024;
    const int c4 = (tid & 15) * 4;
    const int nbusy = (16 * ((l == 1) ? 4 : 5) * 2 < G) ? 16 * ((l == 1) ? 4 : 5) * 2 : G;
    const int nvirt = nbusy + 2 * (G - nbusy);
    const int ustride = (nvirt * NTHREADS) >> 4;
    const int nun = ((l == 1) ? NLAT : NT) * 4;
    const int vb0 = (bid < nbusy) ? bid : nbusy + 2 * (bid - nbusy);
    const int u0 = (vb0 * NTHREADS + tid) >> 4;
    const int h = u0 & 3, hc = h * 64 + c4;
    float cwr[3][4], cwk[3][4], cwv[3][4], kaw[4], rkw[4], gnw[4], gnb[4];
#pragma unroll
    for (int dl = 0; dl < 3; ++dl)
#pragma unroll
      for (int e = 0; e < 4; ++e) { cwr[dl][e] = CW[dl * 1024 + hc + e]; cwk[dl][e] = CW[dl * 1024 + 256 + hc + e]; cwv[dl][e] = CW[dl * 1024 + 512 + hc + e]; }
#pragma unroll
    for (int e = 0; e < 4; ++e) { kaw[e] = uin(p, I_KA)[l * 256 + hc + e]; rkw[e] = uin(p, I_RK)[l * 256 + hc + e]; gnw[e] = uin(p, I_GNW)[l * 256 + hc + e]; gnb[e] = uin(p, I_GNB)[l * 256 + hc + e]; }
    for (int pass = 0; pass < ((bid < nbusy) ? 1 : 2); ++pass)
    for (int u = u0 + pass * 32; u < nun; u += ustride) {
      const int R = u >> 2;
      const int t = R < NLAT ? (R & 2047) : ((R - NLAT) & 255); const int len = R < NLAT ? SEQ : CTXL;
      const float4 yf = *(const float4*)(YF + (size_t)R * 256 + hc), yb = *(const float4*)(YB + (size_t)R * 256 + hc);
      float y[4] = {yf.x + yb.x, yf.y + yb.y, yf.z + yb.z, yf.w + yb.w};
      const float mu = row_sum16(y[0] + y[1] + y[2] + y[3]) * (1.f / 64.f);
      float q = 0.f;
#pragma unroll
      for (int e = 0; e < 4; ++e) { y[e] -= mu; q += y[e] * y[e]; }
      const float rstd = rsqrtf(row_sum16(q) * (1.f / 64.f) + GN_EPS);
      const bf16_t* pr = PROJ + (size_t)R * DIN + hc;
      const uint2 zc = make_uint2(0, 0);
      const uint2 rc = *(const uint2*)pr, kc = *(const uint2*)(pr + 256), vc = *(const uint2*)(pr + 512);
      uint2 rp = zc, kp = zc, vp = zc, rn = zc, kn = zc, vn = zc;
      if (t > 0) { rp = *(const uint2*)(pr - DIN); kp = *(const uint2*)(pr - DIN + 256); vp = *(const uint2*)(pr - DIN + 512); }
      if (t < len - 1) { rn = *(const uint2*)(pr + DIN); kn = *(const uint2*)(pr + DIN + 256); vn = *(const uint2*)(pr + DIN + 512); }
      const float rpf[4] = {lo_bf(rp.x), hi_bf(rp.x), lo_bf(rp.y), hi_bf(rp.y)}, rcf[4] = {lo_bf(rc.x), hi_bf(rc.x), lo_bf(rc.y), hi_bf(rc.y)}, rnf[4] = {lo_bf(rn.x), hi_bf(rn.x), lo_bf(rn.y), hi_bf(rn.y)};
      const float kpf[4] = {lo_bf(kp.x), hi_bf(kp.x), lo_bf(kp.y), hi_bf(kp.y)}, kcf[4] = {lo_bf(kc.x), hi_bf(kc.x), lo_bf(kc.y), hi_bf(kc.y)}, knf[4] = {lo_bf(kn.x), hi_bf(kn.x), lo_bf(kn.y), hi_bf(kn.y)};
      const float vpf[4] = {lo_bf(vp.x), hi_bf(vp.x), lo_bf(vp.y), hi_bf(vp.y)}, vcf[4] = {lo_bf(vc.x), hi_bf(vc.x), lo_bf(vc.y), hi_bf(vc.y)}, vnf[4] = {lo_bf(vn.x), hi_bf(vn.x), lo_bf(vn.y), hi_bf(vn.y)};
      const unsigned short* fr_ = FEAT + (size_t)R * 1280 + hc;
      const uint2 a0u = *(const uint2*)(fr_ + 512), a1u = *(const uint2*)(fr_ + 768), gtu = *(const uint2*)(fr_ + 1024);
      const float a0[4] = {h2f(a0u.x & 0xFFFF), h2f(a0u.x >> 16), h2f(a0u.y & 0xFFFF), h2f(a0u.y >> 16)};
      const float a1[4] = {h2f(a1u.x & 0xFFFF), h2f(a1u.x >> 16), h2f(a1u.y & 0xFFFF), h2f(a1u.y >> 16)};
      const float gt[4] = {h2f(gtu.x & 0xFFFF), h2f(gtu.x >> 16), h2f(gtu.y & 0xFFFF), h2f(gtu.y >> 16)};
      float bs = 0.f, vv[4];
#pragma unroll
      for (int e = 0; e < 4; ++e) {
        const float r = cwr[0][e] * rpf[e] + cwr[1][e] * rcf[e] + cwr[2][e] * rnf[e];
        const float k = cwk[0][e] * kpf[e] + cwk[1][e] * kcf[e] + cwk[2][e] * knf[e];
        vv[e] = cwv[0][e] * vpf[e] + cwv[1][e] * vcf[e] + cwv[2][e] * vnf[e];
        const float ksum = k * (2.f + (a0[e] + a1[e] - 2.f) * kaw[e]);
        bs += r * ksum * rkw[e];
      }
      bs = row_sum16(bs);
      float o[4];
#pragma unroll
      for (int e = 0; e < 4; ++e) {
        const float yn = y[e] * rstd * gnw[e] + gnb[e];
        o[e] = (yn + bs * vv[e]) * gt[e];
      }
      uint2 w; w.x = pack2(o[0], o[1]); w.y = pack2(o[2], o[3]);
      *(uint2*)(YMIX + (size_t)R * D + hc) = w;
    }
  }
}

struct EpiGlu {
  static constexpr bool PERM = true;
  const bf16_t* ZB; bf16_t* YMIX; const float* gb;
  DEVI void operator()(const f32x4 (&acc)[2][2][4][2], const g8::Unit& u) const {
    const int tid = tid_(), wid = __builtin_amdgcn_readfirstlane(tid >> 6), lane = tid & 63, wr = wid >> 2, wc = wid & 3, fr = lane & 15, fq = lane >> 4;
#pragma unroll
    for (int ai = 0; ai < 2; ++ai)
#pragma unroll
      for (int m = 0; m < 4; ++m) {
        const int row = u.pm * 256 + ai * 128 + wr * 64 + m * 16 + fr;
#pragma unroll
        for (int bj = 0; bj < 2; ++bj) {
          const int col = bj * 128 + wc * 32 + 8 * fq;
          const uint4 zz = *(const uint4*)(ZB + (size_t)row * 256 + col);
          const float4 b0 = *(const float4*)(gb + col), b1 = *(const float4*)(gb + col + 4);
          const f32x4 v0 = acc[ai][bj][m][0], v1 = acc[ai][bj][m][1];
          *(uint4*)(YMIX + (size_t)row * D + 256 + col) = make_uint4(
            pack2(lo_bf(zz.x) * sigmoidf(v0[0] + b0.x), hi_bf(zz.x) * sigmoidf(v0[1] + b0.y)), pack2(lo_bf(zz.y) * sigmoidf(v0[2] + b0.z), hi_bf(zz.y) * sigmoidf(v0[3] + b0.w)),
            pack2(lo_bf(zz.z) * sigmoidf(v1[0] + b1.x), hi_bf(zz.z) * sigmoidf(v1[1] + b1.y)), pack2(lo_bf(zz.w) * sigmoidf(v1[2] + b1.z), hi_bf(zz.w) * sigmoidf(v1[3] + b1.w)));
        }
        asm volatile("" ::: "memory");
      }
  }
};
DEVI void phase_glu(const Params& p, int l, unsigned char* smem) {
  unsigned char* ws = uws(p);
  g8::DenseSched S{(const bf16_t*)((unsigned char*)uout(p) + DO_ZB), (const bf16_t*)(ws + WS_GLU_T) + (size_t)l * 65536, 256, (l == 1) ? 128 : 144, 1, (int)gridDim.x, bid_()};
  EpiGlu E{(const bf16_t*)((unsigned char*)uout(p) + DO_ZB), (bf16_t*)(ws + WS_YMIX), uin(p, I_GLUB) + l * 256};
  __syncthreads();
  g8::gemm((G8_LAS unsigned char*)smem, 256, S, E);
  __syncthreads();
}

struct EpiBf16 {
  static constexpr bool PERM = true;
  bf16_t* O; int ldc;
  DEVI void operator()(const f32x4 (&acc)[2][2][4][2], const g8::Unit& u) const {
    const int tid = tid_(), wid = __builtin_amdgcn_readfirstlane(tid >> 6), lane = tid & 63, wr = wid >> 2, wc = wid & 3, fr = lane & 15, fq = lane >> 4;
#pragma unroll
    for (int ai = 0; ai < 2; ++ai)
#pragma unroll
      for (int m = 0; m < 4; ++m) {
        bf16_t* rowp = O + (size_t)(u.pm * 256 + ai * 128 + wr * 64 + m * 16 + fr) * ldc + u.pn * 256 + wc * 32 + 8 * fq;
#pragma unroll
        for (int bj = 0; bj < 2; ++bj) {
          const f32x4 v0 = acc[ai][bj][m][0], v1 = acc[ai][bj][m][1];
          *(uint4*)(rowp + bj * 128) = make_uint4(pack2(v0[0], v0[1]), pack2(v0[2], v0[3]), pack2(v1[0], v1[1]), pack2(v1[2], v1[3]));
        }
      }
  }
};
DEVI void phase_outproj(const Params& p, int l, unsigned char* smem) {
  unsigned char* ws = uws(p);
  g8::DenseSched S{(const bf16_t*)(ws + WS_YMIX), (const bf16_t*)(ws + WS_WOUT_T) + (size_t)l * D * D, D, (l == 1) ? 128 : 144, 4, (int)gridDim.x, bid_()};
  EpiBf16 E{(bf16_t*)(ws + WS_MIX), D};
  __syncthreads();
  g8::gemm((G8_LAS unsigned char*)smem, D, S, E);
  __syncthreads();
}

DEVI void phase_ln1(const Params& p, int l, unsigned char* smem) {
  unsigned char* ws = uws(p);
  const int tid = tid_(), lane = tid & 63, wid = tid >> 6;
  const bf16_t* MIX = (const bf16_t*)(ws + WS_MIX);
  _Float16* X = (_Float16*)(ws + WS_X);
  bf16_t* H = (bf16_t*)(ws + WS_H);
  const float* MOD = (const float*)(ws + WS_MOD);
  const int nrows1 = (l == 1) ? NLAT : NT;
  const int nw = gridDim.x * 8, gw = bid_() * 8 + wid;
  const int rpw = (nrows1 + nw - 1) / nw;
  const int R0 = gw * rpw, R1 = (R0 + rpw < nrows1) ? (R0 + rpw) : nrows1;
  const int c0 = lane * 8, c1 = 512 + lane * 8;
  float g[2][8], bb[2][8], gt[2][8], sh[2][8], sc[2][8];
  ld8f(uin(p, I_LN1G) + l * D + c0, g[0]); ld8f(uin(p, I_LN1G) + l * D + c1, g[1]);
  ld8f(uin(p, I_LN1B) + l * D + c0, bb[0]); ld8f(uin(p, I_LN1B) + l * D + c1, bb[1]);
  int curb = -1;
  float xv[2][8], mx[2][8];
  auto load_row = [&](int Rr, float (&xo)[2][8], float (&mo)[2][8]) {
    if (l == 0) { const float* xr = xin_row(p, Rr); ld8f(xr + c0, xo[0]); ld8f(xr + c1, xo[1]); }
    else { const _Float16* xr = X + (size_t)Rr * D; ld8h(xr + c0, xo[0]); ld8h(xr + c1, xo[1]); }
    ld8b(MIX + (size_t)Rr * D + c0, mo[0]); ld8b(MIX + (size_t)Rr * D + c1, mo[1]);
  };
  if (R0 < R1) load_row(R0, xv, mx);
  for (int R = R0; R < R1; ++R) {
    float xn[2][8], mn[2][8];
#pragma unroll
    for (int h = 0; h < 2; ++h)
#pragma unroll
      for (int e = 0; e < 8; ++e) { xn[h][e] = 0.f; mn[h][e] = 0.f; }
    if (R + 1 < R1) load_row(R + 1, xn, mn);
    const int bi = bidx_of(R);
    if (bi != curb) {
      curb = bi;
      const float* modl = MOD + (size_t)(l * 17 + bi) * 6144;
      ld8f(modl + 2048 + c0, gt[0]); ld8f(modl + 2048 + c1, gt[1]);
      ld8f(modl + 3072 + c0, sh[0]); ld8f(modl + 3072 + c1, sh[1]);
      ld8f(modl + 4096 + c0, sc[0]); ld8f(modl + 4096 + c1, sc[1]);
    }
    float v[2][8]; float s = 0.f;
#pragma unroll
    for (int h = 0; h < 2; ++h)
#pragma unroll
      for (int e = 0; e < 8; ++e) { v[h][e] = ALPHA * xv[h][e] + gt[h][e] * mx[h][e]; s += v[h][e]; }
    const float mu = wave_sum(s) * (1.f / 1024.f);
    float q = 0.f;
#pragma unroll
    for (int h = 0; h < 2; ++h)
#pragma unroll
      for (int e = 0; e < 8; ++e) { v[h][e] -= mu; q += v[h][e] * v[h][e]; }
    const float rstd = rsqrtf(wave_sum(q) * (1.f / 1024.f) + LN_EPS);
#pragma unroll
    for (int h = 0; h < 2; ++h) {
      float x1[8], hm[8];
#pragma unroll
      for (int e = 0; e < 8; ++e) { x1[e] = v[h][e] * rstd * g[h][e] + bb[h][e]; hm[e] = x1[e] * (1.f + sc[h][e]) + sh[h][e]; }
      st8h(X + (size_t)R * D + (h ? c1 : c0), x1);
      st8b(H + (size_t)R * D + (h ? c1 : c0), hm);
    }
#pragma unroll
    for (int h = 0; h < 2; ++h)
#pragma unroll
      for (int e = 0; e < 8; ++e) { xv[h][e] = xn[h][e]; mx[h][e] = mn[h][e]; }
  }
}

DEVI void phase_router(const Params& p, int l, unsigned char* smem) {
  unsigned char* ws = uws(p);
  const int tid = tid_(), lrow = tid >> 2;
  const bf16_t* H = (const bf16_t*)(ws + WS_H);
  const bf16_t* RWH = (const bf16_t*)(ws + WS_RW) + (size_t)l * 2 * 128 * 1024;
  int* CNT = (int*)(ws + WS_CTL) + l * 32;
  int* LIST = (int*)(ws + WS_LIST);
  int4* ROUTE = (int4*)(ws + WS_ROUTE);
  float2* RWT = (float2*)(ws + WS_RWT);
  bf16_t* EW1 = (bf16_t*)(ws + WS_EW); bf16_t* EW2 = EW1 + (size_t)32 * 1024 * 1024;
  constexpr int N_CONV = 32 * 96;
  const int nmt = (l == 1) ? 128 : 144;
  for (int it0 = bid_(); it0 < nmt; it0 += gridDim.x) {
    {
      const int mt = it0;
      const bf16_t* a0 = H + (size_t)(mt * 256 + lrow) * D; const bf16_t* a1 = a0 + (size_t)128 * D;
      const bf16_t* b0 = RWH + (size_t)lrow * 1024;
      gemm_tile(smem, 0, D,
        [&](int i, int k) { return *(const uint4*)((i ? a1 : a0) + k); },
        [&](int k) { return *(const uint4*)(b0 + k); },
        [&](f32x4 (&acc)[4][4], int wr, int wc, int fr, int fq) {
          float* sLog = (float*)smem;
          if (wc == 0) {
#pragma unroll
            for (int m = 0; m < 4; ++m)
#pragma unroll
              for (int n = 0; n < 3; ++n)
#pragma unroll
                for (int j = 0; j < 4; ++j) { const int col = n * 16 + fq * 4 + j; if (col < 36) sLog[(wr * 64 + m * 16 + fr) * 37 + col] = acc[m][n][j]; }
          }
        });
      int* sHist = (int*)(smem + 40960); int* sBase = sHist + 32;
      if (tid < 32) sHist[tid] = 0;
      __syncthreads();
      int e1 = 0, e2 = 0, lp1 = 0, lp2 = 0; float w1 = 0.f, w2 = 0.f;
      if (tid < 256) {
        const float* lg = (const float*)smem + tid * 37;
        float gl[4]; int gi = 0; float gmax;
#pragma unroll
        for (int i = 0; i < 4; ++i) gl[i] = lg[i] + uin(p, I_RGB)[l * 4 + i];
        gmax = gl[0];
#pragma unroll
        for (int i = 1; i < 4; ++i) if (gl[i] > gmax) { gmax = gl[i]; gi = i; }
        float gs = 0.f;
#pragma unroll
        for (int i = 0; i < 4; ++i) gs += expf(gl[i] - gmax);
        const float gprob = 1.f / gs;
        float el[8];
#pragma unroll
        for (int j = 0; j < 8; ++j) el[j] = lg[4 + gi * 8 + j] + uin(p, I_REB)[l * 32 + gi * 8 + j];
        int i1 = 0; float l1 = el[0];
#pragma unroll
        for (int j = 1; j < 8; ++j) if (el[j] > l1) { l1 = el[j]; i1 = j; }
        int i2 = (i1 == 0) ? 1 : 0; float l2 = -3.0e38f;
#pragma unroll
        for (int j = 0; j < 8; ++j) if (j != i1 && el[j] > l2) { l2 = el[j]; i2 = j; }
        const float ex = expf(l2 - l1);
        w1 = gprob / (1.f + ex); w2 = gprob * ex / (1.f + ex);
        e1 = gi * 8 + i1; e2 = gi * 8 + i2;
        lp1 = atomicAdd(&sHist[e1], 1); lp2 = atomicAdd(&sHist[e2], 1);
      }
      __syncthreads();
      if (tid < 32) sBase[tid] = atomicAdd(&CNT[tid], sHist[tid]);
      __syncthreads();
      if (tid < 256) {
        const int R = mt * 256 + tid;
        const int p1 = sBase[e1] + lp1, p2 = sBase[e2] + lp2;
        LIST[(size_t)e1 * NT + p1] = R; LIST[(size_t)e2 * NT + p2] = R;
        ROUTE[R] = make_int4(e1, p1, e2, p2);
        RWT[R] = make_float2(w1, w2);
      }
      __syncthreads();
    }
  }
  {
    auto conv_src = [&](int j, const float*& src, int& ld, int& k0, int& n0) {
      const int e = j / 96, r = j % 96;
      if (r < 64) { const int kt = r >> 2, ct = r & 3, up = ct >> 1; src = (up ? uin(p, I_EWU) : uin(p, I_EWG)) + (size_t)(l * 32 + e) * 1024 * 512; ld = 512; k0 = kt * 64; n0 = (ct & 1) * 256; }
      else { const int r2 = r - 64, kt = r2 >> 2, ntl = r2 & 3; src = uin(p, I_EWD) + (size_t)(l * 32 + e) * 512 * 1024; ld = 1024; k0 = kt * 64; n0 = ntl * 256; }
    };
    const int G = gridDim.x;
    int j = bid_();
    TrRegs cur, nxt;
    const float* src; int ld, k0, n0;
    if (j < N_CONV) { conv_src(j, src, ld, k0, n0); transpose_load(cur, src, ld, k0, n0); }
    while (j < N_CONV) {
      int jn;
      if (j < 8 * G) { jn = j + G; if (jn >= 8 * G) jn = (bid_() >= nmt) ? (8 * G + bid_() - nmt) : N_CONV; }
      else jn = j + (G - nmt);
      if (jn < N_CONV) { const float* s2; int ld2, k2, n2; conv_src(jn, s2, ld2, k2, n2); transpose_load(nxt, s2, ld2, k2, n2); }
      const int e = j / 96, r = j % 96;
      if (r < 64) {
        const int kt = r >> 2, ct = r & 3, up = ct >> 1;
        transpose_finish(smem, cur, kt * 64, (ct & 1) * 256, EW1 + (size_t)e * 1024 * 1024, 1024,
          [&](int c) { return 256 * (c >> 7) + 128 * ((c >> 6) & 1) + 32 * ((c >> 4) & 3) + 16 * up + (c & 15); });
      } else {
        const int r2 = r - 64, kt = r2 >> 2, ntl = r2 & 3;
        transpose_finish(smem, cur, kt * 64, ntl * 256, EW2 + (size_t)e * 1024 * 512, 512, [](int n) { return n; });
      }
      cur = nxt; j = jn;
    }
  }
}

DEVI void moe_prefix(const Params& p, int l, int* sPre, int* sCnt) {
  const int* CNT = (const int*)(uws(p) + WS_CTL) + l * 32;
  if (tid_() == 0) {
    int s = 0;
    for (int e = 0; e < 32; ++e) { const int c = CNT[e]; sCnt[e] = c; sPre[e] = s; s += (c + 255) >> 8; }
    sPre[32] = s;
  }
  __syncthreads();
  {
    unsigned char* sBlkE = (unsigned char*)sPre + (MISC_BLKE - MISC_PRE);
    const int nb = sPre[32];
    for (int rb = tid_(); rb < nb; rb += NTHREADS) { int e = 0; for (int q = 1; q < 32; ++q) if (sPre[q] <= rb) e = q; sBlkE[rb] = (unsigned char)e; }
  }
  __syncthreads();
}

struct MoeSched {
  const int* sPre; const int* sCnt; const unsigned char* sBlkE; const bf16_t* Abase; const int* LIST; const bf16_t* Wbase; int K; size_t wstride; int nN, G, c, gather;
  DEVI bool next(int i, g8::Unit& u) const {
    const int nwg = sPre[32] * nN; const long L = (long)i * G + c; if (L >= nwg) return false;
    const int w = g8::xcd_remap((int)L, nwg);
    u.pm = w / nN; u.pn = w % nN;
    u.e = sBlkE[u.pm]; return true;
  }
  DEVI const char* a_base() const { return (const char*)Abase; }
  DEVI void a_offs(const g8::Unit& u, int tid, unsigned (&ao)[2][2]) const {
#pragma unroll
    for (int i = 0; i < 2; ++i) {
      int R, C; g8::stage_rc(tid * 16 + i * 8192, R, C);
#pragma unroll
      for (int h = 0; h < 2; ++h) {
        int row = u.pm * 256 + h * 128 + R;
        if (gather) {
          const int sl = (u.pm - sPre[u.e]) * 256 + h * 128 + R;
          row = LIST[(size_t)u.e * NT + (sl < sCnt[u.e] ? sl : 0)];
        }
        ao[h][i] = ((unsigned)row * (unsigned)K + (unsigned)C) * 2u;
      }
    }
  }
  DEVI const char* b_ptr(const g8::Unit& u) const { return (const char*)(Wbase + (size_t)u.e * wstride + (size_t)u.pn * 256 * K); }
};
struct EpiMoe1 {
  static constexpr bool PERM = false;
  bf16_t* ACT;
  DEVI void operator()(const f32x4 (&acc)[2][2][4][2], const g8::Unit& u) const {
    const int tid = tid_(), wid = __builtin_amdgcn_readfirstlane(tid >> 6), lane = tid & 63, wr = wid >> 2, wc = wid & 3, fr = lane & 15, fq = lane >> 4;
#pragma unroll
    for (int ai = 0; ai < 2; ++ai)
#pragma unroll
      for (int m = 0; m < 4; ++m) {
        const size_t slot = (size_t)u.pm * 256 + ai * 128 + wr * 64 + m * 16 + fr;
#pragma unroll
        for (int bj = 0; bj < 2; ++bj) {
          const f32x4 g = acc[ai][bj][m][0], up = acc[ai][bj][m][1];
          float o[4];
#pragma unroll
          for (int j = 0; j < 4; ++j) o[j] = g[j] * __builtin_amdgcn_rcpf(1.f + __expf(-g[j])) * up[j];
          uint2 w; w.x = pack2(o[0], o[1]); w.y = pack2(o[2], o[3]);
          *(uint2*)(ACT + slot * 512 + u.pn * 128 + bj * 64 + wc * 16 + 4 * fq) = w;
        }
      }
  }
};
DEVI void phase_moe1(const Params& p, int l, unsigned char* smem) {
  unsigned char* ws = uws(p);
  int* sPre = (int*)(smem + SMEM_BYTES + MISC_PRE); int* sCnt = (int*)(smem + SMEM_BYTES + MISC_CNT);
  moe_prefix(p, l, sPre, sCnt);
  MoeSched S{sPre, sCnt, (const unsigned char*)(smem + SMEM_BYTES + MISC_BLKE), (const bf16_t*)(ws + WS_H), (const int*)(ws + WS_LIST), (const bf16_t*)(ws + WS_EW), D, (size_t)1024 * 1024, 4, (int)gridDim.x, bid_(), 1};
  EpiMoe1 E{(bf16_t*)(ws + WS_ACT)};
  g8::gemm((G8_LAS unsigned char*)smem, D, S, E);
  __syncthreads();
}
DEVI void phase_moe2(const Params& p, int l, unsigned char* smem) {
  unsigned char* ws = uws(p);
  int* sPre = (int*)(smem + SMEM_BYTES + MISC_PRE); int* sCnt = (int*)(smem + SMEM_BYTES + MISC_CNT);
  moe_prefix(p, l, sPre, sCnt);
  MoeSched S{sPre, sCnt, (const unsigned char*)(smem + SMEM_BYTES + MISC_BLKE), (const bf16_t*)(ws + WS_ACT), (const int*)(ws + WS_LIST), (const bf16_t*)(ws + WS_EW) + (size_t)32 * 1024 * 1024, 512, (size_t)1024 * 512, 4, (int)gridDim.x, bid_(), 0};
  EpiBf16 E{(bf16_t*)(ws + WS_YROWS), D};
  g8::gemm((G8_LAS unsigned char*)smem, 512, S, E);
  __syncthreads();
}

DEVI void phase_ln2(const Params& p, int l, unsigned char* smem) {
  unsigned char* ws = uws(p);
  int* sPre = (int*)(smem + SMEM_BYTES + MISC_PRE); int* sCnt = (int*)(smem + SMEM_BYTES + MISC_CNT);
  moe_prefix(p, l, sPre, sCnt);
  const int tid = tid_(), lane = tid & 63, wid = tid >> 6;
  _Float16* X = (_Float16*)(ws + WS_X);
  const bf16_t* YR = (const bf16_t*)(ws + WS_YROWS);
  const int4* ROUTE = (const int4*)(ws + WS_ROUTE);
  const float2* RWT = (const float2*)(ws + WS_RWT);
  const float* MOD = (const float*)(ws + WS_MOD);
  const float* g2 = uin(p, I_LN2G) + l * D; const float* b2 = uin(p, I_LN2B) + l * D;
  bf16_t* XM = (bf16_t*)((unsigned char*)uout(p) + DO_XMOD);
  const int nrows = (l == 0) ? NT : NLAT;
  const int nw = gridDim.x * 8, gw = bid_() * 8 + wid;
  const int rpw = (nrows + nw - 1) / nw;
  const int R0 = gw * rpw, R1 = (R0 + rpw < nrows) ? (R0 + rpw) : nrows;
  const int c0 = lane * 8, c1 = 512 + lane * 8;
  float g[2][8], bb[2][8], gt[2][8], sh1n[2][8], sc1n[2][8];
  ld8f(g2 + c0, g[0]); ld8f(g2 + c1, g[1]); ld8f(b2 + c0, bb[0]); ld8f(b2 + c1, bb[1]);
  int curb = -1;
  float xv[2][8], ua[2][8], ub[2][8]; float2 rw = make_float2(0.f, 0.f);
  int4 rt_n = make_int4(0, 0, 0, 0); float2 rw_n = make_float2(0.f, 0.f);
  auto load_data = [&](int Rr, const int4& rt, float (&xo)[2][8], float (&ao)[2][8], float (&bo)[2][8]) {
    const bf16_t* ya = YR + ((size_t)sPre[rt.x] * 256 + rt.y) * 1024; const bf16_t* yb = YR + ((size_t)sPre[rt.z] * 256 + rt.w) * 1024;
    const _Float16* xr = X + (size_t)Rr * D;
    ld8h(xr + c0, xo[0]); ld8h(xr + c1, xo[1]); ld8b(ya + c0, ao[0]); ld8b(ya + c1, ao[1]); ld8b(yb + c0, bo[0]); ld8b(yb + c1, bo[1]);
  };
  if (R0 < R1) { const int4 rt0 = ROUTE[R0]; rw = RWT[R0]; load_data(R0, rt0, xv, ua, ub); }
  if (R0 + 1 < R1) { rt_n = ROUTE[R0 + 1]; rw_n = RWT[R0 + 1]; }
  for (int R = R0; R < R1; ++R) {
    float xn[2][8], an[2][8], bn[2][8];
#pragma unroll
    for (int h = 0; h < 2; ++h)
#pragma unroll
      for (int e = 0; e < 8; ++e) { xn[h][e] = 0.f; an[h][e] = 0.f; bn[h][e] = 0.f; }
    if (R + 1 < R1) load_data(R + 1, rt_n, xn, an, bn);
    const float2 rw_next = rw_n;
    if (R + 2 < R1) { rt_n = ROUTE[R + 2]; rw_n = RWT[R + 2]; }
    const int bi = bidx_of(R);
    if (bi != curb) {
      curb = bi;
      const float* modl = MOD + (size_t)(l * 17 + bi) * 6144;
      ld8f(modl + 5120 + c0, gt[0]); ld8f(modl + 5120 + c1, gt[1]);
      if (l == 0) {
        const float* modn = MOD + (size_t)(1 * 17 + bi) * 6144;
        ld8f(modn + c0, sh1n[0]); ld8f(modn + c1, sh1n[1]); ld8f(modn + 1024 + c0, sc1n[0]); ld8f(modn + 1024 + c1, sc1n[1]);
      }
    }
    float v[2][8]; float s = 0.f;
#pragma unroll
    for (int h = 0; h < 2; ++h)
#pragma unroll
      for (int e = 0; e < 8; ++e) { v[h][e] = ALPHA * xv[h][e] + gt[h][e] * (rw.x * ua[h][e] + rw.y * ub[h][e]); s += v[h][e]; }
    const float mu = wave_sum(s) * (1.f / 1024.f);
    float q = 0.f;
#pragma unroll
    for (int h = 0; h < 2; ++h)
#pragma unroll
      for (int e = 0; e < 8; ++e) { v[h][e] -= mu; q += v[h][e] * v[h][e]; }
    const float rstd = rsqrtf(wave_sum(q) * (1.f / 1024.f) + LN_EPS);
#pragma unroll
    for (int h = 0; h < 2; ++h) {
      float x2[8];
#pragma unroll
      for (int e = 0; e < 8; ++e) x2[e] = v[h][e] * rstd * g[h][e] + bb[h][e];
      const int cc = h ? c1 : c0;
      if (l == 0) {
        st8h(X + (size_t)R * D + cc, x2);
        float xm[8];
#pragma unroll
        for (int e = 0; e < 8; ++e) xm[e] = x2[e] * (1.f + sc1n[h][e]) + sh1n[h][e];
        st8b(XM + (size_t)R * D + cc, xm);
      } else {
        st8f(uout(p) + (size_t)R * D + cc, x2);
      }
    }
#pragma unroll
    for (int h = 0; h < 2; ++h)
#pragma unroll
      for (int e = 0; e < 8; ++e) { xv[h][e] = xn[h][e]; ua[h][e] = an[h][e]; ub[h][e] = bn[h][e]; }
    rw = rw_next;
  }
}

#define XB_TMO      128
#define XB_XCNT(j)  (256  + 64 * (j))
#define XB_XSUB(j)  (1280 + 64 * (j))
#define XB_XGEN(j)  (2304 + 64 * (j))
#define XB_TOP      3328
#define XB_TOPGEN   3392
#define XCD_BAR_WORDS 3456
#define XB_SPIN_CAP (1u << 20)
DEVI unsigned xb_ld(unsigned* p) { return __hip_atomic_load(p, __ATOMIC_RELAXED, __HIP_MEMORY_SCOPE_AGENT); }
DEVI unsigned xb_add(unsigned* p, unsigned v) { return __hip_atomic_fetch_add(p, v, __ATOMIC_RELAXED, __HIP_MEMORY_SCOPE_AGENT); }
DEVI unsigned xb_xcc_id() { return (unsigned)__builtin_amdgcn_s_getreg((3 << 11) | 20) & 0xFu; }
#define XB_SPIN(cond, bar) do { unsigned _sp = 0; while (cond) { __builtin_amdgcn_s_sleep(1); \
    if ((++_sp & 255u) == 0u) { if (xb_ld(&(bar)[XB_TMO])) break; if (_sp > XB_SPIN_CAP) { atomicAdd(&(bar)[XB_TMO], 1u); break; } } } } while (0)
DEVI void xcd_barrier_complete(unsigned* bar, unsigned x, unsigned& nloc, unsigned& nx) {
  const unsigned G = gridDim.x;
  unsigned sum, cnt, mine, sp = 0u;
  for (;;) {
    sum = 0u; cnt = 0u; mine = 0u;
#pragma unroll
    for (unsigned j = 0; j < 16; ++j) { const unsigned c = xb_ld(&bar[XB_XCNT(j)]); sum += c; cnt += (c > 0u) ? 1u : 0u; mine = (j == x) ? c : mine; }
    if (sum == G) break;
    __builtin_amdgcn_s_sleep(1);
    if ((++sp & 255u) == 0u) { if (xb_ld(&bar[XB_TMO])) break; if (sp > XB_SPIN_CAP) { atomicAdd(&bar[XB_TMO], 1u); break; } }
  }
  nloc = mine > 0u ? mine : 1u; nx = cnt > 0u ? cnt : 1u;
}
DEVI void xcd_barrier(unsigned* bar, volatile unsigned* st) {
  asm volatile("s_waitcnt vmcnt(0)" ::: "memory");
  __syncthreads();
  if (threadIdx.x == 0) {
    __builtin_amdgcn_s_waitcnt(0);
    const unsigned x = xb_xcc_id();
    unsigned nloc = st[0], nx = st[1];
    if (nloc == 0u) { xcd_barrier_complete(bar, x, nloc, nx); st[0] = nloc; st[1] = nx; }
    const unsigned old = xb_add(&bar[XB_XSUB(x)], 1u);
    const unsigned gen = old / nloc;
    if (old + 1u == (gen + 1u) * nloc) {
      __builtin_amdgcn_fence(__ATOMIC_RELEASE, "agent");
      asm volatile("s_waitcnt vmcnt(0)" ::: "memory");
      const unsigned og = xb_add(&bar[XB_TOP], 1u);
      const unsigned tg = og / nx;
      if (og + 1u == (tg + 1u) * nx) xb_add(&bar[XB_TOPGEN], 1u);
      else XB_SPIN(xb_ld(&bar[XB_TOPGEN]) == tg, bar);
      __builtin_amdgcn_fence(__ATOMIC_ACQUIRE, "agent");
      xb_add(&bar[XB_XGEN(x)], 1u);
      asm volatile("s_waitcnt vmcnt(0)" ::: "memory");
    } else {
      XB_SPIN(xb_ld(&bar[XB_XGEN(x)]) == gen, bar);
      __builtin_amdgcn_fence(__ATOMIC_ACQUIRE, "agent");
      asm volatile("s_waitcnt vmcnt(0)" ::: "memory");
    }
  }
  __syncthreads();
}

constexpr int N_PHASES = 24;
DEVI void run_phase(const Params& p, int ph, unsigned char* smem) {
  if (ph == 0) { phase0a(p, smem); return; }
  if (ph == 1) { phase0b(p, smem); return; }
  const int l = (ph - 2) / 11, s = (ph - 2) % 11;
  switch (s) {
    case 0: phase_inproj(p, l, smem); break;
    case 1: phase_feat(p, l, smem); break;
    case 2: phase_mixers(p, l, smem); break;
    case 3: phase_mixfin(p, l, smem); break;
    case 4: phase_glu(p, l, smem); break;
    case 5: phase_outproj(p, l, smem); break;
    case 6: phase_ln1(p, l, smem); break;
    case 7: phase_router(p, l, smem); break;
    case 8: phase_moe1(p, l, smem); break;
    case 9: phase_moe2(p, l, smem); break;
    default: phase_ln2(p, l, smem); break;
  }
}

__global__ void __launch_bounds__(NTHREADS, 2) fwd_megakernel(Params pk) {
  extern __shared__ __attribute__((aligned(16))) unsigned char smem[];
  Params* spp = (Params*)(smem + SMEM_BYTES + MISC_PARAMS);
  if (threadIdx.x == 0) { *spp = pk; ((volatile unsigned*)(smem + SMEM_BYTES + MISC_XB))[0] = 0u; ((volatile unsigned*)(smem + SMEM_BYTES + MISC_XB))[1] = 0u; }
  __syncthreads();
  const Params& p = *spp;
  const int ph_lo = __builtin_amdgcn_readfirstlane(p.ph_lo), ph_hi = __builtin_amdgcn_readfirstlane(p.ph_hi);
#if MK_MULTI
  for (int ph = ph_lo; ph < ph_hi; ++ph) run_phase(p, ph, smem);
#else
  cg::grid_group grid = cg::this_grid();
  if (threadIdx.x == 0) (void)xb_add(&((unsigned*)(uws(p) + WS_BAR))[XB_XCNT(xb_xcc_id())], 1u);
  for (int ph = ph_lo; ph < ph_hi; ++ph) {
    run_phase(p, ph, smem);
#ifdef DUP_MASK
    if ((DUP_MASK >> ph) & 1) { __syncthreads(); run_phase(p, ph, smem); }
#endif
    if (ph + 1 < ph_hi) {
      if (ph == ph_lo) grid.sync();
      else xcd_barrier((unsigned*)(uws(p) + WS_BAR), (volatile unsigned*)(smem + SMEM_BYTES + MISC_XB));
    }
  }
#endif
}

extern "C" void kernel_launch(void* const* d_in, const int* in_sizes, int n_in, void* d_out, int out_size,
                              void* d_ws, size_t ws_size, hipStream_t stream) {
  static int grid_blocks = 0;
  if (!grid_blocks) {
    int dev = 0, cus = 0, per_cu = 0;
    (void)hipGetDevice(&dev);
    (void)hipDeviceGetAttribute(&cus, hipDeviceAttributeMultiprocessorCount, dev);
    (void)hipFuncSetAttribute((const void*)fwd_megakernel, hipFuncAttributeMaxDynamicSharedMemorySize, DSM_BYTES);
    (void)hipOccupancyMaxActiveBlocksPerMultiprocessor(&per_cu, fwd_megakernel, NTHREADS, DSM_BYTES);
    if (per_cu > 1) per_cu = 1;
    grid_blocks = cus * per_cu;
    if (n_in != N_IN || out_size != NLAT * D || ws_size < WS_END) {
      fprintf(stderr, "kernel_launch: unexpected sizes n_in=%d out=%d ws=%zu (need %zu)\n", n_in, out_size, ws_size, (size_t)WS_END);
      grid_blocks = -1;
    }
    fprintf(stderr, "kernel_launch: grid=%d (cus=%d per_cu=%d) ws=%zu\n", grid_blocks, cus, per_cu, ws_size);
  }
  if (grid_blocks <= 0) return;
  Params p{};
  for (int i = 0; i < N_IN; ++i) p.in[i] = (const float*)d_in[i];
  p.out = (float*)d_out; p.ws = (unsigned char*)d_ws;
#if MK_MULTI
  for (int ph = 0; ph < N_PHASES; ++ph) {
    p.ph_lo = ph; p.ph_hi = ph + 1;
    hipLaunchKernelGGL(fwd_megakernel, dim3(grid_blocks), dim3(NTHREADS), DSM_BYTES, stream, p);
  }
#else
  p.ph_lo = 0; p.ph_hi = N_PHASES;
  (void)hipMemsetAsync((unsigned char*)d_ws + WS_BAR, 0, XCD_BAR_WORDS * 4, stream);
  void* args[] = {&p};
  hipError_t e = hipLaunchCooperativeKernel((void*)fwd_megakernel, dim3(grid_blocks), dim3(NTHREADS), args, DSM_BYTES, stream);
  if (e != hipSuccess) fprintf(stderr, "cooperative launch failed: %s (grid %d)\n", hipGetErrorString(e), grid_blocks);
#endif
}
```

```cpp
#include <hip/hip_runtime.h>
#include <hip/hip_cooperative_groups.h>
#include <cstdio>
#include <cstdint>
namespace cg = cooperative_groups;

#ifndef MK_MULTI
#define MK_MULTI 0
#endif

#define DEVI __device__ __forceinline__
typedef unsigned short bf16_t;
typedef short bf16x8 __attribute__((ext_vector_type(8)));
typedef float f32x4 __attribute__((ext_vector_type(4)));
typedef float f32x16 __attribute__((ext_vector_type(16)));

constexpr int D = 1024, NB = 16, SEQ = 2048, CTXL = 256;
constexpr int NLAT = NB * SEQ;
constexpr int NCTX = NB * CTXL;
constexpr int NT = NLAT + NCTX;
constexpr int DIN = 2048;
constexpr int NTHREADS = 512;
constexpr float ALPHA = 1.41421356237309515f;
constexpr float LN_EPS = 1e-5f, GN_EPS = 64e-5f;
constexpr int NCH = NT / 32;
constexpr int SLOT_CAP = 81920;

enum { I_X = 0, I_C, I_CTX, I_CCTX, I_WMOD, I_BMOD, I_WIN, I_CONV, I_W0, I_W2, I_A0, I_A2, I_G2, I_KK, I_KA, I_RK, I_GNW, I_GNB,
       I_LRE, I_LIM, I_LDT, I_BRE, I_BIM, I_CRE, I_CIM, I_SD, I_GLUW, I_GLUB, I_SINK, I_WOUT, I_LN1G, I_LN1B, I_LN2G, I_LN2B,
       I_RGW, I_RGB, I_REW, I_REB, I_EWG, I_EWU, I_EWD, N_IN };

constexpr size_t MiB = 1048576;
constexpr size_t WS_CTL = 0;
constexpr size_t WS_BAR = 512 * 1024;
constexpr size_t WS_MOD = 1 * MiB;
constexpr size_t WS_ROPE = 2 * MiB;
constexpr size_t WS_WIN_T = 4 * MiB;
constexpr size_t WS_WOUT_T = 12 * MiB;
constexpr size_t WS_FW = 16 * MiB;
constexpr size_t WS_GLU_T = 18 * MiB;
constexpr size_t WS_RW = 19 * MiB;
constexpr size_t WS_KTAB = 20 * MiB;
constexpr size_t WS_TTG = 22 * MiB;
constexpr size_t WS_EM = 46 * MiB;
constexpr size_t WS_HC = 54 * MiB;
constexpr size_t WS_LIST = 63 * MiB;
constexpr size_t WS_ROUTE = 68 * MiB;
constexpr size_t WS_RWT = 69 * MiB;
constexpr size_t WS_APOW = 70 * MiB;
constexpr size_t WS_BBT = 71 * MiB + 512 * 1024;
constexpr size_t WS_X = 72 * MiB;
constexpr size_t WS_R = 216 * MiB;
constexpr size_t WS_PROJ = WS_R;
constexpr size_t WS_FEAT = WS_R + 144 * MiB;
constexpr size_t WS_YMIX = WS_R + 234 * MiB;
constexpr size_t WS_MIX = WS_R + 144 * MiB;
constexpr size_t WS_EW = WS_R;
constexpr size_t WS_H = WS_R + 234 * MiB;
constexpr size_t WS_ACT = WS_R + 96 * MiB;
constexpr size_t WS_YROWS = WS_R + 176 * MiB;
constexpr size_t WS_UDH = WS_R + 336 * MiB;
constexpr size_t WS_END = WS_UDH + 28 * MiB;
constexpr size_t DO_XMOD = 0;
constexpr size_t DO_YF = 0;
constexpr size_t DO_YB = 36 * MiB;
constexpr size_t DO_HE = 72 * MiB;
constexpr size_t DO_ZB = 90 * MiB;

struct Params {
  const float* in[N_IN];
  float* out;
  unsigned char* ws;
  int ph_lo, ph_hi;
};


DEVI unsigned long long rfl64(unsigned long long v) { const unsigned lo = __builtin_amdgcn_readfirstlane((unsigned)v), hi = __builtin_amdgcn_readfirstlane((unsigned)(v >> 32)); return ((unsigned long long)hi << 32) | lo; }
DEVI unsigned char* uws(const Params& p) { return (unsigned char*)rfl64((unsigned long long)p.ws); }
DEVI float* uout(const Params& p) { return (float*)rfl64((unsigned long long)p.out); }
DEVI const float* uin(const Params& p, int i) { return (const float*)rfl64((unsigned long long)p.in[i]); }

DEVI float bf2f(bf16_t v) { return __uint_as_float(((unsigned)v) << 16); }
typedef __bf16 hwbf2 __attribute__((ext_vector_type(2)));
typedef float hwf2 __attribute__((ext_vector_type(2)));
DEVI bf16_t f2bf(float f) { return __builtin_bit_cast(unsigned short, (__bf16)f); }
DEVI unsigned pack2(float a, float b) { const hwf2 v = {a, b}; return __builtin_bit_cast(unsigned, __builtin_convertvector(v, hwbf2)); }
DEVI float lo_bf(unsigned u) { return __uint_as_float(u << 16); }
DEVI float hi_bf(unsigned u) { return __uint_as_float(u & 0xFFFF0000u); }
DEVI unsigned short f2h(float f) { _Float16 h = (_Float16)f; return __builtin_bit_cast(unsigned short, h); }
DEVI float h2f(unsigned short u) { return (float)__builtin_bit_cast(_Float16, u); }
DEVI float sigmoidf(float x) { return __builtin_amdgcn_rcpf(1.f + __expf(-x)); }
DEVI float gelu_tanh(float x) { const float u = 0.7978845608028654f * (x + 0.044715f * x * x * x); return x - x * __builtin_amdgcn_rcpf(1.f + __expf(2.f * u)); }

template <int CTRL> DEVI float dpp_f(float x) { return __int_as_float(__builtin_amdgcn_update_dpp(0, __float_as_int(x), CTRL, 0xF, 0xF, false)); }
DEVI float row_sum16(float x) {
  x += dpp_f<0xB1>(x);
  x += dpp_f<0x4E>(x);
  x += dpp_f<0x141>(x);
  x += dpp_f<0x140>(x);
  return x;
}
DEVI float shfl_xor_l(float x, int m) {
  int lane = (int)__builtin_amdgcn_mbcnt_hi(~0u, __builtin_amdgcn_mbcnt_lo(~0u, 0u));
  asm volatile("" : "+v"(lane));
  return __int_as_float(__builtin_amdgcn_ds_bpermute((lane ^ m) << 2, __float_as_int(x)));
}
DEVI float wave_sum(float x) { x = row_sum16(x); x += shfl_xor_l(x, 16); x += shfl_xor_l(x, 32); return x; }

DEVI int tid_() { int t = threadIdx.x; asm volatile("" : "+v"(t)); return t; }
DEVI int bid_() { int b = blockIdx.x; asm volatile("" : "+s"(b)); return b; }
DEVI void ld8f(const float* p, float (&o)[8]) { const float4 a = *(const float4*)p, b = *(const float4*)(p + 4); o[0] = a.x; o[1] = a.y; o[2] = a.z; o[3] = a.w; o[4] = b.x; o[5] = b.y; o[6] = b.z; o[7] = b.w; }
DEVI void ld8b(const bf16_t* p, float (&o)[8]) { const uint4 u = *(const uint4*)p; o[0] = lo_bf(u.x); o[1] = hi_bf(u.x); o[2] = lo_bf(u.y); o[3] = hi_bf(u.y); o[4] = lo_bf(u.z); o[5] = hi_bf(u.z); o[6] = lo_bf(u.w); o[7] = hi_bf(u.w); }
DEVI void st8f(float* p, const float (&v)[8]) { *(float4*)p = make_float4(v[0], v[1], v[2], v[3]); *(float4*)(p + 4) = make_float4(v[4], v[5], v[6], v[7]); }
DEVI void st8b(bf16_t* p, const float (&v)[8]) { *(uint4*)p = make_uint4(pack2(v[0], v[1]), pack2(v[2], v[3]), pack2(v[4], v[5]), pack2(v[6], v[7])); }
typedef _Float16 hx8 __attribute__((ext_vector_type(8)));
DEVI void ld8h(const _Float16* p, float (&o)[8]) { const hx8 u = *(const hx8*)p;
#pragma unroll
  for (int e = 0; e < 8; ++e) o[e] = (float)u[e]; }
DEVI void st8h(_Float16* p, const float (&v)[8]) { hx8 u;
#pragma unroll
  for (int e = 0; e < 8; ++e) u[e] = (_Float16)v[e];
  *(hx8*)p = u; }

DEVI int bidx_of(int R) { return R < NLAT ? (R >> 11) : 16; }
DEVI const float* xin_row(const Params& p, int R) { return R < NLAT ? uin(p, I_X) + (size_t)R * D : uin(p, I_CTX) + (size_t)(R - NLAT) * D; }

constexpr int LDT = 40;
constexpr int SMEM_BYTES = 143360;
constexpr int DSM_BYTES = SMEM_BYTES + 1024;
constexpr int MISC_PARAMS = 0, MISC_PRE = 384, MISC_CNT = 528, MISC_BLKE = 656, MISC_XB = 1008;
template <class AL, class BL, class EP>
DEVI void gemm_tile(unsigned char* smem, int kbeg, int kend, AL&& aload, BL&& bload, EP&& epi) {
  const int tid = tid_(), lane = tid & 63, wid = tid >> 6;
  const int wr = wid >> 1, wc = wid & 1, fr = lane & 15, fq = lane >> 4;
  bf16_t* sA = (bf16_t*)smem;
  bf16_t* sB = (bf16_t*)(smem + 2 * 256 * LDT * 2);
  const int lrow = tid >> 2, kq = (tid & 3) * 8;
  f32x4 acc[4][4];
#pragma unroll
  for (int m = 0; m < 4; ++m)
#pragma unroll
    for (int n = 0; n < 4; ++n) acc[m][n] = (f32x4){0.f, 0.f, 0.f, 0.f};
  uint4 ra0 = aload(0, kbeg + kq), ra1 = aload(1, kbeg + kq), rb = bload(kbeg + kq);
  int buf = 0;
#pragma unroll 1
  for (int k = kbeg; k < kend; k += 32) {
    *(uint4*)(sA + (buf * 256 + lrow) * LDT + kq) = ra0;
    *(uint4*)(sA + (buf * 256 + lrow + 128) * LDT + kq) = ra1;
    *(uint4*)(sB + (buf * 128 + lrow) * LDT + kq) = rb;
    __syncthreads();
    if (k + 32 < kend) { ra0 = aload(0, k + 32 + kq); ra1 = aload(1, k + 32 + kq); rb = bload(k + 32 + kq); }
    bf16x8 bfr[4];
#pragma unroll
    for (int n = 0; n < 4; ++n) bfr[n] = *(const bf16x8*)(sB + (buf * 128 + wc * 64 + n * 16 + fr) * LDT + fq * 8);
#pragma unroll
    for (int m = 0; m < 4; ++m) {
      const bf16x8 af = *(const bf16x8*)(sA + (buf * 256 + wr * 64 + m * 16 + fr) * LDT + fq * 8);
#pragma unroll
      for (int n = 0; n < 4; ++n) acc[m][n] = __builtin_amdgcn_mfma_f32_16x16x32_bf16(bfr[n], af, acc[m][n], 0, 0, 0);
    }
    buf ^= 1;
  }
  __syncthreads();
  epi(acc, wr, wc, fr, fq);
}


namespace g8 {
#define G8_LAS __attribute__((address_space(3)))
constexpr int BM = 256, BK = 64, HALF = 128, HTB = HALF * BK * 2;
DEVI int lds_byte(int r, int c) { const int st = (r >> 4) * 2 + (c >> 5), rr = r & 15, cc = c & 31, ob = rr * 64 + cc * 2; return st * 1024 + (ob ^ (((ob >> 9) & 1) << 5)); }
DEVI void stage_rc(int b, int& R, int& C) { const int st = b / 1024, sb = b % 1024, swz = sb ^ (((sb >> 9) & 1) << 5); R = (st >> 1) * 16 + swz / 64; C = (st & 1) * 32 + (swz % 64) / 2; }
DEVI int perm32(int rho) { const int n = rho >> 4, i = rho & 15; return 8 * (i >> 2) + 4 * n + (i & 3); }
struct Unit { int pm, pn, e; };
DEVI int xcd_remap(int L, int n) { const int q = n >> 3, r = n & 7, x = L & 7, off = L >> 3; return (x < r ? x * (q + 1) : r * (q + 1) + (x - r) * q) + off; }

template <class Epi, class Sched>
DEVI void gemm(G8_LAS unsigned char* lds, const int Kin, const Sched& S, const Epi& E) {
  int K = Kin; asm volatile("" : "+s"(K));
  const int tid = tid_(), wid = __builtin_amdgcn_readfirstlane(tid >> 6), lane = tid & 63, wr = wid >> 2, wc = wid & 3, fr = lane & 15, fq = lane >> 4;
  const int nt = K / BK;
  unsigned voffB[2];
#pragma unroll
  for (int i = 0; i < 2; ++i) { int R, C; stage_rc(tid * 16 + i * 8192, R, C); const int Rb = Epi::PERM ? ((R & ~31) + perm32(R & 31)) : R; voffB[i] = (unsigned)(Rb * K + C) * 2u; }
  const size_t kstep = (size_t)(BK * 2);
  const size_t hstepB = (size_t)HALF * K * 2;
  const unsigned ldsw = (unsigned)wid * 1024u;
  const int aoff = lds_byte(wr * 64 + fr, fq * 8), boff = lds_byte(wc * 32 + fr, fq * 8);
#define G8_SA(b, h) (((b) * 2 + (h)) * HTB)
#define G8_SB(b, h) ((4 + (b) * 2 + (h)) * HTB)
#define G8_STAGE_B(bufoff, gbase) do { _Pragma("unroll") for (int _i = 0; _i < 2; ++_i) \
    __builtin_amdgcn_global_load_lds((const unsigned*)((const char*)(gbase) + voffB[_i]), (G8_LAS unsigned*)(lds + (bufoff) + ldsw + _i * 8192), 16, 0, 0); } while (0)
#define G8_STAGE_A(bufoff, ubase, o0, o1) do { \
    __builtin_amdgcn_global_load_lds((const unsigned*)((ubase) + (o0)), (G8_LAS unsigned*)(lds + (bufoff) + ldsw), 16, 0, 0); \
    __builtin_amdgcn_global_load_lds((const unsigned*)((ubase) + (o1)), (G8_LAS unsigned*)(lds + (bufoff) + ldsw + 8192), 16, 0, 0); } while (0)
#define G8_LDA(dst, b, h) do { _Pragma("unroll") for (int m = 0; m < 4; ++m) _Pragma("unroll") for (int k = 0; k < 2; ++k) dst[m][k] = *(const G8_LAS bf16x8*)(lds + G8_SA(b, h) + aoff + m * 2048 + k * 1024); } while (0)
#define G8_LDB(dst, b, h) do { _Pragma("unroll") for (int n = 0; n < 2; ++n) _Pragma("unroll") for (int k = 0; k < 2; ++k) dst[n][k] = *(const G8_LAS bf16x8*)(lds + G8_SB(b, h) + boff + n * 2048 + k * 1024); } while (0)
#define G8_MMA(ai, bj, At, Bt) do { __builtin_amdgcn_s_setprio(1); _Pragma("unroll") for (int m = 0; m < 4; ++m) _Pragma("unroll") for (int n = 0; n < 2; ++n) _Pragma("unroll") for (int k = 0; k < 2; ++k) \
    acc[ai][bj][m][n] = __builtin_amdgcn_mfma_f32_16x16x32_bf16(Bt[n][k], At[m][k], acc[ai][bj][m][n], 0, 0, 0); __builtin_amdgcn_s_setprio(0); } while (0)
#define G8_WAIT_V(n) asm volatile("s_waitcnt vmcnt(" #n ")" ::: "memory")
#define G8_WAIT_L(n) asm volatile("s_waitcnt lgkmcnt(" #n ")" ::: "memory")
#define G8_BAR __builtin_amdgcn_s_barrier()
#define G8_SCHED __builtin_amdgcn_sched_barrier(0)
  Unit cur, nxt; int ui = 0;
  if (!S.next(0, cur)) return;
  f32x4 acc[2][2][4][2];
#pragma unroll
  for (int a = 0; a < 2; ++a)
#pragma unroll
    for (int b = 0; b < 2; ++b)
#pragma unroll
      for (int m = 0; m < 4; ++m)
#pragma unroll
        for (int n = 0; n < 2; ++n) acc[a][b][m][n] = (f32x4){0.f, 0.f, 0.f, 0.f};
  bf16x8 At[4][2], B0[2][2], B1[2][2];
  unsigned cA[2][2], nA[2][2];
  const char* const Ab = S.a_base();
  S.a_offs(cur, tid, cA);
  const char* cB = S.b_ptr(cur);
  G8_STAGE_B(G8_SB(0, 0), cB); G8_STAGE_A(G8_SA(0, 0), Ab, cA[0][0], cA[0][1]); G8_STAGE_B(G8_SB(0, 1), cB + hstepB); G8_STAGE_A(G8_SA(0, 1), Ab, cA[1][0], cA[1][1]);
  if (wr == 1) G8_BAR;
  G8_WAIT_V(4); G8_BAR;
  G8_STAGE_B(G8_SB(1, 0), cB + kstep); G8_STAGE_A(G8_SA(1, 0), Ab + kstep, cA[0][0], cA[0][1]); G8_STAGE_B(G8_SB(1, 1), cB + hstepB + kstep);
  G8_WAIT_V(6); G8_BAR;
  for (;;) {
    const bool has_next = S.next(ui + 1, nxt);
    const char* nB = cB;
    if (has_next) { S.a_offs(nxt, tid_(), nA); nB = S.b_ptr(nxt); }
    else { nA[0][0] = cA[0][0]; nA[0][1] = cA[0][1]; nA[1][0] = cA[1][0]; nA[1][1] = cA[1][1]; }
    for (int t = 0; t < nt; t += 2) {
      const bool last = (t == nt - 2);
      const size_t k1 = (size_t)(t + 1) * kstep, k2 = (size_t)(t + 2) * kstep;
      const char* b2 = last ? nB : cB + k2; const char* b3 = b2 + kstep;
      const char* Ab2 = last ? Ab : Ab + k2;
      unsigned a2[2][2];
#pragma unroll
      for (int h = 0; h < 2; ++h)
#pragma unroll
        for (int i = 0; i < 2; ++i) a2[h][i] = last ? nA[h][i] : cA[h][i];
      G8_LDB(B0, 0, 0); G8_SCHED; G8_LDA(At, 0, 0); G8_STAGE_A(G8_SA(1, 1), Ab + k1, cA[1][0], cA[1][1]);
      G8_WAIT_L(8); G8_BAR; G8_WAIT_L(0); G8_MMA(0, 0, At, B0); G8_BAR; G8_SCHED;
      G8_LDB(B1, 0, 1); G8_STAGE_B(G8_SB(0, 0), b2);
      G8_BAR; G8_WAIT_L(0); G8_MMA(0, 1, At, B1); G8_BAR;
      G8_LDA(At, 0, 1); G8_STAGE_A(G8_SA(0, 0), Ab2, a2[0][0], a2[0][1]);
      G8_BAR; G8_WAIT_L(0); G8_MMA(1, 0, At, B0); G8_BAR; G8_SCHED;
      G8_STAGE_B(G8_SB(0, 1), b2 + hstepB);
      G8_WAIT_V(6); G8_BAR; G8_MMA(1, 1, At, B1); G8_BAR;
      G8_LDB(B0, 1, 0); G8_SCHED; G8_LDA(At, 1, 0); G8_STAGE_A(G8_SA(0, 1), Ab2, a2[1][0], a2[1][1]);
      G8_WAIT_L(8); G8_BAR; G8_WAIT_L(0); G8_MMA(0, 0, At, B0); G8_BAR; G8_SCHED;
      G8_LDB(B1, 1, 1); G8_STAGE_B(G8_SB(1, 0), b3);
      G8_BAR; G8_WAIT_L(0); G8_MMA(0, 1, At, B1); G8_BAR;
      G8_LDA(At, 1, 1); G8_STAGE_A(G8_SA(1, 0), Ab2 + kstep, a2[0][0], a2[0][1]);
      G8_BAR; G8_WAIT_L(0); G8_MMA(1, 0, At, B0); G8_BAR; G8_SCHED;
      G8_STAGE_B(G8_SB(1, 1), b3 + hstepB);
      G8_WAIT_V(6); G8_BAR; G8_MMA(1, 1, At, B1); G8_BAR;
    }
    E(acc, cur);
    if (!has_next) break;
#pragma unroll
    for (int a = 0; a < 2; ++a)
#pragma unroll
      for (int b = 0; b < 2; ++b)
#pragma unroll
        for (int m = 0; m < 4; ++m)
#pragma unroll
          for (int n = 0; n < 2; ++n) acc[a][b][m][n] = (f32x4){0.f, 0.f, 0.f, 0.f};
    cur = nxt; cB = nB; ++ui;
#pragma unroll
    for (int h = 0; h < 2; ++h)
#pragma unroll
      for (int i = 0; i < 2; ++i) cA[h][i] = nA[h][i];
  }
  G8_WAIT_V(0);
  if (wr == 0) G8_BAR;
  G8_BAR;
#undef G8_SA
#undef G8_SB
#undef G8_STAGE_A
#undef G8_STAGE_B
#undef G8_LDA
#undef G8_LDB
#undef G8_MMA
#undef G8_WAIT_V
#undef G8_WAIT_L
#undef G8_BAR
#undef G8_SCHED
}

struct DenseSched {
  const bf16_t* A; const bf16_t* Bt; int K, nM, nN, G, c;
  DEVI bool next(int i, Unit& u) const {
    const int nwg = nM * nN; const long L = (long)i * G + c; if (L >= nwg) return false;
    const int wgid = xcd_remap((int)L, nwg);
    const int nig = 8 * nN, gid = wgid / nig, fm = gid * 8, gsz = (nM - fm) < 8 ? (nM - fm) : 8;
    u.pm = fm + ((wgid % nig) % gsz); u.pn = (wgid % nig) / gsz; u.e = 0; return true;
  }
  DEVI const char* a_base() const { return (const char*)A; }
  DEVI void a_offs(const Unit& u, int tid, unsigned (&ao)[2][2]) const {
#pragma unroll
    for (int i = 0; i < 2; ++i) {
      int R, C; stage_rc(tid * 16 + i * 8192, R, C);
#pragma unroll
      for (int h = 0; h < 2; ++h) ao[h][i] = ((unsigned)(u.pm * 256 + h * 128 + R) * (unsigned)K + (unsigned)C) * 2u;
    }
  }
  DEVI const char* b_ptr(const Unit& u) const { return (const char*)(Bt + (size_t)u.pn * 256 * K); }
};
}

struct TrRegs { float4 v[2][4]; };
DEVI void transpose_load(TrRegs& t, const float* __restrict__ src, int ld_src, int k0, int n0) {
  const int tid = tid_();
  const int kr = tid >> 4, c4 = (tid & 15) * 4;
#pragma unroll
  for (int i = 0; i < 2; ++i)
#pragma unroll
    for (int w = 0; w < 4; ++w) t.v[i][w] = *(const float4*)(src + (size_t)(k0 + kr + 32 * i) * ld_src + n0 + w * 64 + c4);
}
template <class RM>
DEVI void transpose_finish(unsigned char* smem, const TrRegs& t, int k0, int n0, bf16_t* dst, int ld_dst, RM&& rowmap) {
  bf16_t* T = (bf16_t*)smem;
  const int tid = tid_();
  const int kr = tid >> 4, c4 = (tid & 15) * 4;
#pragma unroll
  for (int i = 0; i < 2; ++i)
#pragma unroll
    for (int w = 0; w < 4; ++w) {
      const int kk = kr + 32 * i; bf16_t* tp = T + (w * 64 + c4) * 72 + kk;
      tp[0] = f2bf(t.v[i][w].x); tp[72] = f2bf(t.v[i][w].y); tp[144] = f2bf(t.v[i][w].z); tp[216] = f2bf(t.v[i][w].w);
    }
  __syncthreads();
  const int k8 = (tid & 7) * 8;
#pragma unroll
  for (int j = 0; j < 4; ++j) {
    const int nn = (tid >> 3) + 64 * j;
    const uint4 o = *(const uint4*)(T + nn * 72 + k8);
    *(uint4*)(dst + (size_t)rowmap(n0 + nn) * ld_dst + k0 + k8) = o;
  }
  __syncthreads();
}
template <class RM>
DEVI void transpose_tile(unsigned char* smem, const float* __restrict__ src, int ld_src, int k0, int n0, bf16_t* dst, int ld_dst, RM&& rowmap) {
  TrRegs t; transpose_load(t, src, ld_src, k0, n0);
  transpose_finish(smem, t, k0, n0, dst, ld_dst, rowmap);
}

struct S5Disc { float lm, th, ar, ai, cr, ci; };
DEVI S5Disc s5disc(const Params& p, int l, int d, int g, int pp) {
  const int idx = ((l * 2 + d) * 16 + g) * 64 + pp;
  const float lr = uin(p, I_LRE)[idx], li = uin(p, I_LIM)[idx];
  const float dt = expf(uin(p, I_LDT)[(l * 2 + d) * 16 + g]);
  S5Disc r; r.lm = lr * dt; r.th = li * dt;
  const float mag = expf(r.lm), cs = cosf(r.th), sn = sinf(r.th), sh = sinf(0.5f * r.th);
  r.ar = mag * cs; r.ai = mag * sn;
  const float nr = expm1f(r.lm) * cs - 2.f * sh * sh, ni = r.ai, den = lr * lr + li * li;
  r.cr = (nr * lr + ni * li) / den; r.ci = (ni * lr - nr * li) / den;
  return r;
}

DEVI void phase0a(const Params& p, unsigned char* smem) {
  const int tid = tid_(), bid = bid_(), G = gridDim.x;
  unsigned char* ws = uws(p);
  if (bid == 0 && tid < 128) ((int*)(ws + WS_CTL))[tid] = 0;
  constexpr int N_MOD = 384, N_KT = 256, N_ROPE = 128, N_TRW = 256 + 128, N_EL = 640;
  constexpr int N_AP = 265;
  constexpr int N_BB = 128;
  const int total = N_MOD + N_KT + N_ROPE + N_TRW + N_EL + N_AP + N_BB;
  for (int it0 = bid; it0 < total; it0 += G) {
    int it = it0;
    if (it < N_MOD) {
      const int l = it / 192, col0 = (it % 192) * 32;
      const int c = tid & 31, kg = tid >> 5;
      float* sS = (float*)smem;
      float acc[17];
#pragma unroll
      for (int b = 0; b < 17; ++b) acc[b] = 0.f;
      const float* W = uin(p, I_WMOD) + (size_t)l * D * 6144 + col0 + c;
      for (int kc = 0; kc < 4; ++kc) {
        __syncthreads();
        for (int e = tid; e < 17 * 256; e += NTHREADS) {
          const int b = e >> 8, k = kc * 256 + (e & 255);
          const float cv = (b < 16) ? uin(p, I_C)[b * D + k] : uin(p, I_CCTX)[k];
          sS[e] = cv / (1.f + __expf(-cv));
        }
        __syncthreads();
        float wv[16];
#pragma unroll
        for (int i = 0; i < 16; ++i) wv[i] = W[(size_t)(kc * 256 + kg + 16 * i) * 6144];
#pragma unroll
        for (int i = 0; i < 16; ++i) {
          const int kl = kg + 16 * i;
#pragma unroll
          for (int b = 0; b < 17; ++b) acc[b] = fmaf(sS[b * 256 + kl], wv[i], acc[b]);
        }
      }
      __syncthreads();
      float* sR = (float*)smem;
#pragma unroll
      for (int b = 0; b < 17; ++b) sR[(kg * 17 + b) * 32 + c] = acc[b];
      __syncthreads();
      for (int e = tid; e < 17 * 32; e += NTHREADS) {
        const int b = e >> 5, cc = e & 31;
        float s = 0.f;
#pragma unroll
        for (int q = 0; q < 16; ++q) s += sR[(q * 17 + b) * 32 + cc];
        ((float*)(ws + WS_MOD))[(size_t)(l * 17 + b) * 6144 + col0 + cc] = s + uin(p, I_BMOD)[l * 6144 + col0 + cc];
      }
      __syncthreads();
      continue;
    }
    it -= N_MOD;
    if (it < N_KT) {
      const int gid = it * NTHREADS + tid;
      const int pg = gid & 7, cc = (gid >> 3) & 255, c = cc >> 4, c2 = cc & 15;
      const int lgd = gid >> 11, d = lgd & 1, g = (lgd >> 1) & 15, l = lgd >> 5;
      float K[32];
#pragma unroll
      for (int j = 0; j < 32; ++j) K[j] = 0.f;
      for (int q = 0; q < 8; ++q) {
        const int pp = pg * 8 + q;
        const S5Disc dd = s5disc(p, l, d, g, pp);
        const float ar = dd.ar, ai = dd.ai;
        const float br = uin(p, I_BRE)[((l * 16 + g) * 64 + pp) * 16 + c2], bi = uin(p, I_BIM)[((l * 16 + g) * 64 + pp) * 16 + c2];
        const float bbr = dd.cr * br - dd.ci * bi, bbi = dd.cr * bi + dd.ci * br;
        const float cr = uin(p, I_CRE)[((l * 16 + g) * 16 + c) * 64 + pp], ci = uin(p, I_CIM)[((l * 16 + g) * 16 + c) * 64 + pp];
        const float zr = cr * bbr - ci * bbi, zi = cr * bbi + ci * bbr;
        float pr = 1.f, pi = 0.f;
#pragma unroll
        for (int j = 0; j < 32; ++j) {
          K[j] += zr * pr - zi * pi;
          const float nr = pr * ar - pi * ai, ni = pr * ai + pi * ar;
          pr = nr; pi = ni;
        }
      }
#pragma unroll
      for (int j = 0; j < 32; ++j) { float v = K[j]; v += dpp_f<0xB1>(v); v += dpp_f<0x4E>(v); v += dpp_f<0x141>(v); K[j] = v; }
      if (pg == 0) {
        float* KT = (float*)(ws + WS_KTAB) + (size_t)(((l * 16 + g) * 2 + d) * 32) * 256 + c * 16 + c2;
#pragma unroll
        for (int j = 0; j < 32; ++j) KT[j * 256] = K[j];
      }
      continue;
    }
    it -= N_KT;
    if (it < N_ROPE) {
      const int e = it * NTHREADS + tid;
      const int pos = e >> 5, i = e & 31;
      const float inv = powf(10000.f, -(float)(i & 15) / 16.f);
      const float ang = (float)((i < 16) ? (pos >> 6) : (pos & 63)) * inv;
      ((float*)(ws + WS_ROPE))[e] = cosf(ang);
      ((float*)(ws + WS_ROPE))[65536 + e] = sinf(ang);
      continue;
    }
    it -= N_ROPE;
    if (it < N_TRW) {
      if (it < 256) {
        const int l = it >> 7, r = it & 127, kt = r >> 3, ntl = r & 7;
        transpose_tile(smem, uin(p, I_WIN) + (size_t)l * D * DIN, DIN, kt * 64, ntl * 256, (bf16_t*)(ws + WS_WIN_T) + (size_t)l * DIN * D, D,
          [](int n) { if (n >= 1280 && n < 1920) { const int d = n & 63; return (n & ~63) + 32 * ((d >> 4) & 1) + 8 * ((d >> 2) & 3) + 4 * (d >> 5) + (d & 3); } return n; });
      } else {
        const int r0 = it - 256, l = r0 >> 6, r = r0 & 63, kt = r >> 2, ntl = r & 3;
        transpose_tile(smem, uin(p, I_WOUT) + (size_t)l * D * D, D, kt * 64, ntl * 256, (bf16_t*)(ws + WS_WOUT_T) + (size_t)l * D * D, D, [](int n) { return n; });
      }
      continue;
    }
    it -= N_TRW;
    if (it < N_EL) {
      for (int q = 0; q < 4; ++q) {
        int e = (it * 4 + q) * NTHREADS + tid;
        if (e < 655360) {
          const int l = e / 327680, r = e % 327680, n = r >> 8, k = r & 255;
          float v = 0.f;
          if (n < 512) { const int d = n >> 8, col = n & 255; if (k < 64) v = uin(p, I_W2)[((l * 2 + d) * 64 + k) * 256 + col]; }
          else if (n < 1024) { const int d = (n - 512) >> 8, col = n & 255; if (k >= 64 && k < 128) v = uin(p, I_A2)[((l * 2 + d) * 64 + (k - 64)) * 256 + col]; }
          else { const int col = n - 1024; if (k >= 128) v = uin(p, I_G2)[(l * 128 + (k - 128)) * 256 + col]; }
          ((bf16_t*)(ws + WS_FW))[e] = f2bf(v);
          continue;
        }
        e -= 655360;
        if (e < 131072) {
          const int l = e >> 16, r = e & 65535, n = r >> 8, k = r & 255;
          ((bf16_t*)(ws + WS_GLU_T))[e] = f2bf(uin(p, I_GLUW)[(l * 256 + k) * 256 + n]);
          continue;
        }
        e -= 131072;
        if (e < 524288) {
          const int l = e >> 18, r = e & 262143, hl = r >> 17, n = (r >> 10) & 127, k = r & 1023;
          float v = 0.f;
          if (n < 4) v = uin(p, I_RGW)[(l * D + k) * 4 + n];
          else if (n < 36) v = uin(p, I_REW)[(l * D + k) * 32 + (n - 4)];
          const bf16_t h = f2bf(v);
          ((bf16_t*)(ws + WS_RW))[e] = hl ? f2bf(v - bf2f(h)) : h;
        }
      }
      continue;
    }
    it -= N_EL;
    if (it < N_AP) {
      const int e = it * NTHREADS + tid;
      if (e < 2 * 2 * 16 * 64 * 33) {
        const int j = e % 33, r = e / 33, pp = r & 63, g = (r >> 6) & 15, d = (r >> 10) & 1, l = r >> 11;
        const S5Disc dd = s5disc(p, l, d, g, pp);
        const float mg = expf(dd.lm * (float)j), an = dd.th * (float)j;
        ((float2*)(ws + WS_APOW))[e] = make_float2(mg * cosf(an), mg * sinf(an));
      }
      continue;
    }
    it -= N_AP;
    {
      const int e = it * NTHREADS + tid;
      const int c2 = e & 15, pp = (e >> 4) & 63, g = (e >> 10) & 15, d = (e >> 14) & 1, l = e >> 15;
      const S5Disc dd = s5disc(p, l, d, g, pp);
      const float br = uin(p, I_BRE)[((l * 16 + g) * 64 + pp) * 16 + c2], bi = uin(p, I_BIM)[((l * 16 + g) * 64 + pp) * 16 + c2];
      ((float2*)(ws + WS_BBT))[e] = make_float2(dd.cr * br - dd.ci * bi, dd.cr * bi + dd.ci * br);
    }
  }
}

DEVI void write_xmod_row(const float4 v[4], const float* modl, bf16_t* dstrow, int lane) {
#pragma unroll
  for (int i = 0; i < 4; ++i) {
    const int col = i * 256 + lane * 4;
    const float4 sh = *(const float4*)(modl + col), sc = *(const float4*)(modl + 1024 + col);
    uint2 o; o.x = pack2(v[i].x * (1.f + sc.x) + sh.x, v[i].y * (1.f + sc.y) + sh.y); o.y = pack2(v[i].z * (1.f + sc.z) + sh.z, v[i].w * (1.f + sc.w) + sh.w);
    *(uint2*)(dstrow + col) = o;
  }
}
DEVI void phase0b(const Params& p, unsigned char* smem) {
  const int tid = tid_(), bid = bid_(), G = gridDim.x, lane = tid & 63, wid = tid >> 6;
  unsigned char* ws = uws(p);
  {
    bf16_t* XM = (bf16_t*)((unsigned char*)uout(p) + DO_XMOD);
    const float* MOD = (const float*)(ws + WS_MOD);
    const int nw = G * 8, gw = bid * 8 + wid, rpw = (NT + nw - 1) / nw;
    const int R0 = gw * rpw, R1 = (R0 + rpw < NT) ? (R0 + rpw) : NT;
    const int c0 = lane * 8, c1 = 512 + lane * 8;
    float sh[2][8], sc[2][8], xv[2][8];
    int curb = -1;
    if (R0 < R1) { ld8f(xin_row(p, R0) + c0, xv[0]); ld8f(xin_row(p, R0) + c1, xv[1]); }
    for (int R = R0; R < R1; ++R) {
      float xn[2][8];
#pragma unroll
      for (int h = 0; h < 2; ++h)
#pragma unroll
        for (int e = 0; e < 8; ++e) xn[h][e] = 0.f;
      if (R + 1 < R1) { ld8f(xin_row(p, R + 1) + c0, xn[0]); ld8f(xin_row(p, R + 1) + c1, xn[1]); }
      const int bi = bidx_of(R);
      if (bi != curb) { curb = bi; const float* modl = MOD + (size_t)bi * 6144; ld8f(modl + c0, sh[0]); ld8f(modl + c1, sh[1]); ld8f(modl + 1024 + c0, sc[0]); ld8f(modl + 1024 + c1, sc[1]); }
#pragma unroll
      for (int h = 0; h < 2; ++h) {
        float xm[8];
#pragma unroll
        for (int e = 0; e < 8; ++e) xm[e] = xv[h][e] * (1.f + sc[h][e]) + sh[h][e];
        st8b(XM + (size_t)R * D + (h ? c1 : c0), xm);
      }
#pragma unroll
      for (int h = 0; h < 2; ++h)
#pragma unroll
        for (int e = 0; e < 8; ++e) xv[h][e] = xn[h][e];
    }
  }
}

DEVI void build_ttg_em(const Params& p, int lsel, int vb, int nvb) {
  unsigned char* ws = uws(p);
  const int tid = tid_();
  const float* KT = (const float*)(ws + WS_KTAB);
  const float2* AP = (const float2*)(ws + WS_APOW);
  const float2* BB = (const float2*)(ws + WS_BBT);
  const long nthreads = (long)nvb * NTHREADS, gt = (long)vb * NTHREADS + tid;
  const long n_ttg = 16L * 512 * 96;
  for (long e = (long)lsel * n_ttg + gt; e < (long)(lsel + 1) * n_ttg; e += nthreads) {
    const int k8 = (int)(e % 96), m = (int)((e / 96) & 511), g = (int)((e / (96 * 512)) & 15), l = (int)(e / (96 * 512 * 16));
    const int tau = m >> 4, c = m & 15, k = k8 * 8;
    float v[8];
    if (k < 512) {
      const int sg = k >> 4, c2 = k & 15;
      const float* K0 = KT + (size_t)(((l * 16 + g) * 2 + 0) * 32) * 256 + c * 16 + c2;
      const float* K1 = KT + (size_t)(((l * 16 + g) * 2 + 1) * 32) * 256 + c * 16 + c2;
      if (sg < tau) { for (int q = 0; q < 8; ++q) v[q] = K0[(tau - sg) * 256 + q]; }
      else if (sg > tau) { for (int q = 0; q < 8; ++q) v[q] = K1[(sg - tau) * 256 + q]; }
      else { for (int q = 0; q < 8; ++q) v[q] = K0[q] + K1[q] + ((c2 + q == c) ? uin(p, I_SD)[l * 256 + g * 16 + c] : 0.f); }
    } else {
      const int q0 = k - 512, d = q0 >> 7, isim = (q0 >> 6) & 1, p0 = q0 & 63;
      const int j = d ? (32 - tau) : (tau + 1);
      for (int q = 0; q < 8; ++q) {
        const int pp = p0 + q;
        const float2 a = AP[((size_t)(((l * 2 + d) * 16 + g) * 64 + pp)) * 33 + j];
        const float cr = uin(p, I_CRE)[((l * 16 + g) * 16 + c) * 64 + pp], ci = uin(p, I_CIM)[((l * 16 + g) * 16 + c) * 64 + pp];
        v[q] = isim ? -(cr * a.y + ci * a.x) : (cr * a.x - ci * a.y);
      }
    }
    uint4 o; o.x = pack2(v[0], v[1]); o.y = pack2(v[2], v[3]); o.z = pack2(v[4], v[5]); o.w = pack2(v[6], v[7]);
    *(uint4*)((bf16_t*)(ws + WS_TTG) + (size_t)e * 8) = o;
  }
  const long n_em = 16L * 256 * 64;
  for (long e = (long)lsel * n_em + gt; e < (long)(lsel + 1) * n_em; e += nthreads) {
    const int k8 = (int)(e & 63), r = (int)((e >> 6) & 255), g = (int)((e >> 14) & 15), l = (int)(e >> 18);
    const int d = r >> 7, isim = (r >> 6) & 1, pp = r & 63, k = k8 * 8, sg = k >> 4, c2 = k & 15;
    const int j = d ? sg : (31 - sg);
    const float2 a = AP[((size_t)(((l * 2 + d) * 16 + g) * 64 + pp)) * 33 + j];
    float v[8];
    for (int q = 0; q < 8; ++q) {
      const float2 bb = BB[(size_t)((((l * 2 + d) * 16 + g) * 64 + pp) * 16) + c2 + q];
      v[q] = isim ? (a.x * bb.y + a.y * bb.x) : (a.x * bb.x - a.y * bb.y);
    }
    uint4 o; o.x = pack2(v[0], v[1]); o.y = pack2(v[2], v[3]); o.z = pack2(v[4], v[5]); o.w = pack2(v[6], v[7]);
    *(uint4*)((bf16_t*)(ws + WS_EM) + (size_t)e * 8) = o;
  }
}

struct EpiInproj {
  static constexpr bool PERM = true;
  bf16_t* PROJ; bf16_t* UDH; const float* RC; const float* RS;
  DEVI void operator()(const f32x4 (&acc)[2][2][4][2], const g8::Unit& u) const {
    const int tid = tid_(), wid = __builtin_amdgcn_readfirstlane(tid >> 6), lane = tid & 63, wr = wid >> 2, wc = wid & 3, fr = lane & 15, fq = lane >> 4;
    const bool lat = u.pm < 128;
#pragma unroll
    for (int ai = 0; ai < 2; ++ai)
#pragma unroll
      for (int m = 0; m < 4; ++m) {
        const int row = u.pm * 256 + ai * 128 + wr * 64 + m * 16 + fr, pos = row & 2047;
#pragma unroll
        for (int bj = 0; bj < 2; ++bj) {
          const int cb = u.pn * 256 + bj * 128 + wc * 32 + 8 * fq;
          f32x4 x0 = acc[ai][bj][m][0], x1 = acc[ai][bj][m][1];
          const bool isq = (u.pn == 5 || u.pn == 6), isk = (u.pn == 7 && bj == 0);
          if ((isq || isk) && lat) {
            const int i0 = 16 * (wc & 1) + 4 * fq;
            const float4 cs = *(const float4*)(RC + pos * 32 + i0), sn = *(const float4*)(RS + pos * 32 + i0);
            const f32x4 y0 = (f32x4){x0[0] * cs.x - x1[0] * sn.x, x0[1] * cs.y - x1[1] * sn.y, x0[2] * cs.z - x1[2] * sn.z, x0[3] * cs.w - x1[3] * sn.w};
            const f32x4 y1 = (f32x4){x1[0] * cs.x + x0[0] * sn.x, x1[1] * cs.y + x0[1] * sn.y, x1[2] * cs.z + x0[2] * sn.z, x1[3] * cs.w + x0[3] * sn.w};
            x0 = y0; x1 = y1;
          }
          if (isq) { x0 = x0 * 0.125f; x1 = x1 * 0.125f; }
          const uint4 o = make_uint4(pack2(x0[0], x0[1]), pack2(x0[2], x0[3]), pack2(x1[0], x1[1]), pack2(x1[2], x1[3]));
          if (u.pn == 4) {
            const int g = (cb - 1024) >> 4, c = cb & 15;
            *(uint4*)(UDH + ((size_t)(g * NCH + (row >> 5))) * 768 + (row & 31) * 16 + c) = o;
          } else {
            *(uint4*)(PROJ + (size_t)row * DIN + cb) = o;
          }
        }
        asm volatile("" ::: "memory");
      }
  }
};
DEVI void phase_inproj(const Params& p, int l, unsigned char* smem) {
  unsigned char* ws = uws(p);
  g8::DenseSched S{(const bf16_t*)((unsigned char*)uout(p) + DO_XMOD), (const bf16_t*)(ws + WS_WIN_T) + (size_t)l * DIN * D, D, 144, 8, (int)gridDim.x, bid_()};
  EpiInproj E{(bf16_t*)(ws + WS_PROJ), (bf16_t*)(ws + WS_UDH), (const float*)(ws + WS_ROPE), (const float*)(ws + WS_ROPE) + 65536};
  __syncthreads();
  g8::gemm((G8_LAS unsigned char*)smem, D, S, E);
  __syncthreads();
  if (l == 0) { const int G = gridDim.x, rem = (144 * 8) % G; if (rem == 0) build_ttg_em(p, 0, bid_(), G); else if (bid_() >= rem) build_ttg_em(p, 0, bid_() - rem, G - rem); }
}

DEVI void phase_feat(const Params& p, int l, unsigned char* smem) {
  unsigned char* ws = uws(p);
  const bf16_t* PROJ = (const bf16_t*)(ws + WS_PROJ);
  unsigned short* FEAT = (unsigned short*)(ws + WS_FEAT);
  const bf16_t* FW = (const bf16_t*)(ws + WS_FW) + (size_t)l * 1280 * 256;
  const bf16_t* EM = (const bf16_t*)(ws + WS_EM) + (size_t)l * 16 * 256 * 512;
  float* HE = (float*)((unsigned char*)uout(p) + DO_HE);
  const float* CW = uin(p, I_CONV) + l * 3 * 1024;
  const int tid = tid_(), lrow = tid >> 2;
  for (int it = bid_(); it < 432 + 160; it += gridDim.x) {
    if (it < 432) {
      const int mt = it / 3, typ = it % 3;
      const int kb = typ == 0 ? 0 : (typ == 1 ? 64 : 128), KK = typ == 2 ? 128 : 64, lda = KK + 8;
      const int nt_lo = typ == 0 ? 0 : (typ == 1 ? 4 : 8), nt_n = typ == 2 ? 2 : 4;
      bf16_t* sA = (bf16_t*)smem;
      bf16_t* sB = sA + 256 * 136;
      {
        const int ppr = KK >> 3;
        const int kfix = kb + (tid % ppr) * 8;
        float wc0[8], wc1[8], wc2[8];
        ld8f(CW + 768 + kfix, wc0); ld8f(CW + 1024 + 768 + kfix, wc1); ld8f(CW + 2048 + 768 + kfix, wc2);
        for (int pc = tid; pc < 256 * ppr; pc += NTHREADS) {
          const int rr = pc / ppr, k = kfix;
          const int R = mt * 256 + rr;
          const int t = R < NLAT ? (R & 2047) : ((R - NLAT) & 255); const int len = R < NLAT ? SEQ : CTXL;
          const bf16_t* pcur = PROJ + (size_t)R * DIN + 768 + k;
          const uint4 vc = *(const uint4*)pcur;
          uint4 vp = make_uint4(0, 0, 0, 0), vn = make_uint4(0, 0, 0, 0);
          if (t > 0) vp = *(const uint4*)(pcur - DIN);
          if (t < len - 1) vn = *(const uint4*)(pcur + DIN);
          float x[8];
          const unsigned up[4] = {vp.x, vp.y, vp.z, vp.w}, uc[4] = {vc.x, vc.y, vc.z, vc.w}, un[4] = {vn.x, vn.y, vn.z, vn.w};
#pragma unroll
          for (int q = 0; q < 4; ++q) {
            x[2 * q] = lo_bf(up[q]) * wc0[2 * q] + lo_bf(uc[q]) * wc1[2 * q] + lo_bf(un[q]) * wc2[2 * q];
            x[2 * q + 1] = hi_bf(up[q]) * wc0[2 * q + 1] + hi_bf(uc[q]) * wc1[2 * q + 1] + hi_bf(un[q]) * wc2[2 * q + 1];
          }
          if (typ == 0) { for (int q = 0; q < 8; ++q) x[q] = 1.f - 2.f * __builtin_amdgcn_rcpf(1.f + __expf(2.f * x[q])); }
          else if (typ == 2) { for (int q = 0; q < 8; ++q) x[q] = sigmoidf(x[q]); }
          *(uint4*)(sA + rr * lda + (k - kb)) = make_uint4(pack2(x[0], x[1]), pack2(x[2], x[3]), pack2(x[4], x[5]), pack2(x[6], x[7]));
        }
      }
      const int lane = tid & 63, wid = tid >> 6, wr = wid >> 1, wc = wid & 1, fr = lane & 15, fq = lane >> 4;
      for (int nq = 0; nq < nt_n; ++nq) {
        const int ntl = nt_lo + nq;
        __syncthreads();
        {
          const int ppr = KK >> 3;
          for (int pc = tid; pc < 128 * ppr; pc += NTHREADS) {
            const int rr = pc / ppr, k = (pc % ppr) * 8;
            *(uint4*)(sB + rr * lda + k) = *(const uint4*)(FW + (size_t)(ntl * 128 + rr) * 256 + kb + k);
          }
        }
        __syncthreads();
        f32x4 acc[4][4];
#pragma unroll
        for (int m = 0; m < 4; ++m)
#pragma unroll
          for (int n = 0; n < 4; ++n) acc[m][n] = (f32x4){0.f, 0.f, 0.f, 0.f};
        for (int k0 = 0; k0 < KK; k0 += 32) {
          bf16x8 bfr[4];
#pragma unroll
          for (int n = 0; n < 4; ++n) bfr[n] = *(const bf16x8*)(sB + (wc * 64 + n * 16 + fr) * lda + k0 + fq * 8);
#pragma unroll
          for (int m = 0; m < 4; ++m) {
            const bf16x8 af = *(const bf16x8*)(sA + (wr * 64 + m * 16 + fr) * lda + k0 + fq * 8);
#pragma unroll
            for (int n = 0; n < 4; ++n) acc[m][n] = __builtin_amdgcn_mfma_f32_16x16x32_bf16(bfr[n], af, acc[m][n], 0, 0, 0);
          }
        }
#pragma unroll
        for (int m = 0; m < 4; ++m) {
          const int row = mt * 256 + wr * 64 + m * 16 + fr;
#pragma unroll
          for (int n = 0; n < 4; ++n) {
            const int ng = ntl * 128 + wc * 64 + n * 16 + fq * 4;
            float o[4];
            if (typ == 0) {
              const float4 w0 = *(const float4*)(uin(p, I_W0) + (l * 2 + (ng >> 8)) * 256 + (ng & 255));
              const float wv[4] = {w0.x, w0.y, w0.z, w0.w};
#pragma unroll
              for (int j = 0; j < 4; ++j) {
                const float e = 0.6065306597126334f * sigmoidf(acc[m][n][j] + wv[j]);
                o[j] = 1.f - __expf(-e);
              }
            } else if (typ == 1) {
              const float4 a0 = *(const float4*)(uin(p, I_A0) + (l * 2 + ((ng - 512) >> 8)) * 256 + (ng & 255));
              const float av[4] = {a0.x, a0.y, a0.z, a0.w};
#pragma unroll
              for (int j = 0; j < 4; ++j) o[j] = sigmoidf(acc[m][n][j] + av[j]);
            } else {
#pragma unroll
              for (int j = 0; j < 4; ++j) o[j] = acc[m][n][j];
            }
            uint2 w; w.x = (unsigned)f2h(o[0]) | ((unsigned)f2h(o[1]) << 16); w.y = (unsigned)f2h(o[2]) | ((unsigned)f2h(o[3]) << 16);
            *(uint2*)(FEAT + (size_t)row * 1280 + ng) = w;
          }
        }
      }
      __syncthreads();
    } else {
      const int j = it - 432, g = j / 10, rest = j % 10, mt5 = rest >> 1, nt2 = rest & 1;
      int n0 = mt5 * 256 + lrow, n1 = n0 + 128; if (n0 > NCH - 1) n0 = NCH - 1; if (n1 > NCH - 1) n1 = NCH - 1;
      const bf16_t* UDH = (const bf16_t*)(ws + WS_UDH);
      const bf16_t* a0 = UDH + (size_t)(g * NCH + n0) * 768; const bf16_t* a1 = UDH + (size_t)(g * NCH + n1) * 768;
      const bf16_t* b0 = EM + (size_t)(g * 256 + nt2 * 128 + lrow) * 512;
      gemm_tile(smem, 0, 512,
        [&](int i, int k) { return *(const uint4*)((i ? a1 : a0) + k); },
        [&](int k) { return *(const uint4*)(b0 + k); },
        [&](f32x4 (&acc)[4][4], int wr, int wc, int fr, int fq) {
#pragma unroll
          for (int m = 0; m < 4; ++m) {
            const int n = mt5 * 256 + wr * 64 + m * 16 + fr;
            if (n < NCH) {
#pragma unroll
              for (int nn = 0; nn < 4; ++nn)
                *(f32x4*)(HE + (size_t)(g * NCH + n) * 256 + nt2 * 128 + wc * 64 + nn * 16 + fq * 4) = acc[m][nn];
            }
          }
        });
    }
  }
}


DEVI float row_reduce_scatter16(const float (&v)[16], int lane16) {
  float a[8], b[4], c[2];
  const bool b3 = (lane16 & 8) != 0, b2 = (lane16 & 4) != 0, b1 = (lane16 & 2) != 0, b0 = (lane16 & 1) != 0;
#pragma unroll
  for (int k = 0; k < 8; ++k) { const float send = b3 ? v[k] : v[k + 8], keep = b3 ? v[k + 8] : v[k]; a[k] = keep + dpp_f<0x128>(send); }
#pragma unroll
  for (int k = 0; k < 4; ++k) { const float send = b2 ? a[k] : a[k + 4], keep = b2 ? a[k + 4] : a[k]; b[k] = keep + dpp_f<0x141>(send); }
#pragma unroll
  for (int k = 0; k < 2; ++k) { const float send = b1 ? b[k] : b[k + 2], keep = b1 ? b[k + 2] : b[k]; c[k] = keep + dpp_f<0x4E>(send); }
  { const float send = b0 ? c[0] : c[1], keep = b0 ? c[1] : c[0]; return keep + dpp_f<0xB1>(send); }
}
DEVI float mul_mix_lo(float a, unsigned hpair) { float r; asm("v_fma_mix_f32 %0, %1, %2, 0 op_sel_hi:[0,1,0]" : "=v"(r) : "v"(a), "v"(hpair)); return r; }
constexpr int RC_SLOT = 17664;
constexpr int RC_KK = 0, RC_RR = 2304, RC_KDB = 4608, RC_TT = 8704, RC_MM = 9728, RC_V = 10752, RC_G = 12800, RC_KD = 13056, RC_BB = 15360;
DEVI bf16x8 rc_pack8(const f32x4& a, const f32x4& b) {
  typedef unsigned u4v __attribute__((ext_vector_type(4)));
  const u4v u = {pack2(a[0], a[1]), pack2(a[2], a[3]), pack2(b[0], b[1]), pack2(b[2], b[3])};
  return __builtin_bit_cast(bf16x8, u);
}
DEVI bf16x8 rc_pack8(const f32x4& a, uint2 b) {
  typedef unsigned u4v __attribute__((ext_vector_type(4)));
  const u4v u = {pack2(a[0], a[1]), pack2(a[2], a[3]), b.x, b.y};
  return __builtin_bit_cast(bf16x8, u);
}
DEVI bf16x8 rc_pack8(uint2 a, const f32x4& b) {
  typedef unsigned u4v __attribute__((ext_vector_type(4)));
  const u4v u = {a.x, a.y, pack2(b[0], b[1]), pack2(b[2], b[3])};
  return __builtin_bit_cast(bf16x8, u);
}
template <int DIR>
DEVI void rwkv_chunked(const Params& p, int l, int it, unsigned char* smem) {
  unsigned char* ws = uws(p);
  const int b = it >> 3, h = (it >> 1) & 3;
  const bf16_t* PROJ = (const bf16_t*)(ws + WS_PROJ);
  const unsigned short* FEAT = (const unsigned short*)(ws + WS_FEAT);
  float* Y = (float*)((unsigned char*)uout(p) + (DIR ? DO_YB : DO_YF));
  const int tid = tid_(), lane = tid & 63, wid = __builtin_amdgcn_readfirstlane(tid >> 6);
  const int cl = lane & 15, cq = lane >> 4;
  const int hc = h * 64 + lane;
  const float* CW = uin(p, I_CONV) + l * 3 * 1024;
  float cwr[3], cwk[3], cwv[3];
#pragma unroll
  for (int dl = 0; dl < 3; ++dl) { cwr[dl] = CW[dl * 1024 + hc]; cwk[dl] = CW[dl * 1024 + 256 + hc]; cwv[dl] = CW[dl * 1024 + 512 + hc]; }
  const float kkw = uin(p, I_KK)[l * 256 + hc], kaw = uin(p, I_KA)[l * 256 + hc];
  const int pj = 32 * (lane >> 5) + 8 * ((lane >> 2) & 3) + 4 * ((lane >> 4) & 1) + (lane & 3);
  unsigned char* slot = smem + wid * RC_SLOT;
  const f32x4 zero4 = {0.f, 0.f, 0.f, 0.f};
  f32x4 acc[4] = {zero4, zero4, zero4, zero4};
  uint4 raw0, raw1, raw2, raw3, raw4, raw5, raw6, raw7, raw8, raw9, raw10;
  auto chunk_geom = [&](int c, bool& isctx, int& seqlen, int& lo, int& rowbase) __attribute__((always_inline)) {
    const int n0 = c * 16; isctx = n0 < 256; seqlen = isctx ? 256 : 2048; const int m0 = isctx ? n0 : n0 - 256;
    lo = DIR ? (seqlen - 16 - m0) : m0;
    rowbase = isctx ? (NLAT + b * CTXL) : (b * SEQ);
  };
#define RC_LDP(ld, dst) do { const int L_ = (ld) * 64 + lane_; const int Lc_ = L_ < 432 ? L_ : 431; const int u_ = Lc_ / 24, sg_ = (Lc_ % 24) >> 3, part_ = Lc_ & 7; \
    int tau_ = lo_ - 1 + u_; tau_ = tau_ < 0 ? 0 : (tau_ >= seqlen_ ? seqlen_ - 1 : tau_); \
    dst = *(const uint4*)(PROJ + (size_t)(rowbase_ + tau_) * DIN + h * 64 + sg_ * 256 + part_ * 8); } while (0)
#define RC_LDF(ld, dst) do { const int L_ = (ld) * 64 + lane_; const int o_ = L_ >> 4, sg_ = (L_ >> 3) & 1, part_ = L_ & 7; \
    dst = *(const uint4*)(FEAT + (size_t)(rowbase_ + lo_ + o_) * 1280 + DIR * 256 + sg_ * 512 + h * 64 + part_ * 8); } while (0)
#define RC_LOAD_RAW(c) do { bool isctx_; int seqlen_, lo_, rowbase_; chunk_geom((c), isctx_, seqlen_, lo_, rowbase_); const int lane_ = tid_() & 63;     \
    RC_LDP(0, raw0); RC_LDP(1, raw1); RC_LDP(2, raw2); RC_LDP(3, raw3); RC_LDP(4, raw4); RC_LDP(5, raw5); RC_LDP(6, raw6); \
    RC_LDF(0, raw7); RC_LDF(1, raw8); RC_LDF(2, raw9); RC_LDF(3, raw10); } while (0)
  RC_LOAD_RAW(wid);
  for (int batch = 0; batch < 18; ++batch) {
    {
      const int c = batch * 8 + wid;
      bool isctx; int seqlen, lo, rowbase; chunk_geom(c, isctx, seqlen, lo, rowbase);
      *(uint4*)(slot + (0 * 64 + lane) * 16) = raw0; *(uint4*)(slot + (1 * 64 + lane) * 16) = raw1; *(uint4*)(slot + (2 * 64 + lane) * 16) = raw2; *(uint4*)(slot + (3 * 64 + lane) * 16) = raw3;
      *(uint4*)(slot + (4 * 64 + lane) * 16) = raw4; *(uint4*)(slot + (5 * 64 + lane) * 16) = raw5; if (6 * 64 + lane < 432) *(uint4*)(slot + (6 * 64 + lane) * 16) = raw6;
      *(uint4*)(slot + 6912 + (0 * 64 + lane) * 16) = raw7; *(uint4*)(slot + 6912 + (1 * 64 + lane) * 16) = raw8; *(uint4*)(slot + 6912 + (2 * 64 + lane) * 16) = raw9; *(uint4*)(slot + 6912 + (3 * 64 + lane) * 16) = raw10;
      const unsigned short* sraw = (const unsigned short*)slot + lane;
      const bool ok_lo = lo - 1 >= 0, ok_hi = lo + 16 < seqlen;
      float kC[16], kkr[16], sq[16];
      {
        float Rk[18];
#pragma unroll
        for (int u = 0; u < 18; ++u) Rk[u] = __uint_as_float((unsigned)sraw[(u * 3 + 1) * 64] << 16);
        if (!ok_lo) Rk[0] = 0.f;
        if (!ok_hi) Rk[17] = 0.f;
#pragma unroll
        for (int o = 0; o < 16; ++o) { kC[o] = cwk[0] * Rk[o] + cwk[1] * Rk[o + 1] + cwk[2] * Rk[o + 2]; kkr[o] = kC[o] * kkw; sq[o] = kkr[o] * kkr[o]; }
      }
      float tot = row_reduce_scatter16(sq, cl);
      tot += shfl_xor_l(tot, 16); tot += shfl_xor_l(tot, 32);
      const float invv = rsqrtf(tot + 1e-12f);
      float rC[16], vC[16], xwF[16], aF[16];
      {
        float Rr[18], Rv[18];
#pragma unroll
        for (int u = 0; u < 18; ++u) { Rr[u] = __uint_as_float((unsigned)sraw[(u * 3 + 0) * 64] << 16); Rv[u] = __uint_as_float((unsigned)sraw[(u * 3 + 2) * 64] << 16); }
        if (!ok_lo) { Rr[0] = 0.f; Rv[0] = 0.f; }
        if (!ok_hi) { Rr[17] = 0.f; Rv[17] = 0.f; }
#pragma unroll
        for (int o = 0; o < 16; ++o) { rC[o] = cwr[0] * Rr[o] + cwr[1] * Rr[o + 1] + cwr[2] * Rr[o + 2]; vC[o] = cwv[0] * Rv[o] + cwv[1] * Rv[o + 1] + cwv[2] * Rv[o + 2]; }
#pragma unroll
        for (int o = 0; o < 16; ++o) { xwF[o] = h2f(sraw[3456 + (o * 2 + 0) * 64]); aF[o] = h2f(sraw[3456 + (o * 2 + 1) * 64]); }
      }
      float G = 1.f;
      float kdq[4], bbq[4], vq[4];
      bf16_t* sKK = (bf16_t*)(slot + RC_KK); bf16_t* sRR = (bf16_t*)(slot + RC_RR); bf16_t* sKD = (bf16_t*)(slot + RC_KD); bf16_t* sBB = (bf16_t*)(slot + RC_BB);
#pragma unroll
      for (int s = 0; s < 16; ++s) {
        const int o = DIR ? (15 - s) : s;
        const float inv = __int_as_float(__builtin_amdgcn_readlane(__float_as_int(invv), o));
        const float okk = kkr[o] * inv, a = aF[o], ob = okk * a, okd = kC[o] * (1.f + (a - 1.f) * kaw), w = 1.f - xwF[o];
        const float kkt = okk * G;
        G *= w;
        const float ig = __builtin_amdgcn_rcpf(G);
        const float rt = rC[o] * G, kdt = okd * ig, bt = ob * ig;
        sKK[s * 72 + pj] = f2bf(kkt); sRR[s * 72 + pj] = f2bf(rt); sKD[s * 72 + pj] = f2bf(kdt); sBB[s * 72 + pj] = f2bf(bt);
        kdq[s & 3] = kdt; bbq[s & 3] = -bt; vq[s & 3] = vC[o];
        if ((s & 3) == 3) {
          const int fi = ((lane >> 4) * 4 + (s >> 2)) * 16 + (lane & 15);
          *(uint4*)(slot + RC_KDB + fi * 16) = make_uint4(pack2(kdq[0], kdq[1]), pack2(kdq[2], kdq[3]), pack2(bbq[0], bbq[1]), pack2(bbq[2], bbq[3]));
          *(uint2*)(slot + RC_V + fi * 8) = make_uint2(pack2(vq[0], vq[1]), pack2(vq[2], vq[3]));
        }
      }
      ((float*)(slot + RC_G))[lane] = G;
      const bf16x8 aK0 = *(const bf16x8*)(sKK + cl * 72 + 8 * cq), aK1 = *(const bf16x8*)(sKK + cl * 72 + 32 + 8 * cq);
      const bf16x8 aR0 = *(const bf16x8*)(sRR + cl * 72 + 8 * cq), aR1 = *(const bf16x8*)(sRR + cl * 72 + 32 + 8 * cq);
      const bf16x8 bD0 = *(const bf16x8*)(sKD + cl * 72 + 8 * cq), bD1 = *(const bf16x8*)(sKD + cl * 72 + 32 + 8 * cq);
      const bf16x8 bB0 = *(const bf16x8*)(sBB + cl * 72 + 8 * cq), bB1 = *(const bf16x8*)(sBB + cl * 72 + 32 + 8 * cq);
      f32x4 Abk = __builtin_amdgcn_mfma_f32_16x16x32_bf16(aK0, bB0, zero4, 0, 0, 0); Abk = __builtin_amdgcn_mfma_f32_16x16x32_bf16(aK1, bB1, Abk, 0, 0, 0);
      f32x4 Avk = __builtin_amdgcn_mfma_f32_16x16x32_bf16(aK0, bD0, zero4, 0, 0, 0); Avk = __builtin_amdgcn_mfma_f32_16x16x32_bf16(aK1, bD1, Avk, 0, 0, 0);
      f32x4 Mbr = __builtin_amdgcn_mfma_f32_16x16x32_bf16(aR0, bB0, zero4, 0, 0, 0); Mbr = __builtin_amdgcn_mfma_f32_16x16x32_bf16(aR1, bB1, Mbr, 0, 0, 0);
      f32x4 Mvr = __builtin_amdgcn_mfma_f32_16x16x32_bf16(aR0, bD0, zero4, 0, 0, 0); Mvr = __builtin_amdgcn_mfma_f32_16x16x32_bf16(aR1, bD1, Mvr, 0, 0, 0);
      float* tA = (float*)(slot + RC_KD); float* tVT = tA + 256;
      bf16_t* sMM = (bf16_t*)(slot + RC_MM);
#pragma unroll
      for (int r = 0; r < 4; ++r) {
        const int t = 4 * cq + r;
        const float abk = (cl < t) ? Abk[r] : 0.f, avk = (cl < t) ? Avk[r] : 0.f, mbr = (cl <= t) ? Mbr[r] : 0.f, mvr = (cl <= t) ? Mvr[r] : 0.f;
        tA[t * 16 + cl] = abk; Avk[r] = avk;
        sMM[((cl >> 2) * 16 + t) * 8 + (cl & 3)] = f2bf(mvr); sMM[((cl >> 2) * 16 + t) * 8 + 4 + (cl & 3)] = f2bf(-mbr);
      }
      *(float4*)(tVT + cl * 16 + 4 * cq) = make_float4(Avk[0], Avk[1], Avk[2], Avk[3]);
      {
        const bool isTA = ((lane >> 4) & 1) != 0;
        float X[16];
        {
          const float4* pv = (const float4*)(tVT + cl * 16);
          const float4 r0 = pv[0], r1 = pv[1], r2 = pv[2], r3 = pv[3];
          const float rh[16] = {r0.x, r0.y, r0.z, r0.w, r1.x, r1.y, r1.z, r1.w, r2.x, r2.y, r2.z, r2.w, r3.x, r3.y, r3.z, r3.w};
#pragma unroll
          for (int t = 0; t < 16; ++t) X[t] = isTA ? rh[t] : ((t == cl) ? 1.f : 0.f);
        }
#pragma unroll
        for (int t = 1; t < 16; ++t) {
          float a = X[t];
#pragma unroll
          for (int s4 = 0; s4 * 4 < t; ++s4) {
            const float4 ar = *(const float4*)(tA + t * 16 + 4 * s4);
            if (4 * s4 + 0 < t) a = fmaf(-ar.x, X[4 * s4 + 0], a);
            if (4 * s4 + 1 < t) a = fmaf(-ar.y, X[4 * s4 + 1], a);
            if (4 * s4 + 2 < t) a = fmaf(-ar.z, X[4 * s4 + 2], a);
            if (4 * s4 + 3 < t) a = fmaf(-ar.w, X[4 * s4 + 3], a);
          }
          X[t] = a;
        }
        bf16_t* sTT = (bf16_t*)(slot + RC_TT);
        if (lane < 32) {
#pragma unroll
          for (int t = 0; t < 16; ++t) sTT[((cl >> 2) * 16 + t) * 8 + (cl & 3) + (isTA ? 4 : 0)] = f2bf(X[t]);
        }
      }
    }
    __syncthreads();
    if (batch + 1 < 18) RC_LOAD_RAW((batch + 1) * 8 + wid);
    if (wid < 4) {
      const int itile = wid;
      bf16x8 nK0, nK1, nR0, nR1, nTT; uint2 nV;
#define RC_CONS_LOAD(sl_) do { nK0 = *(const bf16x8*)((sl_) + RC_KK + (cl * 72 + 8 * cq) * 2); nK1 = *(const bf16x8*)((sl_) + RC_KK + (cl * 72 + 32 + 8 * cq) * 2); \
        nR0 = *(const bf16x8*)((sl_) + RC_RR + (cl * 72 + 8 * cq) * 2); nR1 = *(const bf16x8*)((sl_) + RC_RR + (cl * 72 + 32 + 8 * cq) * 2); \
        nTT = *(const bf16x8*)((sl_) + RC_TT + lane * 16); nV = *(const uint2*)((sl_) + RC_V + (itile * 64 + lane) * 8); } while (0)
      RC_CONS_LOAD(smem);
#pragma unroll 1
      for (int k = 0; k < 8; ++k) {
        const unsigned char* sl = smem + k * RC_SLOT;
        const bf16x8 aK0 = nK0, aK1 = nK1, aR0 = nR0, aR1 = nR1, fTT = nTT; const uint2 fV = nV;
        const bf16x8 fMM = *(const bf16x8*)(sl + RC_MM + lane * 16);
        const bf16x8 Bs0 = rc_pack8(acc[0], acc[1]), Bs1 = rc_pack8(acc[2], acc[3]);
        f32x4 P = __builtin_amdgcn_mfma_f32_16x16x32_bf16(aK0, Bs0, zero4, 0, 0, 0); P = __builtin_amdgcn_mfma_f32_16x16x32_bf16(aK1, Bs1, P, 0, 0, 0);
        f32x4 Yv = __builtin_amdgcn_mfma_f32_16x16x32_bf16(aR0, Bs0, zero4, 0, 0, 0); Yv = __builtin_amdgcn_mfma_f32_16x16x32_bf16(aR1, Bs1, Yv, 0, 0, 0);
        if (k + 1 < 8) RC_CONS_LOAD(sl + RC_SLOT);
        const f32x4 SA = __builtin_amdgcn_mfma_f32_16x16x32_bf16(fTT, rc_pack8(P, fV), zero4, 0, 0, 0);
        const bf16x8 Bvs = rc_pack8(fV, SA);
        Yv = __builtin_amdgcn_mfma_f32_16x16x32_bf16(fMM, Bvs, Yv, 0, 0, 0);
#pragma unroll
        for (int jt = 0; jt < 4; ++jt) {
          const bf16x8 fKDB = *(const bf16x8*)(sl + RC_KDB + (jt * 64 + lane) * 16);
          const float4 g = *(const float4*)(sl + RC_G + (16 * jt + 4 * cq) * 4);
          acc[jt] = __builtin_amdgcn_mfma_f32_16x16x32_bf16(fKDB, Bvs, acc[jt], 0, 0, 0);
          acc[jt][0] *= g.x; acc[jt][1] *= g.y; acc[jt][2] *= g.z; acc[jt][3] *= g.w;
        }
        bool isctx; int seqlen, lo, rowbase; chunk_geom(batch * 8 + k, isctx, seqlen, lo, rowbase);
        if (!(l == 1 && isctx)) {
#pragma unroll
          for (int r = 0; r < 4; ++r) {
            const int t = 4 * cq + r, o = DIR ? (15 - t) : t;
            Y[(size_t)(rowbase + lo + o) * 256 + h * 64 + itile * 16 + cl] = Yv[r];
          }
        }
      }
    }
    __syncthreads();
  }
#undef RC_LDP
#undef RC_LDF
#undef RC_LOAD_RAW
#undef RC_CONS_LOAD
}

DEVI void s5_carry_item(const Params& p, int l, int g, int b) {
  unsigned char* ws = uws(p);
  const int tid = tid_();
  if (tid >= 128) return;
  const float* HE = (const float*)((unsigned char*)uout(p) + DO_HE) + (size_t)g * NCH * 256;
  bf16_t* UDH = (bf16_t*)(ws + WS_UDH) + (size_t)g * NCH * 768;
  const int dd = tid >> 6, pp = tid & 63;
  const float2 aT = ((const float2*)(ws + WS_APOW))[((size_t)(((l * 2 + dd) * 16 + g) * 64 + pp)) * 33 + 32];
  const int off = dd * 128 + pp;
  float hr = 0.f, hi = 0.f;
  {
    float er[8], ei[8];
#pragma unroll
    for (int c = 0; c < 8; ++c) { const int n = 1024 + b * 8 + (dd ? (7 - c) : c); er[c] = HE[(size_t)n * 256 + off]; ei[c] = HE[(size_t)n * 256 + off + 64]; }
#pragma unroll
    for (int c = 0; c < 8; ++c) {
      const int n = 1024 + b * 8 + (dd ? (7 - c) : c);
      UDH[(size_t)n * 768 + 512 + off] = f2bf(hr); UDH[(size_t)n * 768 + 512 + off + 64] = f2bf(hi);
      const float nr = aT.x * hr - aT.y * hi + er[c], ni = aT.x * hi + aT.y * hr + ei[c];
      hr = nr; hi = ni;
    }
  }
#pragma unroll 1
  for (int c0 = 0; c0 < 64; c0 += 16) {
    float er[16], ei[16];
#pragma unroll
    for (int c = 0; c < 16; ++c) { const int n = b * 64 + (dd ? (63 - c0 - c) : (c0 + c)); er[c] = HE[(size_t)n * 256 + off]; ei[c] = HE[(size_t)n * 256 + off + 64]; }
#pragma unroll
    for (int c = 0; c < 16; ++c) {
      const int n = b * 64 + (dd ? (63 - c0 - c) : (c0 + c));
      UDH[(size_t)n * 768 + 512 + off] = f2bf(hr); UDH[(size_t)n * 768 + 512 + off + 64] = f2bf(hi);
      const float nr = aT.x * hr - aT.y * hi + er[c], ni = aT.x * hi + aT.y * hr + ei[c];
      hr = nr; hi = ni;
    }
  }
}

struct S5Sched {
  const bf16_t* UDH; const bf16_t* TTG; int G, c, ntile;
  DEVI bool next(int i, g8::Unit& u) const {
    const int L = i * G + c; if (L >= 16 * ntile * 2) return false;
    u.e = L / (ntile * 2); const int r = L % (ntile * 2); u.pm = r >> 1; u.pn = r & 1; return true;
  }
  DEVI const char* a_base() const { return (const char*)UDH; }
  DEVI void a_offs(const g8::Unit& u, int tid, unsigned (&ao)[2][2]) const {
#pragma unroll
    for (int i = 0; i < 2; ++i) {
      int R, C; g8::stage_rc(tid * 16 + i * 8192, R, C);
#pragma unroll
      for (int h = 0; h < 2; ++h) ao[h][i] = ((unsigned)(u.e * NCH + u.pm * 256 + h * 128 + R) * 768u + (unsigned)C) * 2u;
    }
  }
  DEVI const char* b_ptr(const g8::Unit& u) const { return (const char*)(TTG + ((size_t)u.e * 512 + (size_t)u.pn * 256) * 768); }
};
struct EpiS5 {
  static constexpr bool PERM = true;
  bf16_t* ZB;
  DEVI void operator()(const f32x4 (&acc)[2][2][4][2], const g8::Unit& u) const {
    const int tid = tid_(), wid = __builtin_amdgcn_readfirstlane(tid >> 6), lane = tid & 63, wr = wid >> 2, wc = wid & 3, fr = lane & 15, fq = lane >> 4;
#pragma unroll
    for (int ai = 0; ai < 2; ++ai)
#pragma unroll
      for (int m = 0; m < 4; ++m) {
        const int n = u.pm * 256 + ai * 128 + wr * 64 + m * 16 + fr;
        if (n < NCH) {
#pragma unroll
          for (int bj = 0; bj < 2; ++bj) {
            const int mc = u.pn * 256 + bj * 128 + wc * 32 + 8 * fq, tau = mc >> 4, c = mc & 15;
            const f32x4 v0 = acc[ai][bj][m][0], v1 = acc[ai][bj][m][1];
            *(uint4*)(ZB + ((size_t)n * 32 + tau) * 256 + u.e * 16 + c) = make_uint4(pack2(gelu_tanh(v0[0]), gelu_tanh(v0[1])), pack2(gelu_tanh(v0[2]), gelu_tanh(v0[3])),
                                                                                   pack2(gelu_tanh(v1[0]), gelu_tanh(v1[1])), pack2(gelu_tanh(v1[2]), gelu_tanh(v1[3])));
          }
        }
        asm volatile("" ::: "memory");
      }
  }
};

DEVI void attn_item(const Params& p, int l, int b, int qb, int hq, unsigned char* smem) {
  unsigned char* ws = uws(p);
  const bf16_t* PROJ = (const bf16_t*)(ws + WS_PROJ);
  bf16_t* YMIX = (bf16_t*)(ws + WS_YMIX);
  bf16_t* sKV = (bf16_t*)smem;
  const int tid = tid_(), lane = tid & 63, wid = tid >> 6, r = lane & 31, hh = lane >> 5;
  const int kvh = hq >> 2;
  const bool ctxq = qb < 0;
  const int qrow0 = ctxq ? (NLAT + b * CTXL + wid * 32) : (b * SEQ + qb * 256 + wid * 32);
  const int q0pos = qb * 256 + wid * 32;
  bf16x8 qf[4];
  {
    const bf16_t* qp = PROJ + (size_t)(qrow0 + r) * DIN + 1280 + hq * 64 + hh * 8;
#pragma unroll
    for (int ks = 0; ks < 4; ++ks) qf[ks] = *(const bf16x8*)(qp + ks * 16);
  }
  f32x16 O0, O1;
#pragma unroll
  for (int i = 0; i < 16; ++i) { O0[i] = 0.f; O1[i] = 0.f; }
  float mrun = uin(p, I_SINK)[l * 8 + hq];
  float lsum = (hh == 0) ? 1.f : 0.f;
  const int jlo = ctxq ? 0 : (qb == 0 ? 2 : 0), jhi = ctxq ? 0 : (qb == 7 ? 6 : 8);
  const int nchunk = 4 + (jhi - jlo);
  const int nstage = (nchunk + 2) / 3;
  const int skey = tid >> 3, spc = (tid & 7) * 8;
  auto chunk_row0 = [&](int c) { return c < 4 ? (NLAT + b * CTXL + c * 64) : (b * SEQ + qb * 256 - 128 + (jlo + c - 4) * 64); };
  uint4 kr0, kr1, kr2, vr0, vr1, vr2;
  kr0 = kr1 = kr2 = vr0 = vr1 = vr2 = make_uint4(0, 0, 0, 0);
#define ATT_LOAD1(j, KR, VR, st_) do { const int c_ = (st_) * 3 + (j); if (c_ < nchunk) { \
    const bf16_t* kp_ = PROJ + (size_t)(chunk_row0(c_) + skey) * DIN + 1792 + kvh * 64 + spc; KR = *(const uint4*)kp_; VR = *(const uint4*)(kp_ + 128); } } while (0)
#define ATT_LOAD_STAGE(st_) do { ATT_LOAD1(0, kr0, vr0, st_); ATT_LOAD1(1, kr1, vr1, st_); ATT_LOAD1(2, kr2, vr2, st_); } while (0)
#define ATT_WRITE1(j, KR, VR) do { if (st * 3 + (j) < nchunk) { bf16_t* sKb_ = sB + (j) * (2 * 64 * 72); bf16_t* sVb_ = sKb_ + 64 * 72; \
    *(uint4*)(sKb_ + skey * 72 + spc) = KR; \
    sVb_[(spc + 0) * 72 + skey] = (bf16_t)(VR.x & 0xFFFF); sVb_[(spc + 1) * 72 + skey] = (bf16_t)(VR.x >> 16); \
    sVb_[(spc + 2) * 72 + skey] = (bf16_t)(VR.y & 0xFFFF); sVb_[(spc + 3) * 72 + skey] = (bf16_t)(VR.y >> 16); \
    sVb_[(spc + 4) * 72 + skey] = (bf16_t)(VR.z & 0xFFFF); sVb_[(spc + 5) * 72 + skey] = (bf16_t)(VR.z >> 16); \
    sVb_[(spc + 6) * 72 + skey] = (bf16_t)(VR.w & 0xFFFF); sVb_[(spc + 7) * 72 + skey] = (bf16_t)(VR.w >> 16); } } while (0)
  ATT_LOAD_STAGE(0);
  int buf = 0;
  for (int st = 0; st < nstage; ++st) {
    bf16_t* sB = sKV + buf * (6 * 64 * 72);
    ATT_WRITE1(0, kr0, vr0); ATT_WRITE1(1, kr1, vr1); ATT_WRITE1(2, kr2, vr2);
    __syncthreads();
    if (st + 1 < nstage) ATT_LOAD_STAGE(st + 1);
#pragma unroll 1
    for (int j = 0; j < 3; ++j) {
      const int c = st * 3 + j;
      if (c >= nchunk) break;
      const bf16_t* sKb = sB + j * (2 * 64 * 72); const bf16_t* sVb = sKb + 64 * 72;
      const bool band = c >= 4;
      const int kstart = band ? (qb * 256 - 128 + (jlo + c - 4) * 64) : 0;
#pragma unroll
      for (int tt = 0; tt < 2; ++tt) {
        const int ts = kstart + tt * 32;
        bool need = true, full = true;
        if (band) {
          need = (ts + 31 >= q0pos - 128) && (ts <= q0pos + 31 + 128);
          full = (ts >= q0pos + 31 - 128) && (ts + 31 <= q0pos + 128);
        }
        if (!need) continue;
        f32x16 S;
#pragma unroll
        for (int i = 0; i < 16; ++i) S[i] = 0.f;
#pragma unroll
        for (int ks = 0; ks < 4; ++ks) {
          const bf16x8 kf = *(const bf16x8*)(sKb + (tt * 32 + r) * 72 + ks * 16 + hh * 8);
          S = __builtin_amdgcn_mfma_f32_32x32x16_bf16(kf, qf[ks], S, 0, 0, 0);
        }
        if (!full) {
#pragma unroll
          for (int i = 0; i < 16; ++i) {
            const int kpos = ts + (i & 3) + 8 * (i >> 2) + 4 * hh;
            const int dl = (q0pos + r) - kpos;
            if (dl > 128 || dl < -128) S[i] = -1e30f;
          }
        }
        float mx = S[0];
#pragma unroll
        for (int i = 1; i < 16; ++i) mx = fmaxf(mx, S[i]);
        mx = fmaxf(mx, shfl_xor_l(mx, 32));
        const float mnew = fmaxf(mrun, mx);
        const float alpha = __expf(mrun - mnew);
        mrun = mnew;
        float ps = 0.f;
#pragma unroll
        for (int i = 0; i < 16; ++i) { S[i] = __expf(S[i] - mnew); ps += S[i]; }
        lsum = lsum * alpha + ps;
#pragma unroll
        for (int i = 0; i < 16; ++i) { O0[i] *= alpha; O1[i] *= alpha; }
        bf16x8 pf[2];
#pragma unroll
        for (int s2 = 0; s2 < 2; ++s2) {
          const uint4 u = make_uint4(pack2(S[8 * s2], S[8 * s2 + 1]), pack2(S[8 * s2 + 2], S[8 * s2 + 3]), pack2(S[8 * s2 + 4], S[8 * s2 + 5]), pack2(S[8 * s2 + 6], S[8 * s2 + 7]));
          pf[s2] = __builtin_bit_cast(bf16x8, u);
        }
#pragma unroll
        for (int s2 = 0; s2 < 2; ++s2) {
          {
            const bf16_t* vp = sVb + (0 * 32 + r) * 72 + tt * 32 + 16 * s2 + 4 * hh;
            const uint2 lo = *(const uint2*)vp, hi = *(const uint2*)(vp + 8);
            const uint4 u = make_uint4(lo.x, lo.y, hi.x, hi.y);
            O0 = __builtin_amdgcn_mfma_f32_32x32x16_bf16(__builtin_bit_cast(bf16x8, u), pf[s2], O0, 0, 0, 0);
          }
          {
            const bf16_t* vp = sVb + (1 * 32 + r) * 72 + tt * 32 + 16 * s2 + 4 * hh;
            const uint2 lo = *(const uint2*)vp, hi = *(const uint2*)(vp + 8);
            const uint4 u = make_uint4(lo.x, lo.y, hi.x, hi.y);
            O1 = __builtin_amdgcn_mfma_f32_32x32x16_bf16(__builtin_bit_cast(bf16x8, u), pf[s2], O1, 0, 0, 0);
          }
        }
      }
    }
    buf ^= 1;
  }
  const float lt = lsum + shfl_xor_l(lsum, 32);
  const float inv = 1.f / lt;
  bf16_t* op = YMIX + (size_t)(qrow0 + r) * D + 512 + hq * 64 + 4 * hh;
#pragma unroll
  for (int g4 = 0; g4 < 4; ++g4) {
    uint2 o; o.x = pack2(O0[4 * g4] * inv, O0[4 * g4 + 1] * inv); o.y = pack2(O0[4 * g4 + 2] * inv, O0[4 * g4 + 3] * inv);
    *(uint2*)(op + 8 * g4) = o;
    uint2 o1; o1.x = pack2(O1[4 * g4] * inv, O1[4 * g4 + 1] * inv); o1.y = pack2(O1[4 * g4 + 2] * inv, O1[4 * g4 + 3] * inv);
    *(uint2*)(op + 32 + 8 * g4) = o1;
  }
  __syncthreads();
}

DEVI void phase_mixers(const Params& p, int l, unsigned char* smem) {
  const int bid = bid_(), G = gridDim.x;
  const int nsb = (G >> 4) * 8 + ((G & 15) < 8 ? (G & 15) : 8);
  if (((bid >> 3) & 1) == 0) {
    for (int it = (bid >> 4) * 8 + (bid & 7); it < 128; it += nsb) { if (it & 1) rwkv_chunked<1>(p, l, it, smem); else rwkv_chunked<0>(p, l, it, smem); }
  }
  const int n_attn = (l == 0) ? 1152 : 1024, nq = 256 + n_attn;
  int* ctr = (int*)(uws(p) + WS_CTL) + 64 + l;
  volatile int* sTick = (volatile int*)(smem + SMEM_BYTES - 16);
  const int tid = tid_();
  __syncthreads();
  if (tid == 0) sTick[0] = atomicAdd(ctr, 1);
  __syncthreads();
  int cur = sTick[0];
  while (cur < nq) {
    int nxt = 0;
    if (tid == 0) nxt = atomicAdd(ctr, 1);
    if (cur >= n_attn) { const int c = cur - n_attn; s5_carry_item(p, l, c >> 4, c & 15); }
    else if (cur < 768) { const int bb = cur / 48, r = cur % 48; attn_item(p, l, bb, 1 + (r >> 3), r & 7, smem); }
    else if (cur < 1024) { const int a = cur - 768, bb = a >> 4, r = a & 15; attn_item(p, l, bb, (r >> 3) ? 7 : 0, r & 7, smem); }
    else attn_item(p, l, (cur - 1024) >> 3, -1, (cur - 1024) & 7, smem);
    __syncthreads();
    if (tid == 0) sTick[0] = nxt;
    __syncthreads();
    cur = sTick[0];
  }
}

DEVI void phase_mixfin(const Params& p, int l, unsigned char* smem) {
  unsigned char* ws = uws(p);
  const int tid = tid_(), bid = bid_(), G = gridDim.x;
  bf16_t* YMIX = (bf16_t*)(ws + WS_YMIX);
  {
    S5Sched S{(const bf16_t*)(ws + WS_UDH), (const bf16_t*)(ws + WS_TTG) + (size_t)l * 16 * 512 * 768, G, bid, (l == 1) ? 4 : 5};
    EpiS5 E{(bf16_t*)((unsigned char*)uout(p) + DO_ZB)};
    __syncthreads();
    g8::gemm((G8_LAS unsigned char*)smem, 768, S, E);
    __syncthreads();
  }
  {
    const bf16_t* PROJ = (const bf16_t*)(ws + WS_PROJ);
    const unsigned short* FEAT = (const unsigned short*)(ws + WS_FEAT);
    const float* YF = (const float*)((unsigned char*)uout(p) + DO_YF); const float* YB = (const float*)((unsigned char*)uout(p) + DO_YB);
    const float* CW = uin(p, I_CONV) + l * 3 * 1024;
    const int c4 = (tid & 15) * 4;
    const int nbusy = (16 * ((l == 1) ? 4 : 5) * 2 < G) ? 16 * ((l == 1) ? 4 : 5) * 2 : G;
    const int nvirt = nbusy + 2 * (G - nbusy);
    const int ustride = (nvirt * NTHREADS) >> 4;
    const int nun = ((l == 1) ? NLAT : NT) * 4;
    const int vb0 = (bid < nbusy) ? bid : nbusy + 2 * (bid - nbusy);
    const int u0 = (vb0 * NTHREADS + tid) >> 4;
    const int h = u0 & 3, hc = h * 64 + c4;
    float cwr[3][4], cwk[3][4], cwv[3][4], kaw[4], rkw[4], gnw[4], gnb[4];
#pragma unroll
    for (int dl = 0; dl < 3; ++dl)
#pragma unroll
      for (int e = 0; e < 4; ++e) { cwr[dl][e] = CW[dl * 1024 + hc + e]; cwk[dl][e] = CW[dl * 1024 + 256 + hc + e]; cwv[dl][e] = CW[dl * 1024 + 512 + hc + e]; }
#pragma unroll
    for (int e = 0; e < 4; ++e) { kaw[e] = uin(p, I_KA)[l * 256 + hc + e]; rkw[e] = uin(p, I_RK)[l * 256 + hc + e]; gnw[e] = uin(p, I_GNW)[l * 256 + hc + e]; gnb[e] = uin(p, I_GNB)[l * 256 + hc + e]; }
    for (int pass = 0; pass < ((bid < nbusy) ? 1 : 2); ++pass)
    for (int u = u0 + pass * 32; u < nun; u += ustride) {
      const int R = u >> 2;
      const int t = R < NLAT ? (R & 2047) : ((R - NLAT) & 255); const int len = R < NLAT ? SEQ : CTXL;
      const float4 yf = *(const float4*)(YF + (size_t)R * 256 + hc), yb = *(const float4*)(YB + (size_t)R * 256 + hc);
      float y[4] = {yf.x + yb.x, yf.y + yb.y, yf.z + yb.z, yf.w + yb.w};
      const float mu = row_sum16(y[0] + y[1] + y[2] + y[3]) * (1.f / 64.f);
      float q = 0.f;
#pragma unroll
      for (int e = 0; e < 4; ++e) { y[e] -= mu; q += y[e] * y[e]; }
      const float rstd = rsqrtf(row_sum16(q) * (1.f / 64.f) + GN_EPS);
      const bf16_t* pr = PROJ + (size_t)R * DIN + hc;
      const uint2 zc = make_uint2(0, 0);
      const uint2 rc = *(const uint2*)pr, kc = *(const uint2*)(pr + 256), vc = *(const uint2*)(pr + 512);
      uint2 rp = zc, kp = zc, vp = zc, rn = zc, kn = zc, vn = zc;
      if (t > 0) { rp = *(const uint2*)(pr - DIN); kp = *(const uint2*)(pr - DIN + 256); vp = *(const uint2*)(pr - DIN + 512); }
      if (t < len - 1) { rn = *(const uint2*)(pr + DIN); kn = *(const uint2*)(pr + DIN + 256); vn = *(const uint2*)(pr + DIN + 512); }
      const float rpf[4] = {lo_bf(rp.x), hi_bf(rp.x), lo_bf(rp.y), hi_bf(rp.y)}, rcf[4] = {lo_bf(rc.x), hi_bf(rc.x), lo_bf(rc.y), hi_bf(rc.y)}, rnf[4] = {lo_bf(rn.x), hi_bf(rn.x), lo_bf(rn.y), hi_bf(rn.y)};
      const float kpf[4] = {lo_bf(kp.x), hi_bf(kp.x), lo_bf(kp.y), hi_bf(kp.y)}, kcf[4] = {lo_bf(kc.x), hi_bf(kc.x), lo_bf(kc.y), hi_bf(kc.y)}, knf[4] = {lo_bf(kn.x), hi_bf(kn.x), lo_bf(kn.y), hi_bf(kn.y)};
      const float vpf[4] = {lo_bf(vp.x), hi_bf(vp.x), lo_bf(vp.y), hi_bf(vp.y)}, vcf[4] = {lo_bf(vc.x), hi_bf(vc.x), lo_bf(vc.y), hi_bf(vc.y)}, vnf[4] = {lo_bf(vn.x), hi_bf(vn.x), lo_bf(vn.y), hi_bf(vn.y)};
      const unsigned short* fr_ = FEAT + (size_t)R * 1280 + hc;
      const uint2 a0u = *(const uint2*)(fr_ + 512), a1u = *(const uint2*)(fr_ + 768), gtu = *(const uint2*)(fr_ + 1024);
      const float a0[4] = {h2f(a0u.x & 0xFFFF), h2f(a0u.x >> 16), h2f(a0u.y & 0xFFFF), h2f(a0u.y >> 16)};
      const float a1[4] = {h2f(a1u.x & 0xFFFF), h2f(a1u.x >> 16), h2f(a1u.y & 0xFFFF), h2f(a1u.y >> 16)};
      const float gt[4] = {h2f(gtu.x & 0xFFFF), h2f(gtu.x >> 16), h2f(gtu.y & 0xFFFF), h2f(gtu.y >> 16)};
      float bs = 0.f, vv[4];
#pragma unroll
      for (int e = 0; e < 4; ++e) {
        const float r = cwr[0][e] * rpf[e] + cwr[1][e] * rcf[e] + cwr[2][e] * rnf[e];
        const float k = cwk[0][e] * kpf[e] + cwk[1][e] * kcf[e] + cwk[2][e] * knf[e];
        vv[e] = cwv[0][e] * vpf[e] + cwv[1][e] * vcf[e] + cwv[2][e] * vnf[e];
        const float ksum = k * (2.f + (a0[e] + a1[e] - 2.f) * kaw[e]);
        bs += r * ksum * rkw[e];
      }
      bs = row_sum16(bs);
      float o[4];
#pragma unroll
      for (int e = 0; e < 4; ++e) {
        const float yn = y[e] * rstd * gnw[e] + gnb[e];
        o[e] = (yn + bs * vv[e]) * gt[e];
      }
      uint2 w; w.x = pack2(o[0], o[1]); w.y = pack2(o[2], o[3]);
      *(uint2*)(YMIX + (size_t)R * D + hc) = w;
    }
  }
}

struct EpiGlu {
  static constexpr bool PERM = true;
  const bf16_t* ZB; bf16_t* YMIX; const float* gb;
  DEVI void operator()(const f32x4 (&acc)[2][2][4][2], const g8::Unit& u) const {
    const int tid = tid_(), wid = __builtin_amdgcn_readfirstlane(tid >> 6), lane = tid & 63, wr = wid >> 2, wc = wid & 3, fr = lane & 15, fq = lane >> 4;
#pragma unroll
    for (int ai = 0; ai < 2; ++ai)
#pragma unroll
      for (int m = 0; m < 4; ++m) {
        const int row = u.pm * 256 + ai * 128 + wr * 64 + m * 16 + fr;
#pragma unroll
        for (int bj = 0; bj < 2; ++bj) {
          const int col = bj * 128 + wc * 32 + 8 * fq;
          const uint4 zz = *(const uint4*)(ZB + (size_t)row * 256 + col);
          const float4 b0 = *(const float4*)(gb + col), b1 = *(const float4*)(gb + col + 4);
          const f32x4 v0 = acc[ai][bj][m][0], v1 = acc[ai][bj][m][1];
          *(uint4*)(YMIX + (size_t)row * D + 256 + col) = make_uint4(
            pack2(lo_bf(zz.x) * sigmoidf(v0[0] + b0.x), hi_bf(zz.x) * sigmoidf(v0[1] + b0.y)), pack2(lo_bf(zz.y) * sigmoidf(v0[2] + b0.z), hi_bf(zz.y) * sigmoidf(v0[3] + b0.w)),
            pack2(lo_bf(zz.z) * sigmoidf(v1[0] + b1.x), hi_bf(zz.z) * sigmoidf(v1[1] + b1.y)), pack2(lo_bf(zz.w) * sigmoidf(v1[2] + b1.z), hi_bf(zz.w) * sigmoidf(v1[3] + b1.w)));
        }
        asm volatile("" ::: "memory");
      }
  }
};
DEVI void phase_glu(const Params& p, int l, unsigned char* smem) {
  unsigned char* ws = uws(p);
  g8::DenseSched S{(const bf16_t*)((unsigned char*)uout(p) + DO_ZB), (const bf16_t*)(ws + WS_GLU_T) + (size_t)l * 65536, 256, (l == 1) ? 128 : 144, 1, (int)gridDim.x, bid_()};
  EpiGlu E{(const bf16_t*)((unsigned char*)uout(p) + DO_ZB), (bf16_t*)(ws + WS_YMIX), uin(p, I_GLUB) + l * 256};
  __syncthreads();
  g8::gemm((G8_LAS unsigned char*)smem, 256, S, E);
  __syncthreads();
}

struct EpiBf16 {
  static constexpr bool PERM = true;
  bf16_t* O; int ldc;
  DEVI void operator()(const f32x4 (&acc)[2][2][4][2], const g8::Unit& u) const {
    const int tid = tid_(), wid = __builtin_amdgcn_readfirstlane(tid >> 6), lane = tid & 63, wr = wid >> 2, wc = wid & 3, fr = lane & 15, fq = lane >> 4;
#pragma unroll
    for (int ai = 0; ai < 2; ++ai)
#pragma unroll
      for (int m = 0; m < 4; ++m) {
        bf16_t* rowp = O + (size_t)(u.pm * 256 + ai * 128 + wr * 64 + m * 16 + fr) * ldc + u.pn * 256 + wc * 32 + 8 * fq;
#pragma unroll
        for (int bj = 0; bj < 2; ++bj) {
          const f32x4 v0 = acc[ai][bj][m][0], v1 = acc[ai][bj][m][1];
          *(uint4*)(rowp + bj * 128) = make_uint4(pack2(v0[0], v0[1]), pack2(v0[2], v0[3]), pack2(v1[0], v1[1]), pack2(v1[2], v1[3]));
        }
      }
  }
};
DEVI void phase_outproj(const Params& p, int l, unsigned char* smem) {
  unsigned char* ws = uws(p);
  g8::DenseSched S{(const bf16_t*)(ws + WS_YMIX), (const bf16_t*)(ws + WS_WOUT_T) + (size_t)l * D * D, D, (l == 1) ? 128 : 144, 4, (int)gridDim.x, bid_()};
  EpiBf16 E{(bf16_t*)(ws + WS_MIX), D};
  __syncthreads();
  g8::gemm((G8_LAS unsigned char*)smem, D, S, E);
  __syncthreads();
  if (l == 0) { const int G = gridDim.x, rem = (144 * 4) % G; if (rem == 0) build_ttg_em(p, 1, bid_(), G); else if (bid_() >= rem) build_ttg_em(p, 1, bid_() - rem, G - rem); }
}

DEVI void phase_ln1(const Params& p, int l, unsigned char* smem) {
  unsigned char* ws = uws(p);
  const int tid = tid_(), lane = tid & 63, wid = tid >> 6;
  const bf16_t* MIX = (const bf16_t*)(ws + WS_MIX);
  _Float16* X = (_Float16*)(ws + WS_X);
  bf16_t* H = (bf16_t*)(ws + WS_H);
  const float* MOD = (const float*)(ws + WS_MOD);
  const int nrows1 = (l == 1) ? NLAT : NT;
  const int nw = gridDim.x * 8, gw = bid_() * 8 + wid;
  const int rpw = (nrows1 + nw - 1) / nw;
  const int R0 = gw * rpw, R1 = (R0 + rpw < nrows1) ? (R0 + rpw) : nrows1;
  const int c0 = lane * 8, c1 = 512 + lane * 8;
  float g[2][8], bb[2][8], gt[2][8], sh[2][8], sc[2][8];
  ld8f(uin(p, I_LN1G) + l * D + c0, g[0]); ld8f(uin(p, I_LN1G) + l * D + c1, g[1]);
  ld8f(uin(p, I_LN1B) + l * D + c0, bb[0]); ld8f(uin(p, I_LN1B) + l * D + c1, bb[1]);
  int curb = -1;
  float xv[2][8], mx[2][8];
  auto load_row = [&](int Rr, float (&xo)[2][8], float (&mo)[2][8]) {
    if (l == 0) { const float* xr = xin_row(p, Rr); ld8f(xr + c0, xo[0]); ld8f(xr + c1, xo[1]); }
    else { const _Float16* xr = X + (size_t)Rr * D; ld8h(xr + c0, xo[0]); ld8h(xr + c1, xo[1]); }
    ld8b(MIX + (size_t)Rr * D + c0, mo[0]); ld8b(MIX + (size_t)Rr * D + c1, mo[1]);
  };
  if (R0 < R1) load_row(R0, xv, mx);
  for (int R = R0; R < R1; ++R) {
    float xn[2][8], mn[2][8];
#pragma unroll
    for (int h = 0; h < 2; ++h)
#pragma unroll
      for (int e = 0; e < 8; ++e) { xn[h][e] = 0.f; mn[h][e] = 0.f; }
    if (R + 1 < R1) load_row(R + 1, xn, mn);
    const int bi = bidx_of(R);
    if (bi != curb) {
      curb = bi;
      const float* modl = MOD + (size_t)(l * 17 + bi) * 6144;
      ld8f(modl + 2048 + c0, gt[0]); ld8f(modl + 2048 + c1, gt[1]);
      ld8f(modl + 3072 + c0, sh[0]); ld8f(modl + 3072 + c1, sh[1]);
      ld8f(modl + 4096 + c0, sc[0]); ld8f(modl + 4096 + c1, sc[1]);
    }
    float v[2][8]; float s = 0.f;
#pragma unroll
    for (int h = 0; h < 2; ++h)
#pragma unroll
      for (int e = 0; e < 8; ++e) { v[h][e] = ALPHA * xv[h][e] + gt[h][e] * mx[h][e]; s += v[h][e]; }
    const float mu = wave_sum(s) * (1.f / 1024.f);
    float q = 0.f;
#pragma unroll
    for (int h = 0; h < 2; ++h)
#pragma unroll
      for (int e = 0; e < 8; ++e) { v[h][e] -= mu; q += v[h][e] * v[h][e]; }
    const float rstd = rsqrtf(wave_sum(q) * (1.f / 1024.f) + LN_EPS);
#pragma unroll
    for (int h = 0; h < 2; ++h) {
      float x1[8], hm[8];
#pragma unroll
      for (int e = 0; e < 8; ++e) { x1[e] = v[h][e] * rstd * g[h][e] + bb[h][e]; hm[e] = x1[e] * (1.f + sc[h][e]) + sh[h][e]; }
      st8h(X + (size_t)R * D + (h ? c1 : c0), x1);
      st8b(H + (size_t)R * D + (h ? c1 : c0), hm);
    }
#pragma unroll
    for (int h = 0; h < 2; ++h)
#pragma unroll
      for (int e = 0; e < 8; ++e) { xv[h][e] = xn[h][e]; mx[h][e] = mn[h][e]; }
  }
}

DEVI void phase_router(const Params& p, int l, unsigned char* smem) {
  unsigned char* ws = uws(p);
  const int tid = tid_(), lrow = tid >> 2;
  const bf16_t* H = (const bf16_t*)(ws + WS_H);
  const bf16_t* RWH = (const bf16_t*)(ws + WS_RW) + (size_t)l * 2 * 128 * 1024;
  int* CNT = (int*)(ws + WS_CTL) + l * 32;
  int* LIST = (int*)(ws + WS_LIST);
  int4* ROUTE = (int4*)(ws + WS_ROUTE);
  float2* RWT = (float2*)(ws + WS_RWT);
  bf16_t* EW1 = (bf16_t*)(ws + WS_EW); bf16_t* EW2 = EW1 + (size_t)32 * 1024 * 1024;
  constexpr int N_CONV = 32 * 96;
  const int nmt = (l == 1) ? 128 : 144;
  for (int it0 = bid_(); it0 < nmt; it0 += gridDim.x) {
    {
      const int mt = it0;
      const bf16_t* a0 = H + (size_t)(mt * 256 + lrow) * D; const bf16_t* a1 = a0 + (size_t)128 * D;
      const bf16_t* b0 = RWH + (size_t)lrow * 1024;
      gemm_tile(smem, 0, D,
        [&](int i, int k) { return *(const uint4*)((i ? a1 : a0) + k); },
        [&](int k) { return *(const uint4*)(b0 + k); },
        [&](f32x4 (&acc)[4][4], int wr, int wc, int fr, int fq) {
          float* sLog = (float*)smem;
          if (wc == 0) {
#pragma unroll
            for (int m = 0; m < 4; ++m)
#pragma unroll
              for (int n = 0; n < 3; ++n)
#pragma unroll
                for (int j = 0; j < 4; ++j) { const int col = n * 16 + fq * 4 + j; if (col < 36) sLog[(wr * 64 + m * 16 + fr) * 37 + col] = acc[m][n][j]; }
          }
        });
      int* sHist = (int*)(smem + 40960); int* sBase = sHist + 32;
      if (tid < 32) sHist[tid] = 0;
      __syncthreads();
      int e1 = 0, e2 = 0, lp1 = 0, lp2 = 0; float w1 = 0.f, w2 = 0.f;
      if (tid < 256) {
        const float* lg = (const float*)smem + tid * 37;
        float gl[4]; int gi = 0; float gmax;
#pragma unroll
        for (int i = 0; i < 4; ++i) gl[i] = lg[i] + uin(p, I_RGB)[l * 4 + i];
        gmax = gl[0];
#pragma unroll
        for (int i = 1; i < 4; ++i) if (gl[i] > gmax) { gmax = gl[i]; gi = i; }
        float gs = 0.f;
#pragma unroll
        for (int i = 0; i < 4; ++i) gs += expf(gl[i] - gmax);
        const float gprob = 1.f / gs;
        float el[8];
#pragma unroll
        for (int j = 0; j < 8; ++j) el[j] = lg[4 + gi * 8 + j] + uin(p, I_REB)[l * 32 + gi * 8 + j];
        int i1 = 0; float l1 = el[0];
#pragma unroll
        for (int j = 1; j < 8; ++j) if (el[j] > l1) { l1 = el[j]; i1 = j; }
        int i2 = (i1 == 0) ? 1 : 0; float l2 = -3.0e38f;
#pragma unroll
        for (int j = 0; j < 8; ++j) if (j != i1 && el[j] > l2) { l2 = el[j]; i2 = j; }
        const float ex = expf(l2 - l1);
        w1 = gprob / (1.f + ex); w2 = gprob * ex / (1.f + ex);
        e1 = gi * 8 + i1; e2 = gi * 8 + i2;
        lp1 = atomicAdd(&sHist[e1], 1); lp2 = atomicAdd(&sHist[e2], 1);
      }
      __syncthreads();
      if (tid < 32) sBase[tid] = atomicAdd(&CNT[tid], sHist[tid]);
      __syncthreads();
      if (tid < 256) {
        const int R = mt * 256 + tid;
        const int p1 = sBase[e1] + lp1, p2 = sBase[e2] + lp2;
        LIST[(size_t)e1 * NT + p1] = R; LIST[(size_t)e2 * NT + p2] = R;
        ROUTE[R] = make_int4(e1, p1, e2, p2);
        RWT[R] = make_float2(w1, w2);
      }
      __syncthreads();
    }
  }
  {
    auto conv_src = [&](int j, const float*& src, int& ld, int& k0, int& n0) {
      const int e = j / 96, r = j % 96;
      if (r < 64) { const int kt = r >> 2, ct = r & 3, up = ct >> 1; src = (up ? uin(p, I_EWU) : uin(p, I_EWG)) + (size_t)(l * 32 + e) * 1024 * 512; ld = 512; k0 = kt * 64; n0 = (ct & 1) * 256; }
      else { const int r2 = r - 64, kt = r2 >> 2, ntl = r2 & 3; src = uin(p, I_EWD) + (size_t)(l * 32 + e) * 512 * 1024; ld = 1024; k0 = kt * 64; n0 = ntl * 256; }
    };
    const int G = gridDim.x;
    int j = bid_();
    TrRegs cur, nxt;
    const float* src; int ld, k0, n0;
    if (j < N_CONV) { conv_src(j, src, ld, k0, n0); transpose_load(cur, src, ld, k0, n0); }
    while (j < N_CONV) {
      int jn;
      if (j < 8 * G) { jn = j + G; if (jn >= 8 * G) jn = (bid_() >= nmt) ? (8 * G + bid_() - nmt) : N_CONV; }
      else jn = j + (G - nmt);
      if (jn < N_CONV) { const float* s2; int ld2, k2, n2; conv_src(jn, s2, ld2, k2, n2); transpose_load(nxt, s2, ld2, k2, n2); }
      const int e = j / 96, r = j % 96;
      if (r < 64) {
        const int kt = r >> 2, ct = r & 3, up = ct >> 1;
        transpose_finish(smem, cur, kt * 64, (ct & 1) * 256, EW1 + (size_t)e * 1024 * 1024, 1024,
          [&](int c) { return 256 * (c >> 7) + 128 * ((c >> 6) & 1) + 32 * ((c >> 4) & 3) + 16 * up + (c & 15); });
      } else {
        const int r2 = r - 64, kt = r2 >> 2, ntl = r2 & 3;
        transpose_finish(smem, cur, kt * 64, ntl * 256, EW2 + (size_t)e * 1024 * 512, 512, [](int n) { return n; });
      }
      cur = nxt; j = jn;
    }
  }
}

DEVI void moe_prefix(const Params& p, int l, int* sPre, int* sCnt) {
  const int* CNT = (const int*)(uws(p) + WS_CTL) + l * 32;
  if (tid_() == 0) {
    int s = 0;
    for (int e = 0; e < 32; ++e) { const int c = CNT[e]; sCnt[e] = c; sPre[e] = s; s += (c + 255) >> 8; }
    sPre[32] = s;
  }
  __syncthreads();
  {
    unsigned char* sBlkE = (unsigned char*)sPre + (MISC_BLKE - MISC_PRE);
    const int nb = sPre[32];
    for (int rb = tid_(); rb < nb; rb += NTHREADS) { int e = 0; for (int q = 1; q < 32; ++q) if (sPre[q] <= rb) e = q; sBlkE[rb] = (unsigned char)e; }
  }
  __syncthreads();
}

struct MoeSched {
  const int* sPre; const int* sCnt; const unsigned char* sBlkE; const bf16_t* Abase; const int* LIST; const bf16_t* Wbase; int K; size_t wstride; int nN, G, c, gather;
  DEVI bool next(int i, g8::Unit& u) const {
    const int nwg = sPre[32] * nN; const long L = (long)i * G + c; if (L >= nwg) return false;
    const int w = g8::xcd_remap((int)L, nwg);
    u.pm = w / nN; u.pn = w % nN;
    u.e = sBlkE[u.pm]; return true;
  }
  DEVI const char* a_base() const { return (const char*)Abase; }
  DEVI void a_offs(const g8::Unit& u, int tid, unsigned (&ao)[2][2]) const {
#pragma unroll
    for (int i = 0; i < 2; ++i) {
      int R, C; g8::stage_rc(tid * 16 + i * 8192, R, C);
#pragma unroll
      for (int h = 0; h < 2; ++h) {
        int row = u.pm * 256 + h * 128 + R;
        if (gather) {
          const int sl = (u.pm - sPre[u.e]) * 256 + h * 128 + R;
          row = LIST[(size_t)u.e * NT + (sl < sCnt[u.e] ? sl : 0)];
        }
        ao[h][i] = ((unsigned)row * (unsigned)K + (unsigned)C) * 2u;
      }
    }
  }
  DEVI const char* b_ptr(const g8::Unit& u) const { return (const char*)(Wbase + (size_t)u.e * wstride + (size_t)u.pn * 256 * K); }
};
struct EpiMoe1 {
  static constexpr bool PERM = false;
  bf16_t* ACT;
  DEVI void operator()(const f32x4 (&acc)[2][2][4][2], const g8::Unit& u) const {
    const int tid = tid_(), wid = __builtin_amdgcn_readfirstlane(tid >> 6), lane = tid & 63, wr = wid >> 2, wc = wid & 3, fr = lane & 15, fq = lane >> 4;
#pragma unroll
    for (int ai = 0; ai < 2; ++ai)
#pragma unroll
      for (int m = 0; m < 4; ++m) {
        const size_t slot = (size_t)u.pm * 256 + ai * 128 + wr * 64 + m * 16 + fr;
#pragma unroll
        for (int bj = 0; bj < 2; ++bj) {
          const f32x4 g = acc[ai][bj][m][0], up = acc[ai][bj][m][1];
          float o[4];
#pragma unroll
          for (int j = 0; j < 4; ++j) o[j] = g[j] * __builtin_amdgcn_rcpf(1.f + __expf(-g[j])) * up[j];
          uint2 w; w.x = pack2(o[0], o[1]); w.y = pack2(o[2], o[3]);
          *(uint2*)(ACT + slot * 512 + u.pn * 128 + bj * 64 + wc * 16 + 4 * fq) = w;
        }
      }
  }
};
DEVI void phase_moe1(const Params& p, int l, unsigned char* smem) {
  unsigned char* ws = uws(p);
  int* sPre = (int*)(smem + SMEM_BYTES + MISC_PRE); int* sCnt = (int*)(smem + SMEM_BYTES + MISC_CNT);
  moe_prefix(p, l, sPre, sCnt);
  MoeSched S{sPre, sCnt, (const unsigned char*)(smem + SMEM_BYTES + MISC_BLKE), (const bf16_t*)(ws + WS_H), (const int*)(ws + WS_LIST), (const bf16_t*)(ws + WS_EW), D, (size_t)1024 * 1024, 4, (int)gridDim.x, bid_(), 1};
  EpiMoe1 E{(bf16_t*)(ws + WS_ACT)};
  g8::gemm((G8_LAS unsigned char*)smem, D, S, E);
  __syncthreads();
}
DEVI void phase_moe2(const Params& p, int l, unsigned char* smem) {
  unsigned char* ws = uws(p);
  int* sPre = (int*)(smem + SMEM_BYTES + MISC_PRE); int* sCnt = (int*)(smem + SMEM_BYTES + MISC_CNT);
  moe_prefix(p, l, sPre, sCnt);
  MoeSched S{sPre, sCnt, (const unsigned char*)(smem + SMEM_BYTES + MISC_BLKE), (const bf16_t*)(ws + WS_ACT), (const int*)(ws + WS_LIST), (const bf16_t*)(ws + WS_EW) + (size_t)32 * 1024 * 1024, 512, (size_t)1024 * 512, 4, (int)gridDim.x, bid_(), 0};
  EpiBf16 E{(bf16_t*)(ws + WS_YROWS), D};
  g8::gemm((G8_LAS unsigned char*)smem, 512, S, E);
  __syncthreads();
}

DEVI void phase_ln2(const Params& p, int l, unsigned char* smem) {
  unsigned char* ws = uws(p);
  int* sPre = (int*)(smem + SMEM_BYTES + MISC_PRE); int* sCnt = (int*)(smem + SMEM_BYTES + MISC_CNT);
  moe_prefix(p, l, sPre, sCnt);
  const int tid = tid_(), lane = tid & 63, wid = tid >> 6;
  _Float16* X = (_Float16*)(ws + WS_X);
  const bf16_t* YR = (const bf16_t*)(ws + WS_YROWS);
  const int4* ROUTE = (const int4*)(ws + WS_ROUTE);
  const float2* RWT = (const float2*)(ws + WS_RWT);
  const float* MOD = (const float*)(ws + WS_MOD);
  const float* g2 = uin(p, I_LN2G) + l * D; const float* b2 = uin(p, I_LN2B) + l * D;
  bf16_t* XM = (bf16_t*)((unsigned char*)uout(p) + DO_XMOD);
  const int nrows = (l == 0) ? NT : NLAT;
  const int nw = gridDim.x * 8, gw = bid_() * 8 + wid;
  const int rpw = (nrows + nw - 1) / nw;
  const int R0 = gw * rpw, R1 = (R0 + rpw < nrows) ? (R0 + rpw) : nrows;
  const int c0 = lane * 8, c1 = 512 + lane * 8;
  float g[2][8], bb[2][8], gt[2][8], sh1n[2][8], sc1n[2][8];
  ld8f(g2 + c0, g[0]); ld8f(g2 + c1, g[1]); ld8f(b2 + c0, bb[0]); ld8f(b2 + c1, bb[1]);
  int curb = -1;
  float xv[2][8], ua[2][8], ub[2][8]; float2 rw = make_float2(0.f, 0.f);
  int4 rt_n = make_int4(0, 0, 0, 0); float2 rw_n = make_float2(0.f, 0.f);
  auto load_data = [&](int Rr, const int4& rt, float (&xo)[2][8], float (&ao)[2][8], float (&bo)[2][8]) {
    const bf16_t* ya = YR + ((size_t)sPre[rt.x] * 256 + rt.y) * 1024; const bf16_t* yb = YR + ((size_t)sPre[rt.z] * 256 + rt.w) * 1024;
    const _Float16* xr = X + (size_t)Rr * D;
    ld8h(xr + c0, xo[0]); ld8h(xr + c1, xo[1]); ld8b(ya + c0, ao[0]); ld8b(ya + c1, ao[1]); ld8b(yb + c0, bo[0]); ld8b(yb + c1, bo[1]);
  };
  if (R0 < R1) { const int4 rt0 = ROUTE[R0]; rw = RWT[R0]; load_data(R0, rt0, xv, ua, ub); }
  if (R0 + 1 < R1) { rt_n = ROUTE[R0 + 1]; rw_n = RWT[R0 + 1]; }
  for (int R = R0; R < R1; ++R) {
    float xn[2][8], an[2][8], bn[2][8];
#pragma unroll
    for (int h = 0; h < 2; ++h)
#pragma unroll
      for (int e = 0; e < 8; ++e) { xn[h][e] = 0.f; an[h][e] = 0.f; bn[h][e] = 0.f; }
    if (R + 1 < R1) load_data(R + 1, rt_n, xn, an, bn);
    const float2 rw_next = rw_n;
    if (R + 2 < R1) { rt_n = ROUTE[R + 2]; rw_n = RWT[R + 2]; }
    const int bi = bidx_of(R);
    if (bi != curb) {
      curb = bi;
      const float* modl = MOD + (size_t)(l * 17 + bi) * 6144;
      ld8f(modl + 5120 + c0, gt[0]); ld8f(modl + 5120 + c1, gt[1]);
      if (l == 0) {
        const float* modn = MOD + (size_t)(1 * 17 + bi) * 6144;
        ld8f(modn + c0, sh1n[0]); ld8f(modn + c1, sh1n[1]); ld8f(modn + 1024 + c0, sc1n[0]); ld8f(modn + 1024 + c1, sc1n[1]);
      }
    }
    float v[2][8]; float s = 0.f;
#pragma unroll
    for (int h = 0; h < 2; ++h)
#pragma unroll
      for (int e = 0; e < 8; ++e) { v[h][e] = ALPHA * xv[h][e] + gt[h][e] * (rw.x * ua[h][e] + rw.y * ub[h][e]); s += v[h][e]; }
    const float mu = wave_sum(s) * (1.f / 1024.f);
    float q = 0.f;
#pragma unroll
    for (int h = 0; h < 2; ++h)
#pragma unroll
      for (int e = 0; e < 8; ++e) { v[h][e] -= mu; q += v[h][e] * v[h][e]; }
    const float rstd = rsqrtf(wave_sum(q) * (1.f / 1024.f) + LN_EPS);
#pragma unroll
    for (int h = 0; h < 2; ++h) {
      float x2[8];
#pragma unroll
      for (int e = 0; e < 8; ++e) x2[e] = v[h][e] * rstd * g[h][e] + bb[h][e];
      const int cc = h ? c1 : c0;
      if (l == 0) {
        st8h(X + (size_t)R * D + cc, x2);
        float xm[8];
#pragma unroll
        for (int e = 0; e < 8; ++e) xm[e] = x2[e] * (1.f + sc1n[h][e]) + sh1n[h][e];
        st8b(XM + (size_t)R * D + cc, xm);
      } else {
        st8f(uout(p) + (size_t)R * D + cc, x2);
      }
    }
#pragma unroll
    for (int h = 0; h < 2; ++h)
#pragma unroll
      for (int e = 0; e < 8; ++e) { xv[h][e] = xn[h][e]; ua[h][e] = an[h][e]; ub[h][e] = bn[h][e]; }
    rw = rw_next;
  }
}

#define XB_TMO      128
#define XB_XCNT(j)  (256  + 64 * (j))
#define XB_XSUB(j)  (1280 + 64 * (j))
#define XB_XGEN(j)  (2304 + 64 * (j))
#define XB_TOP      3328
#define XB_TOPGEN   3392
#define XCD_BAR_WORDS 3456
#define XB_SPIN_CAP (1u << 20)
DEVI unsigned xb_ld(unsigned* p) { return __hip_atomic_load(p, __ATOMIC_RELAXED, __HIP_MEMORY_SCOPE_AGENT); }
DEVI unsigned xb_add(unsigned* p, unsigned v) { return __hip_atomic_fetch_add(p, v, __ATOMIC_RELAXED, __HIP_MEMORY_SCOPE_AGENT); }
DEVI unsigned xb_xcc_id() { return (unsigned)__builtin_amdgcn_s_getreg((3 << 11) | 20) & 0xFu; }
#define XB_SPIN(cond, bar) do { unsigned _sp = 0; while (cond) { __builtin_amdgcn_s_sleep(1); \
    if ((++_sp & 255u) == 0u) { if (xb_ld(&(bar)[XB_TMO])) break; if (_sp > XB_SPIN_CAP) { atomicAdd(&(bar)[XB_TMO], 1u); break; } } } } while (0)
DEVI void xcd_barrier_complete(unsigned* bar, unsigned x, unsigned& nloc, unsigned& nx) {
  const unsigned G = gridDim.x;
  unsigned sum, cnt, mine, sp = 0u;
  for (;;) {
    sum = 0u; cnt = 0u; mine = 0u;
#pragma unroll
    for (unsigned j = 0; j < 16; ++j) { const unsigned c = xb_ld(&bar[XB_XCNT(j)]); sum += c; cnt += (c > 0u) ? 1u : 0u; mine = (j == x) ? c : mine; }
    if (sum == G) break;
    __builtin_amdgcn_s_sleep(1);
    if ((++sp & 255u) == 0u) { if (xb_ld(&bar[XB_TMO])) break; if (sp > XB_SPIN_CAP) { atomicAdd(&bar[XB_TMO], 1u); break; } }
  }
  nloc = mine > 0u ? mine : 1u; nx = cnt > 0u ? cnt : 1u;
}
DEVI void xcd_barrier(unsigned* bar, volatile unsigned* st) {
  asm volatile("s_waitcnt vmcnt(0)" ::: "memory");
  __syncthreads();
  if (threadIdx.x == 0) {
    __builtin_amdgcn_s_waitcnt(0);
    const unsigned x = xb_xcc_id();
    unsigned nloc = st[0], nx = st[1];
    if (nloc == 0u) { xcd_barrier_complete(bar, x, nloc, nx); st[0] = nloc; st[1] = nx; }
    const unsigned old = xb_add(&bar[XB_XSUB(x)], 1u);
    const unsigned gen = old / nloc;
    if (old + 1u == (gen + 1u) * nloc) {
      __builtin_amdgcn_fence(__ATOMIC_RELEASE, "agent");
      asm volatile("s_waitcnt vmcnt(0)" ::: "memory");
      const unsigned og = xb_add(&bar[XB_TOP], 1u);
      const unsigned tg = og / nx;
      if (og + 1u == (tg + 1u) * nx) xb_add(&bar[XB_TOPGEN], 1u);
      else XB_SPIN(xb_ld(&bar[XB_TOPGEN]) == tg, bar);
      __builtin_amdgcn_fence(__ATOMIC_ACQUIRE, "agent");
      xb_add(&bar[XB_XGEN(x)], 1u);
      asm volatile("s_waitcnt vmcnt(0)" ::: "memory");
    } else {
      XB_SPIN(xb_ld(&bar[XB_XGEN(x)]) == gen, bar);
      __builtin_amdgcn_fence(__ATOMIC_ACQUIRE, "agent");
      asm volatile("s_waitcnt vmcnt(0)" ::: "memory");
    }
  }
  __syncthreads();
}

constexpr int N_PHASES = 24;
DEVI void run_phase(const Params& p, int ph, unsigned char* smem) {
  if (ph == 0) { phase0a(p, smem); return; }
  if (ph == 1) { phase0b(p, smem); return; }
  const int l = (ph - 2) / 11, s = (ph - 2) % 11;
  switch (s) {
    case 0: phase_inproj(p, l, smem); break;
    case 1: phase_feat(p, l, smem); break;
    case 2: phase_mixers(p, l, smem); break;
    case 3: phase_mixfin(p, l, smem); break;
    case 4: phase_glu(p, l, smem); break;
    case 5: phase_outproj(p, l, smem); break;
    case 6: phase_ln1(p, l, smem); break;
    case 7: phase_router(p, l, smem); break;
    case 8: phase_moe1(p, l, smem); break;
    case 9: phase_moe2(p, l, smem); break;
    default: phase_ln2(p, l, smem); break;
  }
}

__global__ void __launch_bounds__(NTHREADS, 2) fwd_megakernel(Params pk) {
  extern __shared__ __attribute__((aligned(16))) unsigned char smem[];
  Params* spp = (Params*)(smem + SMEM_BYTES + MISC_PARAMS);
  if (threadIdx.x == 0) { *spp = pk; ((volatile unsigned*)(smem + SMEM_BYTES + MISC_XB))[0] = 0u; ((volatile unsigned*)(smem + SMEM_BYTES + MISC_XB))[1] = 0u; }
  __syncthreads();
  const Params& p = *spp;
  const int ph_lo = __builtin_amdgcn_readfirstlane(p.ph_lo), ph_hi = __builtin_amdgcn_readfirstlane(p.ph_hi);
#if MK_MULTI
  for (int ph = ph_lo; ph < ph_hi; ++ph) run_phase(p, ph, smem);
#else
  cg::grid_group grid = cg::this_grid();
  if (threadIdx.x == 0) (void)xb_add(&((unsigned*)(uws(p) + WS_BAR))[XB_XCNT(xb_xcc_id())], 1u);
  for (int ph = ph_lo; ph < ph_hi; ++ph) {
    run_phase(p, ph, smem);
#ifdef DUP_MASK
    if ((DUP_MASK >> ph) & 1) { __syncthreads(); run_phase(p, ph, smem); }
#endif
    if (ph + 1 < ph_hi) {
      if (ph == ph_lo) grid.sync();
      else xcd_barrier((unsigned*)(uws(p) + WS_BAR), (volatile unsigned*)(smem + SMEM_BYTES + MISC_XB));
    }
  }
#endif
}

extern "C" void kernel_launch(void* const* d_in, const int* in_sizes, int n_in, void* d_out, int out_size,
                              void* d_ws, size_t ws_size, hipStream_t stream) {
  static int grid_blocks = 0;
  if (!grid_blocks) {
    int dev = 0, cus = 0, per_cu = 0;
    (void)hipGetDevice(&dev);
    (void)hipDeviceGetAttribute(&cus, hipDeviceAttributeMultiprocessorCount, dev);
    (void)hipFuncSetAttribute((const void*)fwd_megakernel, hipFuncAttributeMaxDynamicSharedMemorySize, DSM_BYTES);
    (void)hipOccupancyMaxActiveBlocksPerMultiprocessor(&per_cu, fwd_megakernel, NTHREADS, DSM_BYTES);
    if (per_cu > 1) per_cu = 1;
    grid_blocks = cus * per_cu;
    if (n_in != N_IN || out_size != NLAT * D || ws_size < WS_END) {
      fprintf(stderr, "kernel_launch: unexpected sizes n_in=%d out=%d ws=%zu (need %zu)\n", n_in, out_size, ws_size, (size_t)WS_END);
      grid_blocks = -1;
    }
    fprintf(stderr, "kernel_launch: grid=%d (cus=%d per_cu=%d) ws=%zu\n", grid_blocks, cus, per_cu, ws_size);
  }
  if (grid_blocks <= 0) return;
  Params p{};
  for (int i = 0; i < N_IN; ++i) p.in[i] = (const float*)d_in[i];
  p.out = (float*)d_out; p.ws = (unsigned char*)d_ws;
#if MK_MULTI
  for (int ph = 0; ph < N_PHASES; ++ph) {
    p.ph_lo = ph; p.ph_hi = ph + 1;
    hipLaunchKernelGGL(fwd_megakernel, dim3(grid_blocks), dim3(NTHREADS), DSM_BYTES, stream, p);
  }
#else
  p.ph_lo = 0; p.ph_hi = N_PHASES;
  (void)hipMemsetAsync((unsigned char*)d_ws + WS_BAR, 0, XCD_BAR_WORDS * 4, stream);
  void* args[] = {&p};
  hipError_t e = hipLaunchCooperativeKernel((void*)fwd_megakernel, dim3(grid_blocks), dim3(NTHREADS), args, DSM_BYTES, stream);
  if (e != hipSuccess) fprintf(stderr, "cooperative launch failed: %s (grid %d)\n", hipGetErrorString(e), grid_blocks);
#endif
}
```

```cpp
#include <hip/hip_runtime.h>
#include <hip/hip_cooperative_groups.h>
#include <cstdio>
#include <cstdint>
namespace cg = cooperative_groups;

#ifndef MK_MULTI
#define MK_MULTI 0
#endif

#define DEVI __device__ __forceinline__
typedef unsigned short bf16_t;
typedef short bf16x8 __attribute__((ext_vector_type(8)));
typedef float f32x4 __attribute__((ext_vector_type(4)));
typedef float f32x16 __attribute__((ext_vector_type(16)));

constexpr int D = 1024, NB = 16, SEQ = 2048, CTXL = 256;
constexpr int NLAT = NB * SEQ;
constexpr int NCTX = NB * CTXL;
constexpr int NT = NLAT + NCTX;
constexpr int DIN = 2048;
constexpr int NTHREADS = 512;
constexpr float ALPHA = 1.41421356237309515f;
constexpr float LN_EPS = 1e-5f, GN_EPS = 64e-5f;
constexpr int NCH = NT / 32;
constexpr int SLOT_CAP = 81920;

enum { I_X = 0, I_C, I_CTX, I_CCTX, I_WMOD, I_BMOD, I_WIN, I_CONV, I_W0, I_W2, I_A0, I_A2, I_G2, I_KK, I_KA, I_RK, I_GNW, I_GNB,
       I_LRE, I_LIM, I_LDT, I_BRE, I_BIM, I_CRE, I_CIM, I_SD, I_GLUW, I_GLUB, I_SINK, I_WOUT, I_LN1G, I_LN1B, I_LN2G, I_LN2B,
       I_RGW, I_RGB, I_REW, I_REB, I_EWG, I_EWU, I_EWD, N_IN };

constexpr size_t MiB = 1048576;
constexpr size_t WS_CTL = 0;
constexpr size_t WS_BAR = 512 * 1024;
constexpr size_t WS_MOD = 1 * MiB;
constexpr size_t WS_ROPE = 2 * MiB;
constexpr size_t WS_WIN_T = 4 * MiB;
constexpr size_t WS_WOUT_T = 12 * MiB;
constexpr size_t WS_FW = 16 * MiB;
constexpr size_t WS_GLU_T = 18 * MiB;
constexpr size_t WS_RW = 19 * MiB;
constexpr size_t WS_KTAB = 20 * MiB;
constexpr size_t WS_TTG = 22 * MiB;
constexpr size_t WS_EM = 46 * MiB;
constexpr size_t WS_HC = 54 * MiB;
constexpr size_t WS_LIST = 63 * MiB;
constexpr size_t WS_ROUTE = 68 * MiB;
constexpr size_t WS_RWT = 69 * MiB;
constexpr size_t WS_APOW = 70 * MiB;
constexpr size_t WS_BBT = 71 * MiB + 512 * 1024;
constexpr size_t WS_X = 72 * MiB;
constexpr size_t WS_R = 216 * MiB;
constexpr size_t WS_PROJ = WS_R;
constexpr size_t WS_FEAT = WS_R + 144 * MiB;
constexpr size_t WS_YMIX = WS_R + 234 * MiB;
constexpr size_t WS_MIX = WS_R + 144 * MiB;
constexpr size_t WS_EW = WS_R;
constexpr size_t WS_H = WS_R + 234 * MiB;
constexpr size_t WS_ACT = WS_R + 96 * MiB;
constexpr size_t WS_YROWS = WS_R + 176 * MiB;
constexpr size_t WS_UDH = WS_R + 336 * MiB;
constexpr size_t WS_END = WS_UDH + 28 * MiB;
constexpr size_t DO_XMOD = 0;
constexpr size_t DO_YF = 0;
constexpr size_t DO_YB = 36 * MiB;
constexpr size_t DO_HE = 72 * MiB;
constexpr size_t DO_ZB = 90 * MiB;

struct Params {
  const float* in[N_IN];
  float* out;
  unsigned char* ws;
  int ph_lo, ph_hi;
};


DEVI unsigned long long rfl64(unsigned long long v) { const unsigned lo = __builtin_amdgcn_readfirstlane((unsigned)v), hi = __builtin_amdgcn_readfirstlane((unsigned)(v >> 32)); return ((unsigned long long)hi << 32) | lo; }
DEVI unsigned char* uws(const Params& p) { return (unsigned char*)rfl64((unsigned long long)p.ws); }
DEVI float* uout(const Params& p) { return (float*)rfl64((unsigned long long)p.out); }
DEVI const float* uin(const Params& p, int i) { return (const float*)rfl64((unsigned long long)p.in[i]); }

DEVI float bf2f(bf16_t v) { return __uint_as_float(((unsigned)v) << 16); }
typedef __bf16 hwbf2 __attribute__((ext_vector_type(2)));
typedef float hwf2 __attribute__((ext_vector_type(2)));
DEVI bf16_t f2bf(float f) { return __builtin_bit_cast(unsigned short, (__bf16)f); }
DEVI unsigned pack2(float a, float b) { const hwf2 v = {a, b}; return __builtin_bit_cast(unsigned, __builtin_convertvector(v, hwbf2)); }
DEVI float lo_bf(unsigned u) { return __uint_as_float(u << 16); }
DEVI float hi_bf(unsigned u) { return __uint_as_float(u & 0xFFFF0000u); }
DEVI unsigned short f2h(float f) { _Float16 h = (_Float16)f; return __builtin_bit_cast(unsigned short, h); }
DEVI float h2f(unsigned short u) { return (float)__builtin_bit_cast(_Float16, u); }
DEVI float sigmoidf(float x) { return __builtin_amdgcn_rcpf(1.f + __expf(-x)); }
DEVI float gelu_tanh(float x) { const float u = 0.7978845608028654f * (x + 0.044715f * x * x * x); return x - x * __builtin_amdgcn_rcpf(1.f + __expf(2.f * u)); }

template <int CTRL> DEVI float dpp_f(float x) { return __int_as_float(__builtin_amdgcn_update_dpp(0, __float_as_int(x), CTRL, 0xF, 0xF, false)); }
DEVI float row_sum16(float x) {
  x += dpp_f<0xB1>(x);
  x += dpp_f<0x4E>(x);
  x += dpp_f<0x141>(x);
  x += dpp_f<0x140>(x);
  return x;
}
DEVI float shfl_xor_l(float x, int m) {
  int lane = (int)__builtin_amdgcn_mbcnt_hi(~0u, __builtin_amdgcn_mbcnt_lo(~0u, 0u));
  asm volatile("" : "+v"(lane));
  return __int_as_float(__builtin_amdgcn_ds_bpermute((lane ^ m) << 2, __float_as_int(x)));
}
DEVI float wave_sum(float x) { x = row_sum16(x); x += shfl_xor_l(x, 16); x += shfl_xor_l(x, 32); return x; }

DEVI int tid_() { int t = threadIdx.x; asm volatile("" : "+v"(t)); return t; }
DEVI int bid_() { int b = blockIdx.x; asm volatile("" : "+s"(b)); return b; }
DEVI void ld8f(const float* p, float (&o)[8]) { const float4 a = *(const float4*)p, b = *(const float4*)(p + 4); o[0] = a.x; o[1] = a.y; o[2] = a.z; o[3] = a.w; o[4] = b.x; o[5] = b.y; o[6] = b.z; o[7] = b.w; }
DEVI void ld8b(const bf16_t* p, float (&o)[8]) { const uint4 u = *(const uint4*)p; o[0] = lo_bf(u.x); o[1] = hi_bf(u.x); o[2] = lo_bf(u.y); o[3] = hi_bf(u.y); o[4] = lo_bf(u.z); o[5] = hi_bf(u.z); o[6] = lo_bf(u.w); o[7] = hi_bf(u.w); }
DEVI void st8f(float* p, const float (&v)[8]) { *(float4*)p = make_float4(v[0], v[1], v[2], v[3]); *(float4*)(p + 4) = make_float4(v[4], v[5], v[6], v[7]); }
DEVI void st8b(bf16_t* p, const float (&v)[8]) { *(uint4*)p = make_uint4(pack2(v[0], v[1]), pack2(v[2], v[3]), pack2(v[4], v[5]), pack2(v[6], v[7])); }
typedef _Float16 hx8 __attribute__((ext_vector_type(8)));
DEVI void ld8h(const _Float16* p, float (&o)[8]) { const hx8 u = *(const hx8*)p;
#pragma unroll
  for (int e = 0; e < 8; ++e) o[e] = (float)u[e]; }
DEVI void st8h(_Float16* p, const float (&v)[8]) { hx8 u;
#pragma unroll
  for (int e = 0; e < 8; ++e) u[e] = (_Float16)v[e];
  *(hx8*)p = u; }

DEVI int bidx_of(int R) { return R < NLAT ? (R >> 11) : 16; }
DEVI const float* xin_row(const Params& p, int R) { return R < NLAT ? uin(p, I_X) + (size_t)R * D : uin(p, I_CTX) + (size_t)(R - NLAT) * D; }

constexpr int LDT = 40;
constexpr int SMEM_BYTES = 143360;
constexpr int DSM_BYTES = SMEM_BYTES + 1024;
constexpr int MISC_PARAMS = 0, MISC_PRE = 384, MISC_CNT = 528, MISC_BLKE = 656, MISC_XB = 1008;
template <class AL, class BL, class EP>
DEVI void gemm_tile(unsigned char* smem, int kbeg, int kend, AL&& aload, BL&& bload, EP&& epi) {
  const int tid = tid_(), lane = tid & 63, wid = tid >> 6;
  const int wr = wid >> 1, wc = wid & 1, fr = lane & 15, fq = lane >> 4;
  bf16_t* sA = (bf16_t*)smem;
  bf16_t* sB = (bf16_t*)(smem + 2 * 256 * LDT * 2);
  const int lrow = tid >> 2, kq = (tid & 3) * 8;
  f32x4 acc[4][4];
#pragma unroll
  for (int m = 0; m < 4; ++m)
#pragma unroll
    for (int n = 0; n < 4; ++n) acc[m][n] = (f32x4){0.f, 0.f, 0.f, 0.f};
  uint4 ra0 = aload(0, kbeg + kq), ra1 = aload(1, kbeg + kq), rb = bload(kbeg + kq);
  int buf = 0;
#pragma unroll 1
  for (int k = kbeg; k < kend; k += 32) {
    *(uint4*)(sA + (buf * 256 + lrow) * LDT + kq) = ra0;
    *(uint4*)(sA + (buf * 256 + lrow + 128) * LDT + kq) = ra1;
    *(uint4*)(sB + (buf * 128 + lrow) * LDT + kq) = rb;
    __syncthreads();
    if (k + 32 < kend) { ra0 = aload(0, k + 32 + kq); ra1 = aload(1, k + 32 + kq); rb = bload(k + 32 + kq); }
    bf16x8 bfr[4];
#pragma unroll
    for (int n = 0; n < 4; ++n) bfr[n] = *(const bf16x8*)(sB + (buf * 128 + wc * 64 + n * 16 + fr) * LDT + fq * 8);
#pragma unroll
    for (int m = 0; m < 4; ++m) {
      const bf16x8 af = *(const bf16x8*)(sA + (buf * 256 + wr * 64 + m * 16 + fr) * LDT + fq * 8);
#pragma unroll
      for (int n = 0; n < 4; ++n) acc[m][n] = __builtin_amdgcn_mfma_f32_16x16x32_bf16(bfr[n], af, acc[m][n], 0, 0, 0);
    }
    buf ^= 1;
  }
  __syncthreads();
  epi(acc, wr, wc, fr, fq);
}


namespace g8 {
#define G8_LAS __attribute__((address_space(3)))
constexpr int BM = 256, BK = 64, HALF = 128, HTB = HALF * BK * 2;
DEVI int lds_byte(int r, int c) { const int st = (r >> 4) * 2 + (c >> 5), rr = r & 15, cc = c & 31, ob = rr * 64 + cc * 2; return st * 1024 + (ob ^ (((ob >> 9) & 1) << 5)); }
DEVI void stage_rc(int b, int& R, int& C) { const int st = b / 1024, sb = b % 1024, swz = sb ^ (((sb >> 9) & 1) << 5); R = (st >> 1) * 16 + swz / 64; C = (st & 1) * 32 + (swz % 64) / 2; }
DEVI int perm32(int rho) { const int n = rho >> 4, i = rho & 15; return 8 * (i >> 2) + 4 * n + (i & 3); }
struct Unit { int pm, pn, e; };
DEVI int xcd_remap(int L, int n) { const int q = n >> 3, r = n & 7, x = L & 7, off = L >> 3; return (x < r ? x * (q + 1) : r * (q + 1) + (x - r) * q) + off; }

template <class Epi, class Sched>
DEVI void gemm(G8_LAS unsigned char* lds, const int Kin, const Sched& S, const Epi& E) {
  int K = Kin; asm volatile("" : "+s"(K));
  const int tid = tid_(), wid = __builtin_amdgcn_readfirstlane(tid >> 6), lane = tid & 63, wr = wid >> 2, wc = wid & 3, fr = lane & 15, fq = lane >> 4;
  const int nt = K / BK;
  unsigned voffB[2];
#pragma unroll
  for (int i = 0; i < 2; ++i) { int R, C; stage_rc(tid * 16 + i * 8192, R, C); const int Rb = Epi::PERM ? ((R & ~31) + perm32(R & 31)) : R; voffB[i] = (unsigned)(Rb * K + C) * 2u; }
  const size_t kstep = (size_t)(BK * 2);
  const size_t hstepB = (size_t)HALF * K * 2;
  const unsigned ldsw = (unsigned)wid * 1024u;
  const int aoff = lds_byte(wr * 64 + fr, fq * 8), boff = lds_byte(wc * 32 + fr, fq * 8);
#define G8_SA(b, h) (((b) * 2 + (h)) * HTB)
#define G8_SB(b, h) ((4 + (b) * 2 + (h)) * HTB)
#define G8_STAGE_B(bufoff, gbase) do { _Pragma("unroll") for (int _i = 0; _i < 2; ++_i) \
    __builtin_amdgcn_global_load_lds((const unsigned*)((const char*)(gbase) + voffB[_i]), (G8_LAS unsigned*)(lds + (bufoff) + ldsw + _i * 8192), 16, 0, 0); } while (0)
#define G8_STAGE_A(bufoff, ubase, o0, o1) do { \
    __builtin_amdgcn_global_load_lds((const unsigned*)((ubase) + (o0)), (G8_LAS unsigned*)(lds + (bufoff) + ldsw), 16, 0, 0); \
    __builtin_amdgcn_global_load_lds((const unsigned*)((ubase) + (o1)), (G8_LAS unsigned*)(lds + (bufoff) + ldsw + 8192), 16, 0, 0); } while (0)
#define G8_LDA(dst, b, h) do { _Pragma("unroll") for (int m = 0; m < 4; ++m) _Pragma("unroll") for (int k = 0; k < 2; ++k) dst[m][k] = *(const G8_LAS bf16x8*)(lds + G8_SA(b, h) + aoff + m * 2048 + k * 1024); } while (0)
#define G8_LDB(dst, b, h) do { _Pragma("unroll") for (int n = 0; n < 2; ++n) _Pragma("unroll") for (int k = 0; k < 2; ++k) dst[n][k] = *(const G8_LAS bf16x8*)(lds + G8_SB(b, h) + boff + n * 2048 + k * 1024); } while (0)
#define G8_MMA(ai, bj, At, Bt) do { __builtin_amdgcn_s_setprio(1); _Pragma("unroll") for (int m = 0; m < 4; ++m) _Pragma("unroll") for (int n = 0; n < 2; ++n) _Pragma("unroll") for (int k = 0; k < 2; ++k) \
    acc[ai][bj][m][n] = __builtin_amdgcn_mfma_f32_16x16x32_bf16(Bt[n][k], At[m][k], acc[ai][bj][m][n], 0, 0, 0); __builtin_amdgcn_s_setprio(0); } while (0)
#define G8_WAIT_V(n) asm volatile("s_waitcnt vmcnt(" #n ")" ::: "memory")
#define G8_WAIT_L(n) asm volatile("s_waitcnt lgkmcnt(" #n ")" ::: "memory")
#define G8_BAR __builtin_amdgcn_s_barrier()
#define G8_SCHED __builtin_amdgcn_sched_barrier(0)
  Unit cur, nxt; int ui = 0;
  if (!S.next(0, cur)) return;
  f32x4 acc[2][2][4][2];
#pragma unroll
  for (int a = 0; a < 2; ++a)
#pragma unroll
    for (int b = 0; b < 2; ++b)
#pragma unroll
      for (int m = 0; m < 4; ++m)
#pragma unroll
        for (int n = 0; n < 2; ++n) acc[a][b][m][n] = (f32x4){0.f, 0.f, 0.f, 0.f};
  bf16x8 At[4][2], B0[2][2], B1[2][2];
  unsigned cA[2][2], nA[2][2];
  const char* const Ab = S.a_base();
  S.a_offs(cur, tid, cA);
  const char* cB = S.b_ptr(cur);
  G8_STAGE_B(G8_SB(0, 0), cB); G8_STAGE_A(G8_SA(0, 0), Ab, cA[0][0], cA[0][1]); G8_STAGE_B(G8_SB(0, 1), cB + hstepB); G8_STAGE_A(G8_SA(0, 1), Ab, cA[1][0], cA[1][1]);
  if (wr == 1) G8_BAR;
  G8_WAIT_V(4); G8_BAR;
  G8_STAGE_B(G8_SB(1, 0), cB + kstep); G8_STAGE_A(G8_SA(1, 0), Ab + kstep, cA[0][0], cA[0][1]); G8_STAGE_B(G8_SB(1, 1), cB + hstepB + kstep);
  G8_WAIT_V(6); G8_BAR;
  for (;;) {
    const bool has_next = S.next(ui + 1, nxt);
    const char* nB = cB;
    if (has_next) { S.a_offs(nxt, tid_(), nA); nB = S.b_ptr(nxt); }
    else { nA[0][0] = cA[0][0]; nA[0][1] = cA[0][1]; nA[1][0] = cA[1][0]; nA[1][1] = cA[1][1]; }
    for (int t = 0; t < nt; t += 2) {
      const bool last = (t == nt - 2);
      const size_t k1 = (size_t)(t + 1) * kstep, k2 = (size_t)(t + 2) * kstep;
      const char* b2 = last ? nB : cB + k2; const char* b3 = b2 + kstep;
      const char* Ab2 = last ? Ab : Ab + k2;
      unsigned a2[2][2];
#pragma unroll
      for (int h = 0; h < 2; ++h)
#pragma unroll
        for (int i = 0; i < 2; ++i) a2[h][i] = last ? nA[h][i] : cA[h][i];
      G8_LDB(B0, 0, 0); G8_SCHED; G8_LDA(At, 0, 0); G8_STAGE_A(G8_SA(1, 1), Ab + k1, cA[1][0], cA[1][1]);
      G8_WAIT_L(8); G8_BAR; G8_WAIT_L(0); G8_MMA(0, 0, At, B0); G8_BAR; G8_SCHED;
      G8_LDB(B1, 0, 1); G8_STAGE_B(G8_SB(0, 0), b2);
      G8_BAR; G8_WAIT_L(0); G8_MMA(0, 1, At, B1); G8_BAR;
      G8_LDA(At, 0, 1); G8_STAGE_A(G8_SA(0, 0), Ab2, a2[0][0], a2[0][1]);
      G8_BAR; G8_WAIT_L(0); G8_MMA(1, 0, At, B0); G8_BAR; G8_SCHED;
      G8_STAGE_B(G8_SB(0, 1), b2 + hstepB);
      G8_WAIT_V(6); G8_BAR; G8_MMA(1, 1, At, B1); G8_BAR;
      G8_LDB(B0, 1, 0); G8_SCHED; G8_LDA(At, 1, 0); G8_STAGE_A(G8_SA(0, 1), Ab2, a2[1][0], a2[1][1]);
      G8_WAIT_L(8); G8_BAR; G8_WAIT_L(0); G8_MMA(0, 0, At, B0); G8_BAR; G8_SCHED;
      G8_LDB(B1, 1, 1); G8_STAGE_B(G8_SB(1, 0), b3);
      G8_BAR; G8_WAIT_L(0); G8_MMA(0, 1, At, B1); G8_BAR;
      G8_LDA(At, 1, 1); G8_STAGE_A(G8_SA(1, 0), Ab2 + kstep, a2[0][0], a2[0][1]);
      G8_BAR; G8_WAIT_L(0); G8_MMA(1, 0, At, B0); G8_BAR; G8_SCHED;
      G8_STAGE_B(G8_SB(1, 1), b3 + hstepB);
      G8_WAIT_V(6); G8_BAR; G8_MMA(1, 1, At, B1); G8_BAR;
    }
    E(acc, cur);
    if (!has_next) break;
#pragma unroll
    for (int a = 0; a < 2; ++a)
#pragma unroll
      for (int b = 0; b < 2; ++b)
#pragma unroll
        for (int m = 0; m < 4; ++m)
#pragma unroll
          for (int n = 0; n < 2; ++n) acc[a][b][m][n] = (f32x4){0.f, 0.f, 0.f, 0.f};
    cur = nxt; cB = nB; ++ui;
#pragma unroll
    for (int h = 0; h < 2; ++h)
#pragma unroll
      for (int i = 0; i < 2; ++i) cA[h][i] = nA[h][i];
  }
  G8_WAIT_V(0);
  if (wr == 0) G8_BAR;
  G8_BAR;
#undef G8_SA
#undef G8_SB
#undef G8_STAGE_A
#undef G8_STAGE_B
#undef G8_LDA
#undef G8_LDB
#undef G8_MMA
#undef G8_WAIT_V
#undef G8_WAIT_L
#undef G8_BAR
#undef G8_SCHED
}

struct DenseSched {
  const bf16_t* A; const bf16_t* Bt; int K, nM, nN, G, c;
  DEVI bool next(int i, Unit& u) const {
    const int nwg = nM * nN; const long L = (long)i * G + c; if (L >= nwg) return false;
    const int wgid = xcd_remap((int)L, nwg);
    const int nig = 8 * nN, gid = wgid / nig, fm = gid * 8, gsz = (nM - fm) < 8 ? (nM - fm) : 8;
    u.pm = fm + ((wgid % nig) % gsz); u.pn = (wgid % nig) / gsz; u.e = 0; return true;
  }
  DEVI const char* a_base() const { return (const char*)A; }
  DEVI void a_offs(const Unit& u, int tid, unsigned (&ao)[2][2]) const {
#pragma unroll
    for (int i = 0; i < 2; ++i) {
      int R, C; stage_rc(tid * 16 + i * 8192, R, C);
#pragma unroll
      for (int h = 0; h < 2; ++h) ao[h][i] = ((unsigned)(u.pm * 256 + h * 128 + R) * (unsigned)K + (unsigned)C) * 2u;
    }
  }
  DEVI const char* b_ptr(const Unit& u) const { return (const char*)(Bt + (size_t)u.pn * 256 * K); }
};
}

struct TrRegs { float4 v[2][4]; };
DEVI void transpose_load(TrRegs& t, const float* __restrict__ src, int ld_src, int k0, int n0) {
  const int tid = tid_();
  const int kr = tid >> 4, c4 = (tid & 15) * 4;
#pragma unroll
  for (int i = 0; i < 2; ++i)
#pragma unroll
    for (int w = 0; w < 4; ++w) t.v[i][w] = *(const float4*)(src + (size_t)(k0 + kr + 32 * i) * ld_src + n0 + w * 64 + c4);
}
template <class RM>
DEVI void transpose_finish(unsigned char* smem, const TrRegs& t, int k0, int n0, bf16_t* dst, int ld_dst, RM&& rowmap) {
  bf16_t* T = (bf16_t*)smem;
  const int tid = tid_();
  const int kr = tid >> 4, c4 = (tid & 15) * 4;
#pragma unroll
  for (int i = 0; i < 2; ++i)
#pragma unroll
    for (int w = 0; w < 4; ++w) {
      const int kk = kr + 32 * i; bf16_t* tp = T + (w * 64 + c4) * 72 + kk;
      tp[0] = f2bf(t.v[i][w].x); tp[72] = f2bf(t.v[i][w].y); tp[144] = f2bf(t.v[i][w].z); tp[216] = f2bf(t.v[i][w].w);
    }
  __syncthreads();
  const int k8 = (tid & 7) * 8;
#pragma unroll
  for (int j = 0; j < 4; ++j) {
    const int nn = (tid >> 3) + 64 * j;
    const uint4 o = *(const uint4*)(T + nn * 72 + k8);
    *(uint4*)(dst + (size_t)rowmap(n0 + nn) * ld_dst + k0 + k8) = o;
  }
  __syncthreads();
}
template <class RM>
DEVI void transpose_tile(unsigned char* smem, const float* __restrict__ src, int ld_src, int k0, int n0, bf16_t* dst, int ld_dst, RM&& rowmap) {
  TrRegs t; transpose_load(t, src, ld_src, k0, n0);
  transpose_finish(smem, t, k0, n0, dst, ld_dst, rowmap);
}

struct S5Disc { float lm, th, ar, ai, cr, ci; };
DEVI S5Disc s5disc(const Params& p, int l, int d, int g, int pp) {
  const int idx = ((l * 2 + d) * 16 + g) * 64 + pp;
  const float lr = uin(p, I_LRE)[idx], li = uin(p, I_LIM)[idx];
  const float dt = expf(uin(p, I_LDT)[(l * 2 + d) * 16 + g]);
  S5Disc r; r.lm = lr * dt; r.th = li * dt;
  const float mag = expf(r.lm), cs = cosf(r.th), sn = sinf(r.th), sh = sinf(0.5f * r.th);
  r.ar = mag * cs; r.ai = mag * sn;
  const float nr = expm1f(r.lm) * cs - 2.f * sh * sh, ni = r.ai, den = lr * lr + li * li;
  r.cr = (nr * lr + ni * li) / den; r.ci = (ni * lr - nr * li) / den;
  return r;
}

DEVI void phase0a(const Params& p, unsigned char* smem) {
  const int tid = tid_(), bid = bid_(), G = gridDim.x;
  unsigned char* ws = uws(p);
  if (bid == 0 && tid < 128) ((int*)(ws + WS_CTL))[tid] = 0;
  constexpr int N_MOD = 384, N_KT = 256, N_ROPE = 128, N_TRW = 256 + 128, N_EL = 640;
  constexpr int N_AP = 265;
  constexpr int N_BB = 128;
  const int total = N_MOD + N_KT + N_ROPE + N_TRW + N_EL + N_AP + N_BB;
  for (int it0 = bid; it0 < total; it0 += G) {
    int it = it0;
    if (it < N_MOD) {
      const int l = it / 192, col0 = (it % 192) * 32;
      const int c = tid & 31, kg = tid >> 5;
      float* sS = (float*)smem;
      float acc[17];
#pragma unroll
      for (int b = 0; b < 17; ++b) acc[b] = 0.f;
      const float* W = uin(p, I_WMOD) + (size_t)l * D * 6144 + col0 + c;
      for (int kc = 0; kc < 4; ++kc) {
        __syncthreads();
        for (int e = tid; e < 17 * 256; e += NTHREADS) {
          const int b = e >> 8, k = kc * 256 + (e & 255);
          const float cv = (b < 16) ? uin(p, I_C)[b * D + k] : uin(p, I_CCTX)[k];
          sS[e] = cv / (1.f + __expf(-cv));
        }
        __syncthreads();
        float wv[16];
#pragma unroll
        for (int i = 0; i < 16; ++i) wv[i] = W[(size_t)(kc * 256 + kg + 16 * i) * 6144];
#pragma unroll
        for (int i = 0; i < 16; ++i) {
          const int kl = kg + 16 * i;
#pragma unroll
          for (int b = 0; b < 17; ++b) acc[b] = fmaf(sS[b * 256 + kl], wv[i], acc[b]);
        }
      }
      __syncthreads();
      float* sR = (float*)smem;
#pragma unroll
      for (int b = 0; b < 17; ++b) sR[(kg * 17 + b) * 32 + c] = acc[b];
      __syncthreads();
      for (int e = tid; e < 17 * 32; e += NTHREADS) {
        const int b = e >> 5, cc = e & 31;
        float s = 0.f;
#pragma unroll
        for (int q = 0; q < 16; ++q) s += sR[(q * 17 + b) * 32 + cc];
        ((float*)(ws + WS_MOD))[(size_t)(l * 17 + b) * 6144 + col0 + cc] = s + uin(p, I_BMOD)[l * 6144 + col0 + cc];
      }
      __syncthreads();
      continue;
    }
    it -= N_MOD;
    if (it < N_KT) {
      const int gid = it * NTHREADS + tid;
      const int pg = gid & 7, cc = (gid >> 3) & 255, c = cc >> 4, c2 = cc & 15;
      const int lgd = gid >> 11, d = lgd & 1, g = (lgd >> 1) & 15, l = lgd >> 5;
      float K[32];
#pragma unroll
      for (int j = 0; j < 32; ++j) K[j] = 0.f;
      for (int q = 0; q < 8; ++q) {
        const int pp = pg * 8 + q;
        const S5Disc dd = s5disc(p, l, d, g, pp);
        const float ar = dd.ar, ai = dd.ai;
        const float br = uin(p, I_BRE)[((l * 16 + g) * 64 + pp) * 16 + c2], bi = uin(p, I_BIM)[((l * 16 + g) * 64 + pp) * 16 + c2];
        const float bbr = dd.cr * br - dd.ci * bi, bbi = dd.cr * bi + dd.ci * br;
        const float cr = uin(p, I_CRE)[((l * 16 + g) * 16 + c) * 64 + pp], ci = uin(p, I_CIM)[((l * 16 + g) * 16 + c) * 64 + pp];
        const float zr = cr * bbr - ci * bbi, zi = cr * bbi + ci * bbr;
        float pr = 1.f, pi = 0.f;
#pragma unroll
        for (int j = 0; j < 32; ++j) {
          K[j] += zr * pr - zi * pi;
          const float nr = pr * ar - pi * ai, ni = pr * ai + pi * ar;
          pr = nr; pi = ni;
        }
      }
#pragma unroll
      for (int j = 0; j < 32; ++j) { float v = K[j]; v += dpp_f<0xB1>(v); v += dpp_f<0x4E>(v); v += dpp_f<0x141>(v); K[j] = v; }
      if (pg == 0) {
        float* KT = (float*)(ws + WS_KTAB) + (size_t)(((l * 16 + g) * 2 + d) * 32) * 256 + c * 16 + c2;
#pragma unroll
        for (int j = 0; j < 32; ++j) KT[j * 256] = K[j];
      }
      continue;
    }
    it -= N_KT;
    if (it < N_ROPE) {
      const int e = it * NTHREADS + tid;
      const int pos = e >> 5, i = e & 31;
      const float inv = powf(10000.f, -(float)(i & 15) / 16.f);
      const float ang = (float)((i < 16) ? (pos >> 6) : (pos & 63)) * inv;
      ((float*)(ws + WS_ROPE))[e] = cosf(ang);
      ((float*)(ws + WS_ROPE))[65536 + e] = sinf(ang);
      continue;
    }
    it -= N_ROPE;
    if (it < N_TRW) {
      if (it < 256) {
        const int l = it >> 7, r = it & 127, kt = r >> 3, ntl = r & 7;
        transpose_tile(smem, uin(p, I_WIN) + (size_t)l * D * DIN, DIN, kt * 64, ntl * 256, (bf16_t*)(ws + WS_WIN_T) + (size_t)l * DIN * D, D,
          [](int n) { if (n >= 1280 && n < 1920) { const int d = n & 63; return (n & ~63) + 32 * ((d >> 4) & 1) + 8 * ((d >> 2) & 3) + 4 * (d >> 5) + (d & 3); } return n; });
      } else {
        const int r0 = it - 256, l = r0 >> 6, r = r0 & 63, kt = r >> 2, ntl = r & 3;
        transpose_tile(smem, uin(p, I_WOUT) + (size_t)l * D * D, D, kt * 64, ntl * 256, (bf16_t*)(ws + WS_WOUT_T) + (size_t)l * D * D, D, [](int n) { return n; });
      }
      continue;
    }
    it -= N_TRW;
    if (it < N_EL) {
      for (int q = 0; q < 4; ++q) {
        int e = (it * 4 + q) * NTHREADS + tid;
        if (e < 655360) {
          const int l = e / 327680, r = e % 327680, n = r >> 8, k = r & 255;
          float v = 0.f;
          if (n < 512) { const int d = n >> 8, col = n & 255; if (k < 64) v = uin(p, I_W2)[((l * 2 + d) * 64 + k) * 256 + col]; }
          else if (n < 1024) { const int d = (n - 512) >> 8, col = n & 255; if (k >= 64 && k < 128) v = uin(p, I_A2)[((l * 2 + d) * 64 + (k - 64)) * 256 + col]; }
          else { const int col = n - 1024; if (k >= 128) v = uin(p, I_G2)[(l * 128 + (k - 128)) * 256 + col]; }
          ((bf16_t*)(ws + WS_FW))[e] = f2bf(v);
          continue;
        }
        e -= 655360;
        if (e < 131072) {
          const int l = e >> 16, r = e & 65535, n = r >> 8, k = r & 255;
          ((bf16_t*)(ws + WS_GLU_T))[e] = f2bf(uin(p, I_GLUW)[(l * 256 + k) * 256 + n]);
          continue;
        }
        e -= 131072;
        if (e < 524288) {
          const int l = e >> 18, r = e & 262143, hl = r >> 17, n = (r >> 10) & 127, k = r & 1023;
          float v = 0.f;
          if (n < 4) v = uin(p, I_RGW)[(l * D + k) * 4 + n];
          else if (n < 36) v = uin(p, I_REW)[(l * D + k) * 32 + (n - 4)];
          const bf16_t h = f2bf(v);
          ((bf16_t*)(ws + WS_RW))[e] = hl ? f2bf(v - bf2f(h)) : h;
        }
      }
      continue;
    }
    it -= N_EL;
    if (it < N_AP) {
      const int e = it * NTHREADS + tid;
      if (e < 2 * 2 * 16 * 64 * 33) {
        const int j = e % 33, r = e / 33, pp = r & 63, g = (r >> 6) & 15, d = (r >> 10) & 1, l = r >> 11;
        const S5Disc dd = s5disc(p, l, d, g, pp);
        const float mg = expf(dd.lm * (float)j), an = dd.th * (float)j;
        ((float2*)(ws + WS_APOW))[e] = make_float2(mg * cosf(an), mg * sinf(an));
      }
      continue;
    }
    it -= N_AP;
    {
      const int e = it * NTHREADS + tid;
      const int c2 = e & 15, pp = (e >> 4) & 63, g = (e >> 10) & 15, d = (e >> 14) & 1, l = e >> 15;
      const S5Disc dd = s5disc(p, l, d, g, pp);
      const float br = uin(p, I_BRE)[((l * 16 + g) * 64 + pp) * 16 + c2], bi = uin(p, I_BIM)[((l * 16 + g) * 64 + pp) * 16 + c2];
      ((float2*)(ws + WS_BBT))[e] = make_float2(dd.cr * br - dd.ci * bi, dd.cr * bi + dd.ci * br);
    }
  }
}

DEVI void write_xmod_row(const float4 v[4], const float* modl, bf16_t* dstrow, int lane) {
#pragma unroll
  for (int i = 0; i < 4; ++i) {
    const int col = i * 256 + lane * 4;
    const float4 sh = *(const float4*)(modl + col), sc = *(const float4*)(modl + 1024 + col);
    uint2 o; o.x = pack2(v[i].x * (1.f + sc.x) + sh.x, v[i].y * (1.f + sc.y) + sh.y); o.y = pack2(v[i].z * (1.f + sc.z) + sh.z, v[i].w * (1.f + sc.w) + sh.w);
    *(uint2*)(dstrow + col) = o;
  }
}
DEVI void phase0b(const Params& p, unsigned char* smem) {
  const int tid = tid_(), bid = bid_(), G = gridDim.x, lane = tid & 63, wid = tid >> 6;
  unsigned char* ws = uws(p);
  {
    bf16_t* XM = (bf16_t*)((unsigned char*)uout(p) + DO_XMOD);
    const float* MOD = (const float*)(ws + WS_MOD);
    const int nw = G * 8, gw = bid * 8 + wid, rpw = (NT + nw - 1) / nw;
    const int R0 = gw * rpw, R1 = (R0 + rpw < NT) ? (R0 + rpw) : NT;
    const int c0 = lane * 8, c1 = 512 + lane * 8;
    float sh[2][8], sc[2][8], xv[2][8];
    int curb = -1;
    if (R0 < R1) { ld8f(xin_row(p, R0) + c0, xv[0]); ld8f(xin_row(p, R0) + c1, xv[1]); }
    for (int R = R0; R < R1; ++R) {
      float xn[2][8];
#pragma unroll
      for (int h = 0; h < 2; ++h)
#pragma unroll
        for (int e = 0; e < 8; ++e) xn[h][e] = 0.f;
      if (R + 1 < R1) { ld8f(xin_row(p, R + 1) + c0, xn[0]); ld8f(xin_row(p, R + 1) + c1, xn[1]); }
      const int bi = bidx_of(R);
      if (bi != curb) { curb = bi; const float* modl = MOD + (size_t)bi * 6144; ld8f(modl + c0, sh[0]); ld8f(modl + c1, sh[1]); ld8f(modl + 1024 + c0, sc[0]); ld8f(modl + 1024 + c1, sc[1]); }
#pragma unroll
      for (int h = 0; h < 2; ++h) {
        float xm[8];
#pragma unroll
        for (int e = 0; e < 8; ++e) xm[e] = xv[h][e] * (1.f + sc[h][e]) + sh[h][e];
        st8b(XM + (size_t)R * D + (h ? c1 : c0), xm);
      }
#pragma unroll
      for (int h = 0; h < 2; ++h)
#pragma unroll
        for (int e = 0; e < 8; ++e) xv[h][e] = xn[h][e];
    }
  }
}

DEVI void build_ttg_em(const Params& p, int lsel, int vb, int nvb) {
  unsigned char* ws = uws(p);
  const int tid = tid_();
  const float* KT = (const float*)(ws + WS_KTAB);
  const float2* AP = (const float2*)(ws + WS_APOW);
  const float2* BB = (const float2*)(ws + WS_BBT);
  const long nthreads = (long)nvb * NTHREADS, gt = (long)vb * NTHREADS + tid;
  const long n_ttg = 16L * 512 * 96;
  for (long e = (long)lsel * n_ttg + gt; e < (long)(lsel + 1) * n_ttg; e += nthreads) {
    const int k8 = (int)(e % 96), m = (int)((e / 96) & 511), g = (int)((e / (96 * 512)) & 15), l = (int)(e / (96 * 512 * 16));
    const int tau = m >> 4, c = m & 15, k = k8 * 8;
    float v[8];
    if (k < 512) {
      const int sg = k >> 4, c2 = k & 15;
      const float* K0 = KT + (size_t)(((l * 16 + g) * 2 + 0) * 32) * 256 + c * 16 + c2;
      const float* K1 = KT + (size_t)(((l * 16 + g) * 2 + 1) * 32) * 256 + c * 16 + c2;
      if (sg < tau) { for (int q = 0; q < 8; ++q) v[q] = K0[(tau - sg) * 256 + q]; }
      else if (sg > tau) { for (int q = 0; q < 8; ++q) v[q] = K1[(sg - tau) * 256 + q]; }
      else { for (int q = 0; q < 8; ++q) v[q] = K0[q] + K1[q] + ((c2 + q == c) ? uin(p, I_SD)[l * 256 + g * 16 + c] : 0.f); }
    } else {
      const int q0 = k - 512, d = q0 >> 7, isim = (q0 >> 6) & 1, p0 = q0 & 63;
      const int j = d ? (32 - tau) : (tau + 1);
      for (int q = 0; q < 8; ++q) {
        const int pp = p0 + q;
        const float2 a = AP[((size_t)(((l * 2 + d) * 16 + g) * 64 + pp)) * 33 + j];
        const float cr = uin(p, I_CRE)[((l * 16 + g) * 16 + c) * 64 + pp], ci = uin(p, I_CIM)[((l * 16 + g) * 16 + c) * 64 + pp];
        v[q] = isim ? -(cr * a.y + ci * a.x) : (cr * a.x - ci * a.y);
      }
    }
    uint4 o; o.x = pack2(v[0], v[1]); o.y = pack2(v[2], v[3]); o.z = pack2(v[4], v[5]); o.w = pack2(v[6], v[7]);
    *(uint4*)((bf16_t*)(ws + WS_TTG) + (size_t)e * 8) = o;
  }
  const long n_em = 16L * 256 * 64;
  for (long e = (long)lsel * n_em + gt; e < (long)(lsel + 1) * n_em; e += nthreads) {
    const int k8 = (int)(e & 63), r = (int)((e >> 6) & 255), g = (int)((e >> 14) & 15), l = (int)(e >> 18);
    const int d = r >> 7, isim = (r >> 6) & 1, pp = r & 63, k = k8 * 8, sg = k >> 4, c2 = k & 15;
    const int j = d ? sg : (31 - sg);
    const float2 a = AP[((size_t)(((l * 2 + d) * 16 + g) * 64 + pp)) * 33 + j];
    float v[8];
    for (int q = 0; q < 8; ++q) {
      const float2 bb = BB[(size_t)((((l * 2 + d) * 16 + g) * 64 + pp) * 16) + c2 + q];
      v[q] = isim ? (a.x * bb.y + a.y * bb.x) : (a.x * bb.x - a.y * bb.y);
    }
    uint4 o; o.x = pack2(v[0], v[1]); o.y = pack2(v[2], v[3]); o.z = pack2(v[4], v[5]); o.w = pack2(v[6], v[7]);
    *(uint4*)((bf16_t*)(ws + WS_EM) + (size_t)e * 8) = o;
  }
}

struct EpiInproj {
  static constexpr bool PERM = true;
  bf16_t* PROJ; bf16_t* UDH; const float* RC; const float* RS;
  DEVI void operator()(const f32x4 (&acc)[2][2][4][2], const g8::Unit& u) const {
    const int tid = tid_(), wid = __builtin_amdgcn_readfirstlane(tid >> 6), lane = tid & 63, wr = wid >> 2, wc = wid & 3, fr = lane & 15, fq = lane >> 4;
    const bool lat = u.pm < 128;
#pragma unroll
    for (int ai = 0; ai < 2; ++ai)
#pragma unroll
      for (int m = 0; m < 4; ++m) {
        const int row = u.pm * 256 + ai * 128 + wr * 64 + m * 16 + fr, pos = row & 2047;
#pragma unroll
        for (int bj = 0; bj < 2; ++bj) {
          const int cb = u.pn * 256 + bj * 128 + wc * 32 + 8 * fq;
          f32x4 x0 = acc[ai][bj][m][0], x1 = acc[ai][bj][m][1];
          const bool isq = (u.pn == 5 || u.pn == 6), isk = (u.pn == 7 && bj == 0);
          if ((isq || isk) && lat) {
            const int i0 = 16 * (wc & 1) + 4 * fq;
            const float4 cs = *(const float4*)(RC + pos * 32 + i0), sn = *(const float4*)(RS + pos * 32 + i0);
            const f32x4 y0 = (f32x4){x0[0] * cs.x - x1[0] * sn.x, x0[1] * cs.y - x1[1] * sn.y, x0[2] * cs.z - x1[2] * sn.z, x0[3] * cs.w - x1[3] * sn.w};
            const f32x4 y1 = (f32x4){x1[0] * cs.x + x0[0] * sn.x, x1[1] * cs.y + x0[1] * sn.y, x1[2] * cs.z + x0[2] * sn.z, x1[3] * cs.w + x0[3] * sn.w};
            x0 = y0; x1 = y1;
          }
          if (isq) { x0 = x0 * (0.125f * 1.4426950408889634f); x1 = x1 * (0.125f * 1.4426950408889634f); }
          const uint4 o = make_uint4(pack2(x0[0], x0[1]), pack2(x0[2], x0[3]), pack2(x1[0], x1[1]), pack2(x1[2], x1[3]));
          if (u.pn == 4) {
            const int g = (cb - 1024) >> 4, c = cb & 15;
            *(uint4*)(UDH + ((size_t)(g * NCH + (row >> 5))) * 768 + (row & 31) * 16 + c) = o;
          } else {
            *(uint4*)(PROJ + (size_t)row * DIN + cb) = o;
          }
        }
        asm volatile("" ::: "memory");
      }
  }
};
DEVI void phase_inproj(const Params& p, int l, unsigned char* smem) {
  unsigned char* ws = uws(p);
  g8::DenseSched S{(const bf16_t*)((unsigned char*)uout(p) + DO_XMOD), (const bf16_t*)(ws + WS_WIN_T) + (size_t)l * DIN * D, D, 144, 8, (int)gridDim.x, bid_()};
  EpiInproj E{(bf16_t*)(ws + WS_PROJ), (bf16_t*)(ws + WS_UDH), (const float*)(ws + WS_ROPE), (const float*)(ws + WS_ROPE) + 65536};
  __syncthreads();
  g8::gemm((G8_LAS unsigned char*)smem, D, S, E);
  __syncthreads();
  if (l == 0) { const int G = gridDim.x, rem = (144 * 8) % G; if (rem == 0) build_ttg_em(p, 0, bid_(), G); else if (bid_() >= rem) build_ttg_em(p, 0, bid_() - rem, G - rem); }
}

DEVI void phase_feat(const Params& p, int l, unsigned char* smem) {
  unsigned char* ws = uws(p);
  const bf16_t* PROJ = (const bf16_t*)(ws + WS_PROJ);
  unsigned short* FEAT = (unsigned short*)(ws + WS_FEAT);
  const bf16_t* FW = (const bf16_t*)(ws + WS_FW) + (size_t)l * 1280 * 256;
  const bf16_t* EM = (const bf16_t*)(ws + WS_EM) + (size_t)l * 16 * 256 * 512;
  float* HE = (float*)((unsigned char*)uout(p) + DO_HE);
  const float* CW = uin(p, I_CONV) + l * 3 * 1024;
  const int tid = tid_(), lrow = tid >> 2;
  for (int it = bid_(); it < 432 + 160; it += gridDim.x) {
    if (it < 432) {
      const int mt = it / 3, typ = it % 3;
      const int kb = typ == 0 ? 0 : (typ == 1 ? 64 : 128), KK = typ == 2 ? 128 : 64, lda = KK + 8;
      const int nt_lo = typ == 0 ? 0 : (typ == 1 ? 4 : 8), nt_n = typ == 2 ? 2 : 4;
      bf16_t* sA = (bf16_t*)smem;
      bf16_t* sB = sA + 256 * 136;
      {
        const int ppr = KK >> 3;
        const int kfix = kb + (tid % ppr) * 8;
        float wc0[8], wc1[8], wc2[8];
        ld8f(CW + 768 + kfix, wc0); ld8f(CW + 1024 + 768 + kfix, wc1); ld8f(CW + 2048 + 768 + kfix, wc2);
        for (int pc = tid; pc < 256 * ppr; pc += NTHREADS) {
          const int rr = pc / ppr, k = kfix;
          const int R = mt * 256 + rr;
          const int t = R < NLAT ? (R & 2047) : ((R - NLAT) & 255); const int len = R < NLAT ? SEQ : CTXL;
          const bf16_t* pcur = PROJ + (size_t)R * DIN + 768 + k;
          const uint4 vc = *(const uint4*)pcur;
          uint4 vp = make_uint4(0, 0, 0, 0), vn = make_uint4(0, 0, 0, 0);
          if (t > 0) vp = *(const uint4*)(pcur - DIN);
          if (t < len - 1) vn = *(const uint4*)(pcur + DIN);
          float x[8];
          const unsigned up[4] = {vp.x, vp.y, vp.z, vp.w}, uc[4] = {vc.x, vc.y, vc.z, vc.w}, un[4] = {vn.x, vn.y, vn.z, vn.w};
#pragma unroll
          for (int q = 0; q < 4; ++q) {
            x[2 * q] = lo_bf(up[q]) * wc0[2 * q] + lo_bf(uc[q]) * wc1[2 * q] + lo_bf(un[q]) * wc2[2 * q];
            x[2 * q + 1] = hi_bf(up[q]) * wc0[2 * q + 1] + hi_bf(uc[q]) * wc1[2 * q + 1] + hi_bf(un[q]) * wc2[2 * q + 1];
          }
          if (typ == 0) { for (int q = 0; q < 8; ++q) x[q] = 1.f - 2.f * __builtin_amdgcn_rcpf(1.f + __expf(2.f * x[q])); }
          else if (typ == 2) { for (int q = 0; q < 8; ++q) x[q] = sigmoidf(x[q]); }
          *(uint4*)(sA + rr * lda + (k - kb)) = make_uint4(pack2(x[0], x[1]), pack2(x[2], x[3]), pack2(x[4], x[5]), pack2(x[6], x[7]));
        }
      }
      const int lane = tid & 63, wid = tid >> 6, wr = wid >> 1, wc = wid & 1, fr = lane & 15, fq = lane >> 4;
      for (int nq = 0; nq < nt_n; ++nq) {
        const int ntl = nt_lo + nq;
        __syncthreads();
        {
          const int ppr = KK >> 3;
          for (int pc = tid; pc < 128 * ppr; pc += NTHREADS) {
            const int rr = pc / ppr, k = (pc % ppr) * 8;
            *(uint4*)(sB + rr * lda + k) = *(const uint4*)(FW + (size_t)(ntl * 128 + rr) * 256 + kb + k);
          }
        }
        __syncthreads();
        f32x4 acc[4][4];
#pragma unroll
        for (int m = 0; m < 4; ++m)
#pragma unroll
          for (int n = 0; n < 4; ++n) acc[m][n] = (f32x4){0.f, 0.f, 0.f, 0.f};
        for (int k0 = 0; k0 < KK; k0 += 32) {
          bf16x8 bfr[4];
#pragma unroll
          for (int n = 0; n < 4; ++n) bfr[n] = *(const bf16x8*)(sB + (wc * 64 + n * 16 + fr) * lda + k0 + fq * 8);
#pragma unroll
          for (int m = 0; m < 4; ++m) {
            const bf16x8 af = *(const bf16x8*)(sA + (wr * 64 + m * 16 + fr) * lda + k0 + fq * 8);
#pragma unroll
            for (int n = 0; n < 4; ++n) acc[m][n] = __builtin_amdgcn_mfma_f32_16x16x32_bf16(bfr[n], af, acc[m][n], 0, 0, 0);
          }
        }
#pragma unroll
        for (int m = 0; m < 4; ++m) {
          const int row = mt * 256 + wr * 64 + m * 16 + fr;
#pragma unroll
          for (int n = 0; n < 4; ++n) {
            const int ng = ntl * 128 + wc * 64 + n * 16 + fq * 4;
            float o[4];
            if (typ == 0) {
              const float4 w0 = *(const float4*)(uin(p, I_W0) + (l * 2 + (ng >> 8)) * 256 + (ng & 255));
              const float wv[4] = {w0.x, w0.y, w0.z, w0.w};
#pragma unroll
              for (int j = 0; j < 4; ++j) {
                const float e = 0.6065306597126334f * sigmoidf(acc[m][n][j] + wv[j]);
                o[j] = 1.f - __expf(-e);
              }
            } else if (typ == 1) {
              const float4 a0 = *(const float4*)(uin(p, I_A0) + (l * 2 + ((ng - 512) >> 8)) * 256 + (ng & 255));
              const float av[4] = {a0.x, a0.y, a0.z, a0.w};
#pragma unroll
              for (int j = 0; j < 4; ++j) o[j] = sigmoidf(acc[m][n][j] + av[j]);
            } else {
#pragma unroll
              for (int j = 0; j < 4; ++j) o[j] = acc[m][n][j];
            }
            uint2 w; w.x = (unsigned)f2h(o[0]) | ((unsigned)f2h(o[1]) << 16); w.y = (unsigned)f2h(o[2]) | ((unsigned)f2h(o[3]) << 16);
            *(uint2*)(FEAT + (size_t)row * 1280 + ng) = w;
          }
        }
      }
      __syncthreads();
    } else {
      const int j = it - 432, g = j / 10, rest = j % 10, mt5 = rest >> 1, nt2 = rest & 1;
      int n0 = mt5 * 256 + lrow, n1 = n0 + 128; if (n0 > NCH - 1) n0 = NCH - 1; if (n1 > NCH - 1) n1 = NCH - 1;
      const bf16_t* UDH = (const bf16_t*)(ws + WS_UDH);
      const bf16_t* a0 = UDH + (size_t)(g * NCH + n0) * 768; const bf16_t* a1 = UDH + (size_t)(g * NCH + n1) * 768;
      const bf16_t* b0 = EM + (size_t)(g * 256 + nt2 * 128 + lrow) * 512;
      gemm_tile(smem, 0, 512,
        [&](int i, int k) { return *(const uint4*)((i ? a1 : a0) + k); },
        [&](int k) { return *(const uint4*)(b0 + k); },
        [&](f32x4 (&acc)[4][4], int wr, int wc, int fr, int fq) {
#pragma unroll
          for (int m = 0; m < 4; ++m) {
            const int n = mt5 * 256 + wr * 64 + m * 16 + fr;
            if (n < NCH) {
#pragma unroll
              for (int nn = 0; nn < 4; ++nn)
                *(f32x4*)(HE + (size_t)(g * NCH + n) * 256 + nt2 * 128 + wc * 64 + nn * 16 + fq * 4) = acc[m][nn];
            }
          }
        });
    }
  }
}


DEVI float row_reduce_scatter16(const float (&v)[16], int lane16) {
  float a[8], b[4], c[2];
  const bool b3 = (lane16 & 8) != 0, b2 = (lane16 & 4) != 0, b1 = (lane16 & 2) != 0, b0 = (lane16 & 1) != 0;
#pragma unroll
  for (int k = 0; k < 8; ++k) { const float send = b3 ? v[k] : v[k + 8], keep = b3 ? v[k + 8] : v[k]; a[k] = keep + dpp_f<0x128>(send); }
#pragma unroll
  for (int k = 0; k < 4; ++k) { const float send = b2 ? a[k] : a[k + 4], keep = b2 ? a[k + 4] : a[k]; b[k] = keep + dpp_f<0x141>(send); }
#pragma unroll
  for (int k = 0; k < 2; ++k) { const float send = b1 ? b[k] : b[k + 2], keep = b1 ? b[k + 2] : b[k]; c[k] = keep + dpp_f<0x4E>(send); }
  { const float send = b0 ? c[0] : c[1], keep = b0 ? c[1] : c[0]; return keep + dpp_f<0xB1>(send); }
}
DEVI float mul_mix_lo(float a, unsigned hpair) { float r; asm("v_fma_mix_f32 %0, %1, %2, 0 op_sel_hi:[0,1,0]" : "=v"(r) : "v"(a), "v"(hpair)); return r; }
constexpr int RC_SLOT = 17664;
constexpr int RC_KK = 0, RC_RR = 2304, RC_KDB = 4608, RC_TT = 8704, RC_MM = 9728, RC_V = 10752, RC_G = 12800, RC_KD = 13056, RC_BB = 15360;
DEVI bf16x8 rc_pack8(const f32x4& a, const f32x4& b) {
  typedef unsigned u4v __attribute__((ext_vector_type(4)));
  const u4v u = {pack2(a[0], a[1]), pack2(a[2], a[3]), pack2(b[0], b[1]), pack2(b[2], b[3])};
  return __builtin_bit_cast(bf16x8, u);
}
DEVI bf16x8 rc_pack8(const f32x4& a, uint2 b) {
  typedef unsigned u4v __attribute__((ext_vector_type(4)));
  const u4v u = {pack2(a[0], a[1]), pack2(a[2], a[3]), b.x, b.y};
  return __builtin_bit_cast(bf16x8, u);
}
DEVI bf16x8 rc_pack8(uint2 a, const f32x4& b) {
  typedef unsigned u4v __attribute__((ext_vector_type(4)));
  const u4v u = {a.x, a.y, pack2(b[0], b[1]), pack2(b[2], b[3])};
  return __builtin_bit_cast(bf16x8, u);
}
template <int DIR>
DEVI void rwkv_chunked(const Params& p, int l, int it, unsigned char* smem) {
  unsigned char* ws = uws(p);
  const int b = it >> 3, h = (it >> 1) & 3;
  const bf16_t* PROJ = (const bf16_t*)(ws + WS_PROJ);
  const unsigned short* FEAT = (const unsigned short*)(ws + WS_FEAT);
  float* Y = (float*)((unsigned char*)uout(p) + (DIR ? DO_YB : DO_YF));
  const int tid = tid_(), lane = tid & 63, wid = __builtin_amdgcn_readfirstlane(tid >> 6);
  const int cl = lane & 15, cq = lane >> 4;
  const int hc = h * 64 + lane;
  const float* CW = uin(p, I_CONV) + l * 3 * 1024;
  float cwr[3], cwk[3], cwv[3];
#pragma unroll
  for (int dl = 0; dl < 3; ++dl) { cwr[dl] = CW[dl * 1024 + hc]; cwk[dl] = CW[dl * 1024 + 256 + hc]; cwv[dl] = CW[dl * 1024 + 512 + hc]; }
  const float kkw = uin(p, I_KK)[l * 256 + hc], kaw = uin(p, I_KA)[l * 256 + hc];
  const int pj = 32 * (lane >> 5) + 8 * ((lane >> 2) & 3) + 4 * ((lane >> 4) & 1) + (lane & 3);
  unsigned char* slot = smem + wid * RC_SLOT;
  const f32x4 zero4 = {0.f, 0.f, 0.f, 0.f};
  f32x4 acc[4] = {zero4, zero4, zero4, zero4};
  uint4 raw0, raw1, raw2, raw3, raw4, raw5, raw6, raw7, raw8, raw9, raw10;
  auto chunk_geom = [&](int c, bool& isctx, int& seqlen, int& lo, int& rowbase) __attribute__((always_inline)) {
    const int n0 = c * 16; isctx = n0 < 256; seqlen = isctx ? 256 : 2048; const int m0 = isctx ? n0 : n0 - 256;
    lo = DIR ? (seqlen - 16 - m0) : m0;
    rowbase = isctx ? (NLAT + b * CTXL) : (b * SEQ);
  };
#define RC_LDP(ld, dst) do { const int L_ = (ld) * 64 + lane_; const int Lc_ = L_ < 432 ? L_ : 431; const int u_ = Lc_ / 24, sg_ = (Lc_ % 24) >> 3, part_ = Lc_ & 7; \
    int tau_ = lo_ - 1 + u_; tau_ = tau_ < 0 ? 0 : (tau_ >= seqlen_ ? seqlen_ - 1 : tau_); \
    dst = *(const uint4*)(PROJ + (size_t)(rowbase_ + tau_) * DIN + h * 64 + sg_ * 256 + part_ * 8); } while (0)
#define RC_LDF(ld, dst) do { const int L_ = (ld) * 64 + lane_; const int o_ = L_ >> 4, sg_ = (L_ >> 3) & 1, part_ = L_ & 7; \
    dst = *(const uint4*)(FEAT + (size_t)(rowbase_ + lo_ + o_) * 1280 + DIR * 256 + sg_ * 512 + h * 64 + part_ * 8); } while (0)
#define RC_LOAD_RAW(c) do { bool isctx_; int seqlen_, lo_, rowbase_; chunk_geom((c), isctx_, seqlen_, lo_, rowbase_); const int lane_ = tid_() & 63;     \
    RC_LDP(0, raw0); RC_LDP(1, raw1); RC_LDP(2, raw2); RC_LDP(3, raw3); RC_LDP(4, raw4); RC_LDP(5, raw5); RC_LDP(6, raw6); \
    RC_LDF(0, raw7); RC_LDF(1, raw8); RC_LDF(2, raw9); RC_LDF(3, raw10); } while (0)
  RC_LOAD_RAW(wid);
  for (int batch = 0; batch < 18; ++batch) {
    {
      const int c = batch * 8 + wid;
      bool isctx; int seqlen, lo, rowbase; chunk_geom(c, isctx, seqlen, lo, rowbase);
      *(uint4*)(slot + (0 * 64 + lane) * 16) = raw0; *(uint4*)(slot + (1 * 64 + lane) * 16) = raw1; *(uint4*)(slot + (2 * 64 + lane) * 16) = raw2; *(uint4*)(slot + (3 * 64 + lane) * 16) = raw3;
      *(uint4*)(slot + (4 * 64 + lane) * 16) = raw4; *(uint4*)(slot + (5 * 64 + lane) * 16) = raw5; if (6 * 64 + lane < 432) *(uint4*)(slot + (6 * 64 + lane) * 16) = raw6;
      *(uint4*)(slot + 6912 + (0 * 64 + lane) * 16) = raw7; *(uint4*)(slot + 6912 + (1 * 64 + lane) * 16) = raw8; *(uint4*)(slot + 6912 + (2 * 64 + lane) * 16) = raw9; *(uint4*)(slot + 6912 + (3 * 64 + lane) * 16) = raw10;
      const unsigned short* sraw = (const unsigned short*)slot + lane;
      const bool ok_lo = lo - 1 >= 0, ok_hi = lo + 16 < seqlen;
      float kC[16], kkr[16], sq[16];
      {
        float Rk[18];
#pragma unroll
        for (int u = 0; u < 18; ++u) Rk[u] = __uint_as_float((unsigned)sraw[(u * 3 + 1) * 64] << 16);
        if (!ok_lo) Rk[0] = 0.f;
        if (!ok_hi) Rk[17] = 0.f;
#pragma unroll
        for (int o = 0; o < 16; ++o) { kC[o] = cwk[0] * Rk[o] + cwk[1] * Rk[o + 1] + cwk[2] * Rk[o + 2]; kkr[o] = kC[o] * kkw; sq[o] = kkr[o] * kkr[o]; }
      }
      float tot = row_reduce_scatter16(sq, cl);
      tot += shfl_xor_l(tot, 16); tot += shfl_xor_l(tot, 32);
      const float invv = rsqrtf(tot + 1e-12f);
      float rC[16], vC[16], xwF[16], aF[16];
      {
        float Rr[18], Rv[18];
#pragma unroll
        for (int u = 0; u < 18; ++u) { Rr[u] = __uint_as_float((unsigned)sraw[(u * 3 + 0) * 64] << 16); Rv[u] = __uint_as_float((unsigned)sraw[(u * 3 + 2) * 64] << 16); }
        if (!ok_lo) { Rr[0] = 0.f; Rv[0] = 0.f; }
        if (!ok_hi) { Rr[17] = 0.f; Rv[17] = 0.f; }
#pragma unroll
        for (int o = 0; o < 16; ++o) { rC[o] = cwr[0] * Rr[o] + cwr[1] * Rr[o + 1] + cwr[2] * Rr[o + 2]; vC[o] = cwv[0] * Rv[o] + cwv[1] * Rv[o + 1] + cwv[2] * Rv[o + 2]; }
#pragma unroll
        for (int o = 0; o < 16; ++o) { xwF[o] = h2f(sraw[3456 + (o * 2 + 0) * 64]); aF[o] = h2f(sraw[3456 + (o * 2 + 1) * 64]); }
      }
      float G = 1.f;
      float kdq[4], bbq[4], vq[4];
      bf16_t* sKK = (bf16_t*)(slot + RC_KK); bf16_t* sRR = (bf16_t*)(slot + RC_RR); bf16_t* sKD = (bf16_t*)(slot + RC_KD); bf16_t* sBB = (bf16_t*)(slot + RC_BB);
#pragma unroll
      for (int s = 0; s < 16; ++s) {
        const int o = DIR ? (15 - s) : s;
        const float inv = __int_as_float(__builtin_amdgcn_readlane(__float_as_int(invv), o));
        const float okk = kkr[o] * inv, a = aF[o], ob = okk * a, okd = kC[o] * (1.f + (a - 1.f) * kaw), w = 1.f - xwF[o];
        const float kkt = okk * G;
        G *= w;
        const float ig = __builtin_amdgcn_rcpf(G);
        const float rt = rC[o] * G, kdt = okd * ig, bt = ob * ig;
        sKK[s * 72 + pj] = f2bf(kkt); sRR[s * 72 + pj] = f2bf(rt); sKD[s * 72 + pj] = f2bf(kdt); sBB[s * 72 + pj] = f2bf(bt);
        kdq[s & 3] = kdt; bbq[s & 3] = -bt; vq[s & 3] = vC[o];
        if ((s & 3) == 3) {
          const int fi = ((lane >> 4) * 4 + (s >> 2)) * 16 + (lane & 15);
          *(uint4*)(slot + RC_KDB + fi * 16) = make_uint4(pack2(kdq[0], kdq[1]), pack2(kdq[2], kdq[3]), pack2(bbq[0], bbq[1]), pack2(bbq[2], bbq[3]));
          *(uint2*)(slot + RC_V + fi * 8) = make_uint2(pack2(vq[0], vq[1]), pack2(vq[2], vq[3]));
        }
      }
      ((float*)(slot + RC_G))[lane] = G;
      const bf16x8 aK0 = *(const bf16x8*)(sKK + cl * 72 + 8 * cq), aK1 = *(const bf16x8*)(sKK + cl * 72 + 32 + 8 * cq);
      const bf16x8 aR0 = *(const bf16x8*)(sRR + cl * 72 + 8 * cq), aR1 = *(const bf16x8*)(sRR + cl * 72 + 32 + 8 * cq);
      const bf16x8 bD0 = *(const bf16x8*)(sKD + cl * 72 + 8 * cq), bD1 = *(const bf16x8*)(sKD + cl * 72 + 32 + 8 * cq);
      const bf16x8 bB0 = *(const bf16x8*)(sBB + cl * 72 + 8 * cq), bB1 = *(const bf16x8*)(sBB + cl * 72 + 32 + 8 * cq);
      f32x4 Abk = __builtin_amdgcn_mfma_f32_16x16x32_bf16(aK0, bB0, zero4, 0, 0, 0); Abk = __builtin_amdgcn_mfma_f32_16x16x32_bf16(aK1, bB1, Abk, 0, 0, 0);
      f32x4 Avk = __builtin_amdgcn_mfma_f32_16x16x32_bf16(aK0, bD0, zero4, 0, 0, 0); Avk = __builtin_amdgcn_mfma_f32_16x16x32_bf16(aK1, bD1, Avk, 0, 0, 0);
      f32x4 Mbr = __builtin_amdgcn_mfma_f32_16x16x32_bf16(aR0, bB0, zero4, 0, 0, 0); Mbr = __builtin_amdgcn_mfma_f32_16x16x32_bf16(aR1, bB1, Mbr, 0, 0, 0);
      f32x4 Mvr = __builtin_amdgcn_mfma_f32_16x16x32_bf16(aR0, bD0, zero4, 0, 0, 0); Mvr = __builtin_amdgcn_mfma_f32_16x16x32_bf16(aR1, bD1, Mvr, 0, 0, 0);
      float* tA = (float*)(slot + RC_KD); float* tVT = tA + 256;
      bf16_t* sMM = (bf16_t*)(slot + RC_MM);
#pragma unroll
      for (int r = 0; r < 4; ++r) {
        const int t = 4 * cq + r;
        const float abk = (cl < t) ? Abk[r] : 0.f, avk = (cl < t) ? Avk[r] : 0.f, mbr = (cl <= t) ? Mbr[r] : 0.f, mvr = (cl <= t) ? Mvr[r] : 0.f;
        tA[t * 16 + cl] = abk; Avk[r] = avk;
        sMM[((cl >> 2) * 16 + t) * 8 + (cl & 3)] = f2bf(mvr); sMM[((cl >> 2) * 16 + t) * 8 + 4 + (cl & 3)] = f2bf(-mbr);
      }
      *(float4*)(tVT + cl * 16 + 4 * cq) = make_float4(Avk[0], Avk[1], Avk[2], Avk[3]);
      {
        const bool isTA = ((lane >> 4) & 1) != 0;
        float X[16];
        {
          const float4* pv = (const float4*)(tVT + cl * 16);
          const float4 r0 = pv[0], r1 = pv[1], r2 = pv[2], r3 = pv[3];
          const float rh[16] = {r0.x, r0.y, r0.z, r0.w, r1.x, r1.y, r1.z, r1.w, r2.x, r2.y, r2.z, r2.w, r3.x, r3.y, r3.z, r3.w};
#pragma unroll
          for (int t = 0; t < 16; ++t) X[t] = isTA ? rh[t] : ((t == cl) ? 1.f : 0.f);
        }
#pragma unroll
        for (int t = 1; t < 16; ++t) {
          float a = X[t];
#pragma unroll
          for (int s4 = 0; s4 * 4 < t; ++s4) {
            const float4 ar = *(const float4*)(tA + t * 16 + 4 * s4);
            if (4 * s4 + 0 < t) a = fmaf(-ar.x, X[4 * s4 + 0], a);
            if (4 * s4 + 1 < t) a = fmaf(-ar.y, X[4 * s4 + 1], a);
            if (4 * s4 + 2 < t) a = fmaf(-ar.z, X[4 * s4 + 2], a);
            if (4 * s4 + 3 < t) a = fmaf(-ar.w, X[4 * s4 + 3], a);
          }
          X[t] = a;
        }
        bf16_t* sTT = (bf16_t*)(slot + RC_TT);
        if (lane < 32) {
#pragma unroll
          for (int t = 0; t < 16; ++t) sTT[((cl >> 2) * 16 + t) * 8 + (cl & 3) + (isTA ? 4 : 0)] = f2bf(X[t]);
        }
      }
    }
    __syncthreads();
    if (batch + 1 < 18) RC_LOAD_RAW((batch + 1) * 8 + wid);
    if (wid < 4) {
      const int itile = wid;
      bf16x8 nK0, nK1, nR0, nR1, nTT; uint2 nV;
#define RC_CONS_LOAD(sl_) do { nK0 = *(const bf16x8*)((sl_) + RC_KK + (cl * 72 + 8 * cq) * 2); nK1 = *(const bf16x8*)((sl_) + RC_KK + (cl * 72 + 32 + 8 * cq) * 2); \
        nR0 = *(const bf16x8*)((sl_) + RC_RR + (cl * 72 + 8 * cq) * 2); nR1 = *(const bf16x8*)((sl_) + RC_RR + (cl * 72 + 32 + 8 * cq) * 2); \
        nTT = *(const bf16x8*)((sl_) + RC_TT + lane * 16); nV = *(const uint2*)((sl_) + RC_V + (itile * 64 + lane) * 8); } while (0)
      RC_CONS_LOAD(smem);
#pragma unroll 1
      for (int k = 0; k < 8; ++k) {
        const unsigned char* sl = smem + k * RC_SLOT;
        const bf16x8 aK0 = nK0, aK1 = nK1, aR0 = nR0, aR1 = nR1, fTT = nTT; const uint2 fV = nV;
        const bf16x8 fMM = *(const bf16x8*)(sl + RC_MM + lane * 16);
        const bf16x8 Bs0 = rc_pack8(acc[0], acc[1]), Bs1 = rc_pack8(acc[2], acc[3]);
        f32x4 P = __builtin_amdgcn_mfma_f32_16x16x32_bf16(aK0, Bs0, zero4, 0, 0, 0); P = __builtin_amdgcn_mfma_f32_16x16x32_bf16(aK1, Bs1, P, 0, 0, 0);
        f32x4 Yv = __builtin_amdgcn_mfma_f32_16x16x32_bf16(aR0, Bs0, zero4, 0, 0, 0); Yv = __builtin_amdgcn_mfma_f32_16x16x32_bf16(aR1, Bs1, Yv, 0, 0, 0);
        if (k + 1 < 8) RC_CONS_LOAD(sl + RC_SLOT);
        const f32x4 SA = __builtin_amdgcn_mfma_f32_16x16x32_bf16(fTT, rc_pack8(P, fV), zero4, 0, 0, 0);
        const bf16x8 Bvs = rc_pack8(fV, SA);
        Yv = __builtin_amdgcn_mfma_f32_16x16x32_bf16(fMM, Bvs, Yv, 0, 0, 0);
#pragma unroll
        for (int jt = 0; jt < 4; ++jt) {
          const bf16x8 fKDB = *(const bf16x8*)(sl + RC_KDB + (jt * 64 + lane) * 16);
          const float4 g = *(const float4*)(sl + RC_G + (16 * jt + 4 * cq) * 4);
          acc[jt] = __builtin_amdgcn_mfma_f32_16x16x32_bf16(fKDB, Bvs, acc[jt], 0, 0, 0);
          acc[jt][0] *= g.x; acc[jt][1] *= g.y; acc[jt][2] *= g.z; acc[jt][3] *= g.w;
        }
        bool isctx; int seqlen, lo, rowbase; chunk_geom(batch * 8 + k, isctx, seqlen, lo, rowbase);
        if (!(l == 1 && isctx)) {
#pragma unroll
          for (int r = 0; r < 4; ++r) {
            const int t = 4 * cq + r, o = DIR ? (15 - t) : t;
            Y[(size_t)(rowbase + lo + o) * 256 + h * 64 + itile * 16 + cl] = Yv[r];
          }
        }
      }
    }
    __syncthreads();
  }
#undef RC_LDP
#undef RC_LDF
#undef RC_LOAD_RAW
#undef RC_CONS_LOAD
}

DEVI void s5_carry_item(const Params& p, int l, int g, int b) {
  unsigned char* ws = uws(p);
  const int tid = tid_();
  if (tid >= 128) return;
  const float* HE = (const float*)((unsigned char*)uout(p) + DO_HE) + (size_t)g * NCH * 256;
  bf16_t* UDH = (bf16_t*)(ws + WS_UDH) + (size_t)g * NCH * 768;
  const int dd = tid >> 6, pp = tid & 63;
  const float2 aT = ((const float2*)(ws + WS_APOW))[((size_t)(((l * 2 + dd) * 16 + g) * 64 + pp)) * 33 + 32];
  const int off = dd * 128 + pp;
  float hr = 0.f, hi = 0.f;
  {
    float er[8], ei[8];
#pragma unroll
    for (int c = 0; c < 8; ++c) { const int n = 1024 + b * 8 + (dd ? (7 - c) : c); er[c] = HE[(size_t)n * 256 + off]; ei[c] = HE[(size_t)n * 256 + off + 64]; }
#pragma unroll
    for (int c = 0; c < 8; ++c) {
      const int n = 1024 + b * 8 + (dd ? (7 - c) : c);
      UDH[(size_t)n * 768 + 512 + off] = f2bf(hr); UDH[(size_t)n * 768 + 512 + off + 64] = f2bf(hi);
      const float nr = aT.x * hr - aT.y * hi + er[c], ni = aT.x * hi + aT.y * hr + ei[c];
      hr = nr; hi = ni;
    }
  }
#pragma unroll 1
  for (int c0 = 0; c0 < 64; c0 += 16) {
    float er[16], ei[16];
#pragma unroll
    for (int c = 0; c < 16; ++c) { const int n = b * 64 + (dd ? (63 - c0 - c) : (c0 + c)); er[c] = HE[(size_t)n * 256 + off]; ei[c] = HE[(size_t)n * 256 + off + 64]; }
#pragma unroll
    for (int c = 0; c < 16; ++c) {
      const int n = b * 64 + (dd ? (63 - c0 - c) : (c0 + c));
      UDH[(size_t)n * 768 + 512 + off] = f2bf(hr); UDH[(size_t)n * 768 + 512 + off + 64] = f2bf(hi);
      const float nr = aT.x * hr - aT.y * hi + er[c], ni = aT.x * hi + aT.y * hr + ei[c];
      hr = nr; hi = ni;
    }
  }
}

struct S5Sched {
  const bf16_t* UDH; const bf16_t* TTG; int G, c, ntile;
  DEVI bool next(int i, g8::Unit& u) const {
    const int L = i * G + c; if (L >= 16 * ntile * 2) return false;
    u.e = L / (ntile * 2); const int r = L % (ntile * 2); u.pm = r >> 1; u.pn = r & 1; return true;
  }
  DEVI const char* a_base() const { return (const char*)UDH; }
  DEVI void a_offs(const g8::Unit& u, int tid, unsigned (&ao)[2][2]) const {
#pragma unroll
    for (int i = 0; i < 2; ++i) {
      int R, C; g8::stage_rc(tid * 16 + i * 8192, R, C);
#pragma unroll
      for (int h = 0; h < 2; ++h) ao[h][i] = ((unsigned)(u.e * NCH + u.pm * 256 + h * 128 + R) * 768u + (unsigned)C) * 2u;
    }
  }
  DEVI const char* b_ptr(const g8::Unit& u) const { return (const char*)(TTG + ((size_t)u.e * 512 + (size_t)u.pn * 256) * 768); }
};
struct EpiS5 {
  static constexpr bool PERM = true;
  bf16_t* ZB;
  DEVI void operator()(const f32x4 (&acc)[2][2][4][2], const g8::Unit& u) const {
    const int tid = tid_(), wid = __builtin_amdgcn_readfirstlane(tid >> 6), lane = tid & 63, wr = wid >> 2, wc = wid & 3, fr = lane & 15, fq = lane >> 4;
#pragma unroll
    for (int ai = 0; ai < 2; ++ai)
#pragma unroll
      for (int m = 0; m < 4; ++m) {
        const int n = u.pm * 256 + ai * 128 + wr * 64 + m * 16 + fr;
        if (n < NCH) {
#pragma unroll
          for (int bj = 0; bj < 2; ++bj) {
            const int mc = u.pn * 256 + bj * 128 + wc * 32 + 8 * fq, tau = mc >> 4, c = mc & 15;
            const f32x4 v0 = acc[ai][bj][m][0], v1 = acc[ai][bj][m][1];
            *(uint4*)(ZB + ((size_t)n * 32 + tau) * 256 + u.e * 16 + c) = make_uint4(pack2(gelu_tanh(v0[0]), gelu_tanh(v0[1])), pack2(gelu_tanh(v0[2]), gelu_tanh(v0[3])),
                                                                                   pack2(gelu_tanh(v1[0]), gelu_tanh(v1[1])), pack2(gelu_tanh(v1[2]), gelu_tanh(v1[3])));
          }
        }
        asm volatile("" ::: "memory");
      }
  }
};

DEVI void attn_item(const Params& p, int l, int b, int qb, int hq, unsigned char* smem) {
  unsigned char* ws = uws(p);
  const bf16_t* PROJ = (const bf16_t*)(ws + WS_PROJ);
  bf16_t* YMIX = (bf16_t*)(ws + WS_YMIX);
  bf16_t* sKV = (bf16_t*)smem;
  const int tid = tid_(), lane = tid & 63, wid = tid >> 6, r = lane & 31, hh = lane >> 5;
  const int kvh = hq >> 2;
  const bool ctxq = qb < 0;
  const int qrow0 = ctxq ? (NLAT + b * CTXL + wid * 32) : (b * SEQ + qb * 256 + wid * 32);
  const int q0pos = qb * 256 + wid * 32;
  bf16x8 qf[4];
  {
    const bf16_t* qp = PROJ + (size_t)(qrow0 + r) * DIN + 1280 + hq * 64 + hh * 8;
#pragma unroll
    for (int ks = 0; ks < 4; ++ks) qf[ks] = *(const bf16x8*)(qp + ks * 16);
  }
  f32x16 O0, O1;
#pragma unroll
  for (int i = 0; i < 16; ++i) { O0[i] = 0.f; O1[i] = 0.f; }
  float mrun = uin(p, I_SINK)[l * 8 + hq] * 1.4426950408889634f;
  float lsum = (hh == 0) ? 1.f : 0.f;
  const int jlo = ctxq ? 0 : (qb == 0 ? 2 : 0), jhi = ctxq ? 0 : (qb == 7 ? 6 : 8);
  const int nchunk = 4 + (jhi - jlo);
  const int nstage = (nchunk + 2) / 3;
  const int skey = tid >> 3, spc = (tid & 7) * 8;
  auto chunk_row0 = [&](int c) { return c < 4 ? (NLAT + b * CTXL + c * 64) : (b * SEQ + qb * 256 - 128 + (jlo + c - 4) * 64); };
  uint4 kr0, kr1, kr2, vr0, vr1, vr2;
  kr0 = kr1 = kr2 = vr0 = vr1 = vr2 = make_uint4(0, 0, 0, 0);
#define ATT_LOAD1(j, KR, VR, st_) do { const int c_ = (st_) * 3 + (j); if (c_ < nchunk) { \
    const bf16_t* kp_ = PROJ + (size_t)(chunk_row0(c_) + skey) * DIN + 1792 + kvh * 64 + spc; KR = *(const uint4*)kp_; VR = *(const uint4*)(kp_ + 128); } } while (0)
#define ATT_LOAD_STAGE(st_) do { ATT_LOAD1(0, kr0, vr0, st_); ATT_LOAD1(1, kr1, vr1, st_); ATT_LOAD1(2, kr2, vr2, st_); } while (0)
#define ATT_WRITE1(j, KR, VR) do { if (st * 3 + (j) < nchunk) { bf16_t* sKb_ = sB + (j) * (2 * 64 * 72); bf16_t* sVb_ = sKb_ + 64 * 72; \
    *(uint4*)(sKb_ + skey * 72 + spc) = KR; \
    sVb_[(spc + 0) * 72 + skey] = (bf16_t)(VR.x & 0xFFFF); sVb_[(spc + 1) * 72 + skey] = (bf16_t)(VR.x >> 16); \
    sVb_[(spc + 2) * 72 + skey] = (bf16_t)(VR.y & 0xFFFF); sVb_[(spc + 3) * 72 + skey] = (bf16_t)(VR.y >> 16); \
    sVb_[(spc + 4) * 72 + skey] = (bf16_t)(VR.z & 0xFFFF); sVb_[(spc + 5) * 72 + skey] = (bf16_t)(VR.z >> 16); \
    sVb_[(spc + 6) * 72 + skey] = (bf16_t)(VR.w & 0xFFFF); sVb_[(spc + 7) * 72 + skey] = (bf16_t)(VR.w >> 16); } } while (0)
  ATT_LOAD_STAGE(0);
  int buf = 0;
  for (int st = 0; st < nstage; ++st) {
    bf16_t* sB = sKV + buf * (6 * 64 * 72);
    ATT_WRITE1(0, kr0, vr0); ATT_WRITE1(1, kr1, vr1); ATT_WRITE1(2, kr2, vr2);
    __syncthreads();
    if (st + 1 < nstage) ATT_LOAD_STAGE(st + 1);
#pragma unroll 1
    for (int j = 0; j < 3; ++j) {
      const int c = st * 3 + j;
      if (c >= nchunk) break;
      const bf16_t* sKb = sB + j * (2 * 64 * 72); const bf16_t* sVb = sKb + 64 * 72;
      const bool band = c >= 4;
      const int kstart = band ? (qb * 256 - 128 + (jlo + c - 4) * 64) : 0;
#pragma unroll
      for (int tt = 0; tt < 2; ++tt) {
        const int ts = kstart + tt * 32;
        bool need = true, full = true;
        if (band) {
          need = (ts + 31 >= q0pos - 128) && (ts <= q0pos + 31 + 128);
          full = (ts >= q0pos + 31 - 128) && (ts + 31 <= q0pos + 128);
        }
        if (!need) continue;
        f32x16 S;
#pragma unroll
        for (int i = 0; i < 16; ++i) S[i] = 0.f;
#pragma unroll
        for (int ks = 0; ks < 4; ++ks) {
          const bf16x8 kf = *(const bf16x8*)(sKb + (tt * 32 + r) * 72 + ks * 16 + hh * 8);
          S = __builtin_amdgcn_mfma_f32_32x32x16_bf16(kf, qf[ks], S, 0, 0, 0);
        }
        if (!full) {
#pragma unroll
          for (int i = 0; i < 16; ++i) {
            const int kpos = ts + (i & 3) + 8 * (i >> 2) + 4 * hh;
            const int dl = (q0pos + r) - kpos;
            if (dl > 128 || dl < -128) S[i] = -1e30f;
          }
        }
        float mx = S[0];
#pragma unroll
        for (int i = 1; i < 16; ++i) mx = fmaxf(mx, S[i]);
        mx = fmaxf(mx, shfl_xor_l(mx, 32));
        const float mnew = fmaxf(mrun, mx);
        const float alpha = __builtin_amdgcn_exp2f(mrun - mnew);
        const bool grew = mnew > mrun;
        mrun = mnew;
        float ps = 0.f;
#pragma unroll
        for (int i = 0; i < 16; ++i) { S[i] = __builtin_amdgcn_exp2f(S[i] - mnew); ps += S[i]; }
        lsum = lsum * alpha + ps;
        if (__builtin_amdgcn_ballot_w64(grew) != 0ull) {
#pragma unroll
          for (int i = 0; i < 16; ++i) { O0[i] *= alpha; O1[i] *= alpha; }
        }
        bf16x8 pf[2];
#pragma unroll
        for (int s2 = 0; s2 < 2; ++s2) {
          const uint4 u = make_uint4(pack2(S[8 * s2], S[8 * s2 + 1]), pack2(S[8 * s2 + 2], S[8 * s2 + 3]), pack2(S[8 * s2 + 4], S[8 * s2 + 5]), pack2(S[8 * s2 + 6], S[8 * s2 + 7]));
          pf[s2] = __builtin_bit_cast(bf16x8, u);
        }
#pragma unroll
        for (int s2 = 0; s2 < 2; ++s2) {
          {
            const bf16_t* vp = sVb + (0 * 32 + r) * 72 + tt * 32 + 16 * s2 + 4 * hh;
            const uint2 lo = *(const uint2*)vp, hi = *(const uint2*)(vp + 8);
            const uint4 u = make_uint4(lo.x, lo.y, hi.x, hi.y);
            O0 = __builtin_amdgcn_mfma_f32_32x32x16_bf16(__builtin_bit_cast(bf16x8, u), pf[s2], O0, 0, 0, 0);
          }
          {
            const bf16_t* vp = sVb + (1 * 32 + r) * 72 + tt * 32 + 16 * s2 + 4 * hh;
            const uint2 lo = *(const uint2*)vp, hi = *(const uint2*)(vp + 8);
            const uint4 u = make_uint4(lo.x, lo.y, hi.x, hi.y);
            O1 = __builtin_amdgcn_mfma_f32_32x32x16_bf16(__builtin_bit_cast(bf16x8, u), pf[s2], O1, 0, 0, 0);
          }
        }
      }
    }
    buf ^= 1;
  }
  const float lt = lsum + shfl_xor_l(lsum, 32);
  const float inv = 1.f / lt;
  bf16_t* op = YMIX + (size_t)(qrow0 + r) * D + 512 + hq * 64 + 4 * hh;
#pragma unroll
  for (int g4 = 0; g4 < 4; ++g4) {
    uint2 o; o.x = pack2(O0[4 * g4] * inv, O0[4 * g4 + 1] * inv); o.y = pack2(O0[4 * g4 + 2] * inv, O0[4 * g4 + 3] * inv);
    *(uint2*)(op + 8 * g4) = o;
    uint2 o1; o1.x = pack2(O1[4 * g4] * inv, O1[4 * g4 + 1] * inv); o1.y = pack2(O1[4 * g4 + 2] * inv, O1[4 * g4 + 3] * inv);
    *(uint2*)(op + 32 + 8 * g4) = o1;
  }
  __syncthreads();
}

DEVI void phase_mixers(const Params& p, int l, unsigned char* smem) {
  const int bid = bid_(), G = gridDim.x;
  const int nsb = (G >> 4) * 8 + ((G & 15) < 8 ? (G & 15) : 8);
  if (((bid >> 3) & 1) == 0) {
    for (int it = (bid >> 4) * 8 + (bid & 7); it < 128; it += nsb) { if (it & 1) rwkv_chunked<1>(p, l, it, smem); else rwkv_chunked<0>(p, l, it, smem); }
  }
  const int n_attn = (l == 0) ? 1152 : 1024, nq = 256 + n_attn;
  int* ctr = (int*)(uws(p) + WS_CTL) + 64 + l;
  volatile int* sTick = (volatile int*)(smem + SMEM_BYTES - 16);
  const int tid = tid_();
  __syncthreads();
  if (tid == 0) sTick[0] = atomicAdd(ctr, 1);
  __syncthreads();
  int cur = sTick[0];
  while (cur < nq) {
    int nxt = 0;
    if (tid == 0) nxt = atomicAdd(ctr, 1);
    if (cur >= n_attn) { const int c = cur - n_attn; s5_carry_item(p, l, c >> 4, c & 15); }
    else if (cur < 768) { const int bb = cur / 48, r = cur % 48; attn_item(p, l, bb, 1 + (r >> 3), r & 7, smem); }
    else if (cur < 1024) { const int a = cur - 768, bb = a >> 4, r = a & 15; attn_item(p, l, bb, (r >> 3) ? 7 : 0, r & 7, smem); }
    else attn_item(p, l, (cur - 1024) >> 3, -1, (cur - 1024) & 7, smem);
    __syncthreads();
    if (tid == 0) sTick[0] = nxt;
    __syncthreads();
    cur = sTick[0];
  }
}

DEVI void phase_mixfin(const Params& p, int l, unsigned char* smem) {
  unsigned char* ws = uws(p);
  const int tid = tid_(), bid = bid_(), G = gridDim.x;
  bf16_t* YMIX = (bf16_t*)(ws + WS_YMIX);
  {
    S5Sched S{(const bf16_t*)(ws + WS_UDH), (const bf16_t*)(ws + WS_TTG) + (size_t)l * 16 * 512 * 768, G, bid, (l == 1) ? 4 : 5};
    EpiS5 E{(bf16_t*)((unsigned char*)uout(p) + DO_ZB)};
    __syncthreads();
    g8::gemm((G8_LAS unsigned char*)smem, 768, S, E);
    __syncthreads();
  }
  {
    const bf16_t* PROJ = (const bf16_t*)(ws + WS_PROJ);
    const unsigned short* FEAT = (const unsigned short*)(ws + WS_FEAT);
    const float* YF = (const float*)((unsigned char*)uout(p) + DO_YF); const float* YB = (const float*)((unsigned char*)uout(p) + DO_YB);
    const float* CW = uin(p, I_CONV) + l * 3 * 1024;
    const int c4 = (tid & 15) * 4;
    const int nbusy = (16 * ((l == 1) ? 4 : 5) * 2 < G) ? 16 * ((l == 1) ? 4 : 5) * 2 : G;
    const int nvirt = nbusy + 2 * (G - nbusy);
    const int ustride = (nvirt * NTHREADS) >> 4;
    const int nun = ((l == 1) ? NLAT : NT) * 4;
    const int vb0 = (bid < nbusy) ? bid : nbusy + 2 * (bid - nbusy);
    const int u0 = (vb0 * NTHREADS + tid) >> 4;
    const int h = u0 & 3, hc = h * 64 + c4;
    float cwr[3][4], cwk[3][4], cwv[3][4], kaw[4], rkw[4], gnw[4], gnb[4];
#pragma unroll
    for (int dl = 0; dl < 3; ++dl)
#pragma unroll
      for (int e = 0; e < 4; ++e) { cwr[dl][e] = CW[dl * 1024 + hc + e]; cwk[dl][e] = CW[dl * 1024 + 256 + hc + e]; cwv[dl][e] = CW[dl * 1024 + 512 + hc + e]; }
#pragma unroll
    for (int e = 0; e < 4; ++e) { kaw[e] = uin(p, I_KA)[l * 256 + hc + e]; rkw[e] = uin(p, I_RK)[l * 256 + hc + e]; gnw[e] = uin(p, I_GNW)[l * 256 + hc + e]; gnb[e] = uin(p, I_GNB)[l * 256 + hc + e]; }
    for (int pass = 0; pass < ((bid < nbusy) ? 1 : 2); ++pass)
    for (int u = u0 + pass * 32; u < nun; u += ustride) {
      const int R = u >> 2;
      const int t = R < NLAT ? (R & 2047) : ((R - NLAT) & 255); const int len = R < NLAT ? SEQ : CTXL;
      const float4 yf = *(const float4*)(YF + (size_t)R * 256 + hc), yb = *(const float4*)(YB + (size_t)R * 256 + hc);
      float y[4] = {yf.x + yb.x, yf.y + yb.y, yf.z + yb.z, yf.w + yb.w};
      const float mu = row_sum16(y[0] + y[1] + y[2] + y[3]) * (1.f / 64.f);
      float q = 0.f;
#pragma unroll
      for (int e = 0; e < 4; ++e) { y[e] -= mu; q += y[e] * y[e]; }
      const float rstd = rsqrtf(row_sum16(q) * (1.f / 64.f) + GN_EPS);
      const bf16_t* pr = PROJ + (size_t)R * DIN + hc;
      const uint2 zc = make_uint2(0, 0);
      const uint2 rc = *(const uint2*)pr, kc = *(const uint2*)(pr + 256), vc = *(const uint2*)(pr + 512);
      uint2 rp = zc, kp = zc, vp = zc, rn = zc, kn = zc, vn = zc;
      if (t > 0) { rp = *(const uint2*)(pr - DIN); kp = *(const uint2*)(pr - DIN + 256); vp = *(const uint2*)(pr - DIN + 512); }
      if (t < len - 1) { rn = *(const uint2*)(pr + DIN); kn = *(const uint2*)(pr + DIN + 256); vn = *(const uint2*)(pr + DIN + 512); }
      const float rpf[4] = {lo_bf(rp.x), hi_bf(rp.x), lo_bf(rp.y), hi_bf(rp.y)}, rcf[4] = {lo_bf(rc.x), hi_bf(rc.x), lo_bf(rc.y), hi_bf(rc.y)}, rnf[4] = {lo_bf(rn.x), hi_bf(rn.x), lo_bf(rn.y), hi_bf(rn.y)};
      const float kpf[4] = {lo_bf(kp.x), hi_bf(kp.x), lo_bf(kp.y), hi_bf(kp.y)}, kcf[4] = {lo_bf(kc.x), hi_bf(kc.x), lo_bf(kc.y), hi_bf(kc.y)}, knf[4] = {lo_bf(kn.x), hi_bf(kn.x), lo_bf(kn.y), hi_bf(kn.y)};
      const float vpf[4] = {lo_bf(vp.x), hi_bf(vp.x), lo_bf(vp.y), hi_bf(vp.y)}, vcf[4] = {lo_bf(vc.x), hi_bf(vc.x), lo_bf(vc.y), hi_bf(vc.y)}, vnf[4] = {lo_bf(vn.x), hi_bf(vn.x), lo_bf(vn.y), hi_bf(vn.y)};
      const unsigned short* fr_ = FEAT + (size_t)R * 1280 + hc;
      const uint2 a0u = *(const uint2*)(fr_ + 512), a1u = *(const uint2*)(fr_ + 768), gtu = *(const uint2*)(fr_ + 1024);
      const float a0[4] = {h2f(a0u.x & 0xFFFF), h2f(a0u.x >> 16), h2f(a0u.y & 0xFFFF), h2f(a0u.y >> 16)};
      const float a1[4] = {h2f(a1u.x & 0xFFFF), h2f(a1u.x >> 16), h2f(a1u.y & 0xFFFF), h2f(a1u.y >> 16)};
      const float gt[4] = {h2f(gtu.x & 0xFFFF), h2f(gtu.x >> 16), h2f(gtu.y & 0xFFFF), h2f(gtu.y >> 16)};
      float bs = 0.f, vv[4];
#pragma unroll
      for (int e = 0; e < 4; ++e) {
        const float r = cwr[0][e] * rpf[e] + cwr[1][e] * rcf[e] + cwr[2][e] * rnf[e];
        const float k = cwk[0][e] * kpf[e] + cwk[1][e] * kcf[e] + cwk[2][e] * knf[e];
        vv[e] = cwv[0][e] * vpf[e] + cwv[1][e] * vcf[e] + cwv[2][e] * vnf[e];
        const float ksum = k * (2.f + (a0[e] + a1[e] - 2.f) * kaw[e]);
        bs += r * ksum * rkw[e];
      }
      bs = row_sum16(bs);
      float o[4];
#pragma unroll
      for (int e = 0; e < 4; ++e) {
        const float yn = y[e] * rstd * gnw[e] + gnb[e];
        o[e] = (yn + bs * vv[e]) * gt[e];
      }
      uint2 w; w.x = pack2(o[0], o[1]); w.y = pack2(o[2], o[3]);
      *(uint2*)(YMIX + (size_t)R * D + hc) = w;
    }
  }
}

struct EpiGlu {
  static constexpr bool PERM = true;
  const bf16_t* ZB; bf16_t* YMIX; const float* gb;
  DEVI void operator()(const f32x4 (&acc)[2][2][4][2], const g8::Unit& u) const {
    const int tid = tid_(), wid = __builtin_amdgcn_readfirstlane(tid >> 6), lane = tid & 63, wr = wid >> 2, wc = wid & 3, fr = lane & 15, fq = lane >> 4;
#pragma unroll
    for (int ai = 0; ai < 2; ++ai)
#pragma unroll
      for (int m = 0; m < 4; ++m) {
        const int row = u.pm * 256 + ai * 128 + wr * 64 + m * 16 + fr;
#pragma unroll
        for (int bj = 0; bj < 2; ++bj) {
          const int col = bj * 128 + wc * 32 + 8 * fq;
          const uint4 zz = *(const uint4*)(ZB + (size_t)row * 256 + col);
          const float4 b0 = *(const float4*)(gb + col), b1 = *(const float4*)(gb + col + 4);
          const f32x4 v0 = acc[ai][bj][m][0], v1 = acc[ai][bj][m][1];
          *(uint4*)(YMIX + (size_t)row * D + 256 + col) = make_uint4(
            pack2(lo_bf(zz.x) * sigmoidf(v0[0] + b0.x), hi_bf(zz.x) * sigmoidf(v0[1] + b0.y)), pack2(lo_bf(zz.y) * sigmoidf(v0[2] + b0.z), hi_bf(zz.y) * sigmoidf(v0[3] + b0.w)),
            pack2(lo_bf(zz.z) * sigmoidf(v1[0] + b1.x), hi_bf(zz.z) * sigmoidf(v1[1] + b1.y)), pack2(lo_bf(zz.w) * sigmoidf(v1[2] + b1.z), hi_bf(zz.w) * sigmoidf(v1[3] + b1.w)));
        }
        asm volatile("" ::: "memory");
      }
  }
};
DEVI void phase_glu(const Params& p, int l, unsigned char* smem) {
  unsigned char* ws = uws(p);
  g8::DenseSched S{(const bf16_t*)((unsigned char*)uout(p) + DO_ZB), (const bf16_t*)(ws + WS_GLU_T) + (size_t)l * 65536, 256, (l == 1) ? 128 : 144, 1, (int)gridDim.x, bid_()};
  EpiGlu E{(const bf16_t*)((unsigned char*)uout(p) + DO_ZB), (bf16_t*)(ws + WS_YMIX), uin(p, I_GLUB) + l * 256};
  __syncthreads();
  g8::gemm((G8_LAS unsigned char*)smem, 256, S, E);
  __syncthreads();
}

struct EpiBf16 {
  static constexpr bool PERM = true;
  bf16_t* O; int ldc;
  DEVI void operator()(const f32x4 (&acc)[2][2][4][2], const g8::Unit& u) const {
    const int tid = tid_(), wid = __builtin_amdgcn_readfirstlane(tid >> 6), lane = tid & 63, wr = wid >> 2, wc = wid & 3, fr = lane & 15, fq = lane >> 4;
#pragma unroll
    for (int ai = 0; ai < 2; ++ai)
#pragma unroll
      for (int m = 0; m < 4; ++m) {
        bf16_t* rowp = O + (size_t)(u.pm * 256 + ai * 128 + wr * 64 + m * 16 + fr) * ldc + u.pn * 256 + wc * 32 + 8 * fq;
#pragma unroll
        for (int bj = 0; bj < 2; ++bj) {
          const f32x4 v0 = acc[ai][bj][m][0], v1 = acc[ai][bj][m][1];
          *(uint4*)(rowp + bj * 128) = make_uint4(pack2(v0[0], v0[1]), pack2(v0[2], v0[3]), pack2(v1[0], v1[1]), pack2(v1[2], v1[3]));
        }
      }
  }
};
DEVI void phase_outproj(const Params& p, int l, unsigned char* smem) {
  unsigned char* ws = uws(p);
  g8::DenseSched S{(const bf16_t*)(ws + WS_YMIX), (const bf16_t*)(ws + WS_WOUT_T) + (size_t)l * D * D, D, (l == 1) ? 128 : 144, 4, (int)gridDim.x, bid_()};
  EpiBf16 E{(bf16_t*)(ws + WS_MIX), D};
  __syncthreads();
  g8::gemm((G8_LAS unsigned char*)smem, D, S, E);
  __syncthreads();
  if (l == 0) { const int G = gridDim.x, rem = (144 * 4) % G; if (rem == 0) build_ttg_em(p, 1, bid_(), G); else if (bid_() >= rem) build_ttg_em(p, 1, bid_() - rem, G - rem); }
}

DEVI void phase_ln1(const Params& p, int l, unsigned char* smem) {
  unsigned char* ws = uws(p);
  const int tid = tid_(), lane = tid & 63, wid = tid >> 6;
  const bf16_t* MIX = (const bf16_t*)(ws + WS_MIX);
  _Float16* X = (_Float16*)(ws + WS_X);
  bf16_t* H = (bf16_t*)(ws + WS_H);
  const float* MOD = (const float*)(ws + WS_MOD);
  const int nrows1 = (l == 1) ? NLAT : NT;
  const int nw = gridDim.x * 8, gw = bid_() * 8 + wid;
  const int rpw = (nrows1 + nw - 1) / nw;
  const int R0 = gw * rpw, R1 = (R0 + rpw < nrows1) ? (R0 + rpw) : nrows1;
  const int c0 = lane * 8, c1 = 512 + lane * 8;
  float g[2][8], bb[2][8], gt[2][8], sh[2][8], sc[2][8];
  ld8f(uin(p, I_LN1G) + l * D + c0, g[0]); ld8f(uin(p, I_LN1G) + l * D + c1, g[1]);
  ld8f(uin(p, I_LN1B) + l * D + c0, bb[0]); ld8f(uin(p, I_LN1B) + l * D + c1, bb[1]);
  int curb = -1;
  float xv[2][8], mx[2][8];
  auto load_row = [&](int Rr, float (&xo)[2][8], float (&mo)[2][8]) {
    if (l == 0) { const float* xr = xin_row(p, Rr); ld8f(xr + c0, xo[0]); ld8f(xr + c1, xo[1]); }
    else { const _Float16* xr = X + (size_t)Rr * D; ld8h(xr + c0, xo[0]); ld8h(xr + c1, xo[1]); }
    ld8b(MIX + (size_t)Rr * D + c0, mo[0]); ld8b(MIX + (size_t)Rr * D + c1, mo[1]);
  };
  if (R0 < R1) load_row(R0, xv, mx);
  for (int R = R0; R < R1; ++R) {
    float xn[2][8], mn[2][8];
#pragma unroll
    for (int h = 0; h < 2; ++h)
#pragma unroll
      for (int e = 0; e < 8; ++e) { xn[h][e] = 0.f; mn[h][e] = 0.f; }
    if (R + 1 < R1) load_row(R + 1, xn, mn);
    const int bi = bidx_of(R);
    if (bi != curb) {
      curb = bi;
      const float* modl = MOD + (size_t)(l * 17 + bi) * 6144;
      ld8f(modl + 2048 + c0, gt[0]); ld8f(modl + 2048 + c1, gt[1]);
      ld8f(modl + 3072 + c0, sh[0]); ld8f(modl + 3072 + c1, sh[1]);
      ld8f(modl + 4096 + c0, sc[0]); ld8f(modl + 4096 + c1, sc[1]);
    }
    float v[2][8]; float s = 0.f;
#pragma unroll
    for (int h = 0; h < 2; ++h)
#pragma unroll
      for (int e = 0; e < 8; ++e) { v[h][e] = ALPHA * xv[h][e] + gt[h][e] * mx[h][e]; s += v[h][e]; }
    const float mu = wave_sum(s) * (1.f / 1024.f);
    float q = 0.f;
#pragma unroll
    for (int h = 0; h < 2; ++h)
#pragma unroll
      for (int e = 0; e < 8; ++e) { v[h][e] -= mu; q += v[h][e] * v[h][e]; }
    const float rstd = rsqrtf(wave_sum(q) * (1.f / 1024.f) + LN_EPS);
#pragma unroll
    for (int h = 0; h < 2; ++h) {
      float x1[8], hm[8];
#pragma unroll
      for (int e = 0; e < 8; ++e) { x1[e] = v[h][e] * rstd * g[h][e] + bb[h][e]; hm[e] = x1[e] * (1.f + sc[h][e]) + sh[h][e]; }
      st8h(X + (size_t)R * D + (h ? c1 : c0), x1);
      st8b(H + (size_t)R * D + (h ? c1 : c0), hm);
    }
#pragma unroll
    for (int h = 0; h < 2; ++h)
#pragma unroll
      for (int e = 0; e < 8; ++e) { xv[h][e] = xn[h][e]; mx[h][e] = mn[h][e]; }
  }
}

DEVI void phase_router(const Params& p, int l, unsigned char* smem) {
  unsigned char* ws = uws(p);
  const int tid = tid_(), lrow = tid >> 2;
  const bf16_t* H = (const bf16_t*)(ws + WS_H);
  const bf16_t* RWH = (const bf16_t*)(ws + WS_RW) + (size_t)l * 2 * 128 * 1024;
  int* CNT = (int*)(ws + WS_CTL) + l * 32;
  int* LIST = (int*)(ws + WS_LIST);
  int4* ROUTE = (int4*)(ws + WS_ROUTE);
  float2* RWT = (float2*)(ws + WS_RWT);
  bf16_t* EW1 = (bf16_t*)(ws + WS_EW); bf16_t* EW2 = EW1 + (size_t)32 * 1024 * 1024;
  constexpr int N_CONV = 32 * 96;
  const int nmt = (l == 1) ? 128 : 144;
  for (int it0 = bid_(); it0 < nmt; it0 += gridDim.x) {
    {
      const int mt = it0;
      const bf16_t* a0 = H + (size_t)(mt * 256 + lrow) * D; const bf16_t* a1 = a0 + (size_t)128 * D;
      const bf16_t* b0 = RWH + (size_t)lrow * 1024;
      gemm_tile(smem, 0, D,
        [&](int i, int k) { return *(const uint4*)((i ? a1 : a0) + k); },
        [&](int k) { return *(const uint4*)(b0 + k); },
        [&](f32x4 (&acc)[4][4], int wr, int wc, int fr, int fq) {
          float* sLog = (float*)smem;
          if (wc == 0) {
#pragma unroll
            for (int m = 0; m < 4; ++m)
#pragma unroll
              for (int n = 0; n < 3; ++n)
#pragma unroll
                for (int j = 0; j < 4; ++j) { const int col = n * 16 + fq * 4 + j; if (col < 36) sLog[(wr * 64 + m * 16 + fr) * 37 + col] = acc[m][n][j]; }
          }
        });
      int* sHist = (int*)(smem + 40960); int* sBase = sHist + 32;
      if (tid < 32) sHist[tid] = 0;
      __syncthreads();
      int e1 = 0, e2 = 0, lp1 = 0, lp2 = 0; float w1 = 0.f, w2 = 0.f;
      if (tid < 256) {
        const float* lg = (const float*)smem + tid * 37;
        float gl[4]; int gi = 0; float gmax;
#pragma unroll
        for (int i = 0; i < 4; ++i) gl[i] = lg[i] + uin(p, I_RGB)[l * 4 + i];
        gmax = gl[0];
#pragma unroll
        for (int i = 1; i < 4; ++i) if (gl[i] > gmax) { gmax = gl[i]; gi = i; }
        float gs = 0.f;
#pragma unroll
        for (int i = 0; i < 4; ++i) gs += expf(gl[i] - gmax);
        const float gprob = 1.f / gs;
        float el[8];
#pragma unroll
        for (int j = 0; j < 8; ++j) el[j] = lg[4 + gi * 8 + j] + uin(p, I_REB)[l * 32 + gi * 8 + j];
        int i1 = 0; float l1 = el[0];
#pragma unroll
        for (int j = 1; j < 8; ++j) if (el[j] > l1) { l1 = el[j]; i1 = j; }
        int i2 = (i1 == 0) ? 1 : 0; float l2 = -3.0e38f;
#pragma unroll
        for (int j = 0; j < 8; ++j) if (j != i1 && el[j] > l2) { l2 = el[j]; i2 = j; }
        const float ex = expf(l2 - l1);
        w1 = gprob / (1.f + ex); w2 = gprob * ex / (1.f + ex);
        e1 = gi * 8 + i1; e2 = gi * 8 + i2;
        lp1 = atomicAdd(&sHist[e1], 1); lp2 = atomicAdd(&sHist[e2], 1);
      }
      __syncthreads();
      if (tid < 32) sBase[tid] = atomicAdd(&CNT[tid], sHist[tid]);
      __syncthreads();
      if (tid < 256) {
        const int R = mt * 256 + tid;
        const int p1 = sBase[e1] + lp1, p2 = sBase[e2] + lp2;
        LIST[(size_t)e1 * NT + p1] = R; LIST[(size_t)e2 * NT + p2] = R;
        ROUTE[R] = make_int4(e1, p1, e2, p2);
        RWT[R] = make_float2(w1, w2);
      }
      __syncthreads();
    }
  }
  {
    auto conv_src = [&](int j, const float*& src, int& ld, int& k0, int& n0) {
      const int e = j / 96, r = j % 96;
      if (r < 64) { const int kt = r >> 2, ct = r & 3, up = ct >> 1; src = (up ? uin(p, I_EWU) : uin(p, I_EWG)) + (size_t)(l * 32 + e) * 1024 * 512; ld = 512; k0 = kt * 64; n0 = (ct & 1) * 256; }
      else { const int r2 = r - 64, kt = r2 >> 2, ntl = r2 & 3; src = uin(p, I_EWD) + (size_t)(l * 32 + e) * 512 * 1024; ld = 1024; k0 = kt * 64; n0 = ntl * 256; }
    };
    const int G = gridDim.x;
    int j = bid_();
    TrRegs cur, nxt;
    const float* src; int ld, k0, n0;
    if (j < N_CONV) { conv_src(j, src, ld, k0, n0); transpose_load(cur, src, ld, k0, n0); }
    while (j < N_CONV) {
      int jn;
      if (j < 8 * G) { jn = j + G; if (jn >= 8 * G) jn = (bid_() >= nmt) ? (8 * G + bid_() - nmt) : N_CONV; }
      else jn = j + (G - nmt);
      if (jn < N_CONV) { const float* s2; int ld2, k2, n2; conv_src(jn, s2, ld2, k2, n2); transpose_load(nxt, s2, ld2, k2, n2); }
      const int e = j / 96, r = j % 96;
      if (r < 64) {
        const int kt = r >> 2, ct = r & 3, up = ct >> 1;
        transpose_finish(smem, cur, kt * 64, (ct & 1) * 256, EW1 + (size_t)e * 1024 * 1024, 1024,
          [&](int c) { return 256 * (c >> 7) + 128 * ((c >> 6) & 1) + 32 * ((c >> 4) & 3) + 16 * up + (c & 15); });
      } else {
        const int r2 = r - 64, kt = r2 >> 2, ntl = r2 & 3;
        transpose_finish(smem, cur, kt * 64, ntl * 256, EW2 + (size_t)e * 1024 * 512, 512, [](int n) { return n; });
      }
      cur = nxt; j = jn;
    }
  }
}

DEVI void moe_prefix(const Params& p, int l, int* sPre, int* sCnt) {
  const int* CNT = (const int*)(uws(p) + WS_CTL) + l * 32;
  if (tid_() == 0) {
    int s = 0;
    for (int e = 0; e < 32; ++e) { const int c = CNT[e]; sCnt[e] = c; sPre[e] = s; s += (c + 255) >> 8; }
    sPre[32] = s;
  }
  __syncthreads();
  {
    unsigned char* sBlkE = (unsigned char*)sPre + (MISC_BLKE - MISC_PRE);
    const int nb = sPre[32];
    for (int rb = tid_(); rb < nb; rb += NTHREADS) { int e = 0; for (int q = 1; q < 32; ++q) if (sPre[q] <= rb) e = q; sBlkE[rb] = (unsigned char)e; }
  }
  __syncthreads();
}

struct MoeSched {
  const int* sPre; const int* sCnt; const unsigned char* sBlkE; const bf16_t* Abase; const int* LIST; const bf16_t* Wbase; int K; size_t wstride; int nN, G, c, gather;
  DEVI bool next(int i, g8::Unit& u) const {
    const int nwg = sPre[32] * nN; const long L = (long)i * G + c; if (L >= nwg) return false;
    const int w = g8::xcd_remap((int)L, nwg);
    u.pm = w / nN; u.pn = w % nN;
    u.e = sBlkE[u.pm]; return true;
  }
  DEVI const char* a_base() const { return (const char*)Abase; }
  DEVI void a_offs(const g8::Unit& u, int tid, unsigned (&ao)[2][2]) const {
#pragma unroll
    for (int i = 0; i < 2; ++i) {
      int R, C; g8::stage_rc(tid * 16 + i * 8192, R, C);
#pragma unroll
      for (int h = 0; h < 2; ++h) {
        int row = u.pm * 256 + h * 128 + R;
        if (gather) {
          const int sl = (u.pm - sPre[u.e]) * 256 + h * 128 + R;
          row = LIST[(size_t)u.e * NT + (sl < sCnt[u.e] ? sl : 0)];
        }
        ao[h][i] = ((unsigned)row * (unsigned)K + (unsigned)C) * 2u;
      }
    }
  }
  DEVI const char* b_ptr(const g8::Unit& u) const { return (const char*)(Wbase + (size_t)u.e * wstride + (size_t)u.pn * 256 * K); }
};
struct EpiMoe1 {
  static constexpr bool PERM = false;
  bf16_t* ACT;
  DEVI void operator()(const f32x4 (&acc)[2][2][4][2], const g8::Unit& u) const {
    const int tid = tid_(), wid = __builtin_amdgcn_readfirstlane(tid >> 6), lane = tid & 63, wr = wid >> 2, wc = wid & 3, fr = lane & 15, fq = lane >> 4;
#pragma unroll
    for (int ai = 0; ai < 2; ++ai)
#pragma unroll
      for (int m = 0; m < 4; ++m) {
        const size_t slot = (size_t)u.pm * 256 + ai * 128 + wr * 64 + m * 16 + fr;
#pragma unroll
        for (int bj = 0; bj < 2; ++bj) {
          const f32x4 g = acc[ai][bj][m][0], up = acc[ai][bj][m][1];
          float o[4];
#pragma unroll
          for (int j = 0; j < 4; ++j) o[j] = g[j] * __builtin_amdgcn_rcpf(1.f + __expf(-g[j])) * up[j];
          uint2 w; w.x = pack2(o[0], o[1]); w.y = pack2(o[2], o[3]);
          *(uint2*)(ACT + slot * 512 + u.pn * 128 + bj * 64 + wc * 16 + 4 * fq) = w;
        }
      }
  }
};
DEVI void phase_moe1(const Params& p, int l, unsigned char* smem) {
  unsigned char* ws = uws(p);
  int* sPre = (int*)(smem + SMEM_BYTES + MISC_PRE); int* sCnt = (int*)(smem + SMEM_BYTES + MISC_CNT);
  moe_prefix(p, l, sPre, sCnt);
  MoeSched S{sPre, sCnt, (const unsigned char*)(smem + SMEM_BYTES + MISC_BLKE), (const bf16_t*)(ws + WS_H), (const int*)(ws + WS_LIST), (const bf16_t*)(ws + WS_EW), D, (size_t)1024 * 1024, 4, (int)gridDim.x, bid_(), 1};
  EpiMoe1 E{(bf16_t*)(ws + WS_ACT)};
  g8::gemm((G8_LAS unsigned char*)smem, D, S, E);
  __syncthreads();
}
DEVI void phase_moe2(const Params& p, int l, unsigned char* smem) {
  unsigned char* ws = uws(p);
  int* sPre = (int*)(smem + SMEM_BYTES + MISC_PRE); int* sCnt = (int*)(smem + SMEM_BYTES + MISC_CNT);
  moe_prefix(p, l, sPre, sCnt);
  MoeSched S{sPre, sCnt, (const unsigned char*)(smem + SMEM_BYTES + MISC_BLKE), (const bf16_t*)(ws + WS_ACT), (const int*)(ws + WS_LIST), (const bf16_t*)(ws + WS_EW) + (size_t)32 * 1024 * 1024, 512, (size_t)1024 * 512, 4, (int)gridDim.x, bid_(), 0};
  EpiBf16 E{(bf16_t*)(ws + WS_YROWS), D};
  g8::gemm((G8_LAS unsigned char*)smem, 512, S, E);
  __syncthreads();
}

DEVI void phase_ln2(const Params& p, int l, unsigned char* smem) {
  unsigned char* ws = uws(p);
  int* sPre = (int*)(smem + SMEM_BYTES + MISC_PRE); int* sCnt = (int*)(smem + SMEM_BYTES + MISC_CNT);
  moe_prefix(p, l, sPre, sCnt);
  const int tid = tid_(), lane = tid & 63, wid = tid >> 6;
  _Float16* X = (_Float16*)(ws + WS_X);
  const bf16_t* YR = (const bf16_t*)(ws + WS_YROWS);
  const int4* ROUTE = (const int4*)(ws + WS_ROUTE);
  const float2* RWT = (const float2*)(ws + WS_RWT);
  const float* MOD = (const float*)(ws + WS_MOD);
  const float* g2 = uin(p, I_LN2G) + l * D; const float* b2 = uin(p, I_LN2B) + l * D;
  bf16_t* XM = (bf16_t*)((unsigned char*)uout(p) + DO_XMOD);
  const int nrows = (l == 0) ? NT : NLAT;
  const int nw = gridDim.x * 8, gw = bid_() * 8 + wid;
  const int rpw = (nrows + nw - 1) / nw;
  const int R0 = gw * rpw, R1 = (R0 + rpw < nrows) ? (R0 + rpw) : nrows;
  const int c0 = lane * 8, c1 = 512 + lane * 8;
  float g[2][8], bb[2][8], gt[2][8], sh1n[2][8], sc1n[2][8];
  ld8f(g2 + c0, g[0]); ld8f(g2 + c1, g[1]); ld8f(b2 + c0, bb[0]); ld8f(b2 + c1, bb[1]);
  int curb = -1;
  float xv[2][8], ua[2][8], ub[2][8]; float2 rw = make_float2(0.f, 0.f);
  int4 rt_n = make_int4(0, 0, 0, 0); float2 rw_n = make_float2(0.f, 0.f);
  auto load_data = [&](int Rr, const int4& rt, float (&xo)[2][8], float (&ao)[2][8], float (&bo)[2][8]) {
    const bf16_t* ya = YR + ((size_t)sPre[rt.x] * 256 + rt.y) * 1024; const bf16_t* yb = YR + ((size_t)sPre[rt.z] * 256 + rt.w) * 1024;
    const _Float16* xr = X + (size_t)Rr * D;
    ld8h(xr + c0, xo[0]); ld8h(xr + c1, xo[1]); ld8b(ya + c0, ao[0]); ld8b(ya + c1, ao[1]); ld8b(yb + c0, bo[0]); ld8b(yb + c1, bo[1]);
  };
  if (R0 < R1) { const int4 rt0 = ROUTE[R0]; rw = RWT[R0]; load_data(R0, rt0, xv, ua, ub); }
  if (R0 + 1 < R1) { rt_n = ROUTE[R0 + 1]; rw_n = RWT[R0 + 1]; }
  for (int R = R0; R < R1; ++R) {
    float xn[2][8], an[2][8], bn[2][8];
#pragma unroll
    for (int h = 0; h < 2; ++h)
#pragma unroll
      for (int e = 0; e < 8; ++e) { xn[h][e] = 0.f; an[h][e] = 0.f; bn[h][e] = 0.f; }
    if (R + 1 < R1) load_data(R + 1, rt_n, xn, an, bn);
    const float2 rw_next = rw_n;
    if (R + 2 < R1) { rt_n = ROUTE[R + 2]; rw_n = RWT[R + 2]; }
    const int bi = bidx_of(R);
    if (bi != curb) {
      curb = bi;
      const float* modl = MOD + (size_t)(l * 17 + bi) * 6144;
      ld8f(modl + 5120 + c0, gt[0]); ld8f(modl + 5120 + c1, gt[1]);
      if (l == 0) {
        const float* modn = MOD + (size_t)(1 * 17 + bi) * 6144;
        ld8f(modn + c0, sh1n[0]); ld8f(modn + c1, sh1n[1]); ld8f(modn + 1024 + c0, sc1n[0]); ld8f(modn + 1024 + c1, sc1n[1]);
      }
    }
    float v[2][8]; float s = 0.f;
#pragma unroll
    for (int h = 0; h < 2; ++h)
#pragma unroll
      for (int e = 0; e < 8; ++e) { v[h][e] = ALPHA * xv[h][e] + gt[h][e] * (rw.x * ua[h][e] + rw.y * ub[h][e]); s += v[h][e]; }
    const float mu = wave_sum(s) * (1.f / 1024.f);
    float q = 0.f;
#pragma unroll
    for (int h = 0; h < 2; ++h)
#pragma unroll
      for (int e = 0; e < 8; ++e) { v[h][e] -= mu; q += v[h][e] * v[h][e]; }
    const float rstd = rsqrtf(wave_sum(q) * (1.f / 1024.f) + LN_EPS);
#pragma unroll
    for (int h = 0; h < 2; ++h) {
      float x2[8];
#pragma unroll
      for (int e = 0; e < 8; ++e) x2[e] = v[h][e] * rstd * g[h][e] + bb[h][e];
      const int cc = h ? c1 : c0;
      if (l == 0) {
        st8h(X + (size_t)R * D + cc, x2);
        float xm[8];
#pragma unroll
        for (int e = 0; e < 8; ++e) xm[e] = x2[e] * (1.f + sc1n[h][e]) + sh1n[h][e];
        st8b(XM + (size_t)R * D + cc, xm);
      } else {
        st8f(uout(p) + (size_t)R * D + cc, x2);
      }
    }
#pragma unroll
    for (int h = 0; h < 2; ++h)
#pragma unroll
      for (int e = 0; e < 8; ++e) { xv[h][e] = xn[h][e]; ua[h][e] = an[h][e]; ub[h][e] = bn[h][e]; }
    rw = rw_next;
  }
}

#define XB_TMO      128
#define XB_XCNT(j)  (256  + 64 * (j))
#define XB_XSUB(j)  (1280 + 64 * (j))
#define XB_XGEN(j)  (2304 + 64 * (j))
#define XB_TOP      3328
#define XB_TOPGEN   3392
#define XCD_BAR_WORDS 3456
#define XB_SPIN_CAP (1u << 20)
DEVI unsigned xb_ld(unsigned* p) { return __hip_atomic_load(p, __ATOMIC_RELAXED, __HIP_MEMORY_SCOPE_AGENT); }
DEVI unsigned xb_add(unsigned* p, unsigned v) { return __hip_atomic_fetch_add(p, v, __ATOMIC_RELAXED, __HIP_MEMORY_SCOPE_AGENT); }
DEVI unsigned xb_xcc_id() { return (unsigned)__builtin_amdgcn_s_getreg((3 << 11) | 20) & 0xFu; }
#define XB_SPIN(cond, bar) do { unsigned _sp = 0; while (cond) { __builtin_amdgcn_s_sleep(1); \
    if ((++_sp & 255u) == 0u) { if (xb_ld(&(bar)[XB_TMO])) break; if (_sp > XB_SPIN_CAP) { atomicAdd(&(bar)[XB_TMO], 1u); break; } } } } while (0)
DEVI void xcd_barrier_complete(unsigned* bar, unsigned x, unsigned& nloc, unsigned& nx) {
  const unsigned G = gridDim.x;
  unsigned sum, cnt, mine, sp = 0u;
  for (;;) {
    sum = 0u; cnt = 0u; mine = 0u;
#pragma unroll
    for (unsigned j = 0; j < 16; ++j) { const unsigned c = xb_ld(&bar[XB_XCNT(j)]); sum += c; cnt += (c > 0u) ? 1u : 0u; mine = (j == x) ? c : mine; }
    if (sum == G) break;
    __builtin_amdgcn_s_sleep(1);
    if ((++sp & 255u) == 0u) { if (xb_ld(&bar[XB_TMO])) break; if (sp > XB_SPIN_CAP) { atomicAdd(&bar[XB_TMO], 1u); break; } }
  }
  nloc = mine > 0u ? mine : 1u; nx = cnt > 0u ? cnt : 1u;
}
DEVI void xcd_barrier(unsigned* bar, volatile unsigned* st) {
  asm volatile("s_waitcnt vmcnt(0)" ::: "memory");
  __syncthreads();
  if (threadIdx.x == 0) {
    __builtin_amdgcn_s_waitcnt(0);
    const unsigned x = xb_xcc_id();
    unsigned nloc = st[0], nx = st[1];
    if (nloc == 0u) { xcd_barrier_complete(bar, x, nloc, nx); st[0] = nloc; st[1] = nx; }
    const unsigned old = xb_add(&bar[XB_XSUB(x)], 1u);
    const unsigned gen = old / nloc;
    if (old + 1u == (gen + 1u) * nloc) {
      __builtin_amdgcn_fence(__ATOMIC_RELEASE, "agent");
      asm volatile("s_waitcnt vmcnt(0)" ::: "memory");
      const unsigned og = xb_add(&bar[XB_TOP], 1u);
      const unsigned tg = og / nx;
      if (og + 1u == (tg + 1u) * nx) xb_add(&bar[XB_TOPGEN], 1u);
      else XB_SPIN(xb_ld(&bar[XB_TOPGEN]) == tg, bar);
      __builtin_amdgcn_fence(__ATOMIC_ACQUIRE, "agent");
      xb_add(&bar[XB_XGEN(x)], 1u);
      asm volatile("s_waitcnt vmcnt(0)" ::: "memory");
    } else {
      XB_SPIN(xb_ld(&bar[XB_XGEN(x)]) == gen, bar);
      __builtin_amdgcn_fence(__ATOMIC_ACQUIRE, "agent");
      asm volatile("s_waitcnt vmcnt(0)" ::: "memory");
    }
  }
  __syncthreads();
}

constexpr int N_PHASES = 24;
DEVI void run_phase(const Params& p, int ph, unsigned char* smem) {
  if (ph == 0) { phase0a(p, smem); return; }
  if (ph == 1) { phase0b(p, smem); return; }
  const int l = (ph - 2) / 11, s = (ph - 2) % 11;
  switch (s) {
    case 0: phase_inproj(p, l, smem); break;
    case 1: phase_feat(p, l, smem); break;
    case 2: phase_mixers(p, l, smem); break;
    case 3: phase_mixfin(p, l, smem); break;
    case 4: phase_glu(p, l, smem); break;
    case 5: phase_outproj(p, l, smem); break;
    case 6: phase_ln1(p, l, smem); break;
    case 7: phase_router(p, l, smem); break;
    case 8: phase_moe1(p, l, smem); break;
    case 9: phase_moe2(p, l, smem); break;
    default: phase_ln2(p, l, smem); break;
  }
}

__global__ void __launch_bounds__(NTHREADS, 2) fwd_megakernel(Params pk) {
  extern __shared__ __attribute__((aligned(16))) unsigned char smem[];
  Params* spp = (Params*)(smem + SMEM_BYTES + MISC_PARAMS);
  if (threadIdx.x == 0) { *spp = pk; ((volatile unsigned*)(smem + SMEM_BYTES + MISC_XB))[0] = 0u; ((volatile unsigned*)(smem + SMEM_BYTES + MISC_XB))[1] = 0u; }
  __syncthreads();
  const Params& p = *spp;
  const int ph_lo = __builtin_amdgcn_readfirstlane(p.ph_lo), ph_hi = __builtin_amdgcn_readfirstlane(p.ph_hi);
#if MK_MULTI
  for (int ph = ph_lo; ph < ph_hi; ++ph) run_phase(p, ph, smem);
#else
  cg::grid_group grid = cg::this_grid();
  if (threadIdx.x == 0) (void)xb_add(&((unsigned*)(uws(p) + WS_BAR))[XB_XCNT(xb_xcc_id())], 1u);
  for (int ph = ph_lo; ph < ph_hi; ++ph) {
    run_phase(p, ph, smem);
#ifdef DUP_MASK
    if ((DUP_MASK >> ph) & 1) { __syncthreads(); run_phase(p, ph, smem); }
#endif
    if (ph + 1 < ph_hi) {
      if (ph == ph_lo) grid.sync();
      else xcd_barrier((unsigned*)(uws(p) + WS_BAR), (volatile unsigned*)(smem + SMEM_BYTES + MISC_XB));
    }
  }
#endif
}

extern "C" void kernel_launch(void* const* d_in, const int* in_sizes, int n_in, void* d_out, int out_size,
                              void* d_ws, size_t ws_size, hipStream_t stream) {
  static int grid_blocks = 0;
  if (!grid_blocks) {
    int dev = 0, cus = 0, per_cu = 0;
    (void)hipGetDevice(&dev);
    (void)hipDeviceGetAttribute(&cus, hipDeviceAttributeMultiprocessorCount, dev);
    (void)hipFuncSetAttribute((const void*)fwd_megakernel, hipFuncAttributeMaxDynamicSharedMemorySize, DSM_BYTES);
    (void)hipOccupancyMaxActiveBlocksPerMultiprocessor(&per_cu, fwd_megakernel, NTHREADS, DSM_BYTES);
    if (per_cu > 1) per_cu = 1;
    grid_blocks = cus * per_cu;
    if (n_in != N_IN || out_size != NLAT * D || ws_size < WS_END) {
      fprintf(stderr, "kernel_launch: unexpected sizes n_in=%d out=%d ws=%zu (need %zu)\n", n_in, out_size, ws_size, (size_t)WS_END);
      grid_blocks = -1;
    }
    fprintf(stderr, "kernel_launch: grid=%d (cus=%d per_cu=%d) ws=%zu\n", grid_blocks, cus, per_cu, ws_size);
  }
  if (grid_blocks <= 0) return;
  Params p{};
  for (int i = 0; i < N_IN; ++i) p.in[i] = (const float*)d_in[i];
  p.out = (float*)d_out; p.ws = (unsigned char*)d_ws;
#if MK_MULTI
  for (int ph = 0; ph < N_PHASES; ++ph) {
    p.ph_lo = ph; p.ph_hi = ph + 1;
    hipLaunchKernelGGL(fwd_megakernel, dim3(grid_blocks), dim3(NTHREADS), DSM_BYTES, stream, p);
  }
#else
  p.ph_lo = 0; p.ph_hi = N_PHASES;
  (void)hipMemsetAsync((unsigned char*)d_ws + WS_BAR, 0, XCD_BAR_WORDS * 4, stream);
  void* args[] = {&p};
  hipError_t e = hipLaunchCooperativeKernel((void*)fwd_megakernel, dim3(grid_blocks), dim3(NTHREADS), args, DSM_BYTES, stream);
  if (e != hipSuccess) fprintf(stderr, "cooperative launch failed: %s (grid %d)\n", hipGetErrorString(e), grid_blocks);
#endif
}
```

```cpp
#include <hip/hip_runtime.h>
#include <hip/hip_cooperative_groups.h>
#include <cstdio>
#include <cstdint>
namespace cg = cooperative_groups;

#ifndef MK_MULTI
#define MK_MULTI 0
#endif

#define DEVI __device__ __forceinline__
typedef unsigned short bf16_t;
typedef short bf16x8 __attribute__((ext_vector_type(8)));
typedef float f32x4 __attribute__((ext_vector_type(4)));
typedef float f32x16 __attribute__((ext_vector_type(16)));

constexpr int D = 1024, NB = 16, SEQ = 2048, CTXL = 256;
constexpr int NLAT = NB * SEQ;
constexpr int NCTX = NB * CTXL;
constexpr int NT = NLAT + NCTX;
constexpr int DIN = 2048;
constexpr int NTHREADS = 512;
constexpr float ALPHA = 1.41421356237309515f;
constexpr float LN_EPS = 1e-5f, GN_EPS = 64e-5f;
constexpr int NCH = NT / 32;
constexpr int SLOT_CAP = 81920;

enum { I_X = 0, I_C, I_CTX, I_CCTX, I_WMOD, I_BMOD, I_WIN, I_CONV, I_W0, I_W2, I_A0, I_A2, I_G2, I_KK, I_KA, I_RK, I_GNW, I_GNB,
       I_LRE, I_LIM, I_LDT, I_BRE, I_BIM, I_CRE, I_CIM, I_SD, I_GLUW, I_GLUB, I_SINK, I_WOUT, I_LN1G, I_LN1B, I_LN2G, I_LN2B,
       I_RGW, I_RGB, I_REW, I_REB, I_EWG, I_EWU, I_EWD, N_IN };

constexpr size_t MiB = 1048576;
constexpr size_t WS_CTL = 0;
constexpr size_t WS_BAR = 512 * 1024;
constexpr size_t WS_MOD = 1 * MiB;
constexpr size_t WS_ROPE = 2 * MiB;
constexpr size_t WS_WIN_T = 4 * MiB;
constexpr size_t WS_WOUT_T = 12 * MiB;
constexpr size_t WS_FW = 16 * MiB;
constexpr size_t WS_GLU_T = 18 * MiB;
constexpr size_t WS_RW = 19 * MiB;
constexpr size_t WS_KTAB = 20 * MiB;
constexpr size_t WS_TTG = 22 * MiB;
constexpr size_t WS_EM = 46 * MiB;
constexpr size_t WS_HC = 54 * MiB;
constexpr size_t WS_LIST = 63 * MiB;
constexpr size_t WS_ROUTE = 68 * MiB;
constexpr size_t WS_RWT = 69 * MiB;
constexpr size_t WS_APOW = 70 * MiB;
constexpr size_t WS_BBT = 71 * MiB + 512 * 1024;
constexpr size_t WS_X = 72 * MiB;
constexpr size_t WS_R = 216 * MiB;
constexpr size_t WS_PROJ = WS_R;
constexpr size_t WS_FEAT = WS_R + 144 * MiB;
constexpr size_t WS_YMIX = WS_R + 234 * MiB;
constexpr size_t WS_MIX = WS_R + 144 * MiB;
constexpr size_t WS_EW = WS_R;
constexpr size_t WS_H = WS_R + 234 * MiB;
constexpr size_t WS_ACT = WS_R + 96 * MiB;
constexpr size_t WS_YROWS = WS_R + 176 * MiB;
constexpr size_t WS_UDH = WS_R + 336 * MiB;
constexpr size_t WS_END = WS_UDH + 28 * MiB;
constexpr size_t DO_XMOD = 0;
constexpr size_t DO_YF = 0;
constexpr size_t DO_YB = 36 * MiB;
constexpr size_t DO_HE = 72 * MiB;
constexpr size_t DO_ZB = 90 * MiB;

struct Params {
  const float* in[N_IN];
  float* out;
  unsigned char* ws;
  int ph_lo, ph_hi;
};


DEVI unsigned long long rfl64(unsigned long long v) { const unsigned lo = __builtin_amdgcn_readfirstlane((unsigned)v), hi = __builtin_amdgcn_readfirstlane((unsigned)(v >> 32)); return ((unsigned long long)hi << 32) | lo; }
DEVI unsigned char* uws(const Params& p) { return (unsigned char*)rfl64((unsigned long long)p.ws); }
DEVI float* uout(const Params& p) { return (float*)rfl64((unsigned long long)p.out); }
DEVI const float* uin(const Params& p, int i) { return (const float*)rfl64((unsigned long long)p.in[i]); }

DEVI float bf2f(bf16_t v) { return __uint_as_float(((unsigned)v) << 16); }
typedef __bf16 hwbf2 __attribute__((ext_vector_type(2)));
typedef float hwf2 __attribute__((ext_vector_type(2)));
DEVI bf16_t f2bf(float f) { return __builtin_bit_cast(unsigned short, (__bf16)f); }
DEVI unsigned pack2(float a, float b) { const hwf2 v = {a, b}; return __builtin_bit_cast(unsigned, __builtin_convertvector(v, hwbf2)); }
DEVI unsigned pack2o(float a, float b) { asm("" : "+v"(a)); asm("" : "+v"(b)); const hwf2 v = {a, b}; return __builtin_bit_cast(unsigned, __builtin_convertvector(v, hwbf2)); }
DEVI float lo_bf(unsigned u) { return __uint_as_float(u << 16); }
DEVI float hi_bf(unsigned u) { return __uint_as_float(u & 0xFFFF0000u); }
DEVI unsigned short f2h(float f) { _Float16 h = (_Float16)f; return __builtin_bit_cast(unsigned short, h); }
DEVI float h2f(unsigned short u) { return (float)__builtin_bit_cast(_Float16, u); }
DEVI float sigmoidf(float x) { return __builtin_amdgcn_rcpf(1.f + __expf(-x)); }
DEVI float gelu_tanh(float x) { const float u = 0.7978845608028654f * (x + 0.044715f * x * x * x); return x - x * __builtin_amdgcn_rcpf(1.f + __expf(2.f * u)); }

template <int CTRL> DEVI float dpp_f(float x) { return __int_as_float(__builtin_amdgcn_update_dpp(0, __float_as_int(x), CTRL, 0xF, 0xF, false)); }
DEVI float row_sum16(float x) {
  x += dpp_f<0xB1>(x);
  x += dpp_f<0x4E>(x);
  x += dpp_f<0x141>(x);
  x += dpp_f<0x140>(x);
  return x;
}
DEVI float shfl_xor_l(float x, int m) {
  int lane = (int)__builtin_amdgcn_mbcnt_hi(~0u, __builtin_amdgcn_mbcnt_lo(~0u, 0u));
  asm volatile("" : "+v"(lane));
  return __int_as_float(__builtin_amdgcn_ds_bpermute((lane ^ m) << 2, __float_as_int(x)));
}
DEVI float wave_sum(float x) { x = row_sum16(x); x += shfl_xor_l(x, 16); x += shfl_xor_l(x, 32); return x; }

DEVI int tid_() { int t = threadIdx.x; asm volatile("" : "+v"(t)); return t; }
DEVI int bid_() { int b = blockIdx.x; asm volatile("" : "+s"(b)); return b; }
DEVI void ld8f(const float* p, float (&o)[8]) { const float4 a = *(const float4*)p, b = *(const float4*)(p + 4); o[0] = a.x; o[1] = a.y; o[2] = a.z; o[3] = a.w; o[4] = b.x; o[5] = b.y; o[6] = b.z; o[7] = b.w; }
DEVI void ld8b(const bf16_t* p, float (&o)[8]) { const uint4 u = *(const uint4*)p; o[0] = lo_bf(u.x); o[1] = hi_bf(u.x); o[2] = lo_bf(u.y); o[3] = hi_bf(u.y); o[4] = lo_bf(u.z); o[5] = hi_bf(u.z); o[6] = lo_bf(u.w); o[7] = hi_bf(u.w); }
DEVI void st8f(float* p, const float (&v)[8]) { *(float4*)p = make_float4(v[0], v[1], v[2], v[3]); *(float4*)(p + 4) = make_float4(v[4], v[5], v[6], v[7]); }
DEVI void st8b(bf16_t* p, const float (&v)[8]) { *(uint4*)p = make_uint4(pack2(v[0], v[1]), pack2(v[2], v[3]), pack2(v[4], v[5]), pack2(v[6], v[7])); }
typedef _Float16 hx8 __attribute__((ext_vector_type(8)));
DEVI void ld8h(const _Float16* p, float (&o)[8]) { const hx8 u = *(const hx8*)p;
#pragma unroll
  for (int e = 0; e < 8; ++e) o[e] = (float)u[e]; }
DEVI void st8h(_Float16* p, const float (&v)[8]) { hx8 u;
#pragma unroll
  for (int e = 0; e < 8; ++e) u[e] = (_Float16)v[e];
  *(hx8*)p = u; }

DEVI int bidx_of(int R) { return R < NLAT ? (R >> 11) : 16; }
DEVI const float* xin_row(const Params& p, int R) { return R < NLAT ? uin(p, I_X) + (size_t)R * D : uin(p, I_CTX) + (size_t)(R - NLAT) * D; }

constexpr int LDT = 40;
constexpr int SMEM_BYTES = 143360;
constexpr int DSM_BYTES = SMEM_BYTES + 1024;
constexpr int MISC_PARAMS = 0, MISC_PRE = 384, MISC_CNT = 528, MISC_BLKE = 656, MISC_XB = 1008;
template <class AL, class BL, class EP>
DEVI void gemm_tile(unsigned char* smem, int kbeg, int kend, AL&& aload, BL&& bload, EP&& epi) {
  const int tid = tid_(), lane = tid & 63, wid = tid >> 6;
  const int wr = wid >> 1, wc = wid & 1, fr = lane & 15, fq = lane >> 4;
  bf16_t* sA = (bf16_t*)smem;
  bf16_t* sB = (bf16_t*)(smem + 2 * 256 * LDT * 2);
  const int lrow = tid >> 2, kq = (tid & 3) * 8;
  f32x4 acc[4][4];
#pragma unroll
  for (int m = 0; m < 4; ++m)
#pragma unroll
    for (int n = 0; n < 4; ++n) acc[m][n] = (f32x4){0.f, 0.f, 0.f, 0.f};
  uint4 ra0 = aload(0, kbeg + kq), ra1 = aload(1, kbeg + kq), rb = bload(kbeg + kq);
  int buf = 0;
#pragma unroll 1
  for (int k = kbeg; k < kend; k += 32) {
    *(uint4*)(sA + (buf * 256 + lrow) * LDT + kq) = ra0;
    *(uint4*)(sA + (buf * 256 + lrow + 128) * LDT + kq) = ra1;
    *(uint4*)(sB + (buf * 128 + lrow) * LDT + kq) = rb;
    __syncthreads();
    if (k + 32 < kend) { ra0 = aload(0, k + 32 + kq); ra1 = aload(1, k + 32 + kq); rb = bload(k + 32 + kq); }
    bf16x8 bfr[4];
#pragma unroll
    for (int n = 0; n < 4; ++n) bfr[n] = *(const bf16x8*)(sB + (buf * 128 + wc * 64 + n * 16 + fr) * LDT + fq * 8);
#pragma unroll
    for (int m = 0; m < 4; ++m) {
      const bf16x8 af = *(const bf16x8*)(sA + (buf * 256 + wr * 64 + m * 16 + fr) * LDT + fq * 8);
#pragma unroll
      for (int n = 0; n < 4; ++n) acc[m][n] = __builtin_amdgcn_mfma_f32_16x16x32_bf16(bfr[n], af, acc[m][n], 0, 0, 0);
    }
    buf ^= 1;
  }
  __syncthreads();
  epi(acc, wr, wc, fr, fq);
}


namespace g8 {
#define G8_LAS __attribute__((address_space(3)))
constexpr int BM = 256, BK = 64, HALF = 128, HTB = HALF * BK * 2;
DEVI int lds_byte(int r, int c) { const int st = (r >> 4) * 2 + (c >> 5), rr = r & 15, cc = c & 31, ob = rr * 64 + cc * 2; return st * 1024 + (ob ^ (((ob >> 9) & 1) << 5)); }
DEVI void stage_rc(int b, int& R, int& C) { const int st = b / 1024, sb = b % 1024, swz = sb ^ (((sb >> 9) & 1) << 5); R = (st >> 1) * 16 + swz / 64; C = (st & 1) * 32 + (swz % 64) / 2; }
DEVI int perm32(int rho) { const int n = rho >> 4, i = rho & 15; return 8 * (i >> 2) + 4 * n + (i & 3); }
struct Unit { int pm, pn, e; };
DEVI int xcd_remap(int L, int n) { const int q = n >> 3, r = n & 7, x = L & 7, off = L >> 3; return (x < r ? x * (q + 1) : r * (q + 1) + (x - r) * q) + off; }

template <class Epi, class Sched>
DEVI void gemm(G8_LAS unsigned char* lds, const int Kin, const Sched& S, const Epi& E) {
  int K = Kin; asm volatile("" : "+s"(K));
  const int tid = tid_(), wid = __builtin_amdgcn_readfirstlane(tid >> 6), lane = tid & 63, wr = wid >> 2, wc = wid & 3, fr = lane & 15, fq = lane >> 4;
  const int nt = K / BK;
  unsigned voffB[2];
#pragma unroll
  for (int i = 0; i < 2; ++i) { int R, C; stage_rc(tid * 16 + i * 8192, R, C); const int Rb = Epi::PERM ? ((R & ~31) + perm32(R & 31)) : R; voffB[i] = (unsigned)(Rb * K + C) * 2u; }
  const size_t kstep = (size_t)(BK * 2);
  const size_t hstepB = (size_t)HALF * K * 2;
  const unsigned ldsw = (unsigned)wid * 1024u;
  const int aoff = lds_byte(wr * 64 + fr, fq * 8), boff = lds_byte(wc * 32 + fr, fq * 8);
#define G8_SA(b, h) (((b) * 2 + (h)) * HTB)
#define G8_SB(b, h) ((4 + (b) * 2 + (h)) * HTB)
#define G8_STAGE_B(bufoff, gbase) do { _Pragma("unroll") for (int _i = 0; _i < 2; ++_i) \
    __builtin_amdgcn_global_load_lds((const unsigned*)((const char*)(gbase) + voffB[_i]), (G8_LAS unsigned*)(lds + (bufoff) + ldsw + _i * 8192), 16, 0, 0); } while (0)
#define G8_STAGE_A(bufoff, ubase, o0, o1) do { \
    __builtin_amdgcn_global_load_lds((const unsigned*)((ubase) + (o0)), (G8_LAS unsigned*)(lds + (bufoff) + ldsw), 16, 0, 0); \
    __builtin_amdgcn_global_load_lds((const unsigned*)((ubase) + (o1)), (G8_LAS unsigned*)(lds + (bufoff) + ldsw + 8192), 16, 0, 0); } while (0)
#define G8_LDA(dst, b, h) do { _Pragma("unroll") for (int m = 0; m < 4; ++m) _Pragma("unroll") for (int k = 0; k < 2; ++k) dst[m][k] = *(const G8_LAS bf16x8*)(lds + G8_SA(b, h) + aoff + m * 2048 + k * 1024); } while (0)
#define G8_LDB(dst, b, h) do { _Pragma("unroll") for (int n = 0; n < 2; ++n) _Pragma("unroll") for (int k = 0; k < 2; ++k) dst[n][k] = *(const G8_LAS bf16x8*)(lds + G8_SB(b, h) + boff + n * 2048 + k * 1024); } while (0)
#define G8_MMA(ai, bj, At, Bt) do { __builtin_amdgcn_s_setprio(1); _Pragma("unroll") for (int m = 0; m < 4; ++m) _Pragma("unroll") for (int n = 0; n < 2; ++n) _Pragma("unroll") for (int k = 0; k < 2; ++k) \
    acc[ai][bj][m][n] = __builtin_amdgcn_mfma_f32_16x16x32_bf16(Bt[n][k], At[m][k], acc[ai][bj][m][n], 0, 0, 0); __builtin_amdgcn_s_setprio(0); } while (0)
#define G8_WAIT_V(n) asm volatile("s_waitcnt vmcnt(" #n ")" ::: "memory")
#define G8_WAIT_L(n) asm volatile("s_waitcnt lgkmcnt(" #n ")" ::: "memory")
#define G8_BAR __builtin_amdgcn_s_barrier()
#define G8_SCHED __builtin_amdgcn_sched_barrier(0)
  Unit cur, nxt; int ui = 0;
  if (!S.next(0, cur)) return;
  f32x4 acc[2][2][4][2];
#pragma unroll
  for (int a = 0; a < 2; ++a)
#pragma unroll
    for (int b = 0; b < 2; ++b)
#pragma unroll
      for (int m = 0; m < 4; ++m)
#pragma unroll
        for (int n = 0; n < 2; ++n) acc[a][b][m][n] = (f32x4){0.f, 0.f, 0.f, 0.f};
  bf16x8 At[4][2], B0[2][2], B1[2][2];
  unsigned cA[2][2], nA[2][2];
  const char* const Ab = S.a_base();
  S.a_offs(cur, tid, cA);
  const char* cB = S.b_ptr(cur);
  G8_STAGE_B(G8_SB(0, 0), cB); G8_STAGE_A(G8_SA(0, 0), Ab, cA[0][0], cA[0][1]); G8_STAGE_B(G8_SB(0, 1), cB + hstepB); G8_STAGE_A(G8_SA(0, 1), Ab, cA[1][0], cA[1][1]);
  if (wr == 1) G8_BAR;
  G8_WAIT_V(4); G8_BAR;
  G8_STAGE_B(G8_SB(1, 0), cB + kstep); G8_STAGE_A(G8_SA(1, 0), Ab + kstep, cA[0][0], cA[0][1]); G8_STAGE_B(G8_SB(1, 1), cB + hstepB + kstep);
  G8_WAIT_V(6); G8_BAR;
  for (;;) {
    const bool has_next = S.next(ui + 1, nxt);
    const char* nB = cB;
    if (has_next) { S.a_offs(nxt, tid_(), nA); nB = S.b_ptr(nxt); }
    else { nA[0][0] = cA[0][0]; nA[0][1] = cA[0][1]; nA[1][0] = cA[1][0]; nA[1][1] = cA[1][1]; }
    for (int t = 0; t < nt; t += 2) {
      const bool last = (t == nt - 2);
      const size_t k1 = (size_t)(t + 1) * kstep, k2 = (size_t)(t + 2) * kstep;
      const char* b2 = last ? nB : cB + k2; const char* b3 = b2 + kstep;
      const char* Ab2 = last ? Ab : Ab + k2;
      unsigned a2[2][2];
#pragma unroll
      for (int h = 0; h < 2; ++h)
#pragma unroll
        for (int i = 0; i < 2; ++i) a2[h][i] = last ? nA[h][i] : cA[h][i];
      G8_LDB(B0, 0, 0); G8_SCHED; G8_LDA(At, 0, 0); G8_STAGE_A(G8_SA(1, 1), Ab + k1, cA[1][0], cA[1][1]);
      G8_WAIT_L(8); G8_BAR; G8_WAIT_L(0); G8_MMA(0, 0, At, B0); G8_BAR; G8_SCHED;
      G8_LDB(B1, 0, 1); G8_STAGE_B(G8_SB(0, 0), b2);
      G8_BAR; G8_WAIT_L(0); G8_MMA(0, 1, At, B1); G8_BAR;
      G8_LDA(At, 0, 1); G8_STAGE_A(G8_SA(0, 0), Ab2, a2[0][0], a2[0][1]);
      G8_BAR; G8_WAIT_L(0); G8_MMA(1, 0, At, B0); G8_BAR; G8_SCHED;
      G8_STAGE_B(G8_SB(0, 1), b2 + hstepB);
      G8_WAIT_V(6); G8_BAR; G8_MMA(1, 1, At, B1); G8_BAR;
      G8_LDB(B0, 1, 0); G8_SCHED; G8_LDA(At, 1, 0); G8_STAGE_A(G8_SA(0, 1), Ab2, a2[1][0], a2[1][1]);
      G8_WAIT_L(8); G8_BAR; G8_WAIT_L(0); G8_MMA(0, 0, At, B0); G8_BAR; G8_SCHED;
      G8_LDB(B1, 1, 1); G8_STAGE_B(G8_SB(1, 0), b3);
      G8_BAR; G8_WAIT_L(0); G8_MMA(0, 1, At, B1); G8_BAR;
      G8_LDA(At, 1, 1); G8_STAGE_A(G8_SA(1, 0), Ab2 + kstep, a2[0][0], a2[0][1]);
      G8_BAR; G8_WAIT_L(0); G8_MMA(1, 0, At, B0); G8_BAR; G8_SCHED;
      G8_STAGE_B(G8_SB(1, 1), b3 + hstepB);
      G8_WAIT_V(6); G8_BAR; G8_MMA(1, 1, At, B1); G8_BAR;
    }
    E(acc, cur);
    if (!has_next) break;
#pragma unroll
    for (int a = 0; a < 2; ++a)
#pragma unroll
      for (int b = 0; b < 2; ++b)
#pragma unroll
        for (int m = 0; m < 4; ++m)
#pragma unroll
          for (int n = 0; n < 2; ++n) acc[a][b][m][n] = (f32x4){0.f, 0.f, 0.f, 0.f};
    cur = nxt; cB = nB; ++ui;
#pragma unroll
    for (int h = 0; h < 2; ++h)
#pragma unroll
      for (int i = 0; i < 2; ++i) cA[h][i] = nA[h][i];
  }
  G8_WAIT_V(0);
  if (wr == 0) G8_BAR;
  G8_BAR;
#undef G8_SA
#undef G8_SB
#undef G8_STAGE_A
#undef G8_STAGE_B
#undef G8_LDA
#undef G8_LDB
#undef G8_MMA
#undef G8_WAIT_V
#undef G8_WAIT_L
#undef G8_BAR
#undef G8_SCHED
}

struct DenseSched {
  const bf16_t* A; const bf16_t* Bt; int K, nM, nN, G, c;
  DEVI bool next(int i, Unit& u) const {
    const int nwg = nM * nN; const long L = (long)i * G + c; if (L >= nwg) return false;
    const int wgid = xcd_remap((int)L, nwg);
    const int nig = 8 * nN, gid = wgid / nig, fm = gid * 8, gsz = (nM - fm) < 8 ? (nM - fm) : 8;
    u.pm = fm + ((wgid % nig) % gsz); u.pn = (wgid % nig) / gsz; u.e = 0; return true;
  }
  DEVI const char* a_base() const { return (const char*)A; }
  DEVI void a_offs(const Unit& u, int tid, unsigned (&ao)[2][2]) const {
#pragma unroll
    for (int i = 0; i < 2; ++i) {
      int R, C; stage_rc(tid * 16 + i * 8192, R, C);
#pragma unroll
      for (int h = 0; h < 2; ++h) ao[h][i] = ((unsigned)(u.pm * 256 + h * 128 + R) * (unsigned)K + (unsigned)C) * 2u;
    }
  }
  DEVI const char* b_ptr(const Unit& u) const { return (const char*)(Bt + (size_t)u.pn * 256 * K); }
};
}

struct TrRegs { float4 v[2][4]; };
DEVI void transpose_load(TrRegs& t, const float* __restrict__ src, int ld_src, int k0, int n0) {
  const int tid = tid_();
  const int kr = tid >> 4, c4 = (tid & 15) * 4;
#pragma unroll
  for (int i = 0; i < 2; ++i)
#pragma unroll
    for (int w = 0; w < 4; ++w) t.v[i][w] = *(const float4*)(src + (size_t)(k0 + 2 * kr + i) * ld_src + n0 + w * 64 + c4);
}
template <class RM>
DEVI void transpose_finish(unsigned char* smem, const TrRegs& t, int k0, int n0, bf16_t* dst, int ld_dst, RM&& rowmap) {
  bf16_t* T = (bf16_t*)smem;
  const int tid = tid_();
  const int kr = tid >> 4, c4 = (tid & 15) * 4;
#pragma unroll
  for (int w = 0; w < 4; ++w) {
    unsigned* tp = (unsigned*)(T + (w * 64 + c4) * 72 + 2 * kr);
    tp[0] = pack2o(t.v[0][w].x, t.v[1][w].x); tp[36] = pack2o(t.v[0][w].y, t.v[1][w].y); tp[72] = pack2o(t.v[0][w].z, t.v[1][w].z); tp[108] = pack2o(t.v[0][w].w, t.v[1][w].w);
  }
  __syncthreads();
  const int k8 = (tid & 7) * 8;
#pragma unroll
  for (int j = 0; j < 4; ++j) {
    const int nn = (tid >> 3) + 64 * j;
    const uint4 o = *(const uint4*)(T + nn * 72 + k8);
    *(uint4*)(dst + (size_t)rowmap(n0 + nn) * ld_dst + k0 + k8) = o;
  }
  __syncthreads();
}
template <class RM>
DEVI void transpose_tile(unsigned char* smem, const float* __restrict__ src, int ld_src, int k0, int n0, bf16_t* dst, int ld_dst, RM&& rowmap) {
  TrRegs t; transpose_load(t, src, ld_src, k0, n0);
  transpose_finish(smem, t, k0, n0, dst, ld_dst, rowmap);
}

struct S5Disc { float lm, th, ar, ai, cr, ci; };
DEVI S5Disc s5disc(const Params& p, int l, int d, int g, int pp) {
  const int idx = ((l * 2 + d) * 16 + g) * 64 + pp;
  const float lr = uin(p, I_LRE)[idx], li = uin(p, I_LIM)[idx];
  const float dt = expf(uin(p, I_LDT)[(l * 2 + d) * 16 + g]);
  S5Disc r; r.lm = lr * dt; r.th = li * dt;
  const float mag = expf(r.lm), cs = cosf(r.th), sn = sinf(r.th), sh = sinf(0.5f * r.th);
  r.ar = mag * cs; r.ai = mag * sn;
  const float nr = expm1f(r.lm) * cs - 2.f * sh * sh, ni = r.ai, den = lr * lr + li * li;
  r.cr = (nr * lr + ni * li) / den; r.ci = (ni * lr - nr * li) / den;
  return r;
}

DEVI void phase0a(const Params& p, unsigned char* smem) {
  const int tid = tid_(), bid = bid_(), G = gridDim.x;
  unsigned char* ws = uws(p);
  if (bid == 0 && tid < 128) ((int*)(ws + WS_CTL))[tid] = 0;
  constexpr int N_MOD = 384, N_KT = 256, N_ROPE = 128, N_TRW = 256 + 128, N_EL = 640;
  constexpr int N_AP = 265;
  constexpr int N_BB = 128;
  const int total = N_MOD + N_KT + N_ROPE + N_TRW + N_EL + N_AP + N_BB;
  for (int it0 = bid; it0 < total; it0 += G) {
    int it = it0;
    if (it < N_MOD) {
      const int l = it / 192, col0 = (it % 192) * 32;
      const int c = tid & 31, kg = tid >> 5;
      float* sS = (float*)smem;
      float acc[17];
#pragma unroll
      for (int b = 0; b < 17; ++b) acc[b] = 0.f;
      const float* W = uin(p, I_WMOD) + (size_t)l * D * 6144 + col0 + c;
      for (int kc = 0; kc < 4; ++kc) {
        __syncthreads();
        for (int e = tid; e < 17 * 256; e += NTHREADS) {
          const int b = e >> 8, k = kc * 256 + (e & 255);
          const float cv = (b < 16) ? uin(p, I_C)[b * D + k] : uin(p, I_CCTX)[k];
          sS[e] = cv / (1.f + __expf(-cv));
        }
        __syncthreads();
        float wv[16];
#pragma unroll
        for (int i = 0; i < 16; ++i) wv[i] = W[(size_t)(kc * 256 + kg + 16 * i) * 6144];
#pragma unroll
        for (int i = 0; i < 16; ++i) {
          const int kl = kg + 16 * i;
#pragma unroll
          for (int b = 0; b < 17; ++b) acc[b] = fmaf(sS[b * 256 + kl], wv[i], acc[b]);
        }
      }
      __syncthreads();
      float* sR = (float*)smem;
#pragma unroll
      for (int b = 0; b < 17; ++b) sR[(kg * 17 + b) * 32 + c] = acc[b];
      __syncthreads();
      for (int e = tid; e < 17 * 32; e += NTHREADS) {
        const int b = e >> 5, cc = e & 31;
        float s = 0.f;
#pragma unroll
        for (int q = 0; q < 16; ++q) s += sR[(q * 17 + b) * 32 + cc];
        ((float*)(ws + WS_MOD))[(size_t)(l * 17 + b) * 6144 + col0 + cc] = s + uin(p, I_BMOD)[l * 6144 + col0 + cc];
      }
      __syncthreads();
      continue;
    }
    it -= N_MOD;
    if (it < N_KT) {
      const int gid = it * NTHREADS + tid;
      const int pg = gid & 7, cc = (gid >> 3) & 255, c = cc >> 4, c2 = cc & 15;
      const int lgd = gid >> 11, d = lgd & 1, g = (lgd >> 1) & 15, l = lgd >> 5;
      float K[32];
#pragma unroll
      for (int j = 0; j < 32; ++j) K[j] = 0.f;
      for (int q = 0; q < 8; ++q) {
        const int pp = pg * 8 + q;
        const S5Disc dd = s5disc(p, l, d, g, pp);
        const float ar = dd.ar, ai = dd.ai;
        const float br = uin(p, I_BRE)[((l * 16 + g) * 64 + pp) * 16 + c2], bi = uin(p, I_BIM)[((l * 16 + g) * 64 + pp) * 16 + c2];
        const float bbr = dd.cr * br - dd.ci * bi, bbi = dd.cr * bi + dd.ci * br;
        const float cr = uin(p, I_CRE)[((l * 16 + g) * 16 + c) * 64 + pp], ci = uin(p, I_CIM)[((l * 16 + g) * 16 + c) * 64 + pp];
        const float zr = cr * bbr - ci * bbi, zi = cr * bbi + ci * bbr;
        float pr = 1.f, pi = 0.f;
#pragma unroll
        for (int j = 0; j < 32; ++j) {
          K[j] += zr * pr - zi * pi;
          const float nr = pr * ar - pi * ai, ni = pr * ai + pi * ar;
          pr = nr; pi = ni;
        }
      }
#pragma unroll
      for (int j = 0; j < 32; ++j) { float v = K[j]; v += dpp_f<0xB1>(v); v += dpp_f<0x4E>(v); v += dpp_f<0x141>(v); K[j] = v; }
      if (pg == 0) {
        float* KT = (float*)(ws + WS_KTAB) + (size_t)(((l * 16 + g) * 2 + d) * 32) * 256 + c * 16 + c2;
#pragma unroll
        for (int j = 0; j < 32; ++j) KT[j * 256] = K[j];
      }
      continue;
    }
    it -= N_KT;
    if (it < N_ROPE) {
      const int e = it * NTHREADS + tid;
      const int pos = e >> 5, i = e & 31;
      const float inv = powf(10000.f, -(float)(i & 15) / 16.f);
      const float ang = (float)((i < 16) ? (pos >> 6) : (pos & 63)) * inv;
      ((float*)(ws + WS_ROPE))[e] = cosf(ang);
      ((float*)(ws + WS_ROPE))[65536 + e] = sinf(ang);
      continue;
    }
    it -= N_ROPE;
    if (it < N_TRW) {
      if (it < 256) {
        const int l = it >> 7, r = it & 127, kt = r >> 3, ntl = r & 7;
        transpose_tile(smem, uin(p, I_WIN) + (size_t)l * D * DIN, DIN, kt * 64, ntl * 256, (bf16_t*)(ws + WS_WIN_T) + (size_t)l * DIN * D, D,
          [](int n) { if (n >= 1280 && n < 1920) { const int d = n & 63; return (n & ~63) + 32 * ((d >> 4) & 1) + 8 * ((d >> 2) & 3) + 4 * (d >> 5) + (d & 3); } return n; });
      } else {
        const int r0 = it - 256, l = r0 >> 6, r = r0 & 63, kt = r >> 2, ntl = r & 3;
        transpose_tile(smem, uin(p, I_WOUT) + (size_t)l * D * D, D, kt * 64, ntl * 256, (bf16_t*)(ws + WS_WOUT_T) + (size_t)l * D * D, D, [](int n) { return n; });
      }
      continue;
    }
    it -= N_TRW;
    if (it < N_EL) {
      for (int q = 0; q < 4; ++q) {
        int e = (it * 4 + q) * NTHREADS + tid;
        if (e < 655360) {
          const int l = e / 327680, r = e % 327680, n = r >> 8, k = r & 255;
          float v = 0.f;
          if (n < 512) { const int d = n >> 8, col = n & 255; if (k < 64) v = uin(p, I_W2)[((l * 2 + d) * 64 + k) * 256 + col]; }
          else if (n < 1024) { const int d = (n - 512) >> 8, col = n & 255; if (k >= 64 && k < 128) v = uin(p, I_A2)[((l * 2 + d) * 64 + (k - 64)) * 256 + col]; }
          else { const int col = n - 1024; if (k >= 128) v = uin(p, I_G2)[(l * 128 + (k - 128)) * 256 + col]; }
          ((bf16_t*)(ws + WS_FW))[e] = f2bf(v);
          continue;
        }
        e -= 655360;
        if (e < 131072) {
          const int l = e >> 16, r = e & 65535, n = r >> 8, k = r & 255;
          ((bf16_t*)(ws + WS_GLU_T))[e] = f2bf(uin(p, I_GLUW)[(l * 256 + k) * 256 + n]);
          continue;
        }
        e -= 131072;
        if (e < 524288) {
          const int l = e >> 18, r = e & 262143, hl = r >> 17, n = (r >> 10) & 127, k = r & 1023;
          float v = 0.f;
          if (n < 4) v = uin(p, I_RGW)[(l * D + k) * 4 + n];
          else if (n < 36) v = uin(p, I_REW)[(l * D + k) * 32 + (n - 4)];
          const bf16_t h = f2bf(v);
          ((bf16_t*)(ws + WS_RW))[e] = hl ? f2bf(v - bf2f(h)) : h;
        }
      }
      continue;
    }
    it -= N_EL;
    if (it < N_AP) {
      const int e = it * NTHREADS + tid;
      if (e < 2 * 2 * 16 * 64 * 33) {
        const int j = e % 33, r = e / 33, pp = r & 63, g = (r >> 6) & 15, d = (r >> 10) & 1, l = r >> 11;
        const S5Disc dd = s5disc(p, l, d, g, pp);
        const float mg = expf(dd.lm * (float)j), an = dd.th * (float)j;
        ((float2*)(ws + WS_APOW))[e] = make_float2(mg * cosf(an), mg * sinf(an));
      }
      continue;
    }
    it -= N_AP;
    {
      const int e = it * NTHREADS + tid;
      const int c2 = e & 15, pp = (e >> 4) & 63, g = (e >> 10) & 15, d = (e >> 14) & 1, l = e >> 15;
      const S5Disc dd = s5disc(p, l, d, g, pp);
      const float br = uin(p, I_BRE)[((l * 16 + g) * 64 + pp) * 16 + c2], bi = uin(p, I_BIM)[((l * 16 + g) * 64 + pp) * 16 + c2];
      ((float2*)(ws + WS_BBT))[e] = make_float2(dd.cr * br - dd.ci * bi, dd.cr * bi + dd.ci * br);
    }
  }
}

DEVI void write_xmod_row(const float4 v[4], const float* modl, bf16_t* dstrow, int lane) {
#pragma unroll
  for (int i = 0; i < 4; ++i) {
    const int col = i * 256 + lane * 4;
    const float4 sh = *(const float4*)(modl + col), sc = *(const float4*)(modl + 1024 + col);
    uint2 o; o.x = pack2(v[i].x * (1.f + sc.x) + sh.x, v[i].y * (1.f + sc.y) + sh.y); o.y = pack2(v[i].z * (1.f + sc.z) + sh.z, v[i].w * (1.f + sc.w) + sh.w);
    *(uint2*)(dstrow + col) = o;
  }
}
DEVI void phase0b(const Params& p, unsigned char* smem) {
  const int tid = tid_(), bid = bid_(), G = gridDim.x, lane = tid & 63, wid = tid >> 6;
  unsigned char* ws = uws(p);
  {
    bf16_t* XM = (bf16_t*)((unsigned char*)uout(p) + DO_XMOD);
    const float* MOD = (const float*)(ws + WS_MOD);
    const int nw = G * 8, gw = bid * 8 + wid, rpw = (NT + nw - 1) / nw;
    const int R0 = gw * rpw, R1 = (R0 + rpw < NT) ? (R0 + rpw) : NT;
    const int c0 = lane * 8, c1 = 512 + lane * 8;
    float sh[2][8], sc[2][8], xv[2][8];
    int curb = -1;
    if (R0 < R1) { ld8f(xin_row(p, R0) + c0, xv[0]); ld8f(xin_row(p, R0) + c1, xv[1]); }
    for (int R = R0; R < R1; ++R) {
      float xn[2][8];
#pragma unroll
      for (int h = 0; h < 2; ++h)
#pragma unroll
        for (int e = 0; e < 8; ++e) xn[h][e] = 0.f;
      if (R + 1 < R1) { ld8f(xin_row(p, R + 1) + c0, xn[0]); ld8f(xin_row(p, R + 1) + c1, xn[1]); }
      const int bi = bidx_of(R);
      if (bi != curb) { curb = bi; const float* modl = MOD + (size_t)bi * 6144; ld8f(modl + c0, sh[0]); ld8f(modl + c1, sh[1]); ld8f(modl + 1024 + c0, sc[0]); ld8f(modl + 1024 + c1, sc[1]); }
#pragma unroll
      for (int h = 0; h < 2; ++h) {
        float xm[8];
#pragma unroll
        for (int e = 0; e < 8; ++e) xm[e] = xv[h][e] * (1.f + sc[h][e]) + sh[h][e];
        st8b(XM + (size_t)R * D + (h ? c1 : c0), xm);
      }
#pragma unroll
      for (int h = 0; h < 2; ++h)
#pragma unroll
        for (int e = 0; e < 8; ++e) xv[h][e] = xn[h][e];
    }
  }
}

DEVI void build_ttg_em(const Params& p, int lsel, int vb, int nvb) {
  unsigned char* ws = uws(p);
  const int tid = tid_();
  const float* KT = (const float*)(ws + WS_KTAB);
  const float2* AP = (const float2*)(ws + WS_APOW);
  const float2* BB = (const float2*)(ws + WS_BBT);
  const long nthreads = (long)nvb * NTHREADS, gt = (long)vb * NTHREADS + tid;
  const long n_ttg = 16L * 512 * 96;
  for (long e = (long)lsel * n_ttg + gt; e < (long)(lsel + 1) * n_ttg; e += nthreads) {
    const int k8 = (int)(e % 96), m = (int)((e / 96) & 511), g = (int)((e / (96 * 512)) & 15), l = (int)(e / (96 * 512 * 16));
    const int tau = m >> 4, c = m & 15, k = k8 * 8;
    float v[8];
    if (k < 512) {
      const int sg = k >> 4, c2 = k & 15;
      const float* K0 = KT + (size_t)(((l * 16 + g) * 2 + 0) * 32) * 256 + c * 16 + c2;
      const float* K1 = KT + (size_t)(((l * 16 + g) * 2 + 1) * 32) * 256 + c * 16 + c2;
      if (sg < tau) { for (int q = 0; q < 8; ++q) v[q] = K0[(tau - sg) * 256 + q]; }
      else if (sg > tau) { for (int q = 0; q < 8; ++q) v[q] = K1[(sg - tau) * 256 + q]; }
      else { for (int q = 0; q < 8; ++q) v[q] = K0[q] + K1[q] + ((c2 + q == c) ? uin(p, I_SD)[l * 256 + g * 16 + c] : 0.f); }
    } else {
      const int q0 = k - 512, d = q0 >> 7, isim = (q0 >> 6) & 1, p0 = q0 & 63;
      const int j = d ? (32 - tau) : (tau + 1);
      for (int q = 0; q < 8; ++q) {
        const int pp = p0 + q;
        const float2 a = AP[((size_t)(((l * 2 + d) * 16 + g) * 64 + pp)) * 33 + j];
        const float cr = uin(p, I_CRE)[((l * 16 + g) * 16 + c) * 64 + pp], ci = uin(p, I_CIM)[((l * 16 + g) * 16 + c) * 64 + pp];
        v[q] = isim ? -(cr * a.y + ci * a.x) : (cr * a.x - ci * a.y);
      }
    }
    uint4 o; o.x = pack2(v[0], v[1]); o.y = pack2(v[2], v[3]); o.z = pack2(v[4], v[5]); o.w = pack2(v[6], v[7]);
    *(uint4*)((bf16_t*)(ws + WS_TTG) + (size_t)e * 8) = o;
  }
  const long n_em = 16L * 256 * 64;
  for (long e = (long)lsel * n_em + gt; e < (long)(lsel + 1) * n_em; e += nthreads) {
    const int k8 = (int)(e & 63), r = (int)((e >> 6) & 255), g = (int)((e >> 14) & 15), l = (int)(e >> 18);
    const int d = r >> 7, isim = (r >> 6) & 1, pp = r & 63, k = k8 * 8, sg = k >> 4, c2 = k & 15;
    const int j = d ? sg : (31 - sg);
    const float2 a = AP[((size_t)(((l * 2 + d) * 16 + g) * 64 + pp)) * 33 + j];
    float v[8];
    for (int q = 0; q < 8; ++q) {
      const float2 bb = BB[(size_t)((((l * 2 + d) * 16 + g) * 64 + pp) * 16) + c2 + q];
      v[q] = isim ? (a.x * bb.y + a.y * bb.x) : (a.x * bb.x - a.y * bb.y);
    }
    uint4 o; o.x = pack2(v[0], v[1]); o.y = pack2(v[2], v[3]); o.z = pack2(v[4], v[5]); o.w = pack2(v[6], v[7]);
    *(uint4*)((bf16_t*)(ws + WS_EM) + (size_t)e * 8) = o;
  }
}

struct EpiInproj {
  static constexpr bool PERM = true;
  bf16_t* PROJ; bf16_t* UDH; const float* RC; const float* RS;
  DEVI void operator()(const f32x4 (&acc)[2][2][4][2], const g8::Unit& u) const {
    const int tid = tid_(), wid = __builtin_amdgcn_readfirstlane(tid >> 6), lane = tid & 63, wr = wid >> 2, wc = wid & 3, fr = lane & 15, fq = lane >> 4;
    const bool lat = u.pm < 128;
#pragma unroll
    for (int ai = 0; ai < 2; ++ai)
#pragma unroll
      for (int m = 0; m < 4; ++m) {
        const int row = u.pm * 256 + ai * 128 + wr * 64 + m * 16 + fr, pos = row & 2047;
#pragma unroll
        for (int bj = 0; bj < 2; ++bj) {
          const int cb = u.pn * 256 + bj * 128 + wc * 32 + 8 * fq;
          f32x4 x0 = acc[ai][bj][m][0], x1 = acc[ai][bj][m][1];
          const bool isq = (u.pn == 5 || u.pn == 6), isk = (u.pn == 7 && bj == 0);
          if ((isq || isk) && lat) {
            const int i0 = 16 * (wc & 1) + 4 * fq;
            const float4 cs = *(const float4*)(RC + pos * 32 + i0), sn = *(const float4*)(RS + pos * 32 + i0);
            const f32x4 y0 = (f32x4){x0[0] * cs.x - x1[0] * sn.x, x0[1] * cs.y - x1[1] * sn.y, x0[2] * cs.z - x1[2] * sn.z, x0[3] * cs.w - x1[3] * sn.w};
            const f32x4 y1 = (f32x4){x1[0] * cs.x + x0[0] * sn.x, x1[1] * cs.y + x0[1] * sn.y, x1[2] * cs.z + x0[2] * sn.z, x1[3] * cs.w + x0[3] * sn.w};
            x0 = y0; x1 = y1;
          }
          if (isq) { x0 = x0 * (0.125f * 1.4426950408889634f); x1 = x1 * (0.125f * 1.4426950408889634f); }
          const uint4 o = make_uint4(pack2(x0[0], x0[1]), pack2(x0[2], x0[3]), pack2(x1[0], x1[1]), pack2(x1[2], x1[3]));
          if (u.pn == 4) {
            const int g = (cb - 1024) >> 4, c = cb & 15;
            *(uint4*)(UDH + ((size_t)(g * NCH + (row >> 5))) * 768 + (row & 31) * 16 + c) = o;
          } else {
            *(uint4*)(PROJ + (size_t)row * DIN + cb) = o;
          }
        }
        asm volatile("" ::: "memory");
      }
  }
};
DEVI void phase_inproj(const Params& p, int l, unsigned char* smem) {
  unsigned char* ws = uws(p);
  g8::DenseSched S{(const bf16_t*)((unsigned char*)uout(p) + DO_XMOD), (const bf16_t*)(ws + WS_WIN_T) + (size_t)l * DIN * D, D, 144, 8, (int)gridDim.x, bid_()};
  EpiInproj E{(bf16_t*)(ws + WS_PROJ), (bf16_t*)(ws + WS_UDH), (const float*)(ws + WS_ROPE), (const float*)(ws + WS_ROPE) + 65536};
  __syncthreads();
  g8::gemm((G8_LAS unsigned char*)smem, D, S, E);
  __syncthreads();
  if (l == 0) { const int G = gridDim.x, rem = (144 * 8) % G; if (rem == 0) build_ttg_em(p, 0, bid_(), G); else if (bid_() >= rem) build_ttg_em(p, 0, bid_() - rem, G - rem); }
}

DEVI void phase_feat(const Params& p, int l, unsigned char* smem) {
  unsigned char* ws = uws(p);
  const bf16_t* PROJ = (const bf16_t*)(ws + WS_PROJ);
  unsigned short* FEAT = (unsigned short*)(ws + WS_FEAT);
  const bf16_t* FW = (const bf16_t*)(ws + WS_FW) + (size_t)l * 1280 * 256;
  const bf16_t* EM = (const bf16_t*)(ws + WS_EM) + (size_t)l * 16 * 256 * 512;
  float* HE = (float*)((unsigned char*)uout(p) + DO_HE);
  const float* CW = uin(p, I_CONV) + l * 3 * 1024;
  const int tid = tid_(), lrow = tid >> 2;
  for (int it = bid_(); it < 432 + 160; it += gridDim.x) {
    if (it < 432) {
      const int mt = it / 3, typ = it % 3;
      const int kb = typ == 0 ? 0 : (typ == 1 ? 64 : 128), KK = typ == 2 ? 128 : 64, lda = KK + 8;
      const int nt_lo = typ == 0 ? 0 : (typ == 1 ? 4 : 8), nt_n = typ == 2 ? 2 : 4;
      bf16_t* sA = (bf16_t*)smem;
      bf16_t* sB = sA + 256 * 136;
      {
        const int ppr = KK >> 3;
        const int kfix = kb + (tid % ppr) * 8;
        float wc0[8], wc1[8], wc2[8];
        ld8f(CW + 768 + kfix, wc0); ld8f(CW + 1024 + 768 + kfix, wc1); ld8f(CW + 2048 + 768 + kfix, wc2);
        for (int pc = tid; pc < 256 * ppr; pc += NTHREADS) {
          const int rr = pc / ppr, k = kfix;
          const int R = mt * 256 + rr;
          const int t = R < NLAT ? (R & 2047) : ((R - NLAT) & 255); const int len = R < NLAT ? SEQ : CTXL;
          const bf16_t* pcur = PROJ + (size_t)R * DIN + 768 + k;
          const uint4 vc = *(const uint4*)pcur;
          uint4 vp = make_uint4(0, 0, 0, 0), vn = make_uint4(0, 0, 0, 0);
          if (t > 0) vp = *(const uint4*)(pcur - DIN);
          if (t < len - 1) vn = *(const uint4*)(pcur + DIN);
          float x[8];
          const unsigned up[4] = {vp.x, vp.y, vp.z, vp.w}, uc[4] = {vc.x, vc.y, vc.z, vc.w}, un[4] = {vn.x, vn.y, vn.z, vn.w};
#pragma unroll
          for (int q = 0; q < 4; ++q) {
            x[2 * q] = lo_bf(up[q]) * wc0[2 * q] + lo_bf(uc[q]) * wc1[2 * q] + lo_bf(un[q]) * wc2[2 * q];
            x[2 * q + 1] = hi_bf(up[q]) * wc0[2 * q + 1] + hi_bf(uc[q]) * wc1[2 * q + 1] + hi_bf(un[q]) * wc2[2 * q + 1];
          }
          if (typ == 0) { for (int q = 0; q < 8; ++q) x[q] = 1.f - 2.f * __builtin_amdgcn_rcpf(1.f + __expf(2.f * x[q])); }
          else if (typ == 2) { for (int q = 0; q < 8; ++q) x[q] = sigmoidf(x[q]); }
          *(uint4*)(sA + rr * lda + (k - kb)) = make_uint4(pack2(x[0], x[1]), pack2(x[2], x[3]), pack2(x[4], x[5]), pack2(x[6], x[7]));
        }
      }
      const int lane = tid & 63, wid = tid >> 6, wr = wid >> 1, wc = wid & 1, fr = lane & 15, fq = lane >> 4;
      for (int nq = 0; nq < nt_n; ++nq) {
        const int ntl = nt_lo + nq;
        __syncthreads();
        {
          const int ppr = KK >> 3;
          for (int pc = tid; pc < 128 * ppr; pc += NTHREADS) {
            const int rr = pc / ppr, k = (pc % ppr) * 8;
            *(uint4*)(sB + rr * lda + k) = *(const uint4*)(FW + (size_t)(ntl * 128 + rr) * 256 + kb + k);
          }
        }
        __syncthreads();
        f32x4 acc[4][4];
#pragma unroll
        for (int m = 0; m < 4; ++m)
#pragma unroll
          for (int n = 0; n < 4; ++n) acc[m][n] = (f32x4){0.f, 0.f, 0.f, 0.f};
        for (int k0 = 0; k0 < KK; k0 += 32) {
          bf16x8 bfr[4];
#pragma unroll
          for (int n = 0; n < 4; ++n) bfr[n] = *(const bf16x8*)(sB + (wc * 64 + n * 16 + fr) * lda + k0 + fq * 8);
#pragma unroll
          for (int m = 0; m < 4; ++m) {
            const bf16x8 af = *(const bf16x8*)(sA + (wr * 64 + m * 16 + fr) * lda + k0 + fq * 8);
#pragma unroll
            for (int n = 0; n < 4; ++n) acc[m][n] = __builtin_amdgcn_mfma_f32_16x16x32_bf16(bfr[n], af, acc[m][n], 0, 0, 0);
          }
        }
#pragma unroll
        for (int m = 0; m < 4; ++m) {
          const int row = mt * 256 + wr * 64 + m * 16 + fr;
#pragma unroll
          for (int n = 0; n < 4; ++n) {
            const int ng = ntl * 128 + wc * 64 + n * 16 + fq * 4;
            float o[4];
            if (typ == 0) {
              const float4 w0 = *(const float4*)(uin(p, I_W0) + (l * 2 + (ng >> 8)) * 256 + (ng & 255));
              const float wv[4] = {w0.x, w0.y, w0.z, w0.w};
#pragma unroll
              for (int j = 0; j < 4; ++j) {
                const float e = 0.6065306597126334f * sigmoidf(acc[m][n][j] + wv[j]);
                o[j] = 1.f - __expf(-e);
              }
            } else if (typ == 1) {
              const float4 a0 = *(const float4*)(uin(p, I_A0) + (l * 2 + ((ng - 512) >> 8)) * 256 + (ng & 255));
              const float av[4] = {a0.x, a0.y, a0.z, a0.w};
#pragma unroll
              for (int j = 0; j < 4; ++j) o[j] = sigmoidf(acc[m][n][j] + av[j]);
            } else {
#pragma unroll
              for (int j = 0; j < 4; ++j) o[j] = acc[m][n][j];
            }
            uint2 w; w.x = (unsigned)f2h(o[0]) | ((unsigned)f2h(o[1]) << 16); w.y = (unsigned)f2h(o[2]) | ((unsigned)f2h(o[3]) << 16);
            *(uint2*)(FEAT + (size_t)row * 1280 + ng) = w;
          }
        }
      }
      __syncthreads();
    } else {
      const int j = it - 432, g = j / 10, rest = j % 10, mt5 = rest >> 1, nt2 = rest & 1;
      int n0 = mt5 * 256 + lrow, n1 = n0 + 128; if (n0 > NCH - 1) n0 = NCH - 1; if (n1 > NCH - 1) n1 = NCH - 1;
      const bf16_t* UDH = (const bf16_t*)(ws + WS_UDH);
      const bf16_t* a0 = UDH + (size_t)(g * NCH + n0) * 768; const bf16_t* a1 = UDH + (size_t)(g * NCH + n1) * 768;
      const bf16_t* b0 = EM + (size_t)(g * 256 + nt2 * 128 + lrow) * 512;
      gemm_tile(smem, 0, 512,
        [&](int i, int k) { return *(const uint4*)((i ? a1 : a0) + k); },
        [&](int k) { return *(const uint4*)(b0 + k); },
        [&](f32x4 (&acc)[4][4], int wr, int wc, int fr, int fq) {
#pragma unroll
          for (int m = 0; m < 4; ++m) {
            const int n = mt5 * 256 + wr * 64 + m * 16 + fr;
            if (n < NCH) {
#pragma unroll
              for (int nn = 0; nn < 4; ++nn)
                *(f32x4*)(HE + (size_t)(g * NCH + n) * 256 + nt2 * 128 + wc * 64 + nn * 16 + fq * 4) = acc[m][nn];
            }
          }
        });
    }
  }
}


DEVI float row_reduce_scatter16(const float (&v)[16], int lane16) {
  float a[8], b[4], c[2];
  const bool b3 = (lane16 & 8) != 0, b2 = (lane16 & 4) != 0, b1 = (lane16 & 2) != 0, b0 = (lane16 & 1) != 0;
#pragma unroll
  for (int k = 0; k < 8; ++k) { const float send = b3 ? v[k] : v[k + 8], keep = b3 ? v[k + 8] : v[k]; a[k] = keep + dpp_f<0x128>(send); }
#pragma unroll
  for (int k = 0; k < 4; ++k) { const float send = b2 ? a[k] : a[k + 4], keep = b2 ? a[k + 4] : a[k]; b[k] = keep + dpp_f<0x141>(send); }
#pragma unroll
  for (int k = 0; k < 2; ++k) { const float send = b1 ? b[k] : b[k + 2], keep = b1 ? b[k + 2] : b[k]; c[k] = keep + dpp_f<0x4E>(send); }
  { const float send = b0 ? c[0] : c[1], keep = b0 ? c[1] : c[0]; return keep + dpp_f<0xB1>(send); }
}
DEVI float mul_mix_lo(float a, unsigned hpair) { float r; asm("v_fma_mix_f32 %0, %1, %2, 0 op_sel_hi:[0,1,0]" : "=v"(r) : "v"(a), "v"(hpair)); return r; }
constexpr int RC_SLOT = 17664;
constexpr int RC_KK = 0, RC_RR = 2304, RC_KDB = 4608, RC_TT = 8704, RC_MM = 9728, RC_V = 10752, RC_G = 12800, RC_KD = 13056, RC_BB = 15360;
DEVI bf16x8 rc_pack8(const f32x4& a, const f32x4& b) {
  typedef unsigned u4v __attribute__((ext_vector_type(4)));
  const u4v u = {pack2(a[0], a[1]), pack2(a[2], a[3]), pack2(b[0], b[1]), pack2(b[2], b[3])};
  return __builtin_bit_cast(bf16x8, u);
}
DEVI bf16x8 rc_pack8(const f32x4& a, uint2 b) {
  typedef unsigned u4v __attribute__((ext_vector_type(4)));
  const u4v u = {pack2(a[0], a[1]), pack2(a[2], a[3]), b.x, b.y};
  return __builtin_bit_cast(bf16x8, u);
}
DEVI bf16x8 rc_pack8(uint2 a, const f32x4& b) {
  typedef unsigned u4v __attribute__((ext_vector_type(4)));
  const u4v u = {a.x, a.y, pack2(b[0], b[1]), pack2(b[2], b[3])};
  return __builtin_bit_cast(bf16x8, u);
}
template <int DIR>
DEVI void rwkv_chunked(const Params& p, int l, int it, unsigned char* smem) {
  unsigned char* ws = uws(p);
  const int b = it >> 3, h = (it >> 1) & 3;
  const bf16_t* PROJ = (const bf16_t*)(ws + WS_PROJ);
  const unsigned short* FEAT = (const unsigned short*)(ws + WS_FEAT);
  float* Y = (float*)((unsigned char*)uout(p) + (DIR ? DO_YB : DO_YF));
  const int tid = tid_(), lane = tid & 63, wid = __builtin_amdgcn_readfirstlane(tid >> 6);
  const int cl = lane & 15, cq = lane >> 4;
  const int hc = h * 64 + lane;
  const float* CW = uin(p, I_CONV) + l * 3 * 1024;
  float cwr[3], cwk[3], cwv[3];
#pragma unroll
  for (int dl = 0; dl < 3; ++dl) { cwr[dl] = CW[dl * 1024 + hc]; cwk[dl] = CW[dl * 1024 + 256 + hc]; cwv[dl] = CW[dl * 1024 + 512 + hc]; }
  const float kkw = uin(p, I_KK)[l * 256 + hc], kaw = uin(p, I_KA)[l * 256 + hc];
  const int pj = 32 * (lane >> 5) + 8 * ((lane >> 2) & 3) + 4 * ((lane >> 4) & 1) + (lane & 3);
  unsigned char* slot = smem + wid * RC_SLOT;
  const f32x4 zero4 = {0.f, 0.f, 0.f, 0.f};
  f32x4 acc[4] = {zero4, zero4, zero4, zero4};
  uint4 raw0, raw1, raw2, raw3, raw4, raw5, raw6, raw7, raw8, raw9, raw10;
  auto chunk_geom = [&](int c, bool& isctx, int& seqlen, int& lo, int& rowbase) __attribute__((always_inline)) {
    const int n0 = c * 16; isctx = n0 < 256; seqlen = isctx ? 256 : 2048; const int m0 = isctx ? n0 : n0 - 256;
    lo = DIR ? (seqlen - 16 - m0) : m0;
    rowbase = isctx ? (NLAT + b * CTXL) : (b * SEQ);
  };
#define RC_LDP(ld, dst) do { const int L_ = (ld) * 64 + lane_; const int Lc_ = L_ < 432 ? L_ : 431; const int u_ = Lc_ / 24, sg_ = (Lc_ % 24) >> 3, part_ = Lc_ & 7; \
    int tau_ = lo_ - 1 + u_; tau_ = tau_ < 0 ? 0 : (tau_ >= seqlen_ ? seqlen_ - 1 : tau_); \
    dst = *(const uint4*)(PROJ + (size_t)(rowbase_ + tau_) * DIN + h * 64 + sg_ * 256 + part_ * 8); } while (0)
#define RC_LDF(ld, dst) do { const int L_ = (ld) * 64 + lane_; const int o_ = L_ >> 4, sg_ = (L_ >> 3) & 1, part_ = L_ & 7; \
    dst = *(const uint4*)(FEAT + (size_t)(rowbase_ + lo_ + o_) * 1280 + DIR * 256 + sg_ * 512 + h * 64 + part_ * 8); } while (0)
#define RC_LOAD_RAW(c) do { bool isctx_; int seqlen_, lo_, rowbase_; chunk_geom((c), isctx_, seqlen_, lo_, rowbase_); const int lane_ = tid_() & 63;     \
    RC_LDP(0, raw0); RC_LDP(1, raw1); RC_LDP(2, raw2); RC_LDP(3, raw3); RC_LDP(4, raw4); RC_LDP(5, raw5); RC_LDP(6, raw6); \
    RC_LDF(0, raw7); RC_LDF(1, raw8); RC_LDF(2, raw9); RC_LDF(3, raw10); } while (0)
  RC_LOAD_RAW(wid);
  for (int batch = 0; batch < 18; ++batch) {
    {
      const int c = batch * 8 + wid;
      bool isctx; int seqlen, lo, rowbase; chunk_geom(c, isctx, seqlen, lo, rowbase);
      *(uint4*)(slot + (0 * 64 + lane) * 16) = raw0; *(uint4*)(slot + (1 * 64 + lane) * 16) = raw1; *(uint4*)(slot + (2 * 64 + lane) * 16) = raw2; *(uint4*)(slot + (3 * 64 + lane) * 16) = raw3;
      *(uint4*)(slot + (4 * 64 + lane) * 16) = raw4; *(uint4*)(slot + (5 * 64 + lane) * 16) = raw5; if (6 * 64 + lane < 432) *(uint4*)(slot + (6 * 64 + lane) * 16) = raw6;
      *(uint4*)(slot + 6912 + (0 * 64 + lane) * 16) = raw7; *(uint4*)(slot + 6912 + (1 * 64 + lane) * 16) = raw8; *(uint4*)(slot + 6912 + (2 * 64 + lane) * 16) = raw9; *(uint4*)(slot + 6912 + (3 * 64 + lane) * 16) = raw10;
      const unsigned short* sraw = (const unsigned short*)slot + lane;
      const bool ok_lo = lo - 1 >= 0, ok_hi = lo + 16 < seqlen;
      float kC[16], kkr[16], sq[16];
      {
        float Rk[18];
#pragma unroll
        for (int u = 0; u < 18; ++u) Rk[u] = __uint_as_float((unsigned)sraw[(u * 3 + 1) * 64] << 16);
        if (!ok_lo) Rk[0] = 0.f;
        if (!ok_hi) Rk[17] = 0.f;
#pragma unroll
        for (int o = 0; o < 16; ++o) { kC[o] = cwk[0] * Rk[o] + cwk[1] * Rk[o + 1] + cwk[2] * Rk[o + 2]; kkr[o] = kC[o] * kkw; sq[o] = kkr[o] * kkr[o]; }
      }
      float tot = row_reduce_scatter16(sq, cl);
      tot += shfl_xor_l(tot, 16); tot += shfl_xor_l(tot, 32);
      const float invv = rsqrtf(tot + 1e-12f);
      float rC[16], vC[16], xwF[16], aF[16];
      {
        float Rr[18], Rv[18];
#pragma unroll
        for (int u = 0; u < 18; ++u) { Rr[u] = __uint_as_float((unsigned)sraw[(u * 3 + 0) * 64] << 16); Rv[u] = __uint_as_float((unsigned)sraw[(u * 3 + 2) * 64] << 16); }
        if (!ok_lo) { Rr[0] = 0.f; Rv[0] = 0.f; }
        if (!ok_hi) { Rr[17] = 0.f; Rv[17] = 0.f; }
#pragma unroll
        for (int o = 0; o < 16; ++o) { rC[o] = cwr[0] * Rr[o] + cwr[1] * Rr[o + 1] + cwr[2] * Rr[o + 2]; vC[o] = cwv[0] * Rv[o] + cwv[1] * Rv[o + 1] + cwv[2] * Rv[o + 2]; }
#pragma unroll
        for (int o = 0; o < 16; ++o) { xwF[o] = h2f(sraw[3456 + (o * 2 + 0) * 64]); aF[o] = h2f(sraw[3456 + (o * 2 + 1) * 64]); }
      }
      float G = 1.f;
      float kdq[4], bbq[4], vq[4];
      bf16_t* sKK = (bf16_t*)(slot + RC_KK); bf16_t* sRR = (bf16_t*)(slot + RC_RR); bf16_t* sKD = (bf16_t*)(slot + RC_KD); bf16_t* sBB = (bf16_t*)(slot + RC_BB);
#pragma unroll
      for (int s = 0; s < 16; ++s) {
        const int o = DIR ? (15 - s) : s;
        const float inv = __int_as_float(__builtin_amdgcn_readlane(__float_as_int(invv), o));
        const float okk = kkr[o] * inv, a = aF[o], ob = okk * a, okd = kC[o] * (1.f + (a - 1.f) * kaw), w = 1.f - xwF[o];
        const float kkt = okk * G;
        G *= w;
        const float ig = __builtin_amdgcn_rcpf(G);
        const float rt = rC[o] * G, kdt = okd * ig, bt = ob * ig;
        sKK[s * 72 + pj] = f2bf(kkt); sRR[s * 72 + pj] = f2bf(rt); sKD[s * 72 + pj] = f2bf(kdt); sBB[s * 72 + pj] = f2bf(bt);
        kdq[s & 3] = kdt; bbq[s & 3] = -bt; vq[s & 3] = vC[o];
        if ((s & 3) == 3) {
          const int fi = ((lane >> 4) * 4 + (s >> 2)) * 16 + (lane & 15);
          *(uint4*)(slot + RC_KDB + fi * 16) = make_uint4(pack2(kdq[0], kdq[1]), pack2(kdq[2], kdq[3]), pack2(bbq[0], bbq[1]), pack2(bbq[2], bbq[3]));
          *(uint2*)(slot + RC_V + fi * 8) = make_uint2(pack2(vq[0], vq[1]), pack2(vq[2], vq[3]));
        }
      }
      ((float*)(slot + RC_G))[lane] = G;
      const bf16x8 aK0 = *(const bf16x8*)(sKK + cl * 72 + 8 * cq), aK1 = *(const bf16x8*)(sKK + cl * 72 + 32 + 8 * cq);
      const bf16x8 aR0 = *(const bf16x8*)(sRR + cl * 72 + 8 * cq), aR1 = *(const bf16x8*)(sRR + cl * 72 + 32 + 8 * cq);
      const bf16x8 bD0 = *(const bf16x8*)(sKD + cl * 72 + 8 * cq), bD1 = *(const bf16x8*)(sKD + cl * 72 + 32 + 8 * cq);
      const bf16x8 bB0 = *(const bf16x8*)(sBB + cl * 72 + 8 * cq), bB1 = *(const bf16x8*)(sBB + cl * 72 + 32 + 8 * cq);
      f32x4 Abk = __builtin_amdgcn_mfma_f32_16x16x32_bf16(aK0, bB0, zero4, 0, 0, 0); Abk = __builtin_amdgcn_mfma_f32_16x16x32_bf16(aK1, bB1, Abk, 0, 0, 0);
      f32x4 Avk = __builtin_amdgcn_mfma_f32_16x16x32_bf16(aK0, bD0, zero4, 0, 0, 0); Avk = __builtin_amdgcn_mfma_f32_16x16x32_bf16(aK1, bD1, Avk, 0, 0, 0);
      f32x4 Mbr = __builtin_amdgcn_mfma_f32_16x16x32_bf16(aR0, bB0, zero4, 0, 0, 0); Mbr = __builtin_amdgcn_mfma_f32_16x16x32_bf16(aR1, bB1, Mbr, 0, 0, 0);
      f32x4 Mvr = __builtin_amdgcn_mfma_f32_16x16x32_bf16(aR0, bD0, zero4, 0, 0, 0); Mvr = __builtin_amdgcn_mfma_f32_16x16x32_bf16(aR1, bD1, Mvr, 0, 0, 0);
      float* tA = (float*)(slot + RC_KD); float* tVT = tA + 256;
      bf16_t* sMM = (bf16_t*)(slot + RC_MM);
#pragma unroll
      for (int r = 0; r < 4; ++r) {
        const int t = 4 * cq + r;
        const float abk = (cl < t) ? Abk[r] : 0.f, avk = (cl < t) ? Avk[r] : 0.f, mbr = (cl <= t) ? Mbr[r] : 0.f, mvr = (cl <= t) ? Mvr[r] : 0.f;
        tA[t * 16 + cl] = abk; Avk[r] = avk;
        sMM[((cl >> 2) * 16 + t) * 8 + (cl & 3)] = f2bf(mvr); sMM[((cl >> 2) * 16 + t) * 8 + 4 + (cl & 3)] = f2bf(-mbr);
      }
      *(float4*)(tVT + cl * 16 + 4 * cq) = make_float4(Avk[0], Avk[1], Avk[2], Avk[3]);
      {
        const bool isTA = ((lane >> 4) & 1) != 0;
        float X[16];
        {
          const float4* pv = (const float4*)(tVT + cl * 16);
          const float4 r0 = pv[0], r1 = pv[1], r2 = pv[2], r3 = pv[3];
          const float rh[16] = {r0.x, r0.y, r0.z, r0.w, r1.x, r1.y, r1.z, r1.w, r2.x, r2.y, r2.z, r2.w, r3.x, r3.y, r3.z, r3.w};
#pragma unroll
          for (int t = 0; t < 16; ++t) X[t] = isTA ? rh[t] : ((t == cl) ? 1.f : 0.f);
        }
#pragma unroll
        for (int t = 1; t < 16; ++t) {
          float a = X[t];
#pragma unroll
          for (int s4 = 0; s4 * 4 < t; ++s4) {
            const float4 ar = *(const float4*)(tA + t * 16 + 4 * s4);
            if (4 * s4 + 0 < t) a = fmaf(-ar.x, X[4 * s4 + 0], a);
            if (4 * s4 + 1 < t) a = fmaf(-ar.y, X[4 * s4 + 1], a);
            if (4 * s4 + 2 < t) a = fmaf(-ar.z, X[4 * s4 + 2], a);
            if (4 * s4 + 3 < t) a = fmaf(-ar.w, X[4 * s4 + 3], a);
          }
          X[t] = a;
        }
        bf16_t* sTT = (bf16_t*)(slot + RC_TT);
        if (lane < 32) {
#pragma unroll
          for (int t = 0; t < 16; ++t) sTT[((cl >> 2) * 16 + t) * 8 + (cl & 3) + (isTA ? 4 : 0)] = f2bf(X[t]);
        }
      }
    }
    __syncthreads();
    if (batch + 1 < 18) RC_LOAD_RAW((batch + 1) * 8 + wid);
    if (wid < 4) {
      const int itile = wid;
      bf16x8 nK0, nK1, nR0, nR1, nTT; uint2 nV;
#define RC_CONS_LOAD(sl_) do { nK0 = *(const bf16x8*)((sl_) + RC_KK + (cl * 72 + 8 * cq) * 2); nK1 = *(const bf16x8*)((sl_) + RC_KK + (cl * 72 + 32 + 8 * cq) * 2); \
        nR0 = *(const bf16x8*)((sl_) + RC_RR + (cl * 72 + 8 * cq) * 2); nR1 = *(const bf16x8*)((sl_) + RC_RR + (cl * 72 + 32 + 8 * cq) * 2); \
        nTT = *(const bf16x8*)((sl_) + RC_TT + lane * 16); nV = *(const uint2*)((sl_) + RC_V + (itile * 64 + lane) * 8); } while (0)
      RC_CONS_LOAD(smem);
#pragma unroll 1
      for (int k = 0; k < 8; ++k) {
        const unsigned char* sl = smem + k * RC_SLOT;
        const bf16x8 aK0 = nK0, aK1 = nK1, aR0 = nR0, aR1 = nR1, fTT = nTT; const uint2 fV = nV;
        const bf16x8 fMM = *(const bf16x8*)(sl + RC_MM + lane * 16);
        const bf16x8 Bs0 = rc_pack8(acc[0], acc[1]), Bs1 = rc_pack8(acc[2], acc[3]);
        f32x4 P = __builtin_amdgcn_mfma_f32_16x16x32_bf16(aK0, Bs0, zero4, 0, 0, 0); P = __builtin_amdgcn_mfma_f32_16x16x32_bf16(aK1, Bs1, P, 0, 0, 0);
        f32x4 Yv = __builtin_amdgcn_mfma_f32_16x16x32_bf16(aR0, Bs0, zero4, 0, 0, 0); Yv = __builtin_amdgcn_mfma_f32_16x16x32_bf16(aR1, Bs1, Yv, 0, 0, 0);
        if (k + 1 < 8) RC_CONS_LOAD(sl + RC_SLOT);
        const f32x4 SA = __builtin_amdgcn_mfma_f32_16x16x32_bf16(fTT, rc_pack8(P, fV), zero4, 0, 0, 0);
        const bf16x8 Bvs = rc_pack8(fV, SA);
        Yv = __builtin_amdgcn_mfma_f32_16x16x32_bf16(fMM, Bvs, Yv, 0, 0, 0);
#pragma unroll
        for (int jt = 0; jt < 4; ++jt) {
          const bf16x8 fKDB = *(const bf16x8*)(sl + RC_KDB + (jt * 64 + lane) * 16);
          const float4 g = *(const float4*)(sl + RC_G + (16 * jt + 4 * cq) * 4);
          acc[jt] = __builtin_amdgcn_mfma_f32_16x16x32_bf16(fKDB, Bvs, acc[jt], 0, 0, 0);
          acc[jt][0] *= g.x; acc[jt][1] *= g.y; acc[jt][2] *= g.z; acc[jt][3] *= g.w;
        }
        bool isctx; int seqlen, lo, rowbase; chunk_geom(batch * 8 + k, isctx, seqlen, lo, rowbase);
        if (!(l == 1 && isctx)) {
#pragma unroll
          for (int r = 0; r < 4; ++r) {
            const int t = 4 * cq + r, o = DIR ? (15 - t) : t;
            Y[(size_t)(rowbase + lo + o) * 256 + h * 64 + itile * 16 + cl] = Yv[r];
          }
        }
      }
    }
    __syncthreads();
  }
#undef RC_LDP
#undef RC_LDF
#undef RC_LOAD_RAW
#undef RC_CONS_LOAD
}

DEVI void s5_carry_item(const Params& p, int l, int g, int b) {
  unsigned char* ws = uws(p);
  const int tid = tid_();
  if (tid >= 128) return;
  const float* HE = (const float*)((unsigned char*)uout(p) + DO_HE) + (size_t)g * NCH * 256;
  bf16_t* UDH = (bf16_t*)(ws + WS_UDH) + (size_t)g * NCH * 768;
  const int dd = tid >> 6, pp = tid & 63;
  const float2 aT = ((const float2*)(ws + WS_APOW))[((size_t)(((l * 2 + dd) * 16 + g) * 64 + pp)) * 33 + 32];
  const int off = dd * 128 + pp;
  float hr = 0.f, hi = 0.f;
  {
    float er[8], ei[8];
#pragma unroll
    for (int c = 0; c < 8; ++c) { const int n = 1024 + b * 8 + (dd ? (7 - c) : c); er[c] = HE[(size_t)n * 256 + off]; ei[c] = HE[(size_t)n * 256 + off + 64]; }
#pragma unroll
    for (int c = 0; c < 8; ++c) {
      const int n = 1024 + b * 8 + (dd ? (7 - c) : c);
      UDH[(size_t)n * 768 + 512 + off] = f2bf(hr); UDH[(size_t)n * 768 + 512 + off + 64] = f2bf(hi);
      const float nr = aT.x * hr - aT.y * hi + er[c], ni = aT.x * hi + aT.y * hr + ei[c];
      hr = nr; hi = ni;
    }
  }
#pragma unroll 1
  for (int c0 = 0; c0 < 64; c0 += 16) {
    float er[16], ei[16];
#pragma unroll
    for (int c = 0; c < 16; ++c) { const int n = b * 64 + (dd ? (63 - c0 - c) : (c0 + c)); er[c] = HE[(size_t)n * 256 + off]; ei[c] = HE[(size_t)n * 256 + off + 64]; }
#pragma unroll
    for (int c = 0; c < 16; ++c) {
      const int n = b * 64 + (dd ? (63 - c0 - c) : (c0 + c));
      UDH[(size_t)n * 768 + 512 + off] = f2bf(hr); UDH[(size_t)n * 768 + 512 + off + 64] = f2bf(hi);
      const float nr = aT.x * hr - aT.y * hi + er[c], ni = aT.x * hi + aT.y * hr + ei[c];
      hr = nr; hi = ni;
    }
  }
}

struct S5Sched {
  const bf16_t* UDH; const bf16_t* TTG; int G, c, ntile;
  DEVI bool next(int i, g8::Unit& u) const {
    const int L = i * G + c; if (L >= 16 * ntile * 2) return false;
    u.e = L / (ntile * 2); const int r = L % (ntile * 2); u.pm = r >> 1; u.pn = r & 1; return true;
  }
  DEVI const char* a_base() const { return (const char*)UDH; }
  DEVI void a_offs(const g8::Unit& u, int tid, unsigned (&ao)[2][2]) const {
#pragma unroll
    for (int i = 0; i < 2; ++i) {
      int R, C; g8::stage_rc(tid * 16 + i * 8192, R, C);
#pragma unroll
      for (int h = 0; h < 2; ++h) ao[h][i] = ((unsigned)(u.e * NCH + u.pm * 256 + h * 128 + R) * 768u + (unsigned)C) * 2u;
    }
  }
  DEVI const char* b_ptr(const g8::Unit& u) const { return (const char*)(TTG + ((size_t)u.e * 512 + (size_t)u.pn * 256) * 768); }
};
struct EpiS5 {
  static constexpr bool PERM = true;
  bf16_t* ZB;
  DEVI void operator()(const f32x4 (&acc)[2][2][4][2], const g8::Unit& u) const {
    const int tid = tid_(), wid = __builtin_amdgcn_readfirstlane(tid >> 6), lane = tid & 63, wr = wid >> 2, wc = wid & 3, fr = lane & 15, fq = lane >> 4;
#pragma unroll
    for (int ai = 0; ai < 2; ++ai)
#pragma unroll
      for (int m = 0; m < 4; ++m) {
        const int n = u.pm * 256 + ai * 128 + wr * 64 + m * 16 + fr;
        if (n < NCH) {
#pragma unroll
          for (int bj = 0; bj < 2; ++bj) {
            const int mc = u.pn * 256 + bj * 128 + wc * 32 + 8 * fq, tau = mc >> 4, c = mc & 15;
            const f32x4 v0 = acc[ai][bj][m][0], v1 = acc[ai][bj][m][1];
            *(uint4*)(ZB + ((size_t)n * 32 + tau) * 256 + u.e * 16 + c) = make_uint4(pack2(gelu_tanh(v0[0]), gelu_tanh(v0[1])), pack2(gelu_tanh(v0[2]), gelu_tanh(v0[3])),
                                                                                   pack2(gelu_tanh(v1[0]), gelu_tanh(v1[1])), pack2(gelu_tanh(v1[2]), gelu_tanh(v1[3])));
          }
        }
        asm volatile("" ::: "memory");
      }
  }
};

DEVI void attn_item(const Params& p, int l, int b, int qb, int hq, unsigned char* smem) {
  unsigned char* ws = uws(p);
  const bf16_t* PROJ = (const bf16_t*)(ws + WS_PROJ);
  bf16_t* YMIX = (bf16_t*)(ws + WS_YMIX);
  bf16_t* sKV = (bf16_t*)smem;
  const int tid = tid_(), lane = tid & 63, wid = tid >> 6, r = lane & 31, hh = lane >> 5;
  const int kvh = hq >> 2;
  const bool ctxq = qb < 0;
  const int qrow0 = ctxq ? (NLAT + b * CTXL + wid * 32) : (b * SEQ + qb * 256 + wid * 32);
  const int q0pos = qb * 256 + wid * 32;
  bf16x8 qf[4];
  {
    const bf16_t* qp = PROJ + (size_t)(qrow0 + r) * DIN + 1280 + hq * 64 + hh * 8;
#pragma unroll
    for (int ks = 0; ks < 4; ++ks) qf[ks] = *(const bf16x8*)(qp + ks * 16);
  }
  f32x16 O0, O1;
#pragma unroll
  for (int i = 0; i < 16; ++i) { O0[i] = 0.f; O1[i] = 0.f; }
  float mrun = uin(p, I_SINK)[l * 8 + hq] * 1.4426950408889634f;
  float lsum = (hh == 0) ? 1.f : 0.f;
  const int jlo = ctxq ? 0 : (qb == 0 ? 2 : 0), jhi = ctxq ? 0 : (qb == 7 ? 6 : 8);
  const int nchunk = 4 + (jhi - jlo);
  const int nstage = (nchunk + 2) / 3;
  const int skey = tid >> 3, spc = (tid & 7) * 8;
  auto chunk_row0 = [&](int c) { return c < 4 ? (NLAT + b * CTXL + c * 64) : (b * SEQ + qb * 256 - 128 + (jlo + c - 4) * 64); };
  uint4 kr0, kr1, kr2, vr0, vr1, vr2;
  kr0 = kr1 = kr2 = vr0 = vr1 = vr2 = make_uint4(0, 0, 0, 0);
#define ATT_LOAD1(j, KR, VR, st_) do { const int c_ = (st_) * 3 + (j); if (c_ < nchunk) { \
    const bf16_t* kp_ = PROJ + (size_t)(chunk_row0(c_) + skey) * DIN + 1792 + kvh * 64 + spc; KR = *(const uint4*)kp_; VR = *(const uint4*)(kp_ + 128); } } while (0)
#define ATT_LOAD_STAGE(st_) do { ATT_LOAD1(0, kr0, vr0, st_); ATT_LOAD1(1, kr1, vr1, st_); ATT_LOAD1(2, kr2, vr2, st_); } while (0)
#define ATT_WRITE1(j, KR, VR) do { if (st * 3 + (j) < nchunk) { bf16_t* sKb_ = sB + (j) * (2 * 64 * 72); bf16_t* sVb_ = sKb_ + 64 * 72; \
    *(uint4*)(sKb_ + skey * 72 + spc) = KR; \
    sVb_[(spc + 0) * 72 + skey] = (bf16_t)(VR.x & 0xFFFF); sVb_[(spc + 1) * 72 + skey] = (bf16_t)(VR.x >> 16); \
    sVb_[(spc + 2) * 72 + skey] = (bf16_t)(VR.y & 0xFFFF); sVb_[(spc + 3) * 72 + skey] = (bf16_t)(VR.y >> 16); \
    sVb_[(spc + 4) * 72 + skey] = (bf16_t)(VR.z & 0xFFFF); sVb_[(spc + 5) * 72 + skey] = (bf16_t)(VR.z >> 16); \
    sVb_[(spc + 6) * 72 + skey] = (bf16_t)(VR.w & 0xFFFF); sVb_[(spc + 7) * 72 + skey] = (bf16_t)(VR.w >> 16); } } while (0)
  ATT_LOAD_STAGE(0);
  int buf = 0;
  for (int st = 0; st < nstage; ++st) {
    bf16_t* sB = sKV + buf * (6 * 64 * 72);
    ATT_WRITE1(0, kr0, vr0); ATT_WRITE1(1, kr1, vr1); ATT_WRITE1(2, kr2, vr2);
    __syncthreads();
    if (st + 1 < nstage) ATT_LOAD_STAGE(st + 1);
#pragma unroll 1
    for (int j = 0; j < 3; ++j) {
      const int c = st * 3 + j;
      if (c >= nchunk) break;
      const bf16_t* sKb = sB + j * (2 * 64 * 72); const bf16_t* sVb = sKb + 64 * 72;
      const bool band = c >= 4;
      const int kstart = band ? (qb * 256 - 128 + (jlo + c - 4) * 64) : 0;
#pragma unroll
      for (int tt = 0; tt < 2; ++tt) {
        const int ts = kstart + tt * 32;
        bool need = true, full = true;
        if (band) {
          need = (ts + 31 >= q0pos - 128) && (ts <= q0pos + 31 + 128);
          full = (ts >= q0pos + 31 - 128) && (ts + 31 <= q0pos + 128);
        }
        if (!need) continue;
        f32x16 S;
#pragma unroll
        for (int i = 0; i < 16; ++i) S[i] = 0.f;
#pragma unroll
        for (int ks = 0; ks < 4; ++ks) {
          const bf16x8 kf = *(const bf16x8*)(sKb + (tt * 32 + r) * 72 + ks * 16 + hh * 8);
          S = __builtin_amdgcn_mfma_f32_32x32x16_bf16(kf, qf[ks], S, 0, 0, 0);
        }
        if (!full) {
#pragma unroll
          for (int i = 0; i < 16; ++i) {
            const int kpos = ts + (i & 3) + 8 * (i >> 2) + 4 * hh;
            const int dl = (q0pos + r) - kpos;
            if (dl > 128 || dl < -128) S[i] = -1e30f;
          }
        }
        float mx = S[0];
#pragma unroll
        for (int i = 1; i < 16; ++i) mx = fmaxf(mx, S[i]);
        mx = fmaxf(mx, shfl_xor_l(mx, 32));
        const float mnew = fmaxf(mrun, mx);
        const float alpha = __builtin_amdgcn_exp2f(mrun - mnew);
        const bool grew = mnew > mrun;
        mrun = mnew;
        float ps = 0.f;
#pragma unroll
        for (int i = 0; i < 16; ++i) { S[i] = __builtin_amdgcn_exp2f(S[i] - mnew); ps += S[i]; }
        lsum = lsum * alpha + ps;
        if (__builtin_amdgcn_ballot_w64(grew) != 0ull) {
#pragma unroll
          for (int i = 0; i < 16; ++i) { O0[i] *= alpha; O1[i] *= alpha; }
        }
        bf16x8 pf[2];
#pragma unroll
        for (int s2 = 0; s2 < 2; ++s2) {
          const uint4 u = make_uint4(pack2(S[8 * s2], S[8 * s2 + 1]), pack2(S[8 * s2 + 2], S[8 * s2 + 3]), pack2(S[8 * s2 + 4], S[8 * s2 + 5]), pack2(S[8 * s2 + 6], S[8 * s2 + 7]));
          pf[s2] = __builtin_bit_cast(bf16x8, u);
        }
#pragma unroll
        for (int s2 = 0; s2 < 2; ++s2) {
          {
            const bf16_t* vp = sVb + (0 * 32 + r) * 72 + tt * 32 + 16 * s2 + 4 * hh;
            const uint2 lo = *(const uint2*)vp, hi = *(const uint2*)(vp + 8);
            const uint4 u = make_uint4(lo.x, lo.y, hi.x, hi.y);
            O0 = __builtin_amdgcn_mfma_f32_32x32x16_bf16(__builtin_bit_cast(bf16x8, u), pf[s2], O0, 0, 0, 0);
          }
          {
            const bf16_t* vp = sVb + (1 * 32 + r) * 72 + tt * 32 + 16 * s2 + 4 * hh;
            const uint2 lo = *(const uint2*)vp, hi = *(const uint2*)(vp + 8);
            const uint4 u = make_uint4(lo.x, lo.y, hi.x, hi.y);
            O1 = __builtin_amdgcn_mfma_f32_32x32x16_bf16(__builtin_bit_cast(bf16x8, u), pf[s2], O1, 0, 0, 0);
          }
        }
      }
    }
    buf ^= 1;
  }
  const float lt = lsum + shfl_xor_l(lsum, 32);
  const float inv = 1.f / lt;
  bf16_t* op = YMIX + (size_t)(qrow0 + r) * D + 512 + hq * 64 + 4 * hh;
#pragma unroll
  for (int g4 = 0; g4 < 4; ++g4) {
    uint2 o; o.x = pack2(O0[4 * g4] * inv, O0[4 * g4 + 1] * inv); o.y = pack2(O0[4 * g4 + 2] * inv, O0[4 * g4 + 3] * inv);
    *(uint2*)(op + 8 * g4) = o;
    uint2 o1; o1.x = pack2(O1[4 * g4] * inv, O1[4 * g4 + 1] * inv); o1.y = pack2(O1[4 * g4 + 2] * inv, O1[4 * g4 + 3] * inv);
    *(uint2*)(op + 32 + 8 * g4) = o1;
  }
  __syncthreads();
}

DEVI void phase_mixers(const Params& p, int l, unsigned char* smem) {
  const int bid = bid_(), G = gridDim.x;
  const int nsb = (G >> 4) * 8 + ((G & 15) < 8 ? (G & 15) : 8);
  if (((bid >> 3) & 1) == 0) {
    for (int it = (bid >> 4) * 8 + (bid & 7); it < 128; it += nsb) { if (it & 1) rwkv_chunked<1>(p, l, it, smem); else rwkv_chunked<0>(p, l, it, smem); }
  }
  const int n_attn = (l == 0) ? 1152 : 1024, nq = 256 + n_attn;
  int* ctr = (int*)(uws(p) + WS_CTL) + 64 + l;
  volatile int* sTick = (volatile int*)(smem + SMEM_BYTES - 16);
  const int tid = tid_();
  __syncthreads();
  if (tid == 0) sTick[0] = atomicAdd(ctr, 1);
  __syncthreads();
  int cur = sTick[0];
  while (cur < nq) {
    int nxt = 0;
    if (tid == 0) nxt = atomicAdd(ctr, 1);
    if (cur >= n_attn) { const int c = cur - n_attn; s5_carry_item(p, l, c >> 4, c & 15); }
    else if (cur < 768) { const int bb = cur / 48, r = cur % 48; attn_item(p, l, bb, 1 + (r >> 3), r & 7, smem); }
    else if (cur < 1024) { const int a = cur - 768, bb = a >> 4, r = a & 15; attn_item(p, l, bb, (r >> 3) ? 7 : 0, r & 7, smem); }
    else attn_item(p, l, (cur - 1024) >> 3, -1, (cur - 1024) & 7, smem);
    __syncthreads();
    if (tid == 0) sTick[0] = nxt;
    __syncthreads();
    cur = sTick[0];
  }
}

DEVI void phase_mixfin(const Params& p, int l, unsigned char* smem) {
  unsigned char* ws = uws(p);
  const int tid = tid_(), bid = bid_(), G = gridDim.x;
  bf16_t* YMIX = (bf16_t*)(ws + WS_YMIX);
  {
    S5Sched S{(const bf16_t*)(ws + WS_UDH), (const bf16_t*)(ws + WS_TTG) + (size_t)l * 16 * 512 * 768, G, bid, (l == 1) ? 4 : 5};
    EpiS5 E{(bf16_t*)((unsigned char*)uout(p) + DO_ZB)};
    __syncthreads();
    g8::gemm((G8_LAS unsigned char*)smem, 768, S, E);
    __syncthreads();
  }
  {
    const bf16_t* PROJ = (const bf16_t*)(ws + WS_PROJ);
    const unsigned short* FEAT = (const unsigned short*)(ws + WS_FEAT);
    const float* YF = (const float*)((unsigned char*)uout(p) + DO_YF); const float* YB = (const float*)((unsigned char*)uout(p) + DO_YB);
    const float* CW = uin(p, I_CONV) + l * 3 * 1024;
    const int c4 = (tid & 15) * 4;
    const int nbusy = (16 * ((l == 1) ? 4 : 5) * 2 < G) ? 16 * ((l == 1) ? 4 : 5) * 2 : G;
    const int nvirt = nbusy + 2 * (G - nbusy);
    const int ustride = (nvirt * NTHREADS) >> 4;
    const int nun = ((l == 1) ? NLAT : NT) * 4;
    const int vb0 = (bid < nbusy) ? bid : nbusy + 2 * (bid - nbusy);
    const int u0 = (vb0 * NTHREADS + tid) >> 4;
    const int h = u0 & 3, hc = h * 64 + c4;
    float cwr[3][4], cwk[3][4], cwv[3][4], kaw[4], rkw[4], gnw[4], gnb[4];
#pragma unroll
    for (int dl = 0; dl < 3; ++dl)
#pragma unroll
      for (int e = 0; e < 4; ++e) { cwr[dl][e] = CW[dl * 1024 + hc + e]; cwk[dl][e] = CW[dl * 1024 + 256 + hc + e]; cwv[dl][e] = CW[dl * 1024 + 512 + hc + e]; }
#pragma unroll
    for (int e = 0; e < 4; ++e) { kaw[e] = uin(p, I_KA)[l * 256 + hc + e]; rkw[e] = uin(p, I_RK)[l * 256 + hc + e]; gnw[e] = uin(p, I_GNW)[l * 256 + hc + e]; gnb[e] = uin(p, I_GNB)[l * 256 + hc + e]; }
    for (int pass = 0; pass < ((bid < nbusy) ? 1 : 2); ++pass)
    for (int u = u0 + pass * 32; u < nun; u += ustride) {
      const int R = u >> 2;
      const int t = R < NLAT ? (R & 2047) : ((R - NLAT) & 255); const int len = R < NLAT ? SEQ : CTXL;
      const float4 yf = *(const float4*)(YF + (size_t)R * 256 + hc), yb = *(const float4*)(YB + (size_t)R * 256 + hc);
      float y[4] = {yf.x + yb.x, yf.y + yb.y, yf.z + yb.z, yf.w + yb.w};
      const float mu = row_sum16(y[0] + y[1] + y[2] + y[3]) * (1.f / 64.f);
      float q = 0.f;
#pragma unroll
      for (int e = 0; e < 4; ++e) { y[e] -= mu; q += y[e] * y[e]; }
      const float rstd = rsqrtf(row_sum16(q) * (1.f / 64.f) + GN_EPS);
      const bf16_t* pr = PROJ + (size_t)R * DIN + hc;
      const uint2 zc = make_uint2(0, 0);
      const uint2 rc = *(const uint2*)pr, kc = *(const uint2*)(pr + 256), vc = *(const uint2*)(pr + 512);
      uint2 rp = zc, kp = zc, vp = zc, rn = zc, kn = zc, vn = zc;
      if (t > 0) { rp = *(const uint2*)(pr - DIN); kp = *(const uint2*)(pr - DIN + 256); vp = *(const uint2*)(pr - DIN + 512); }
      if (t < len - 1) { rn = *(const uint2*)(pr + DIN); kn = *(const uint2*)(pr + DIN + 256); vn = *(const uint2*)(pr + DIN + 512); }
      const float rpf[4] = {lo_bf(rp.x), hi_bf(rp.x), lo_bf(rp.y), hi_bf(rp.y)}, rcf[4] = {lo_bf(rc.x), hi_bf(rc.x), lo_bf(rc.y), hi_bf(rc.y)}, rnf[4] = {lo_bf(rn.x), hi_bf(rn.x), lo_bf(rn.y), hi_bf(rn.y)};
      const float kpf[4] = {lo_bf(kp.x), hi_bf(kp.x), lo_bf(kp.y), hi_bf(kp.y)}, kcf[4] = {lo_bf(kc.x), hi_bf(kc.x), lo_bf(kc.y), hi_bf(kc.y)}, knf[4] = {lo_bf(kn.x), hi_bf(kn.x), lo_bf(kn.y), hi_bf(kn.y)};
      const float vpf[4] = {lo_bf(vp.x), hi_bf(vp.x), lo_bf(vp.y), hi_bf(vp.y)}, vcf[4] = {lo_bf(vc.x), hi_bf(vc.x), lo_bf(vc.y), hi_bf(vc.y)}, vnf[4] = {lo_bf(vn.x), hi_bf(vn.x), lo_bf(vn.y), hi_bf(vn.y)};
      const unsigned short* fr_ = FEAT + (size_t)R * 1280 + hc;
      const uint2 a0u = *(const uint2*)(fr_ + 512), a1u = *(const uint2*)(fr_ + 768), gtu = *(const uint2*)(fr_ + 1024);
      const float a0[4] = {h2f(a0u.x & 0xFFFF), h2f(a0u.x >> 16), h2f(a0u.y & 0xFFFF), h2f(a0u.y >> 16)};
      const float a1[4] = {h2f(a1u.x & 0xFFFF), h2f(a1u.x >> 16), h2f(a1u.y & 0xFFFF), h2f(a1u.y >> 16)};
      const float gt[4] = {h2f(gtu.x & 0xFFFF), h2f(gtu.x >> 16), h2f(gtu.y & 0xFFFF), h2f(gtu.y >> 16)};
      float bs = 0.f, vv[4];
#pragma unroll
      for (int e = 0; e < 4; ++e) {
        const float r = cwr[0][e] * rpf[e] + cwr[1][e] * rcf[e] + cwr[2][e] * rnf[e];
        const float k = cwk[0][e] * kpf[e] + cwk[1][e] * kcf[e] + cwk[2][e] * knf[e];
        vv[e] = cwv[0][e] * vpf[e] + cwv[1][e] * vcf[e] + cwv[2][e] * vnf[e];
        const float ksum = k * (2.f + (a0[e] + a1[e] - 2.f) * kaw[e]);
        bs += r * ksum * rkw[e];
      }
      bs = row_sum16(bs);
      float o[4];
#pragma unroll
      for (int e = 0; e < 4; ++e) {
        const float yn = y[e] * rstd * gnw[e] + gnb[e];
        o[e] = (yn + bs * vv[e]) * gt[e];
      }
      uint2 w; w.x = pack2(o[0], o[1]); w.y = pack2(o[2], o[3]);
      *(uint2*)(YMIX + (size_t)R * D + hc) = w;
    }
  }
}

struct EpiGlu {
  static constexpr bool PERM = true;
  const bf16_t* ZB; bf16_t* YMIX; const float* gb;
  DEVI void operator()(const f32x4 (&acc)[2][2][4][2], const g8::Unit& u) const {
    const int tid = tid_(), wid = __builtin_amdgcn_readfirstlane(tid >> 6), lane = tid & 63, wr = wid >> 2, wc = wid & 3, fr = lane & 15, fq = lane >> 4;
#pragma unroll
    for (int ai = 0; ai < 2; ++ai)
#pragma unroll
      for (int m = 0; m < 4; ++m) {
        const int row = u.pm * 256 + ai * 128 + wr * 64 + m * 16 + fr;
#pragma unroll
        for (int bj = 0; bj < 2; ++bj) {
          const int col = bj * 128 + wc * 32 + 8 * fq;
          const uint4 zz = *(const uint4*)(ZB + (size_t)row * 256 + col);
          const float4 b0 = *(const float4*)(gb + col), b1 = *(const float4*)(gb + col + 4);
          const f32x4 v0 = acc[ai][bj][m][0], v1 = acc[ai][bj][m][1];
          *(uint4*)(YMIX + (size_t)row * D + 256 + col) = make_uint4(
            pack2(lo_bf(zz.x) * sigmoidf(v0[0] + b0.x), hi_bf(zz.x) * sigmoidf(v0[1] + b0.y)), pack2(lo_bf(zz.y) * sigmoidf(v0[2] + b0.z), hi_bf(zz.y) * sigmoidf(v0[3] + b0.w)),
            pack2(lo_bf(zz.z) * sigmoidf(v1[0] + b1.x), hi_bf(zz.z) * sigmoidf(v1[1] + b1.y)), pack2(lo_bf(zz.w) * sigmoidf(v1[2] + b1.z), hi_bf(zz.w) * sigmoidf(v1[3] + b1.w)));
        }
        asm volatile("" ::: "memory");
      }
  }
};
DEVI void phase_glu(const Params& p, int l, unsigned char* smem) {
  unsigned char* ws = uws(p);
  g8::DenseSched S{(const bf16_t*)((unsigned char*)uout(p) + DO_ZB), (const bf16_t*)(ws + WS_GLU_T) + (size_t)l * 65536, 256, (l == 1) ? 128 : 144, 1, (int)gridDim.x, bid_()};
  EpiGlu E{(const bf16_t*)((unsigned char*)uout(p) + DO_ZB), (bf16_t*)(ws + WS_YMIX), uin(p, I_GLUB) + l * 256};
  __syncthreads();
  g8::gemm((G8_LAS unsigned char*)smem, 256, S, E);
  __syncthreads();
}

struct EpiBf16 {
  static constexpr bool PERM = true;
  bf16_t* O; int ldc;
  DEVI void operator()(const f32x4 (&acc)[2][2][4][2], const g8::Unit& u) const {
    const int tid = tid_(), wid = __builtin_amdgcn_readfirstlane(tid >> 6), lane = tid & 63, wr = wid >> 2, wc = wid & 3, fr = lane & 15, fq = lane >> 4;
#pragma unroll
    for (int ai = 0; ai < 2; ++ai)
#pragma unroll
      for (int m = 0; m < 4; ++m) {
        bf16_t* rowp = O + (size_t)(u.pm * 256 + ai * 128 + wr * 64 + m * 16 + fr) * ldc + u.pn * 256 + wc * 32 + 8 * fq;
#pragma unroll
        for (int bj = 0; bj < 2; ++bj) {
          const f32x4 v0 = acc[ai][bj][m][0], v1 = acc[ai][bj][m][1];
          *(uint4*)(rowp + bj * 128) = make_uint4(pack2(v0[0], v0[1]), pack2(v0[2], v0[3]), pack2(v1[0], v1[1]), pack2(v1[2], v1[3]));
        }
      }
  }
};
DEVI void phase_outproj(const Params& p, int l, unsigned char* smem) {
  unsigned char* ws = uws(p);
  g8::DenseSched S{(const bf16_t*)(ws + WS_YMIX), (const bf16_t*)(ws + WS_WOUT_T) + (size_t)l * D * D, D, (l == 1) ? 128 : 144, 4, (int)gridDim.x, bid_()};
  EpiBf16 E{(bf16_t*)(ws + WS_MIX), D};
  __syncthreads();
  g8::gemm((G8_LAS unsigned char*)smem, D, S, E);
  __syncthreads();
  if (l == 0) { const int G = gridDim.x, rem = (144 * 4) % G; if (rem == 0) build_ttg_em(p, 1, bid_(), G); else if (bid_() >= rem) build_ttg_em(p, 1, bid_() - rem, G - rem); }
}

DEVI void phase_ln1(const Params& p, int l, unsigned char* smem) {
  unsigned char* ws = uws(p);
  const int tid = tid_(), lane = tid & 63, wid = tid >> 6;
  const bf16_t* MIX = (const bf16_t*)(ws + WS_MIX);
  _Float16* X = (_Float16*)(ws + WS_X);
  bf16_t* H = (bf16_t*)(ws + WS_H);
  const float* MOD = (const float*)(ws + WS_MOD);
  const int nrows1 = (l == 1) ? NLAT : NT;
  const int nw = gridDim.x * 8, gw = bid_() * 8 + wid;
  const int rpw = (nrows1 + nw - 1) / nw;
  const int R0 = gw * rpw, R1 = (R0 + rpw < nrows1) ? (R0 + rpw) : nrows1;
  const int c0 = lane * 8, c1 = 512 + lane * 8;
  float g[2][8], bb[2][8], gt[2][8], sh[2][8], sc[2][8];
  ld8f(uin(p, I_LN1G) + l * D + c0, g[0]); ld8f(uin(p, I_LN1G) + l * D + c1, g[1]);
  ld8f(uin(p, I_LN1B) + l * D + c0, bb[0]); ld8f(uin(p, I_LN1B) + l * D + c1, bb[1]);
  int curb = -1;
  float xv[2][8], mx[2][8];
  auto load_row = [&](int Rr, float (&xo)[2][8], float (&mo)[2][8]) {
    if (l == 0) { const float* xr = xin_row(p, Rr); ld8f(xr + c0, xo[0]); ld8f(xr + c1, xo[1]); }
    else { const _Float16* xr = X + (size_t)Rr * D; ld8h(xr + c0, xo[0]); ld8h(xr + c1, xo[1]); }
    ld8b(MIX + (size_t)Rr * D + c0, mo[0]); ld8b(MIX + (size_t)Rr * D + c1, mo[1]);
  };
  if (R0 < R1) load_row(R0, xv, mx);
  for (int R = R0; R < R1; ++R) {
    float xn[2][8], mn[2][8];
#pragma unroll
    for (int h = 0; h < 2; ++h)
#pragma unroll
      for (int e = 0; e < 8; ++e) { xn[h][e] = 0.f; mn[h][e] = 0.f; }
    if (R + 1 < R1) load_row(R + 1, xn, mn);
    const int bi = bidx_of(R);
    if (bi != curb) {
      curb = bi;
      const float* modl = MOD + (size_t)(l * 17 + bi) * 6144;
      ld8f(modl + 2048 + c0, gt[0]); ld8f(modl + 2048 + c1, gt[1]);
      ld8f(modl + 3072 + c0, sh[0]); ld8f(modl + 3072 + c1, sh[1]);
      ld8f(modl + 4096 + c0, sc[0]); ld8f(modl + 4096 + c1, sc[1]);
    }
    float v[2][8]; float s = 0.f;
#pragma unroll
    for (int h = 0; h < 2; ++h)
#pragma unroll
      for (int e = 0; e < 8; ++e) { v[h][e] = ALPHA * xv[h][e] + gt[h][e] * mx[h][e]; s += v[h][e]; }
    const float mu = wave_sum(s) * (1.f / 1024.f);
    float q = 0.f;
#pragma unroll
    for (int h = 0; h < 2; ++h)
#pragma unroll
      for (int e = 0; e < 8; ++e) { v[h][e] -= mu; q += v[h][e] * v[h][e]; }
    const float rstd = rsqrtf(wave_sum(q) * (1.f / 1024.f) + LN_EPS);
#pragma unroll
    for (int h = 0; h < 2; ++h) {
      float x1[8], hm[8];
#pragma unroll
      for (int e = 0; e < 8; ++e) { x1[e] = v[h][e] * rstd * g[h][e] + bb[h][e]; hm[e] = x1[e] * (1.f + sc[h][e]) + sh[h][e]; }
      st8h(X + (size_t)R * D + (h ? c1 : c0), x1);
      st8b(H + (size_t)R * D + (h ? c1 : c0), hm);
    }
#pragma unroll
    for (int h = 0; h < 2; ++h)
#pragma unroll
      for (int e = 0; e < 8; ++e) { xv[h][e] = xn[h][e]; mx[h][e] = mn[h][e]; }
  }
}

DEVI void phase_router(const Params& p, int l, unsigned char* smem) {
  unsigned char* ws = uws(p);
  const int tid = tid_(), lrow = tid >> 2;
  const bf16_t* H = (const bf16_t*)(ws + WS_H);
  const bf16_t* RWH = (const bf16_t*)(ws + WS_RW) + (size_t)l * 2 * 128 * 1024;
  int* CNT = (int*)(ws + WS_CTL) + l * 32;
  int* LIST = (int*)(ws + WS_LIST);
  int4* ROUTE = (int4*)(ws + WS_ROUTE);
  float2* RWT = (float2*)(ws + WS_RWT);
  bf16_t* EW1 = (bf16_t*)(ws + WS_EW); bf16_t* EW2 = EW1 + (size_t)32 * 1024 * 1024;
  constexpr int N_CONV = 32 * 96;
  const int nmt = (l == 1) ? 128 : 144;
  for (int it0 = bid_(); it0 < nmt; it0 += gridDim.x) {
    {
      const int mt = it0;
      const bf16_t* a0 = H + (size_t)(mt * 256 + lrow) * D; const bf16_t* a1 = a0 + (size_t)128 * D;
      const bf16_t* b0 = RWH + (size_t)lrow * 1024;
      gemm_tile(smem, 0, D,
        [&](int i, int k) { return *(const uint4*)((i ? a1 : a0) + k); },
        [&](int k) { return *(const uint4*)(b0 + k); },
        [&](f32x4 (&acc)[4][4], int wr, int wc, int fr, int fq) {
          float* sLog = (float*)smem;
          if (wc == 0) {
#pragma unroll
            for (int m = 0; m < 4; ++m)
#pragma unroll
              for (int n = 0; n < 3; ++n)
#pragma unroll
                for (int j = 0; j < 4; ++j) { const int col = n * 16 + fq * 4 + j; if (col < 36) sLog[(wr * 64 + m * 16 + fr) * 37 + col] = acc[m][n][j]; }
          }
        });
      int* sHist = (int*)(smem + 40960); int* sBase = sHist + 32;
      if (tid < 32) sHist[tid] = 0;
      __syncthreads();
      int e1 = 0, e2 = 0, lp1 = 0, lp2 = 0; float w1 = 0.f, w2 = 0.f;
      if (tid < 256) {
        const float* lg = (const float*)smem + tid * 37;
        float gl[4]; int gi = 0; float gmax;
#pragma unroll
        for (int i = 0; i < 4; ++i) gl[i] = lg[i] + uin(p, I_RGB)[l * 4 + i];
        gmax = gl[0];
#pragma unroll
        for (int i = 1; i < 4; ++i) if (gl[i] > gmax) { gmax = gl[i]; gi = i; }
        float gs = 0.f;
#pragma unroll
        for (int i = 0; i < 4; ++i) gs += expf(gl[i] - gmax);
        const float gprob = 1.f / gs;
        float el[8];
#pragma unroll
        for (int j = 0; j < 8; ++j) el[j] = lg[4 + gi * 8 + j] + uin(p, I_REB)[l * 32 + gi * 8 + j];
        int i1 = 0; float l1 = el[0];
#pragma unroll
        for (int j = 1; j < 8; ++j) if (el[j] > l1) { l1 = el[j]; i1 = j; }
        int i2 = (i1 == 0) ? 1 : 0; float l2 = -3.0e38f;
#pragma unroll
        for (int j = 0; j < 8; ++j) if (j != i1 && el[j] > l2) { l2 = el[j]; i2 = j; }
        const float ex = expf(l2 - l1);
        w1 = gprob / (1.f + ex); w2 = gprob * ex / (1.f + ex);
        e1 = gi * 8 + i1; e2 = gi * 8 + i2;
        lp1 = atomicAdd(&sHist[e1], 1); lp2 = atomicAdd(&sHist[e2], 1);
      }
      __syncthreads();
      if (tid < 32) sBase[tid] = atomicAdd(&CNT[tid], sHist[tid]);
      __syncthreads();
      if (tid < 256) {
        const int R = mt * 256 + tid;
        const int p1 = sBase[e1] + lp1, p2 = sBase[e2] + lp2;
        LIST[(size_t)e1 * NT + p1] = R; LIST[(size_t)e2 * NT + p2] = R;
        ROUTE[R] = make_int4(e1, p1, e2, p2);
        RWT[R] = make_float2(w1, w2);
      }
      __syncthreads();
    }
  }
  {
    auto conv_src = [&](int j, const float*& src, int& ld, int& k0, int& n0) {
      const int e = j / 96, r = j % 96;
      if (r < 64) { const int kt = r >> 2, ct = r & 3, up = ct >> 1; src = (up ? uin(p, I_EWU) : uin(p, I_EWG)) + (size_t)(l * 32 + e) * 1024 * 512; ld = 512; k0 = kt * 64; n0 = (ct & 1) * 256; }
      else { const int r2 = r - 64, kt = r2 >> 2, ntl = r2 & 3; src = uin(p, I_EWD) + (size_t)(l * 32 + e) * 512 * 1024; ld = 1024; k0 = kt * 64; n0 = ntl * 256; }
    };
    const int G = gridDim.x;
    int j = bid_();
    TrRegs cur, nxt;
    const float* src; int ld, k0, n0;
    if (j < N_CONV) { conv_src(j, src, ld, k0, n0); transpose_load(cur, src, ld, k0, n0); }
    while (j < N_CONV) {
      int jn;
      if (j < 8 * G) { jn = j + G; if (jn >= 8 * G) jn = (bid_() >= nmt) ? (8 * G + bid_() - nmt) : N_CONV; }
      else jn = j + (G - nmt);
      if (jn < N_CONV) { const float* s2; int ld2, k2, n2; conv_src(jn, s2, ld2, k2, n2); transpose_load(nxt, s2, ld2, k2, n2); }
      const int e = j / 96, r = j % 96;
      if (r < 64) {
        const int kt = r >> 2, ct = r & 3, up = ct >> 1;
        transpose_finish(smem, cur, kt * 64, (ct & 1) * 256, EW1 + (size_t)e * 1024 * 1024, 1024,
          [&](int c) { return 256 * (c >> 7) + 128 * ((c >> 6) & 1) + 32 * ((c >> 4) & 3) + 16 * up + (c & 15); });
      } else {
        const int r2 = r - 64, kt = r2 >> 2, ntl = r2 & 3;
        transpose_finish(smem, cur, kt * 64, ntl * 256, EW2 + (size_t)e * 1024 * 512, 512, [](int n) { return n; });
      }
      cur = nxt; j = jn;
    }
  }
}

DEVI void moe_prefix(const Params& p, int l, int* sPre, int* sCnt) {
  const int* CNT = (const int*)(uws(p) + WS_CTL) + l * 32;
  if (tid_() == 0) {
    int s = 0;
    for (int e = 0; e < 32; ++e) { const int c = CNT[e]; sCnt[e] = c; sPre[e] = s; s += (c + 255) >> 8; }
    sPre[32] = s;
  }
  __syncthreads();
  {
    unsigned char* sBlkE = (unsigned char*)sPre + (MISC_BLKE - MISC_PRE);
    const int nb = sPre[32];
    for (int rb = tid_(); rb < nb; rb += NTHREADS) { int e = 0; for (int q = 1; q < 32; ++q) if (sPre[q] <= rb) e = q; sBlkE[rb] = (unsigned char)e; }
  }
  __syncthreads();
}

struct MoeSched {
  const int* sPre; const int* sCnt; const unsigned char* sBlkE; const bf16_t* Abase; const int* LIST; const bf16_t* Wbase; int K; size_t wstride; int nN, G, c, gather;
  DEVI bool next(int i, g8::Unit& u) const {
    const int nwg = sPre[32] * nN; const long L = (long)i * G + c; if (L >= nwg) return false;
    const int w = g8::xcd_remap((int)L, nwg);
    u.pm = w / nN; u.pn = w % nN;
    u.e = sBlkE[u.pm]; return true;
  }
  DEVI const char* a_base() const { return (const char*)Abase; }
  DEVI void a_offs(const g8::Unit& u, int tid, unsigned (&ao)[2][2]) const {
#pragma unroll
    for (int i = 0; i < 2; ++i) {
      int R, C; g8::stage_rc(tid * 16 + i * 8192, R, C);
#pragma unroll
      for (int h = 0; h < 2; ++h) {
        int row = u.pm * 256 + h * 128 + R;
        if (gather) {
          const int sl = (u.pm - sPre[u.e]) * 256 + h * 128 + R;
          row = LIST[(size_t)u.e * NT + (sl < sCnt[u.e] ? sl : 0)];
        }
        ao[h][i] = ((unsigned)row * (unsigned)K + (unsigned)C) * 2u;
      }
    }
  }
  DEVI const char* b_ptr(const g8::Unit& u) const { return (const char*)(Wbase + (size_t)u.e * wstride + (size_t)u.pn * 256 * K); }
};
struct EpiMoe1 {
  static constexpr bool PERM = false;
  bf16_t* ACT;
  DEVI void operator()(const f32x4 (&acc)[2][2][4][2], const g8::Unit& u) const {
    const int tid = tid_(), wid = __builtin_amdgcn_readfirstlane(tid >> 6), lane = tid & 63, wr = wid >> 2, wc = wid & 3, fr = lane & 15, fq = lane >> 4;
#pragma unroll
    for (int ai = 0; ai < 2; ++ai)
#pragma unroll
      for (int m = 0; m < 4; ++m) {
        const size_t slot = (size_t)u.pm * 256 + ai * 128 + wr * 64 + m * 16 + fr;
#pragma unroll
        for (int bj = 0; bj < 2; ++bj) {
          const f32x4 g = acc[ai][bj][m][0], up = acc[ai][bj][m][1];
          float o[4];
#pragma unroll
          for (int j = 0; j < 4; ++j) o[j] = g[j] * __builtin_amdgcn_rcpf(1.f + __expf(-g[j])) * up[j];
          uint2 w; w.x = pack2(o[0], o[1]); w.y = pack2(o[2], o[3]);
          *(uint2*)(ACT + slot * 512 + u.pn * 128 + bj * 64 + wc * 16 + 4 * fq) = w;
        }
      }
  }
};
DEVI void phase_moe1(const Params& p, int l, unsigned char* smem) {
  unsigned char* ws = uws(p);
  int* sPre = (int*)(smem + SMEM_BYTES + MISC_PRE); int* sCnt = (int*)(smem + SMEM_BYTES + MISC_CNT);
  moe_prefix(p, l, sPre, sCnt);
  MoeSched S{sPre, sCnt, (const unsigned char*)(smem + SMEM_BYTES + MISC_BLKE), (const bf16_t*)(ws + WS_H), (const int*)(ws + WS_LIST), (const bf16_t*)(ws + WS_EW), D, (size_t)1024 * 1024, 4, (int)gridDim.x, bid_(), 1};
  EpiMoe1 E{(bf16_t*)(ws + WS_ACT)};
  g8::gemm((G8_LAS unsigned char*)smem, D, S, E);
  __syncthreads();
}
DEVI void phase_moe2(const Params& p, int l, unsigned char* smem) {
  unsigned char* ws = uws(p);
  int* sPre = (int*)(smem + SMEM_BYTES + MISC_PRE); int* sCnt = (int*)(smem + SMEM_BYTES + MISC_CNT);
  moe_prefix(p, l, sPre, sCnt);
  MoeSched S{sPre, sCnt, (const unsigned char*)(smem + SMEM_BYTES + MISC_BLKE), (const bf16_t*)(ws + WS_ACT), (const int*)(ws + WS_LIST), (const bf16_t*)(ws + WS_EW) + (size_t)32 * 1024 * 1024, 512, (size_t)1024 * 512, 4, (int)gridDim.x, bid_(), 0};
  EpiBf16 E{(bf16_t*)(ws + WS_YROWS), D};
  g8::gemm((G8_LAS unsigned char*)smem, 512, S, E);
  __syncthreads();
}

DEVI void phase_ln2(const Params& p, int l, unsigned char* smem) {
  unsigned char* ws = uws(p);
  int* sPre = (int*)(smem + SMEM_BYTES + MISC_PRE); int* sCnt = (int*)(smem + SMEM_BYTES + MISC_CNT);
  moe_prefix(p, l, sPre, sCnt);
  const int tid = tid_(), lane = tid & 63, wid = tid >> 6;
  _Float16* X = (_Float16*)(ws + WS_X);
  const bf16_t* YR = (const bf16_t*)(ws + WS_YROWS);
  const int4* ROUTE = (const int4*)(ws + WS_ROUTE);
  const float2* RWT = (const float2*)(ws + WS_RWT);
  const float* MOD = (const float*)(ws + WS_MOD);
  const float* g2 = uin(p, I_LN2G) + l * D; const float* b2 = uin(p, I_LN2B) + l * D;
  bf16_t* XM = (bf16_t*)((unsigned char*)uout(p) + DO_XMOD);
  const int nrows = (l == 0) ? NT : NLAT;
  const int nw = gridDim.x * 8, gw = bid_() * 8 + wid;
  const int rpw = (nrows + nw - 1) / nw;
  const int R0 = gw * rpw, R1 = (R0 + rpw < nrows) ? (R0 + rpw) : nrows;
  const int c0 = lane * 8, c1 = 512 + lane * 8;
  float g[2][8], bb[2][8], gt[2][8], sh1n[2][8], sc1n[2][8];
  ld8f(g2 + c0, g[0]); ld8f(g2 + c1, g[1]); ld8f(b2 + c0, bb[0]); ld8f(b2 + c1, bb[1]);
  int curb = -1;
  float xv[2][8], ua[2][8], ub[2][8]; float2 rw = make_float2(0.f, 0.f);
  int4 rt_n = make_int4(0, 0, 0, 0); float2 rw_n = make_float2(0.f, 0.f);
  auto load_data = [&](int Rr, const int4& rt, float (&xo)[2][8], float (&ao)[2][8], float (&bo)[2][8]) {
    const bf16_t* ya = YR + ((size_t)sPre[rt.x] * 256 + rt.y) * 1024; const bf16_t* yb = YR + ((size_t)sPre[rt.z] * 256 + rt.w) * 1024;
    const _Float16* xr = X + (size_t)Rr * D;
    ld8h(xr + c0, xo[0]); ld8h(xr + c1, xo[1]); ld8b(ya + c0, ao[0]); ld8b(ya + c1, ao[1]); ld8b(yb + c0, bo[0]); ld8b(yb + c1, bo[1]);
  };
  if (R0 < R1) { const int4 rt0 = ROUTE[R0]; rw = RWT[R0]; load_data(R0, rt0, xv, ua, ub); }
  if (R0 + 1 < R1) { rt_n = ROUTE[R0 + 1]; rw_n = RWT[R0 + 1]; }
  for (int R = R0; R < R1; ++R) {
    float xn[2][8], an[2][8], bn[2][8];
#pragma unroll
    for (int h = 0; h < 2; ++h)
#pragma unroll
      for (int e = 0; e < 8; ++e) { xn[h][e] = 0.f; an[h][e] = 0.f; bn[h][e] = 0.f; }
    if (R + 1 < R1) load_data(R + 1, rt_n, xn, an, bn);
    const float2 rw_next = rw_n;
    if (R + 2 < R1) { rt_n = ROUTE[R + 2]; rw_n = RWT[R + 2]; }
    const int bi = bidx_of(R);
    if (bi != curb) {
      curb = bi;
      const float* modl = MOD + (size_t)(l * 17 + bi) * 6144;
      ld8f(modl + 5120 + c0, gt[0]); ld8f(modl + 5120 + c1, gt[1]);
      if (l == 0) {
        const float* modn = MOD + (size_t)(1 * 17 + bi) * 6144;
        ld8f(modn + c0, sh1n[0]); ld8f(modn + c1, sh1n[1]); ld8f(modn + 1024 + c0, sc1n[0]); ld8f(modn + 1024 + c1, sc1n[1]);
      }
    }
    float v[2][8]; float s = 0.f;
#pragma unroll
    for (int h = 0; h < 2; ++h)
#pragma unroll
      for (int e = 0; e < 8; ++e) { v[h][e] = ALPHA * xv[h][e] + gt[h][e] * (rw.x * ua[h][e] + rw.y * ub[h][e]); s += v[h][e]; }
    const float mu = wave_sum(s) * (1.f / 1024.f);
    float q = 0.f;
#pragma unroll
    for (int h = 0; h < 2; ++h)
#pragma unroll
      for (int e = 0; e < 8; ++e) { v[h][e] -= mu; q += v[h][e] * v[h][e]; }
    const float rstd = rsqrtf(wave_sum(q) * (1.f / 1024.f) + LN_EPS);
#pragma unroll
    for (int h = 0; h < 2; ++h) {
      float x2[8];
#pragma unroll
      for (int e = 0; e < 8; ++e) x2[e] = v[h][e] * rstd * g[h][e] + bb[h][e];
      const int cc = h ? c1 : c0;
      if (l == 0) {
        st8h(X + (size_t)R * D + cc, x2);
        float xm[8];
#pragma unroll
        for (int e = 0; e < 8; ++e) xm[e] = x2[e] * (1.f + sc1n[h][e]) + sh1n[h][e];
        st8b(XM + (size_t)R * D + cc, xm);
      } else {
        st8f(uout(p) + (size_t)R * D + cc, x2);
      }
    }
#pragma unroll
    for (int h = 0; h < 2; ++h)
#pragma unroll
      for (int e = 0; e < 8; ++e) { xv[h][e] = xn[h][e]; ua[h][e] = an[h][e]; ub[h][e] = bn[h][e]; }
    rw = rw_next;
  }
}

#define XB_TMO      128
#define XB_XCNT(j)  (256  + 64 * (j))
#define XB_XSUB(j)  (1280 + 64 * (j))
#define XB_XGEN(j)  (2304 + 64 * (j))
#define XB_TOP      3328
#define XB_TOPGEN   3392
#define XCD_BAR_WORDS 3456
#define XB_SPIN_CAP (1u << 20)
DEVI unsigned xb_ld(unsigned* p) { return __hip_atomic_load(p, __ATOMIC_RELAXED, __HIP_MEMORY_SCOPE_AGENT); }
DEVI unsigned xb_add(unsigned* p, unsigned v) { return __hip_atomic_fetch_add(p, v, __ATOMIC_RELAXED, __HIP_MEMORY_SCOPE_AGENT); }
DEVI unsigned xb_xcc_id() { return (unsigned)__builtin_amdgcn_s_getreg((3 << 11) | 20) & 0xFu; }
#define XB_SPIN(cond, bar) do { unsigned _sp = 0; while (cond) { __builtin_amdgcn_s_sleep(1); \
    if ((++_sp & 255u) == 0u) { if (xb_ld(&(bar)[XB_TMO])) break; if (_sp > XB_SPIN_CAP) { atomicAdd(&(bar)[XB_TMO], 1u); break; } } } } while (0)
DEVI void xcd_barrier_complete(unsigned* bar, unsigned x, unsigned& nloc, unsigned& nx) {
  const unsigned G = gridDim.x;
  unsigned sum, cnt, mine, sp = 0u;
  for (;;) {
    sum = 0u; cnt = 0u; mine = 0u;
#pragma unroll
    for (unsigned j = 0; j < 16; ++j) { const unsigned c = xb_ld(&bar[XB_XCNT(j)]); sum += c; cnt += (c > 0u) ? 1u : 0u; mine = (j == x) ? c : mine; }
    if (sum == G) break;
    __builtin_amdgcn_s_sleep(1);
    if ((++sp & 255u) == 0u) { if (xb_ld(&bar[XB_TMO])) break; if (sp > XB_SPIN_CAP) { atomicAdd(&bar[XB_TMO], 1u); break; } }
  }
  nloc = mine > 0u ? mine : 1u; nx = cnt > 0u ? cnt : 1u;
}
DEVI void xcd_barrier(unsigned* bar, volatile unsigned* st) {
  asm volatile("s_waitcnt vmcnt(0)" ::: "memory");
  __syncthreads();
  if (threadIdx.x == 0) {
    __builtin_amdgcn_s_waitcnt(0);
    const unsigned x = xb_xcc_id();
    unsigned nloc = st[0], nx = st[1];
    if (nloc == 0u) { xcd_barrier_complete(bar, x, nloc, nx); st[0] = nloc; st[1] = nx; }
    const unsigned old = xb_add(&bar[XB_XSUB(x)], 1u);
    const unsigned gen = old / nloc;
    if (old + 1u == (gen + 1u) * nloc) {
      __builtin_amdgcn_fence(__ATOMIC_RELEASE, "agent");
      asm volatile("s_waitcnt vmcnt(0)" ::: "memory");
      const unsigned og = xb_add(&bar[XB_TOP], 1u);
      const unsigned tg = og / nx;
      if (og + 1u == (tg + 1u) * nx) xb_add(&bar[XB_TOPGEN], 1u);
      else XB_SPIN(xb_ld(&bar[XB_TOPGEN]) == tg, bar);
      __builtin_amdgcn_fence(__ATOMIC_ACQUIRE, "agent");
      xb_add(&bar[XB_XGEN(x)], 1u);
      asm volatile("s_waitcnt vmcnt(0)" ::: "memory");
    } else {
      XB_SPIN(xb_ld(&bar[XB_XGEN(x)]) == gen, bar);
      __builtin_amdgcn_fence(__ATOMIC_ACQUIRE, "agent");
      asm volatile("s_waitcnt vmcnt(0)" ::: "memory");
    }
  }
  __syncthreads();
}

constexpr int N_PHASES = 24;
DEVI void run_phase(const Params& p, int ph, unsigned char* smem) {
  if (ph == 0) { phase0a(p, smem); return; }
  if (ph == 1) { phase0b(p, smem); return; }
  const int l = (ph - 2) / 11, s = (ph - 2) % 11;
  switch (s) {
    case 0: phase_inproj(p, l, smem); break;
    case 1: phase_feat(p, l, smem); break;
    case 2: phase_mixers(p, l, smem); break;
    case 3: phase_mixfin(p, l, smem); break;
    case 4: phase_glu(p, l, smem); break;
    case 5: phase_outproj(p, l, smem); break;
    case 6: phase_ln1(p, l, smem); break;
    case 7: phase_router(p, l, smem); break;
    case 8: phase_moe1(p, l, smem); break;
    case 9: phase_moe2(p, l, smem); break;
    default: phase_ln2(p, l, smem); break;
  }
}

__global__ void __launch_bounds__(NTHREADS, 2) fwd_megakernel(Params pk) {
  extern __shared__ __attribute__((aligned(16))) unsigned char smem[];
  Params* spp = (Params*)(smem + SMEM_BYTES + MISC_PARAMS);
  if (threadIdx.x == 0) { *spp = pk; ((volatile unsigned*)(smem + SMEM_BYTES + MISC_XB))[0] = 0u; ((volatile unsigned*)(smem + SMEM_BYTES + MISC_XB))[1] = 0u; }
  __syncthreads();
  const Params& p = *spp;
  const int ph_lo = __builtin_amdgcn_readfirstlane(p.ph_lo), ph_hi = __builtin_amdgcn_readfirstlane(p.ph_hi);
#if MK_MULTI
  for (int ph = ph_lo; ph < ph_hi; ++ph) run_phase(p, ph, smem);
#else
  cg::grid_group grid = cg::this_grid();
  if (threadIdx.x == 0) (void)xb_add(&((unsigned*)(uws(p) + WS_BAR))[XB_XCNT(xb_xcc_id())], 1u);
  for (int ph = ph_lo; ph < ph_hi; ++ph) {
    run_phase(p, ph, smem);
#ifdef DUP_MASK
    if ((DUP_MASK >> ph) & 1) { __syncthreads(); run_phase(p, ph, smem); }
#endif
    if (ph + 1 < ph_hi) {
      if (ph == ph_lo) grid.sync();
      else xcd_barrier((unsigned*)(uws(p) + WS_BAR), (volatile unsigned*)(smem + SMEM_BYTES + MISC_XB));
    }
  }
#endif
}

extern "C" void kernel_launch(void* const* d_in, const int* in_sizes, int n_in, void* d_out, int out_size,
                              void* d_ws, size_t ws_size, hipStream_t stream) {
  static int grid_blocks = 0;
  if (!grid_blocks) {
    int dev = 0, cus = 0, per_cu = 0;
    (void)hipGetDevice(&dev);
    (void)hipDeviceGetAttribute(&cus, hipDeviceAttributeMultiprocessorCount, dev);
    (void)hipFuncSetAttribute((const void*)fwd_megakernel, hipFuncAttributeMaxDynamicSharedMemorySize, DSM_BYTES);
    (void)hipOccupancyMaxActiveBlocksPerMultiprocessor(&per_cu, fwd_megakernel, NTHREADS, DSM_BYTES);
    if (per_cu > 1) per_cu = 1;
    grid_blocks = cus * per_cu;
    if (n_in != N_IN || out_size != NLAT * D || ws_size < WS_END) {
      fprintf(stderr, "kernel_launch: unexpected sizes n_in=%d out=%d ws=%zu (need %zu)\n", n_in, out_size, ws_size, (size_t)WS_END);
      grid_blocks = -1;
    }
    fprintf(stderr, "kernel_launch: grid=%d (cus=%d per_cu=%d) ws=%zu\n", grid_blocks, cus, per_cu, ws_size);
  }
  if (grid_blocks <= 0) return;
  Params p{};
  for (int i = 0; i < N_IN; ++i) p.in[i] = (const float*)d_in[i];
  p.out = (float*)d_out; p.ws = (unsigned char*)d_ws;
#if MK_MULTI
  for (int ph = 0; ph < N_PHASES; ++ph) {
    p.ph_lo = ph; p.ph_hi = ph + 1;
    hipLaunchKernelGGL(fwd_megakernel, dim3(grid_blocks), dim3(NTHREADS), DSM_BYTES, stream, p);
  }
#else
  p.ph_lo = 0; p.ph_hi = N_PHASES;
  (void)hipMemsetAsync((unsigned char*)d_ws + WS_BAR, 0, XCD_BAR_WORDS * 4, stream);
  void* args[] = {&p};
  hipError_t e = hipLaunchCooperativeKernel((void*)fwd_megakernel, dim3(grid_blocks), dim3(NTHREADS), args, DSM_BYTES, stream);
  if (e != hipSuccess) fprintf(stderr, "cooperative launch failed: %s (grid %d)\n", hipGetErrorString(e), grid_blocks);
#endif
}
```
